# Optimizing an MI355X kernel written in HIP

```python
import math
import jax, jax.numpy as jnp
from jax import lax
import numpy as np

D_MODEL = 1024
BATCH = 4
SEQ = 4096
DEPTH = 1

N_MEM = 256
D_MIX = D_MODEL
FOX_HEADS = 8
FOX_HEAD_DIM = 64
FOX_WIDTH = FOX_HEADS * FOX_HEAD_DIM
QUERY_BLOCK = 128
FOX_FORGET_BIAS = 3.0
MLSTM_HEADS = 4
MLSTM_QK_DIM = 64
MLSTM_V_DIM = 128
MLSTM_QK_WIDTH = MLSTM_HEADS * MLSTM_QK_DIM
MLSTM_V_WIDTH = MLSTM_HEADS * MLSTM_V_DIM
MLSTM_CHUNK = 64
MLSTM_FORGET_BIAS = 3.0
CONV_WIDTH = 4
IN_WIDTHS = (FOX_WIDTH, FOX_WIDTH, FOX_WIDTH, FOX_HEADS,
             2 * MLSTM_QK_WIDTH, MLSTM_V_WIDTH, MLSTM_HEADS, MLSTM_HEADS, MLSTM_V_WIDTH)
IN_WIDTH = 3088
XATTN_HEADS = 4
XATTN_HEAD_DIM = D_MODEL // XATTN_HEADS
N_EXPERTS = 32
TOP_K = 4
D_EXPERT = D_MODEL
SWIGLU_LIMIT = 7.0
SWIGLU_ALPHA = 1.702
EXPERT_BLOCK = 256
DEEPNORM_ALPHA = (2 * DEPTH) ** 0.25
DEEPNORM_BETA = (8 * DEPTH) ** -0.25
LN_EPS = 1e-5
RMS_EPS = 1e-6

kernel_name = "fox_mlstm_hymba_deepnorm_moe"


def layer_norm(x, g, b):
    xf = x.astype(jnp.float32)
    mu = jnp.mean(xf, -1, keepdims=True)
    xc = xf - mu
    var = jnp.mean(xc * xc, -1, keepdims=True)
    return (xc * lax.rsqrt(var + LN_EPS) * g + b).astype(x.dtype)


def head_rmsnorm(h, gain):
    B, S = h.shape[0], h.shape[1]
    hf = h.astype(jnp.float32)
    hf = hf * lax.rsqrt(jnp.mean(hf * hf, -1, keepdims=True) + RMS_EPS)
    return hf.reshape(B, S, -1) * gain


def causal_conv(x, w):
    S = x.shape[1]
    xp = jnp.pad(x, ((0, 0), (CONV_WIDTH - 1, 0), (0, 0)))
    out = xp[:, 0:S] * w[0]
    for j in range(1, CONV_WIDTH):
        out = out + xp[:, j:j + S] * w[j]
    return out


def fox_attention(q, k, v, log_f):
    S = q.shape[2]
    c = jnp.cumsum(log_f, axis=-1)
    scale = FOX_HEAD_DIM ** -0.5
    outs = []
    for blk in range(S // QUERY_BLOCK):
        q0 = blk * QUERY_BLOCK
        q1 = q0 + QUERY_BLOCK
        s = jnp.einsum('bhqd,bhkd->bhqk', q[:, :, q0:q1], k[:, :, :q1]).astype(jnp.float32) * scale
        s = s + c[:, :, q0:q1, None] - c[:, :, None, :q1]
        causal = (q0 + jnp.arange(QUERY_BLOCK))[:, None] >= jnp.arange(q1)[None, :]
        p = jax.nn.softmax(jnp.where(causal, s, -jnp.inf), axis=-1)
        outs.append(jnp.einsum('bhqk,bhkd->bhqd', p.astype(v.dtype), v[:, :, :q1]))
    return jnp.concatenate(outs, axis=2)


def mlstm_chunkwise(q, k, v, i_pre, f_pre):
    B, H, S, Dk = q.shape
    Dv = v.shape[-1]
    L = MLSTM_CHUNK
    NC = S // L
    f32 = jnp.float32
    q = q.astype(f32).reshape(B, H, NC, L, Dk)
    k = (k.astype(f32) * Dk ** -0.5).reshape(B, H, NC, L, Dk)
    v = v.astype(f32).reshape(B, H, NC, L, Dv)
    log_i = i_pre.astype(f32).reshape(B, H, NC, L)
    log_f = jax.nn.log_sigmoid(f_pre.astype(f32)).reshape(B, H, NC, L)
    b = jnp.cumsum(log_f, axis=-1)
    g = b[..., -1]
    tri = jnp.tril(jnp.ones((L, L), dtype=bool))
    d = jnp.where(tri, b[..., :, None] - b[..., None, :] + log_i[..., None, :], -jnp.inf)
    a = g[..., None] - b + log_i
    m_loc = jnp.max(a, axis=-1)
    wa = jnp.exp(a - m_loc[..., None])
    kv_chunk = jnp.einsum('bhcl,bhcld,bhcle->bhcde', wa, k, v)
    n_chunk = jnp.einsum('bhcl,bhcld->bhcd', wa, k)

    def step(carry, inp):
        C, n, m = carry
        kv_c, n_c, g_c, m_c = inp
        m_new = jnp.maximum(g_c + m, m_c)
        decay = jnp.exp(g_c + m - m_new)
        scale_in = jnp.exp(m_c - m_new)
        C_new = decay[..., None, None] * C + scale_in[..., None, None] * kv_c
        n_new = decay[..., None] * n + scale_in[..., None] * n_c
        return (C_new, n_new, m_new), (C, n, m)

    init = (jnp.zeros((B, H, Dk, Dv), f32), jnp.zeros((B, H, Dk), f32), jnp.zeros((B, H), f32))
    xs = (jnp.moveaxis(kv_chunk, 2, 0), jnp.moveaxis(n_chunk, 2, 0),
          jnp.moveaxis(g, 2, 0), jnp.moveaxis(m_loc, 2, 0))
    _, (C_prev, n_prev, m_prev) = lax.scan(step, init, xs)
    C_prev = jnp.moveaxis(C_prev, 0, 2)
    n_prev = jnp.moveaxis(n_prev, 0, 2)
    m_prev = jnp.moveaxis(m_prev, 0, 2)

    inter_log = b + m_prev[..., None]
    m_t = jnp.maximum(inter_log, jnp.max(d, axis=-1))
    w_inter = jnp.exp(inter_log - m_t)
    p = jnp.exp(d - m_t[..., None]) * jnp.einsum('bhcld,bhcsd->bhcls', q, k)
    num = (w_inter[..., None] * jnp.einsum('bhcld,bhcde->bhcle', q, C_prev)
           + jnp.einsum('bhcls,bhcse->bhcle', p, v))
    den = w_inter * jnp.einsum('bhcld,bhcd->bhcl', q, n_prev) + jnp.sum(p, axis=-1)
    h = num / jnp.maximum(jnp.abs(den), jnp.exp(-m_t))[..., None]
    return h.reshape(B, H, S, Dv)


def hybrid_mixer(x, w_in, fox_f_bias, conv_w, i_bias, f_bias, fox_g, mlstm_g, w_out):
    B, S, _ = x.shape
    u = x @ w_in
    points = np.cumsum(IN_WIDTHS)[:-1].tolist()
    fq, fk, fv, ff, mqk, mv, mi, mf, mo = jnp.split(u, points, axis=-1)

    def heads(t, h):
        return t.reshape(B, S, h, -1).transpose(0, 2, 1, 3)

    log_f = jax.nn.log_sigmoid((ff + fox_f_bias).astype(jnp.float32)).transpose(0, 2, 1)
    fo = fox_attention(heads(fq, FOX_HEADS), heads(fk, FOX_HEADS), heads(fv, FOX_HEADS), log_f)
    fo = head_rmsnorm(fo.transpose(0, 2, 1, 3), fox_g)

    mqk = jax.nn.silu(causal_conv(mqk, conv_w))
    mq, mk = jnp.split(mqk, [MLSTM_QK_WIDTH], axis=-1)
    h = mlstm_chunkwise(heads(mq, MLSTM_HEADS), heads(mk, MLSTM_HEADS), heads(mv, MLSTM_HEADS),
                        (mi + i_bias).transpose(0, 2, 1), (mf + f_bias).transpose(0, 2, 1))
    mo_out = head_rmsnorm(h.transpose(0, 2, 1, 3), mlstm_g) * jax.nn.sigmoid(mo.astype(jnp.float32))

    mixed = jnp.concatenate([fo, mo_out], axis=-1).astype(x.dtype)
    return mixed @ w_out


def memory_cross_attention(x, mem, w_q, w_k, w_v, w_o):
    B, S, D = x.shape
    M = mem.shape[1]
    q = (x @ w_q).reshape(B, S, XATTN_HEADS, XATTN_HEAD_DIM)
    k = (mem @ w_k).reshape(B, M, XATTN_HEADS, XATTN_HEAD_DIM)
    v = (mem @ w_v).reshape(B, M, XATTN_HEADS, XATTN_HEAD_DIM)
    s = jnp.einsum('bqhd,bkhd->bhqk', q, k).astype(jnp.float32) * XATTN_HEAD_DIM ** -0.5
    p = jax.nn.softmax(s, axis=-1)
    o = jnp.einsum('bhqk,bkhd->bqhd', p.astype(v.dtype), v).reshape(B, S, D)
    return o @ w_o


def clamped_swiglu(h):
    gate, lin = h[..., :D_EXPERT], h[..., D_EXPERT:]
    gate = jnp.minimum(gate, SWIGLU_LIMIT)
    lin = jnp.clip(lin, -SWIGLU_LIMIT, SWIGLU_LIMIT)
    return gate * jax.nn.sigmoid(SWIGLU_ALPHA * gate) * (lin + 1)


def moe_ffn(x, w_router, b_router, w_gu, b_gu, w_down, b_down):
    B, S, D = x.shape
    N = B * S
    G = EXPERT_BLOCK
    xf = x.reshape(N, D)
    logits = (xf @ w_router + b_router).astype(jnp.float32)
    top_vals, top_idx = lax.top_k(logits, TOP_K)
    gates = jax.nn.softmax(top_vals, axis=-1)
    e_flat = top_idx.reshape(-1).astype(jnp.int32)
    tok_flat = jnp.repeat(jnp.arange(N, dtype=jnp.int32), TOP_K)
    g_flat = gates.reshape(-1)
    order = jnp.argsort(e_flat)
    e_sorted = e_flat[order]
    counts = jnp.bincount(e_flat, length=N_EXPERTS).astype(jnp.int32)
    padded = ((counts + G - 1) // G) * G
    start = jnp.cumsum(counts) - counts
    pad_end = jnp.cumsum(padded)
    pad_start = pad_end - padded
    rank = jnp.arange(N * TOP_K, dtype=jnp.int32) - start[e_sorted]
    dest = pad_start[e_sorted] + rank
    P = N * TOP_K + N_EXPERTS * G
    NB = P // G
    row_tok = jnp.full((P,), N, jnp.int32).at[dest].set(tok_flat[order])
    row_gate = jnp.zeros((P,), jnp.float32).at[dest].set(g_flat[order])
    blk_e = jnp.minimum(jnp.searchsorted(pad_end, jnp.arange(NB, dtype=jnp.int32) * G, side='right'),
                        N_EXPERTS - 1)
    x_pad = jnp.concatenate([xf, jnp.zeros((1, D), xf.dtype)], axis=0)
    xb = x_pad[row_tok].reshape(NB, G, D)

    def expert_block(args):
        xblk, e = args
        hid = clamped_swiglu(xblk @ w_gu[e] + b_gu[e])
        return hid @ w_down[e] + b_down[e]

    yb = lax.map(expert_block, (xb, blk_e)).reshape(P, D)
    y = jnp.zeros((N + 1, D), yb.dtype).at[row_tok].add(yb * row_gate[:, None].astype(yb.dtype))
    return y[:N].reshape(B, S, D)


def setup_inputs(seed: int = 0) -> dict:
    key = jax.random.key(seed)
    ks = iter(jax.random.split(key, 32))
    L, D, E, F = DEPTH, D_MODEL, N_EXPERTS, D_EXPERT

    def nrm(shape, scale):
        return jax.random.normal(next(ks), shape, jnp.float32) * scale

    return {
        "x": nrm((BATCH, SEQ, D), 1.0),
        "mem": nrm((BATCH, N_MEM, D), 1.0),
        "w_in": nrm((L, D, IN_WIDTH), D ** -0.5),
        "fox_f_bias": FOX_FORGET_BIAS + nrm((L, FOX_HEADS), 0.1),
        "mlstm_conv_w": nrm((L, CONV_WIDTH, 2 * MLSTM_QK_WIDTH), CONV_WIDTH ** -0.5),
        "mlstm_i_bias": nrm((L, MLSTM_HEADS), 0.1),
        "mlstm_f_bias": MLSTM_FORGET_BIAS + nrm((L, MLSTM_HEADS), 0.1),
        "fox_norm_g": 1.0 + nrm((L, FOX_WIDTH), 0.02),
        "mlstm_norm_g": 1.0 + nrm((L, MLSTM_V_WIDTH), 0.02),
        "w_mix_out": nrm((L, D_MIX, D), D_MIX ** -0.5 * DEEPNORM_BETA),
        "ln1_g": 1.0 + nrm((L, D), 0.02),
        "ln1_b": nrm((L, D), 0.02),
        "w_xq": nrm((L, D, D), D ** -0.5),
        "w_xk": nrm((L, D, D), D ** -0.5),
        "w_xv": nrm((L, D, D), D ** -0.5),
        "w_xo": nrm((L, D, D), D ** -0.5 * DEEPNORM_BETA),
        "ln2_g": 1.0 + nrm((L, D), 0.02),
        "ln2_b": nrm((L, D), 0.02),
        "w_router": nrm((L, D, E), D ** -0.5),
        "b_router": nrm((L, E), 0.01),
        "w_gate_up": nrm((L, E, D, 2 * F), D ** -0.5),
        "b_gate_up": nrm((L, E, 2 * F), 0.02),
        "w_down": nrm((L, E, F, D), F ** -0.5 * DEEPNORM_BETA),
        "b_down": nrm((L, E, D), 0.02),
        "ln3_g": 1.0 + nrm((L, D), 0.02),
        "ln3_b": nrm((L, D), 0.02),
    }


def reference(x, mem, w_in, fox_f_bias, mlstm_conv_w, mlstm_i_bias, mlstm_f_bias, fox_norm_g,
              mlstm_norm_g, w_mix_out, ln1_g, ln1_b, w_xq, w_xk, w_xv, w_xo, ln2_g, ln2_b,
              w_router, b_router, w_gate_up, b_gate_up, w_down, b_down, ln3_g, ln3_b):
    for l in range(DEPTH):
        mix = hybrid_mixer(x, w_in[l], fox_f_bias[l], mlstm_conv_w[l], mlstm_i_bias[l],
                           mlstm_f_bias[l], fox_norm_g[l], mlstm_norm_g[l], w_mix_out[l])
        x = layer_norm(DEEPNORM_ALPHA * x + mix.astype(x.dtype), ln1_g[l], ln1_b[l])
        xa = memory_cross_attention(x, mem, w_xq[l], w_xk[l], w_xv[l], w_xo[l])
        x = layer_norm(DEEPNORM_ALPHA * x + xa.astype(x.dtype), ln2_g[l], ln2_b[l])
        ff = moe_ffn(x, w_router[l], b_router[l], w_gate_up[l], b_gate_up[l], w_down[l], b_down[l])
        x = layer_norm(DEEPNORM_ALPHA * x + ff.astype(x.dtype), ln3_g[l], ln3_b[l])
    return x
```

```cpp
#include <hip/hip_runtime.h>
#include <cstdio>
#include <cstdint>
#include <cmath>

#define DI __device__ __forceinline__
#define LAS __attribute__((address_space(3)))
#define GAS __attribute__((address_space(1)))
typedef unsigned short bf16;
typedef short bf16x8 __attribute__((ext_vector_type(8)));
typedef short s16x4 __attribute__((ext_vector_type(4)));
typedef float f32x2 __attribute__((ext_vector_type(2)));
typedef float f32x4 __attribute__((ext_vector_type(4)));
typedef float f32x16 __attribute__((ext_vector_type(16)));
typedef unsigned u32x2 __attribute__((ext_vector_type(2)));
typedef unsigned u32x4 __attribute__((ext_vector_type(4)));
typedef GAS unsigned gu32;

#ifndef MK_N_LAUNCHES
#define MK_N_LAUNCHES 1
#endif

constexpr int BATCH = 4, SEQ = 4096, D = 1024, M = BATCH * SEQ, NMEM = 256;
constexpr int NIN = 3088;
constexpr int NU = 3072;
constexpr int UC_FQ = 0, UC_FK = 512, UC_FV = 1024, UC_MQ = 1536, UC_MK = 1792, UC_MV = 2048, UC_MO = 2560;
constexpr int NE = 32, TOPK = 4, LCAP = 16384;
constexpr int PROWS = M * TOPK + NE * 256;
constexpr float ALPHA = 1.189207115002721f;
constexpr float LOG2E = 1.4426950408889634f;
constexpr float LN_EPS = 1e-5f, RMS_EPS = 1e-6f;
constexpr int NPHASE = 14;
constexpr int N_LAUNCHES = MK_N_LAUNCHES;

constexpr size_t MiB = 1u << 20;
constexpr size_t WS_CTL = 0, CTL_ZERO_BYTES = 1 * MiB;
constexpr size_t WS_G = 1 * MiB;
constexpr size_t WS_FC2 = 2 * MiB;
constexpr size_t WS_GC = 2 * MiB + 512 * 1024;
constexpr size_t WS_NC = 3 * MiB;
constexpr size_t WS_NP = 3 * MiB + 256 * 1024;
constexpr size_t WS_TIDX = 3 * MiB + 512 * 1024;
constexpr size_t WS_TGATE = 3 * MiB + 768 * 1024;
constexpr size_t WS_TSLOT = 4 * MiB;
constexpr size_t WS_LIST = 5 * MiB;
constexpr size_t WS_MEMKV = 8 * MiB;
constexpr size_t WS_WIN = 16 * MiB, WS_WOUT = 22 * MiB, WS_WXQ = 24 * MiB, WS_WXO = 26 * MiB;
constexpr size_t WS_WGU = 32 * MiB, WS_WDN = 160 * MiB;
constexpr size_t WS_XB = 224 * MiB;
constexpr size_t WS_U = 256 * MiB;
constexpr size_t WS_MQ = 352 * MiB, WS_MK = 360 * MiB;
constexpr size_t WS_KVT = 368 * MiB;
constexpr size_t WS_CPT = 400 * MiB;
constexpr size_t WS_MIX = 432 * MiB;
constexpr size_t WS_Y1 = 464 * MiB;
constexpr size_t WS_X1B = 528 * MiB;
constexpr size_t WS_QX = 560 * MiB;
constexpr size_t WS_Y2 = 596 * MiB;
constexpr size_t WS_X2B = 660 * MiB;
constexpr size_t WS_HID = 692 * MiB;
constexpr size_t WS_YB = 836 * MiB;
constexpr size_t WS_END = 980 * MiB;
constexpr int CW_TMO = 0, CW_CODE = 1;
constexpr int CW_CNT = 1024;
constexpr int CW_BAR = 4096;

constexpr int RING_BYTES = 131072;
constexpr int LDSCTL_OFF = RING_BYTES, MISC_OFF = LDSCTL_OFF + 320;
constexpr int MOE_TB_OFF = LDSCTL_OFF + 1024;
constexpr int RT_OFF = LDSCTL_OFF + 2048;
constexpr int LDS_BYTES = 147456;
constexpr int NWAVES = 8;

#define RLX_AGENT __ATOMIC_RELAXED, __HIP_MEMORY_SCOPE_AGENT
DI float bf_lo(unsigned u) { return __uint_as_float(u << 16); }
DI float bf_hi(unsigned u) { return __uint_as_float(u & 0xffff0000u); }
DI float bf2f(short s) { return __uint_as_float(((unsigned)(unsigned short)s) << 16); }
typedef __bf16 bf16x2_t __attribute__((ext_vector_type(2)));
DI unsigned pk2(float lo, float hi) { f32x2 v = {lo, hi}; bf16x2_t b = __builtin_convertvector(v, bf16x2_t); return __builtin_bit_cast(unsigned, b); }
DI float wave_sum(float v) {
#pragma unroll
    for (int o = 1; o < 64; o <<= 1) v += __shfl_xor(v, o);
    return v;
}
DI float wave_max(float v) {
#pragma unroll
    for (int o = 1; o < 64; o <<= 1) v = fmaxf(v, __shfl_xor(v, o));
    return v;
}
DI float wave_scan_add(float v, int lane) {
#pragma unroll
    for (int o = 1; o < 64; o <<= 1) { const float t = __shfl_up(v, o); if (lane >= o) v += t; }
    return v;
}
DI float wave_scan_max(float v, int lane) {
#pragma unroll
    for (int o = 1; o < 64; o <<= 1) { const float t = __shfl_up(v, o); if (lane >= o) v = fmaxf(v, t); }
    return v;
}
DI float xhalf_sum(float v) { return v + __shfl_xor(v, 32); }
DI float xhalf_max(float v) { return fmaxf(v, __shfl_xor(v, 32)); }
DI float ex2(float x) { return __builtin_amdgcn_exp2f(x); }
DI float exp_fast(float x) { return __builtin_amdgcn_exp2f(x * LOG2E); }
DI float sigmoid_fast(float x) { return __builtin_amdgcn_rcpf(1.f + exp_fast(-x)); }
DI float log_sigmoid_acc(float x) { return fminf(x, 0.f) - log1pf(expf(-fabsf(x))); }
DI f32x16 mfma32(bf16x8 a, bf16x8 b, f32x16 c) { return __builtin_amdgcn_mfma_f32_32x32x16_bf16(a, b, c, 0, 0, 0); }
DI f32x4 mfma16(bf16x8 a, bf16x8 b, f32x4 c) { return __builtin_amdgcn_mfma_f32_16x16x32_bf16(a, b, c, 0, 0, 0); }
typedef short v4i16_t __attribute__((ext_vector_type(4)));
DI s16x4 tr_read(const LAS unsigned char* p) { return __builtin_bit_cast(s16x4, __builtin_amdgcn_ds_read_tr16_b64_v4i16((LAS v4i16_t*)p)); }
DI bf16x8 cat8(s16x4 lo, s16x4 hi) { return __builtin_shufflevector(lo, hi, 0, 1, 2, 3, 4, 5, 6, 7); }
DI int crow(int r, int hi) { return (r & 3) + 8 * (r >> 2) + 4 * hi; }
DI bf16x8 pack8(const f32x16& x, int s) {
    u32x4 p;
    p.x = pk2(x[8 * s + 0], x[8 * s + 1]); p.y = pk2(x[8 * s + 2], x[8 * s + 3]); p.z = pk2(x[8 * s + 4], x[8 * s + 5]); p.w = pk2(x[8 * s + 6], x[8 * s + 7]);
    return __builtin_bit_cast(bf16x8, p);
}

namespace pg8 {
constexpr int BM = 256, BK = 64, HALF = 128, HTB = HALF * BK * 2, STAGE_BYTES = 8 * HTB, NXCD = 8, WGM = 8;
__host__ __device__ __forceinline__ int lds_byte(int r, int c) { const int st = (r >> 4) * 2 + (c >> 5), rr = r & 15, cc = c & 31, ob = rr * 64 + cc * 2; return st * 1024 + (ob ^ (((ob >> 9) & 1) << 5)); }
__host__ __device__ __forceinline__ void stage_rc(int b, int& R, int& C) { const int st = b / 1024, sb = b % 1024, swz = sb ^ (((sb >> 9) & 1) << 5); R = (st >> 1) * 16 + swz / 64; C = (st & 1) * 32 + (swz % 64) / 2; }
__host__ __device__ __forceinline__ int perm32(int rho) { const int n = rho >> 4, i = rho & 15; return 8 * (i >> 2) + 4 * n + (i & 3); }

struct Unit { int pm, pn, e, nvalid; const char* A; const char* B; const int* list; };

struct StaticSched {
    const char* A; const char* B; int K, nM, nN, nwg, G, c;
    DI void init(const void* A_, const void* B_, int M_, int N_, int K_, int G_, int c_) { A = (const char*)A_; B = (const char*)B_; K = K_; nM = M_ / BM; nN = N_ / BM; nwg = nM * nN; G = G_; c = c_; }
    DI bool next(int i, Unit& u) const {
        const long L = (long)i * G + c; if (L >= nwg) return false;
        int wgid = (int)L; { const int q = nwg / NXCD, r = nwg % NXCD, xcd = wgid % NXCD, off = wgid / NXCD; wgid = (xcd < r ? xcd * (q + 1) : r * (q + 1) + (xcd - r) * q) + off; }
        const int nig = WGM * nN, gid = wgid / nig, fm = gid * WGM, gsz = (nM - fm) < WGM ? (nM - fm) : WGM;
        u.pm = fm + ((wgid % nig) % gsz); u.pn = (wgid % nig) / gsz; u.e = 0; u.nvalid = BM; u.list = nullptr;
        u.A = A + (size_t)u.pm * BM * K * 2; u.B = B + (size_t)u.pn * BM * K * 2; return true;
    }
};
struct MoeSched {
    const char* A; const char* B; const int* list; const LAS int* tb; int K, NT, nwg, G, c; size_t bexp; bool gather;
    DI bool next(int i, Unit& u) const {
        const long L = (long)i * G + c; if (L >= nwg) return false;
        int wgid = (int)L; { const int q = nwg / NXCD, r = nwg % NXCD, xcd = wgid % NXCD, off = wgid / NXCD; wgid = (xcd < r ? xcd * (q + 1) : r * (q + 1) + (xcd - r) * q) + off; }
        const int g = wgid / NT, nt = wgid % NT;
        int e = 0;
#pragma unroll
        for (int j = 1; j < 32; ++j) e += (tb[j] <= g) ? 1 : 0;
        const int mt = g - tb[e];
        u.pm = g; u.pn = nt; u.e = e; u.nvalid = tb[40 + e] - mt * BM; u.list = list + (size_t)e * LCAP + mt * BM;
        u.A = gather ? A : A + (size_t)g * BM * K * 2; u.B = B + (size_t)e * bexp + (size_t)nt * BM * K * 2; return true;
    }
};

template <bool GATHER> DI void a_offsets(const Unit& u, int K, const int (&R)[2], const int (&C)[2], unsigned (&v)[2][2]) {
#pragma unroll
    for (int h = 0; h < 2; ++h)
#pragma unroll
        for (int i = 0; i < 2; ++i) {
            const int row = h * HALF + R[i];
            if constexpr (GATHER) { const int rc = row < u.nvalid ? row : u.nvalid - 1; const int tok = u.list[rc]; v[h][i] = (unsigned)(tok * K + C[i]) * 2u; }
            else v[h][i] = (unsigned)(row * K + C[i]) * 2u;
        }
}

struct EpiBf16 {
    static constexpr bool PERM = true;
    bf16* O; int ldc; const float* bias; int bias_estride;
    DI void operator()(const f32x4 (&acc)[2][2][4][2], const Unit& u, int wr, int wc, int fr, int fq) const {
        const int row0 = u.pm * BM + wr * 64 + fr; const int col0 = u.pn * BM + wc * 32 + 8 * fq;
        f32x4 bv[2][2];
#pragma unroll
        for (int bj = 0; bj < 2; ++bj)
#pragma unroll
            for (int n = 0; n < 2; ++n) bv[bj][n] = bias ? *(const f32x4*)(bias + (size_t)u.e * bias_estride + col0 + bj * HALF + 4 * n) : (f32x4){0.f, 0.f, 0.f, 0.f};
#pragma unroll
        for (int ai = 0; ai < 2; ++ai)
#pragma unroll
            for (int m = 0; m < 4; ++m) { bf16* rowp = O + (size_t)(row0 + ai * HALF + m * 16) * ldc + col0;
#pragma unroll
                for (int bj = 0; bj < 2; ++bj) { const f32x4 v0 = acc[ai][bj][m][0] + bv[bj][0], v1 = acc[ai][bj][m][1] + bv[bj][1];
                    u32x4 w; w.x = pk2(v0[0], v0[1]); w.y = pk2(v0[2], v0[3]); w.z = pk2(v1[0], v1[1]); w.w = pk2(v1[2], v1[3]);
                    *(u32x4*)(rowp + bj * HALF) = w; } }
    }
};
struct EpiResF32 {
    static constexpr bool PERM = false;
    const float* base; float* out; int ldc; float alpha;
    DI void operator()(const f32x4 (&acc)[2][2][4][2], const Unit& u, int wr, int wc, int fr, int fq) const {
        const int col0 = u.pn * BM + wc * 32 + 4 * fq;
#pragma unroll
        for (int ai = 0; ai < 2; ++ai)
#pragma unroll
            for (int m = 0; m < 4; ++m) { const size_t off = (size_t)(u.pm * BM + ai * HALF + wr * 64 + m * 16 + fr) * ldc + col0;
#pragma unroll
                for (int bj = 0; bj < 2; ++bj)
#pragma unroll
                    for (int n = 0; n < 2; ++n) { const f32x4 bs = *(const f32x4*)(base + off + bj * HALF + n * 16); *(f32x4*)(out + off + bj * HALF + n * 16) = bs * alpha + acc[ai][bj][m][n]; } }
    }
};
struct EpiSwiglu {
    static constexpr bool PERM = true;
    bf16* O; const float* bias;
    DI void operator()(const f32x4 (&acc)[2][2][4][2], const Unit& u, int wr, int wc, int fr, int fq) const {
        const int row0 = u.pm * BM + wr * 64 + fr; const int j0 = wc * 32 + 8 * fq; const int col0 = u.pn * HALF + j0;
        const float* bg = bias + (size_t)u.e * 2048 + col0; const float* bl = bg + 1024;
        f32x4 bgv[2], blv[2];
#pragma unroll
        for (int n = 0; n < 2; ++n) { bgv[n] = *(const f32x4*)(bg + 4 * n); blv[n] = *(const f32x4*)(bl + 4 * n); }
#pragma unroll
        for (int ai = 0; ai < 2; ++ai)
#pragma unroll
            for (int m = 0; m < 4; ++m) { bf16* rowp = O + (size_t)(row0 + ai * HALF + m * 16) * 1024 + col0;
                float o[8];
#pragma unroll
                for (int n = 0; n < 2; ++n) { const f32x4 g = acc[ai][0][m][n] + bgv[n], l = acc[ai][1][m][n] + blv[n];
#pragma unroll
                    for (int q = 0; q < 4; ++q) { const float gg = fminf(g[q], 7.0f), ll = fminf(fmaxf(l[q], -7.0f), 7.0f);
                        o[4 * n + q] = gg * __builtin_amdgcn_rcpf(1.f + ex2(gg * (-1.702f * LOG2E))) * (ll + 1.f); } }
                u32x4 w; w.x = pk2(o[0], o[1]); w.y = pk2(o[2], o[3]); w.z = pk2(o[4], o[5]); w.w = pk2(o[6], o[7]);
                *(u32x4*)rowp = w; }
    }
};

template <class Epi, class Sched, bool GATHER, bool ALIGN_EPI>
DI void gemm_phase(LAS unsigned char* lds, const int K, const Sched& S, const Epi& E) {
    const int tid = threadIdx.x, wid = __builtin_amdgcn_readfirstlane(tid >> 6), lane = tid & 63, wr = wid >> 2, wc = wid & 3, fr = lane & 15, fq = lane >> 4;
    const int nt = K / BK;
    int Rr[2], Cc[2]; unsigned voffB[2];
#pragma unroll
    for (int i = 0; i < 2; ++i) { int R, C; stage_rc(tid * 16 + i * 8192, R, C); const int Rb = Epi::PERM ? ((R & ~31) + perm32(R & 31)) : R; Rr[i] = R; Cc[i] = C; voffB[i] = (unsigned)(Rb * K + C) * 2u; }
    const size_t kstep = (size_t)(BK * 2);
    const size_t hstep = (size_t)HALF * K * 2;
    const unsigned ldsw = (unsigned)wid * 1024u;
    const int aoff = lds_byte(wr * 64 + fr, fq * 8), boff = lds_byte(wc * 32 + fr, fq * 8);
#define PG8_SA(b, h) (((b) * 2 + (h)) * HTB)
#define PG8_SB(b, h) ((4 + (b) * 2 + (h)) * HTB)
#define PG8_STAGE(bufoff, gbase, voff) do { _Pragma("unroll") for (int _i = 0; _i < 2; ++_i) \
        __builtin_amdgcn_global_load_lds((const unsigned*)((const char*)(gbase) + (voff)[_i]), (LAS unsigned*)(lds + (bufoff) + ldsw + _i * 8192), 16, 0, 0); } while (0)
#define PG8_LDA(dst, b, h) do { _Pragma("unroll") for (int m = 0; m < 4; ++m) _Pragma("unroll") for (int k = 0; k < 2; ++k) dst[m][k] = *(const LAS bf16x8*)(lds + PG8_SA(b, h) + aoff + m * 2048 + k * 1024); } while (0)
#define PG8_LDB(dst, b, h) do { _Pragma("unroll") for (int n = 0; n < 2; ++n) _Pragma("unroll") for (int k = 0; k < 2; ++k) dst[n][k] = *(const LAS bf16x8*)(lds + PG8_SB(b, h) + boff + n * 2048 + k * 1024); } while (0)
#define PG8_MMA(ai, bj, At, Bt) do { __builtin_amdgcn_s_setprio(1); _Pragma("unroll") for (int m = 0; m < 4; ++m) _Pragma("unroll") for (int n = 0; n < 2; ++n) _Pragma("unroll") for (int k = 0; k < 2; ++k) \
        acc[ai][bj][m][n] = __builtin_amdgcn_mfma_f32_16x16x32_bf16(Bt[n][k], At[m][k], acc[ai][bj][m][n], 0, 0, 0); __builtin_amdgcn_s_setprio(0); } while (0)
#define PG8_WAIT_V(n) asm volatile("s_waitcnt vmcnt(" #n ")" ::: "memory")
#define PG8_WAIT_L(n) asm volatile("s_waitcnt lgkmcnt(" #n ")" ::: "memory")
#define PG8_BAR __builtin_amdgcn_s_barrier()
#define PG8_SCHED __builtin_amdgcn_sched_barrier(0)
    Unit cur, nxt; int ui = 0;
    if (!S.next(0, cur)) return;
    unsigned vAc[2][2], vAn[2][2];
    a_offsets<GATHER>(cur, K, Rr, Cc, vAc);
    f32x4 acc[2][2][4][2];
#pragma unroll
    for (int a = 0; a < 2; ++a)
#pragma unroll
        for (int b = 0; b < 2; ++b)
#pragma unroll
            for (int m = 0; m < 4; ++m)
#pragma unroll
                for (int n = 0; n < 2; ++n) acc[a][b][m][n] = (f32x4){0.f, 0.f, 0.f, 0.f};
    bf16x8 At[4][2], B0[2][2], B1[2][2];
    const char* cA = cur.A; const char* cB = cur.B;
    PG8_STAGE(PG8_SB(0, 0), cB, voffB); PG8_STAGE(PG8_SB(0, 1), cB + hstep, voffB); PG8_STAGE(PG8_SA(0, 0), cA, vAc[0]); PG8_STAGE(PG8_SA(0, 1), cA, vAc[1]);
    if (wr == 1) PG8_BAR;
    PG8_WAIT_V(2); PG8_BAR;
    PG8_STAGE(PG8_SB(1, 0), cB + kstep, voffB); PG8_STAGE(PG8_SA(1, 0), cA + kstep, vAc[0]); PG8_STAGE(PG8_SB(1, 1), cB + hstep + kstep, voffB);
    PG8_WAIT_V(6); PG8_BAR;
    for (;;) {
        const bool has_next = S.next(ui + 1, nxt);
        if (has_next) a_offsets<GATHER>(nxt, K, Rr, Cc, vAn);
        else {
#pragma unroll
            for (int h = 0; h < 2; ++h)
#pragma unroll
                for (int i = 0; i < 2; ++i) vAn[h][i] = vAc[h][i]; }
        const char* nA = has_next ? nxt.A : cA; const char* nB = has_next ? nxt.B : cB;
        for (int t = 0; t < nt; t += 2) {
            const bool last = (t == nt - 2);
            const char* a1 = cA + (size_t)(t + 1) * kstep;
            const char* a2 = last ? nA : cA + (size_t)(t + 2) * kstep; const char* b2 = last ? nB : cB + (size_t)(t + 2) * kstep;
            const char* a3 = a2 + kstep; const char* b3 = b2 + kstep;
            unsigned v2[2][2];
#pragma unroll
            for (int h = 0; h < 2; ++h)
#pragma unroll
                for (int i = 0; i < 2; ++i) v2[h][i] = last ? vAn[h][i] : vAc[h][i];
            PG8_LDB(B0, 0, 0); PG8_LDB(B1, 0, 1); PG8_SCHED; PG8_LDA(At, 0, 0); PG8_STAGE(PG8_SA(1, 1), a1, vAc[1]);
            PG8_WAIT_V(8); PG8_WAIT_L(0); PG8_BAR; PG8_MMA(0, 0, At, B0); PG8_MMA(0, 1, At, B1); PG8_BAR; PG8_SCHED;
            PG8_LDA(At, 0, 1); PG8_STAGE(PG8_SB(0, 0), b2, voffB); PG8_STAGE(PG8_SB(0, 1), b2 + hstep, voffB); PG8_STAGE(PG8_SA(0, 0), a2, v2[0]);
            PG8_WAIT_V(8); PG8_WAIT_L(0); PG8_BAR; PG8_MMA(1, 0, At, B0); PG8_MMA(1, 1, At, B1); PG8_BAR; PG8_SCHED;
            PG8_LDB(B0, 1, 0); PG8_LDB(B1, 1, 1); PG8_SCHED; PG8_LDA(At, 1, 0); PG8_STAGE(PG8_SA(0, 1), a2, v2[1]);
            PG8_WAIT_V(8); PG8_WAIT_L(0); PG8_BAR; PG8_MMA(0, 0, At, B0); PG8_MMA(0, 1, At, B1); PG8_BAR; PG8_SCHED;
            PG8_LDA(At, 1, 1); PG8_STAGE(PG8_SB(1, 0), b3, voffB); PG8_STAGE(PG8_SB(1, 1), b3 + hstep, voffB); PG8_STAGE(PG8_SA(1, 0), a3, v2[0]);
            PG8_WAIT_V(8); PG8_WAIT_L(0); PG8_BAR; PG8_MMA(1, 0, At, B0); PG8_MMA(1, 1, At, B1); PG8_BAR; PG8_SCHED;
        }
        if constexpr (ALIGN_EPI) { if (wr == 0) PG8_BAR; }
        E(acc, cur, wr, wc, fr, fq);
        if (!has_next) break;
#pragma unroll
        for (int a = 0; a < 2; ++a)
#pragma unroll
            for (int b = 0; b < 2; ++b)
#pragma unroll
                for (int m = 0; m < 4; ++m)
#pragma unroll
                    for (int n = 0; n < 2; ++n) acc[a][b][m][n] = (f32x4){0.f, 0.f, 0.f, 0.f};
        cur = nxt; cA = nA; cB = nB; ++ui;
#pragma unroll
        for (int h = 0; h < 2; ++h)
#pragma unroll
            for (int i = 0; i < 2; ++i) vAc[h][i] = vAn[h][i];
        if constexpr (ALIGN_EPI) { if (wr == 1) PG8_BAR; }
    }
    PG8_WAIT_V(0);
    if constexpr (!ALIGN_EPI) { if (wr == 0) PG8_BAR; }
    PG8_BAR;
#undef PG8_SA
#undef PG8_SB
#undef PG8_STAGE
#undef PG8_LDA
#undef PG8_LDB
#undef PG8_MMA
#undef PG8_WAIT_V
#undef PG8_WAIT_L
#undef PG8_BAR
#undef PG8_SCHED
}
}

#define XB_TMO      128
#define XB_XCNT(j)  (256  + 64 * (j))
#define XB_XSUB(j)  (1280 + 64 * (j))
#define XB_XGEN(j)  (2304 + 64 * (j))
#define XB_TOP      3328
#define XB_TOPGEN   3392
#define XCD_BAR_WORDS 3456
#define XB_SPIN_CAP (1u << 18)
DI unsigned xb_ld(unsigned* p)              { return __hip_atomic_load(p, __ATOMIC_RELAXED, __HIP_MEMORY_SCOPE_AGENT); }
DI unsigned xb_add(unsigned* p, unsigned v) { return __hip_atomic_fetch_add(p, v, __ATOMIC_RELAXED, __HIP_MEMORY_SCOPE_AGENT); }
DI unsigned xb_xcc_id() { return (unsigned)__builtin_amdgcn_s_getreg((3 << 11) | 20) & 0xFu; }
#define XB_SPIN(cond, bar) do { unsigned _sp = 0; while (cond) { __builtin_amdgcn_s_sleep(1); \
    if ((++_sp & 255u) == 0u) { if (xb_ld(&(bar)[XB_TMO])) break; if (_sp > XB_SPIN_CAP) { atomicAdd(&(bar)[XB_TMO], 1u); break; } } } } while (0)
struct XcdBarrier { unsigned* bar; unsigned x; volatile LAS unsigned* st; };
DI XcdBarrier xcd_barrier_post(unsigned* bar, volatile LAS unsigned* st) {
    XcdBarrier b; b.bar = bar; b.x = xb_xcc_id(); b.st = st;
    if (threadIdx.x == 0) (void)xb_add(&bar[XB_XCNT(b.x)], 1u);
    return b;
}
DI void xcd_barrier_complete(unsigned* bar, unsigned x, unsigned& nloc, unsigned& nx) {
    const unsigned G = gridDim.x * gridDim.y * gridDim.z;
    unsigned sum, cnt, mine, sp = 0u;
    for (;;) {
        sum = 0u; cnt = 0u; mine = 0u;
#pragma unroll
        for (unsigned j = 0; j < 16; ++j) { const unsigned c = xb_ld(&bar[XB_XCNT(j)]); sum += c; cnt += (c > 0u) ? 1u : 0u; mine = (j == x) ? c : mine; }
        if (sum == G) break;
        __builtin_amdgcn_s_sleep(1);
        if ((++sp & 255u) == 0u) { if (xb_ld(&bar[XB_TMO])) break; if (sp > XB_SPIN_CAP) { atomicAdd(&bar[XB_TMO], 1u); break; } }
    }
    nloc = mine > 0u ? mine : 1u; nx = cnt > 0u ? cnt : 1u;
}
DI void xcd_barrier(const XcdBarrier& b) {
    asm volatile("s_waitcnt vmcnt(0)" ::: "memory");
    __syncthreads();
    if (threadIdx.x == 0) {
        unsigned* bar = b.bar;
        __builtin_amdgcn_s_waitcnt(0);
        unsigned nloc = b.st[0], nx = b.st[1];
        if (nloc == 0u) { xcd_barrier_complete(bar, b.x, nloc, nx); b.st[0] = nloc; b.st[1] = nx; }
        const unsigned old = xb_add(&bar[XB_XSUB(b.x)], 1u);
        const unsigned gen = old / nloc;
        if (old + 1u == (gen + 1u) * nloc) {
            __builtin_amdgcn_fence(__ATOMIC_RELEASE, "agent");
            asm volatile("s_waitcnt vmcnt(0)" ::: "memory");
            const unsigned og = xb_add(&bar[XB_TOP], 1u);
            const unsigned tg = og / nx;
            if (og + 1u == (tg + 1u) * nx) xb_add(&bar[XB_TOPGEN], 1u);
            else XB_SPIN(xb_ld(&bar[XB_TOPGEN]) == tg, bar);
            __builtin_amdgcn_fence(__ATOMIC_ACQUIRE, "agent");
            xb_add(&bar[XB_XGEN(b.x)], 1u);
            asm volatile("s_waitcnt vmcnt(0)" ::: "memory");
        } else {
            XB_SPIN(xb_ld(&bar[XB_XGEN(b.x)]) == gen, bar);
            __builtin_amdgcn_fence(__ATOMIC_ACQUIRE, "agent");
            asm volatile("s_waitcnt vmcnt(0)" ::: "memory");
        }
    }
    __syncthreads();
}

DI void p0_transpose_item(const float* W, int ldw, int K, bf16* WT, int src_n0, int dst_n0, int k0, LAS float* scr, int lane) {
#pragma unroll 8
    for (int i = 0; i < 32; ++i) { const int kk = 2 * i + (lane >> 5); scr[kk * 33 + (lane & 31)] = W[(size_t)(k0 + kk) * ldw + src_n0 + (lane & 31)]; }
    asm volatile("s_waitcnt lgkmcnt(0)" ::: "memory");
    const int c = lane & 7;
#pragma unroll
    for (int j = 0; j < 4; ++j) { const int n = (lane >> 3) + 8 * j; const LAS float* s = scr + (8 * c) * 33 + n;
        u32x4 o; o.x = pk2(s[0 * 33], s[1 * 33]); o.y = pk2(s[2 * 33], s[3 * 33]); o.z = pk2(s[4 * 33], s[5 * 33]); o.w = pk2(s[6 * 33], s[7 * 33]);
        *(u32x4*)(WT + (size_t)(dst_n0 + n) * K + k0 + 8 * c) = o; }
    asm volatile("s_waitcnt lgkmcnt(0)" ::: "memory");
}

DI void ln_row(f32x4 (&v)[4], const float* g, const float* bta, int lane) {
    float s = 0.f;
#pragma unroll
    for (int j = 0; j < 4; ++j) s += (v[j].x + v[j].y) + (v[j].z + v[j].w);
    const float mean = wave_sum(s) * (1.f / D); float s2 = 0.f;
#pragma unroll
    for (int j = 0; j < 4; ++j) { v[j] = v[j] - mean; s2 += (v[j].x * v[j].x + v[j].y * v[j].y) + (v[j].z * v[j].z + v[j].w * v[j].w); }
    const float rstd = 1.f / sqrtf(wave_sum(s2) * (1.f / D) + LN_EPS);
#pragma unroll
    for (int j = 0; j < 4; ++j) { const f32x4 gg = *(const f32x4*)(g + 4 * lane + 256 * j), bb = *(const f32x4*)(bta + 4 * lane + 256 * j); v[j] = v[j] * rstd * gg + bb; }
}
DI void store_row_bf16(bf16* orow, const f32x4 (&v)[4], int lane) {
    u32x2* o8 = (u32x2*)orow + lane;
#pragma unroll
    for (int j = 0; j < 4; ++j) { u32x2 w; w.x = pk2(v[j].x, v[j].y); w.y = pk2(v[j].z, v[j].w); o8[64 * j] = w; }
}

DI void fox_unit(int b, int h8, int qb, const bf16* U, const float* Fc2, const float* fox_g, bf16* MIX, LAS unsigned char* lds) {
    const int tid = threadIdx.x, lane = tid & 63, wave = __builtin_amdgcn_readfirstlane(tid >> 6);
    const int r = lane & 31, h = lane >> 5, i16 = lane & 15, q4 = i16 >> 2, p4 = i16 & 3, blk = (lane >> 4) & 1;
    const int tok0 = b * SEQ, q0 = qb * 256, qrow = q0 + wave * 32 + r;
    const float C2 = 0.125f * LOG2E;
    bf16x8 qf[4];
    { const bf16* qp = U + (size_t)(tok0 + qrow) * NU + UC_FQ + h8 * 64 + 8 * h;
#pragma unroll
      for (int d0 = 0; d0 < 4; ++d0) qf[d0] = *(const bf16x8*)(qp + 16 * d0); }
    float m = -1e30f, l = 0.f; f32x16 oT[2];
#pragma unroll
    for (int i = 0; i < 16; ++i) { oT[0][i] = 0.f; oT[1][i] = 0.f; }
    LAS unsigned char* Ks = lds; LAS unsigned char* Vs = lds + 9216; LAS float* nb = (LAS float*)(lds + 18432);
    const int NT = 4 * qb + 4;
    const float* fc = Fc2 + (size_t)(b * 8 + h8) * SEQ;
    for (int t = 0; t < NT; ++t) {
        __syncthreads();
        { const int row = tid >> 3, pc = tid & 7; const bf16* gp = U + (size_t)(tok0 + 64 * t + row) * NU + h8 * 64 + pc * 8;
          const u32x4 kv = *(const u32x4*)(gp + UC_FK), vv = *(const u32x4*)(gp + UC_FV);
          *(LAS u32x4*)(Ks + row * 144 + pc * 16) = kv; *(LAS u32x4*)(Vs + row * 144 + pc * 16) = vv; }
        if (tid < 64) nb[tid] = fc[64 * t + tid];
        __syncthreads();
        f32x16 p[2];
#pragma unroll
        for (int hb = 0; hb < 2; ++hb) {
            f32x16 a;
#pragma unroll
            for (int i = 0; i < 16; ++i) a[i] = 0.f;
#pragma unroll
            for (int d0 = 0; d0 < 4; ++d0) { const bf16x8 kf = *(const LAS bf16x8*)(Ks + (32 * hb + r) * 144 + (16 * d0 + 8 * h) * 2); a = mfma32(kf, qf[d0], a); }
#pragma unroll
            for (int g = 0; g < 4; ++g) { const f32x4 bb = *(const LAS f32x4*)(nb + 32 * hb + 8 * g + 4 * h);
#pragma unroll
                for (int e = 0; e < 4; ++e) a[4 * g + e] = a[4 * g + e] * C2 + bb[e]; }
            p[hb] = a;
        }
        if (t >= NT - 4) {
#pragma unroll
            for (int hb = 0; hb < 2; ++hb)
#pragma unroll
                for (int i = 0; i < 16; ++i) { const int kv = 64 * t + 32 * hb + crow(i, h); if (kv > qrow) p[hb][i] = -INFINITY; }
        }
        float mx = p[0][0];
#pragma unroll
        for (int i = 1; i < 16; ++i) mx = fmaxf(mx, p[0][i]);
#pragma unroll
        for (int i = 0; i < 16; ++i) mx = fmaxf(mx, p[1][i]);
        mx = xhalf_max(mx);
        const float mn = fmaxf(m, mx), alpha = ex2(m - mn); m = mn;
        float rs = 0.f;
#pragma unroll
        for (int hb = 0; hb < 2; ++hb)
#pragma unroll
            for (int i = 0; i < 16; ++i) { const float e = ex2(p[hb][i] - mn); p[hb][i] = e; rs += e; }
        l = l * alpha + rs;
#pragma unroll
        for (int i = 0; i < 16; ++i) { oT[0][i] *= alpha; oT[1][i] *= alpha; }
        bf16x8 pf[2][2];
#pragma unroll
        for (int hb = 0; hb < 2; ++hb)
#pragma unroll
            for (int s = 0; s < 2; ++s) pf[hb][s] = pack8(p[hb], s);
#pragma unroll
        for (int d0 = 0; d0 < 2; ++d0)
#pragma unroll
            for (int hb = 0; hb < 2; ++hb)
#pragma unroll
                for (int s = 0; s < 2; ++s) {
                    const LAS unsigned char* vp = Vs + (32 * hb + 16 * s + 4 * h + q4) * 144 + (32 * d0 + 16 * blk + 4 * p4) * 2;
                    const s16x4 lo = tr_read(vp), hi = tr_read(vp + 8 * 144);
                    oT[d0] = mfma32(cat8(lo, hi), pf[hb][s], oT[d0]);
                }
    }
    l = xhalf_sum(l);
    const float inv = 1.f / l;
    float ss = 0.f;
#pragma unroll
    for (int d0 = 0; d0 < 2; ++d0)
#pragma unroll
        for (int i = 0; i < 16; ++i) { const float o = oT[d0][i] * inv; oT[d0][i] = o; ss += o * o; }
    ss = xhalf_sum(ss);
    const float rr = 1.f / sqrtf(ss * (1.f / 64.f) + RMS_EPS);
    bf16* op = MIX + (size_t)(tok0 + qrow) * D + h8 * 64;
#pragma unroll
    for (int d0 = 0; d0 < 2; ++d0)
#pragma unroll
        for (int g = 0; g < 4; ++g) { const int d = 32 * d0 + 8 * g + 4 * h; const f32x4 gn = *(const f32x4*)(fox_g + h8 * 64 + d);
            u32x2 w; w.x = pk2(oT[d0][4 * g] * rr * gn.x, oT[d0][4 * g + 1] * rr * gn.y); w.y = pk2(oT[d0][4 * g + 2] * rr * gn.z, oT[d0][4 * g + 3] * rr * gn.w);
            *(u32x2*)(op + d) = w; }
}

DI void m1_unit(int bh, int cg, const bf16* U, const float* G, const float* conv_w, bf16* Mq, bf16* Mk, float* KvT, float* Nc, float* Gc, float* Mloc, LAS unsigned char* lds) {
    const int tid = threadIdx.x, lane = tid & 63, wave = __builtin_amdgcn_readfirstlane(tid >> 6);
    const int r = lane & 31, h = lane >> 5, i16 = lane & 15, q4 = i16 >> 2, p4 = i16 & 3, blk = (lane >> 4) & 1;
    const int b = bh >> 2, hh = bh & 3, s0 = cg * 256;
    LAS float* wa = (LAS float*)lds;
    LAS unsigned char* ksb = lds + 1024;
    LAS unsigned char* vsb = lds + 1024 + 36864;
    __syncthreads();
    if (wave < 4) {
        const int c = cg * 4 + wave, tok = b * SEQ + c * 64 + lane;
        const float lf = G[(size_t)tok * 16 + 12 + hh], li = G[(size_t)tok * 16 + 8 + hh];
        const float bsc = wave_scan_add(lf, lane);
        const float g = __shfl(bsc, 63);
        const float a = g - bsc + li;
        const float ml = wave_max(a);
        wa[wave * 64 + lane] = expf(a - ml);
        if (lane == 0) { Gc[bh * 64 + c] = g; Mloc[bh * 64 + c] = ml; }
    }
    __syncthreads();
#pragma unroll 2
    for (int i = 0; i < 8; ++i) {
        const int id = tid + 512 * i, d8 = id & 7, qk = (id >> 3) & 1, t = id >> 4;
        const int ucol = (qk ? UC_MK : UC_MQ) + hh * 64 + 8 * d8, ccol = (qk ? 256 : 0) + hh * 64 + 8 * d8;
        float acc[8];
#pragma unroll
        for (int e = 0; e < 8; ++e) acc[e] = 0.f;
#pragma unroll
        for (int j = 0; j < 4; ++j) {
            const int ts = s0 + t - 3 + j;
            if (ts >= 0) {
                const u32x4 x = *(const u32x4*)(U + (size_t)(b * SEQ + ts) * NU + ucol);
                const f32x4 w0 = *(const f32x4*)(conv_w + j * 512 + ccol), w1 = *(const f32x4*)(conv_w + j * 512 + ccol + 4);
                acc[0] += bf_lo(x.x) * w0.x; acc[1] += bf_hi(x.x) * w0.y; acc[2] += bf_lo(x.y) * w0.z; acc[3] += bf_hi(x.y) * w0.w;
                acc[4] += bf_lo(x.z) * w1.x; acc[5] += bf_hi(x.z) * w1.y; acc[6] += bf_lo(x.w) * w1.z; acc[7] += bf_hi(x.w) * w1.w;
            }
        }
#pragma unroll
        for (int e = 0; e < 8; ++e) acc[e] = acc[e] / (1.f + expf(-acc[e]));
        const size_t orow = ((size_t)bh * SEQ + s0 + t) * 64 + 8 * d8;
        if (qk == 0) {
            u32x4 w; w.x = pk2(acc[0], acc[1]); w.y = pk2(acc[2], acc[3]); w.z = pk2(acc[4], acc[5]); w.w = pk2(acc[6], acc[7]);
            *(u32x4*)(Mq + orow) = w;
        } else {
#pragma unroll
            for (int e = 0; e < 8; ++e) acc[e] *= 0.125f;
            u32x4 w; w.x = pk2(acc[0], acc[1]); w.y = pk2(acc[2], acc[3]); w.z = pk2(acc[4], acc[5]); w.w = pk2(acc[6], acc[7]);
            *(u32x4*)(Mk + orow) = w;
            const float ww = wa[t];
            u32x4 x; x.x = pk2(acc[0] * ww, acc[1] * ww); x.y = pk2(acc[2] * ww, acc[3] * ww); x.z = pk2(acc[4] * ww, acc[5] * ww); x.w = pk2(acc[6] * ww, acc[7] * ww);
            *(LAS u32x4*)(ksb + (t >> 6) * 9216 + (t & 63) * 144 + d8 * 16) = x;
        }
    }
#pragma unroll
    for (int i = 0; i < 8; ++i) { const int id = tid + 512 * i, pc = id & 15, t = id >> 4;
        const u32x4 v = *(const u32x4*)(U + (size_t)(b * SEQ + s0 + t) * NU + UC_MV + hh * 128 + pc * 8);
        *(LAS u32x4*)(vsb + (t >> 6) * 17408 + (t & 63) * 272 + pc * 16) = v; }
    __syncthreads();
    {
        const int cl = wave >> 1, eh = wave & 1, c = cg * 4 + cl;
        const LAS unsigned char* vs = vsb + cl * 17408; const LAS unsigned char* ks = ksb + cl * 9216;
        f32x16 acc[2][2];
#pragma unroll
        for (int a = 0; a < 2; ++a)
#pragma unroll
            for (int bb = 0; bb < 2; ++bb)
#pragma unroll
                for (int i = 0; i < 16; ++i) acc[a][bb][i] = 0.f;
#pragma unroll
        for (int k4 = 0; k4 < 4; ++k4) {
            bf16x8 af[2], bfr[2];
#pragma unroll
            for (int eb = 0; eb < 2; ++eb) { const LAS unsigned char* pp = vs + (16 * k4 + 8 * h + q4) * 272 + (64 * eh + 32 * eb + 16 * blk + 4 * p4) * 2; af[eb] = cat8(tr_read(pp), tr_read(pp + 4 * 272)); }
#pragma unroll
            for (int db = 0; db < 2; ++db) { const LAS unsigned char* pp = ks + (16 * k4 + 8 * h + q4) * 144 + (32 * db + 16 * blk + 4 * p4) * 2; bfr[db] = cat8(tr_read(pp), tr_read(pp + 4 * 144)); }
#pragma unroll
            for (int eb = 0; eb < 2; ++eb)
#pragma unroll
                for (int db = 0; db < 2; ++db) acc[eb][db] = mfma32(af[eb], bfr[db], acc[eb][db]);
        }
        float* op = KvT + (size_t)(bh * 64 + c) * 8192;
#pragma unroll
        for (int eb = 0; eb < 2; ++eb)
#pragma unroll
            for (int db = 0; db < 2; ++db)
#pragma unroll
                for (int i = 0; i < 16; ++i) op[(64 * eh + 32 * eb + crow(i, h)) * 64 + 32 * db + r] = acc[eb][db][i];
    }
    if (tid < 256) { const int cl = tid >> 6, d = tid & 63; const LAS unsigned char* ks = ksb + cl * 9216 + d * 2; float s = 0.f;
#pragma unroll 8
        for (int t = 0; t < 64; ++t) s += __uint_as_float(((unsigned)*(const LAS unsigned short*)(ks + t * 144)) << 16);
        Nc[(size_t)(bh * 64 + cg * 4 + cl) * 64 + d] = s; }
}

DI void m3_unit(int bh, int cg, const bf16* U, const float* G, const bf16* Mq, const bf16* Mk, const bf16* CpT, const float* Np, const float* Mp, const float* mlstm_g, bf16* MIX, LAS unsigned char* lds) {
    const int tid = threadIdx.x, lane = tid & 63, wave = __builtin_amdgcn_readfirstlane(tid >> 6);
    const int r = lane & 31, h = lane >> 5, i16 = lane & 15, q4 = i16 >> 2, p4 = i16 & 3, blk = (lane >> 4) & 1;
    const int b = bh >> 2, hh = bh & 3, cl = wave >> 1, th = wave & 1, c = cg * 4 + cl;
    const int tokc = b * SEQ + c * 64;
    const LAS unsigned char* Vs = lds + cl * 17408;
    LAS float* wsf = (LAS float*)(lds + 69632 + wave * 1024);
    __syncthreads();
#pragma unroll
    for (int i = 0; i < 8; ++i) { const int id = tid + 512 * i, pc = id & 15, t = id >> 4;
        const u32x4 v = *(const u32x4*)(U + (size_t)(b * SEQ + cg * 256 + t) * NU + UC_MV + hh * 128 + pc * 8);
        *(LAS u32x4*)(lds + (t >> 6) * 17408 + (t & 63) * 272 + pc * 16) = v; }
    const float mprev = Mp[bh * 64 + c];
    {
        const float lf = G[(size_t)(tokc + lane) * 16 + 12 + hh], li = G[(size_t)(tokc + lane) * 16 + 8 + hh];
        const float bsc = wave_scan_add(lf, lane);
        const float pm = wave_scan_max(li - bsc, lane);
        wsf[lane] = bsc; wsf[64 + lane] = li; wsf[128 + lane] = bsc + fmaxf(mprev, pm); wsf[192 + lane] = Np[(size_t)(bh * 64 + c) * 64 + lane];
    }
    __syncthreads();
    const int tl = 32 * th + r;
    const float bt = wsf[tl], mtt = wsf[128 + tl];
    const float winter = expf(bt + mprev - mtt);
    bf16x8 qf[4];
    { const bf16* qp = Mq + ((size_t)bh * SEQ + c * 64 + tl) * 64 + 8 * h;
#pragma unroll
      for (int ks = 0; ks < 4; ++ks) qf[ks] = *(const bf16x8*)(qp + 16 * ks); }
    float qn = 0.f;
#pragma unroll
    for (int ks = 0; ks < 4; ++ks)
#pragma unroll
        for (int j = 0; j < 8; ++j) qn += bf2f(qf[ks][j]) * wsf[192 + 16 * ks + 8 * h + j];
    qn = xhalf_sum(qn);
    f32x16 accT[4];
#pragma unroll
    for (int eb = 0; eb < 4; ++eb) {
        f32x16 a;
#pragma unroll
        for (int i = 0; i < 16; ++i) a[i] = 0.f;
#pragma unroll
        for (int ks = 0; ks < 4; ++ks) { const bf16x8 cf = *(const bf16x8*)(CpT + ((size_t)(bh * 64 + c) * 128 + 32 * eb + r) * 64 + 16 * ks + 8 * h); a = mfma32(cf, qf[ks], a); }
#pragma unroll
        for (int i = 0; i < 16; ++i) a[i] *= winter;
        accT[eb] = a;
    }
    float psum = 0.f; f32x16 pT[2];
#pragma unroll
    for (int sb = 0; sb < 2; ++sb) {
        f32x16 a;
#pragma unroll
        for (int i = 0; i < 16; ++i) a[i] = 0.f;
#pragma unroll
        for (int ks = 0; ks < 4; ++ks) { const bf16x8 kf = *(const bf16x8*)(Mk + ((size_t)bh * SEQ + c * 64 + 32 * sb + r) * 64 + 16 * ks + 8 * h); a = mfma32(kf, qf[ks], a); }
#pragma unroll
        for (int g = 0; g < 4; ++g) { const f32x4 b4 = *(const LAS f32x4*)(wsf + 32 * sb + 8 * g + 4 * h), l4 = *(const LAS f32x4*)(wsf + 64 + 32 * sb + 8 * g + 4 * h);
#pragma unroll
            for (int e = 0; e < 4; ++e) { const int s = 32 * sb + 8 * g + 4 * h + e; const float w = (s <= tl) ? expf(bt - b4[e] + l4[e] - mtt) * a[4 * g + e] : 0.f; a[4 * g + e] = w; psum += w; } }
        pT[sb] = a;
    }
    psum = xhalf_sum(psum);
#pragma unroll
    for (int eb = 0; eb < 4; ++eb)
#pragma unroll
        for (int sb = 0; sb < 2; ++sb)
#pragma unroll
            for (int s2 = 0; s2 < 2; ++s2) {
                const LAS unsigned char* vp = Vs + (32 * sb + 16 * s2 + 4 * h + q4) * 272 + (32 * eb + 16 * blk + 4 * p4) * 2;
                const s16x4 lo = tr_read(vp), hi = tr_read(vp + 8 * 272);
                accT[eb] = mfma32(cat8(lo, hi), pack8(pT[sb], s2), accT[eb]);
            }
    const float den = winter * qn + psum;
    const float hs = 1.f / fmaxf(fabsf(den), expf(-mtt));
    float ss = 0.f;
#pragma unroll
    for (int eb = 0; eb < 4; ++eb)
#pragma unroll
        for (int i = 0; i < 16; ++i) { const float v = accT[eb][i] * hs; accT[eb][i] = v; ss += v * v; }
    ss = xhalf_sum(ss);
    const float rr = 1.f / sqrtf(ss * (1.f / 128.f) + RMS_EPS);
    const int tok = tokc + tl;
#pragma unroll
    for (int eb = 0; eb < 4; ++eb)
#pragma unroll
        for (int g = 0; g < 4; ++g) { const int e = 32 * eb + 8 * g + 4 * h;
            const f32x4 gn = *(const f32x4*)(mlstm_g + hh * 128 + e);
            const u32x2 mo = *(const u32x2*)(U + (size_t)tok * NU + UC_MO + hh * 128 + e);
            const float o0 = accT[eb][4 * g] * rr * gn.x * sigmoid_fast(bf_lo(mo.x)), o1 = accT[eb][4 * g + 1] * rr * gn.y * sigmoid_fast(bf_hi(mo.x));
            const float o2 = accT[eb][4 * g + 2] * rr * gn.z * sigmoid_fast(bf_lo(mo.y)), o3 = accT[eb][4 * g + 3] * rr * gn.w * sigmoid_fast(bf_hi(mo.y));
            u32x2 w; w.x = pk2(o0, o1); w.y = pk2(o2, o3);
            *(u32x2*)(MIX + (size_t)tok * D + 512 + hh * 128 + e) = w; }
}

DI void xattn_unit(int b, int hx, int qb, bf16* QX, const bf16* KVx, LAS unsigned char* lds) {
    const int tid = threadIdx.x, lane = tid & 63, wave = __builtin_amdgcn_readfirstlane(tid >> 6);
    const int r = lane & 31, h = lane >> 5, i16 = lane & 15, q4 = i16 >> 2, p4 = i16 & 3, blk = (lane >> 4) & 1;
    const int tok = b * SEQ + qb * 256 + wave * 32 + r;
    bf16x8 qf[16];
    { const bf16* qp = QX + (size_t)tok * D + hx * 256 + 8 * h;
#pragma unroll
      for (int ks = 0; ks < 16; ++ks) qf[ks] = *(const bf16x8*)(qp + 16 * ks); }
    f32x16 sT[8];
    LAS unsigned char* Kx = lds; LAS unsigned char* Vx = lds + 33792;
#pragma unroll
    for (int kt = 0; kt < 4; ++kt) {
        __syncthreads();
#pragma unroll
        for (int i = 0; i < 4; ++i) { const int id = tid + 512 * i, row = id >> 5, pc = id & 31;
            const u32x4 v = *(const u32x4*)(KVx + (size_t)(b * NMEM + 64 * kt + row) * 2048 + hx * 256 + pc * 8);
            *(LAS u32x4*)(Kx + row * 528 + pc * 16) = v; }
        __syncthreads();
#pragma unroll
        for (int mb = 0; mb < 2; ++mb) {
            f32x16 a;
#pragma unroll
            for (int i = 0; i < 16; ++i) a[i] = 0.f;
#pragma unroll
            for (int ks = 0; ks < 16; ++ks) { const bf16x8 kf = *(const LAS bf16x8*)(Kx + (32 * mb + r) * 528 + (16 * ks + 8 * h) * 2); a = mfma32(kf, qf[ks], a); }
            sT[2 * kt + mb] = a;
        }
    }
    const float C2X = 0.0625f * LOG2E;
    float mx = -INFINITY;
#pragma unroll
    for (int j = 0; j < 8; ++j)
#pragma unroll
        for (int i = 0; i < 16; ++i) mx = fmaxf(mx, sT[j][i]);
    mx = xhalf_max(mx);
    const float mb2 = mx * C2X;
    float lsum = 0.f;
#pragma unroll
    for (int j = 0; j < 8; ++j)
#pragma unroll
        for (int i = 0; i < 16; ++i) { const float e = ex2(sT[j][i] * C2X - mb2); sT[j][i] = e; lsum += e; }
    lsum = xhalf_sum(lsum);
    const float inv = 1.f / lsum;
    bf16x8 pf[8][2];
#pragma unroll
    for (int j = 0; j < 8; ++j)
#pragma unroll
        for (int s = 0; s < 2; ++s) pf[j][s] = pack8(sT[j], s);
#pragma unroll
    for (int vh = 0; vh < 2; ++vh) {
        __syncthreads();
#pragma unroll
        for (int i = 0; i < 8; ++i) { const int id = tid + 512 * i, row = id >> 4, pc = id & 15;
            const u32x4 v = *(const u32x4*)(KVx + (size_t)(b * NMEM + row) * 2048 + 1024 + hx * 256 + 128 * vh + pc * 8);
            *(LAS u32x4*)(Vx + row * 272 + pc * 16) = v; }
        __syncthreads();
#pragma unroll
        for (int eb = 0; eb < 4; ++eb) {
            f32x16 acc;
#pragma unroll
            for (int i = 0; i < 16; ++i) acc[i] = 0.f;
#pragma unroll
            for (int j = 0; j < 8; ++j)
#pragma unroll
                for (int s = 0; s < 2; ++s) {
                    const LAS unsigned char* vp = Vx + (32 * j + 16 * s + 4 * h + q4) * 272 + (32 * eb + 16 * blk + 4 * p4) * 2;
                    const s16x4 lo = tr_read(vp), hi = tr_read(vp + 8 * 272);
                    acc = mfma32(cat8(lo, hi), pf[j][s], acc);
                }
#pragma unroll
            for (int g = 0; g < 4; ++g) { const int d = 128 * vh + 32 * eb + 8 * g + 4 * h;
                u32x2 w; w.x = pk2(acc[4 * g] * inv, acc[4 * g + 1] * inv); w.y = pk2(acc[4 * g + 2] * inv, acc[4 * g + 3] * inv);
                *(u32x2*)(QX + (size_t)tok * D + hx * 256 + d) = w; }
        }
    }
}

DI void moe_tables(LAS int* tb, gu32* ctl, int tid) {
    __syncthreads();
    if (tid < 32) tb[40 + tid] = (int)__hip_atomic_load(ctl + CW_CNT + 64 * tid, RLX_AGENT);
    __syncthreads();
    if (tid == 0) { int s = 0; for (int e = 0; e < 32; ++e) { tb[e] = s; s += (tb[40 + e] + 255) >> 8; } tb[32] = s; }
    __syncthreads();
}

struct Args { const float* in[26]; float* out; unsigned char* ws; int ph_lo, ph_hi, li, pad; };

__global__ void __launch_bounds__(NWAVES * 64, 2) fwd(Args args) {
    extern __shared__ __attribute__((aligned(16))) unsigned char lds_raw[];
    LAS unsigned char* lds = (LAS unsigned char*)lds_raw;
    volatile LAS unsigned* MISC = (volatile LAS unsigned*)(lds + MISC_OFF);
    const int tid = threadIdx.x, lane = tid & 63, wave = __builtin_amdgcn_readfirstlane(tid >> 6);
    const int G = gridDim.x, bx = blockIdx.x;
    const int vcu = (G % 8 == 0) ? (bx % 8) * (G / 8) + bx / 8 : bx;
    unsigned char* ws = args.ws;
    gu32* ctl = (gu32*)(ws + WS_CTL);
    const float* x = args.in[0]; const float* mem = args.in[1]; const float* w_in = args.in[2]; const float* fox_f_bias = args.in[3];
    const float* conv_w = args.in[4]; const float* i_bias = args.in[5]; const float* f_bias = args.in[6]; const float* fox_g = args.in[7];
    const float* mlstm_g = args.in[8]; const float* w_out = args.in[9]; const float* ln1_g = args.in[10]; const float* ln1_b = args.in[11];
    const float* w_xq = args.in[12]; const float* w_xk = args.in[13]; const float* w_xv = args.in[14]; const float* w_xo = args.in[15];
    const float* ln2_g = args.in[16]; const float* ln2_b = args.in[17]; const float* w_router = args.in[18]; const float* b_router = args.in[19];
    const float* w_gu = args.in[20]; const float* b_gu = args.in[21]; const float* w_dn = args.in[22]; const float* b_dn = args.in[23];
    const float* ln3_g = args.in[24]; const float* ln3_b = args.in[25];
    float* out = args.out;
    float* Gt = (float*)(ws + WS_G); float* Fc2 = (float*)(ws + WS_FC2);
    float* Gc = (float*)(ws + WS_GC); float* Mloc = Gc + 1024; float* Mp = Gc + 2048;
    float* Nc = (float*)(ws + WS_NC); float* Np = (float*)(ws + WS_NP);
    int* Tidx = (int*)(ws + WS_TIDX); float* Tgate = (float*)(ws + WS_TGATE); int* Tslot = (int*)(ws + WS_TSLOT); int* List = (int*)(ws + WS_LIST);
    bf16* KVx = (bf16*)(ws + WS_MEMKV);
    bf16* Win_t = (bf16*)(ws + WS_WIN); bf16* Wout_t = (bf16*)(ws + WS_WOUT); bf16* Wxq_t = (bf16*)(ws + WS_WXQ); bf16* Wxo_t = (bf16*)(ws + WS_WXO);
    bf16* Wgu_t = (bf16*)(ws + WS_WGU); bf16* Wdn_t = (bf16*)(ws + WS_WDN);
    bf16* XB = (bf16*)(ws + WS_XB); bf16* U = (bf16*)(ws + WS_U); bf16* Mq = (bf16*)(ws + WS_MQ); bf16* Mk = (bf16*)(ws + WS_MK);
    float* KvT = (float*)(ws + WS_KVT); bf16* CpT = (bf16*)(ws + WS_CPT); bf16* MIX = (bf16*)(ws + WS_MIX);
    float* Y1 = (float*)(ws + WS_Y1); bf16* X1B = (bf16*)(ws + WS_X1B); bf16* QX = (bf16*)(ws + WS_QX);
    float* Y2 = (float*)(ws + WS_Y2); bf16* X2B = (bf16*)(ws + WS_X2B); bf16* HID = (bf16*)(ws + WS_HID); bf16* YB = (bf16*)(ws + WS_YB);

    for (int u = tid; u < (LDS_BYTES - LDSCTL_OFF) / 4; u += NWAVES * 64) ((LAS unsigned*)(lds + LDSCTL_OFF))[u] = 0u;
    __syncthreads();
    XcdBarrier bar; bar.bar = (unsigned*)(ctl + CW_BAR); bar.x = 0; bar.st = nullptr;
    if (N_LAUNCHES == 1) bar = xcd_barrier_post((unsigned*)(ctl + CW_BAR), MISC + 8);
#define GRID_BAR() do { if (N_LAUNCHES == 1) xcd_barrier(bar); } while (0)
    const int lo = args.ph_lo, hi = args.ph_hi;
#ifndef PH_MASK
#define PH_MASK 0xFFFF
#endif
#define IN(k) (((PH_MASK >> (k)) & 1) && lo <= (k) && (k) < hi)
#define BOTH(k) (IN(k) && IN((k) + 1))

    if (IN(0)) {
        {
            LAS float* wg = (LAS float*)lds;
            for (int idx = tid; idx < 1024 * 16; idx += 512) { const int k = idx >> 4, c = idx & 15; const int col = c < 8 ? 1536 + c : 2568 + (c - 8); wg[idx] = w_in[(size_t)k * NIN + col]; }
            __syncthreads();
            for (int m = bx * 8 + wave; m < M; m += G * 8) {
                asm volatile("" ::: "memory");
                const f32x4* xr = (const f32x4*)(x + (size_t)m * D) + lane;
                f32x4 v[4];
#pragma unroll
                for (int j = 0; j < 4; ++j) v[j] = xr[64 * j];
                store_row_bf16(XB + (size_t)m * D, v, lane);
                float acc[16];
#pragma unroll
                for (int c = 0; c < 16; ++c) acc[c] = 0.f;
#pragma unroll
                for (int j = 0; j < 4; ++j)
#pragma unroll
                    for (int i = 0; i < 4; ++i) { const LAS f32x4* wp = (const LAS f32x4*)(wg + (256 * j + 4 * lane + i) * 16); const float xv = v[j][i];
#pragma unroll
                        for (int c4 = 0; c4 < 4; ++c4) { const f32x4 w = wp[c4]; acc[4 * c4] += xv * w.x; acc[4 * c4 + 1] += xv * w.y; acc[4 * c4 + 2] += xv * w.z; acc[4 * c4 + 3] += xv * w.w; } }
                float mine = 0.f;
#pragma unroll
                for (int c = 0; c < 16; ++c) { const float s = wave_sum(acc[c]); mine = (lane == c) ? s : mine; }
                if (lane < 16) {
                    float o;
                    if (lane < 8) o = log_sigmoid_acc(mine + fox_f_bias[lane]);
                    else if (lane < 12) o = mine + i_bias[lane - 8];
                    else o = log_sigmoid_acc(mine + f_bias[lane - 12]);
                    Gt[(size_t)m * 16 + lane] = o;
                }
            }
            __syncthreads();
        }
        {
            LAS unsigned char* As = lds; LAS unsigned char* Bs = lds + 17408;
            for (int tile = bx; tile < 256; tile += G) {
                const int rt = tile >> 4, ct = tile & 15;
                const float* W = ct < 8 ? w_xk : w_xv; const int col0 = 128 * (ct & 7);
                f32x4 acc[4];
#pragma unroll
                for (int rb = 0; rb < 4; ++rb) acc[rb] = (f32x4){0.f, 0.f, 0.f, 0.f};
                for (int k0 = 0; k0 < 1024; k0 += 128) {
                    __syncthreads();
#pragma unroll
                    for (int i = 0; i < 4; ++i) { const int p = tid + 512 * i, row = p >> 5, c4 = p & 31;
                        const f32x4 a = *(const f32x4*)(mem + (size_t)(64 * rt + row) * D + k0 + 4 * c4);
                        u32x2 w; w.x = pk2(a.x, a.y); w.y = pk2(a.z, a.w); *(LAS u32x2*)(As + row * 272 + c4 * 8) = w; }
#pragma unroll
                    for (int i = 0; i < 8; ++i) { const int p = tid + 512 * i, k = p >> 5, c4 = p & 31;
                        const f32x4 a = *(const f32x4*)(W + (size_t)(k0 + k) * D + col0 + 4 * c4);
                        LAS unsigned short* bp = (LAS unsigned short*)(Bs + (4 * c4) * 272 + k * 2);
                        const unsigned w0 = pk2(a.x, a.y), w1 = pk2(a.z, a.w);
                        bp[0] = (unsigned short)(w0 & 0xffffu); bp[136] = (unsigned short)(w0 >> 16); bp[272] = (unsigned short)(w1 & 0xffffu); bp[408] = (unsigned short)(w1 >> 16); }
                    __syncthreads();
#pragma unroll
                    for (int kk = 0; kk < 4; ++kk) {
                        const bf16x8 bfr = *(const LAS bf16x8*)(Bs + (16 * wave + (lane & 15)) * 272 + (32 * kk + 8 * (lane >> 4)) * 2);
#pragma unroll
                        for (int rb = 0; rb < 4; ++rb) { const bf16x8 afr = *(const LAS bf16x8*)(As + (16 * rb + (lane & 15)) * 272 + (32 * kk + 8 * (lane >> 4)) * 2); acc[rb] = mfma16(afr, bfr, acc[rb]); }
                    }
                }
#pragma unroll
                for (int rb = 0; rb < 4; ++rb)
#pragma unroll
                    for (int j = 0; j < 4; ++j) { const int row = 64 * rt + 16 * rb + 4 * (lane >> 4) + j, col = 128 * ct + 16 * wave + (lane & 15);
                        KVx[(size_t)row * 2048 + col] = (bf16)(pk2(acc[rb][j], 0.f) & 0xffffu); }
            }
            __syncthreads();
        }
        {
            LAS float* scr = (LAS float*)(lds + wave * 16384);
            const int gw = vcu * NWAVES + wave, NGW = G * NWAVES;
            constexpr int I_GU = 32 * 16 * 64, I_DN = 32 * 16 * 32, I_IN = 16 * 96, I_SQ = 16 * 32;
            constexpr int NITEMS = I_GU + I_DN + I_IN + 3 * I_SQ;
            for (int it = gw; it < NITEMS; it += NGW) {
                int q = it;
                if (q < I_GU) { const int e = q >> 10, rr = q & 1023, kb = rr >> 6, nb = rr & 63, n0 = 32 * nb; const int bj = n0 >> 10, rem = n0 & 1023, pn = rem >> 7, j0 = rem & 127;
                    p0_transpose_item(w_gu + (size_t)e * 1024 * 2048, 2048, 1024, Wgu_t + (size_t)e * 2048 * 1024, n0, 256 * pn + 128 * bj + j0, 64 * kb, scr, lane); continue; }
                q -= I_GU;
                if (q < I_DN) { const int e = q >> 9, rr = q & 511, kb = rr >> 5, nb = rr & 31;
                    p0_transpose_item(w_dn + (size_t)e * 1024 * 1024, 1024, 1024, Wdn_t + (size_t)e * 1024 * 1024, 32 * nb, 32 * nb, 64 * kb, scr, lane); continue; }
                q -= I_DN;
                if (q < I_IN) { const int kb = q / 96, nb = q % 96, dn0 = 32 * nb; const int sn0 = dn0 < 1536 ? dn0 : (dn0 < 2560 ? dn0 + 8 : dn0 + 16);
                    p0_transpose_item(w_in, NIN, 1024, Win_t, sn0, dn0, 64 * kb, scr, lane); continue; }
                q -= I_IN;
                { const int which = q / I_SQ, rr = q % I_SQ, kb = rr >> 5, nb = rr & 31;
                  const float* W = which == 0 ? w_out : (which == 1 ? w_xq : w_xo); bf16* WT = which == 0 ? Wout_t : (which == 1 ? Wxq_t : Wxo_t);
                  p0_transpose_item(W, 1024, 1024, WT, 32 * nb, 32 * nb, 64 * kb, scr, lane); }
            }
        }
        if (BOTH(0)) GRID_BAR();
    }

    if (IN(1)) {
        pg8::StaticSched S; S.init(XB, Win_t, M, NU, D, G, bx);
        pg8::EpiBf16 E{U, NU, nullptr, 0};
        pg8::gemm_phase<pg8::EpiBf16, pg8::StaticSched, false, true>(lds, D, S, E);
        if (BOTH(1)) GRID_BAR();
    }

    if (IN(2)) {
        for (int u = bx; u < 256; u += G) m1_unit(u >> 4, u & 15, U, Gt, conv_w, Mq, Mk, KvT, Nc, Gc, Mloc, lds);
        __syncthreads();
        for (int sq = bx; sq < 32; sq += G) {
            const int b8 = sq >> 3, h8 = sq & 7; LAS float* wt = (LAS float*)lds;
            float v[8]; float run = 0.f;
#pragma unroll
            for (int i = 0; i < 8; ++i) { run += Gt[(size_t)(b8 * SEQ + 8 * tid + i) * 16 + h8]; v[i] = run; }
            const float incl = wave_scan_add(run, lane);
            if (lane == 63) wt[wave] = incl;
            __syncthreads();
            float off = incl - run;
            for (int w = 0; w < wave; ++w) off += wt[w];
#pragma unroll
            for (int i = 0; i < 8; ++i) Fc2[(size_t)sq * SEQ + 8 * tid + i] = -(off + v[i]) * LOG2E;
            __syncthreads();
        }
        if (BOTH(2)) GRID_BAR();
    }

    if (IN(3)) {
        LAS float* sg = (LAS float*)lds;
        for (int ch = bx; ch < 256; ch += G) {
            const int bh = ch >> 4, part = ch & 15, idx = 512 * part + tid;
            __syncthreads();
            if (tid < 64) { sg[tid] = Gc[bh * 64 + tid]; sg[64 + tid] = Mloc[bh * 64 + tid]; }
            __syncthreads();
            if (tid == 0) { float mm = 0.f;
                for (int c = 0; c < 64; ++c) { const float g = sg[c], mc = sg[64 + c]; if (part == 0) Mp[bh * 64 + c] = mm; const float mn = fmaxf(g + mm, mc); sg[128 + c] = expf(g + mm - mn); sg[192 + c] = expf(mc - mn); mm = mn; } }
            __syncthreads();
            float C = 0.f;
            const float* kp = KvT + (size_t)bh * 64 * 8192 + idx; bf16* cp = CpT + (size_t)bh * 64 * 8192 + idx;
#pragma unroll 8
            for (int c = 0; c < 64; ++c) { cp[(size_t)c * 8192] = (bf16)(pk2(C, 0.f) & 0xffffu); C = sg[128 + c] * C + sg[192 + c] * kp[(size_t)c * 8192]; }
            if (part == 0 && tid < 64) { float n = 0.f;
#pragma unroll 8
                for (int c = 0; c < 64; ++c) { Np[(size_t)(bh * 64 + c) * 64 + tid] = n; n = sg[128 + c] * n + sg[192 + c] * Nc[(size_t)(bh * 64 + c) * 64 + tid]; } }
        }
        if (BOTH(3)) GRID_BAR();
    }

    if (IN(4)) {
        for (int pr = vcu; pr < 256; pr += G) { const int bh8 = pr >> 3, s = pr & 7;
            fox_unit(bh8 >> 3, bh8 & 7, 15 - s, U, Fc2, fox_g, MIX, lds);
            fox_unit(bh8 >> 3, bh8 & 7, s, U, Fc2, fox_g, MIX, lds); }
        for (int u = bx; u < 256; u += G) m3_unit(u >> 4, u & 15, U, Gt, Mq, Mk, CpT, Np, Mp, mlstm_g, MIX, lds);
        if (BOTH(4)) GRID_BAR();
    }

    if (IN(5)) {
        pg8::StaticSched S; S.init(MIX, Wout_t, M, D, D, G, bx);
        pg8::EpiResF32 E{x, Y1, D, ALPHA};
        pg8::gemm_phase<pg8::EpiResF32, pg8::StaticSched, false, false>(lds, D, S, E);
        if (BOTH(5)) GRID_BAR();
    }

    if (IN(6)) {
        for (int m = bx * 8 + wave; m < M; m += G * 8) {
            f32x4* yr = (f32x4*)(Y1 + (size_t)m * D) + lane; f32x4 v[4];
#pragma unroll
            for (int j = 0; j < 4; ++j) v[j] = yr[64 * j];
            ln_row(v, ln1_g, ln1_b, lane);
#pragma unroll
            for (int j = 0; j < 4; ++j) yr[64 * j] = v[j];
            store_row_bf16(X1B + (size_t)m * D, v, lane);
        }
        if (BOTH(6)) GRID_BAR();
    }

    if (IN(7)) {
        pg8::StaticSched S; S.init(X1B, Wxq_t, M, D, D, G, bx);
        pg8::EpiBf16 E{QX, D, nullptr, 0};
        pg8::gemm_phase<pg8::EpiBf16, pg8::StaticSched, false, false>(lds, D, S, E);
        if (BOTH(7)) GRID_BAR();
    }

    if (IN(8)) {
        for (int u = vcu; u < 256; u += G) xattn_unit(u >> 6, (u >> 4) & 3, u & 15, QX, KVx, lds);
        if (BOTH(8)) GRID_BAR();
    }

    if (IN(9)) {
        pg8::StaticSched S; S.init(QX, Wxo_t, M, D, D, G, bx);
        pg8::EpiResF32 E{Y1, Y2, D, ALPHA};
        pg8::gemm_phase<pg8::EpiResF32, pg8::StaticSched, false, false>(lds, D, S, E);
        if (BOTH(9)) GRID_BAR();
    }

    if (IN(10)) {
        LAS float* wrT = (LAS float*)lds;
        LAS int* hist = (LAS int*)(lds + RT_OFF); LAS int* ebase = hist + 32; LAS int* tokE = hist + 64; LAS int* tokR = hist + 320;
        __syncthreads();
        for (int idx = tid; idx < 1024 * 8; idx += 512) { const int k = idx >> 3, e4 = (idx & 7) * 4; const f32x4 w = *(const f32x4*)(w_router + k * 32 + e4);
            wrT[(e4 + 0) * 1024 + k] = w.x; wrT[(e4 + 1) * 1024 + k] = w.y; wrT[(e4 + 2) * 1024 + k] = w.z; wrT[(e4 + 3) * 1024 + k] = w.w; }
        if (tid < 32) hist[tid] = 0;
        __syncthreads();
        for (int grp = bx; grp < M / 64; grp += G) {
            for (int tl = wave; tl < 64; tl += 8) {
                const int tok = grp * 64 + tl;
                f32x4* yr = (f32x4*)(Y2 + (size_t)tok * D) + lane; f32x4 v[4];
#pragma unroll
                for (int j = 0; j < 4; ++j) v[j] = yr[64 * j];
                ln_row(v, ln2_g, ln2_b, lane);
#pragma unroll
                for (int j = 0; j < 4; ++j) yr[64 * j] = v[j];
                store_row_bf16(X2B + (size_t)tok * D, v, lane);
                float acc[32];
#pragma unroll
                for (int e = 0; e < 32; ++e) { float a = 0.f;
#pragma unroll
                    for (int j = 0; j < 4; ++j) { const f32x4 w = *(const LAS f32x4*)(wrT + e * 1024 + 256 * j + 4 * lane); a += (v[j].x * w.x + v[j].y * w.y) + (v[j].z * w.z + v[j].w * w.w); }
                    acc[e] = a; }
#define TR_STEP(HALFN, XORM) { const bool up = (lane & (XORM)) != 0; _Pragma("unroll") for (int i = 0; i < (HALFN); ++i) { const float keep = up ? acc[(HALFN) + i] : acc[i], send = up ? acc[i] : acc[(HALFN) + i]; acc[i] = keep + __shfl_xor(send, (XORM)); } }
                TR_STEP(16, 16) TR_STEP(8, 8) TR_STEP(4, 4) TR_STEP(2, 2) TR_STEP(1, 1)
#undef TR_STEP
                float lg = acc[0] + __shfl_xor(acc[0], 32);
                lg += b_router[lane & 31];
                float tv[4]; int ti[4]; float cur = lg;
#pragma unroll
                for (int k = 0; k < 4; ++k) {
                    float bv = cur; int bi = lane & 31;
#pragma unroll
                    for (int o = 1; o < 32; o <<= 1) { const float ov = __shfl_xor(bv, o); const int oi = __shfl_xor(bi, o); if (ov > bv || (ov == bv && oi < bi)) { bv = ov; bi = oi; } }
                    tv[k] = bv; ti[k] = bi; if ((lane & 31) == bi) cur = -INFINITY;
                }
                const float e1 = expf(tv[1] - tv[0]), e2 = expf(tv[2] - tv[0]), e3 = expf(tv[3] - tv[0]); const float isum = 1.f / (1.f + e1 + e2 + e3);
                if (lane == 0) {
                    const float gs[4] = {isum, e1 * isum, e2 * isum, e3 * isum};
#pragma unroll
                    for (int k = 0; k < 4; ++k) { const int rk = atomicAdd((int*)&hist[ti[k]], 1); tokE[tl * 4 + k] = ti[k]; tokR[tl * 4 + k] = rk; Tidx[tok * 4 + k] = ti[k]; Tgate[tok * 4 + k] = gs[k]; }
                }
            }
            __syncthreads();
            if (tid < 32) { const int c = hist[tid]; ebase[tid] = c ? (int)__hip_atomic_fetch_add(ctl + CW_CNT + 64 * tid, (unsigned)c, RLX_AGENT) : 0; hist[tid] = 0; }
            __syncthreads();
            if (tid < 256) { const int tl = tid >> 2, e = tokE[tid], slot = ebase[e] + tokR[tid]; List[(size_t)e * LCAP + slot] = grp * 64 + tl; Tslot[(grp * 64 + tl) * 4 + (tid & 3)] = slot; }
            __syncthreads();
        }
        if (BOTH(10)) GRID_BAR();
    }

    if (IN(11)) {
        LAS int* tb = (LAS int*)(lds + MOE_TB_OFF);
        moe_tables(tb, ctl, tid);
        pg8::MoeSched S; S.A = (const char*)X2B; S.B = (const char*)Wgu_t; S.list = List; S.tb = tb; S.K = D; S.NT = 8; S.nwg = tb[32] * 8; S.G = G; S.c = bx; S.bexp = (size_t)2048 * 1024 * 2; S.gather = true;
        pg8::EpiSwiglu E{HID, b_gu};
        pg8::gemm_phase<pg8::EpiSwiglu, pg8::MoeSched, true, true>(lds, D, S, E);
        if (BOTH(11)) GRID_BAR();
    }

    if (IN(12)) {
        LAS int* tb = (LAS int*)(lds + MOE_TB_OFF);
        moe_tables(tb, ctl, tid);
        pg8::MoeSched S; S.A = (const char*)HID; S.B = (const char*)Wdn_t; S.list = List; S.tb = tb; S.K = D; S.NT = 4; S.nwg = tb[32] * 4; S.G = G; S.c = bx; S.bexp = (size_t)1024 * 1024 * 2; S.gather = false;
        pg8::EpiBf16 E{YB, D, b_dn, 1024};
        pg8::gemm_phase<pg8::EpiBf16, pg8::MoeSched, false, true>(lds, D, S, E);
        if (BOTH(12)) GRID_BAR();
    }

    if (IN(13)) {
        LAS int* tb = (LAS int*)(lds + MOE_TB_OFF);
        moe_tables(tb, ctl, tid);
        for (int m = bx * 8 + wave; m < M; m += G * 8) {
            const f32x4* xr = (const f32x4*)(Y2 + (size_t)m * D) + lane; f32x4 v[4];
#pragma unroll
            for (int j = 0; j < 4; ++j) v[j] = xr[64 * j] * ALPHA;
#pragma unroll
            for (int k = 0; k < 4; ++k) {
                const int e = Tidx[m * 4 + k], slot = Tslot[m * 4 + k]; const float gk = Tgate[m * 4 + k];
                const u32x2* yr = (const u32x2*)(YB + ((size_t)tb[e] * 256 + slot) * D) + lane;
#pragma unroll
                for (int j = 0; j < 4; ++j) { const u32x2 w = yr[64 * j]; v[j].x += gk * bf_lo(w.x); v[j].y += gk * bf_hi(w.x); v[j].z += gk * bf_lo(w.y); v[j].w += gk * bf_hi(w.y); }
            }
            ln_row(v, ln3_g, ln3_b, lane);
            f32x4* orow = (f32x4*)(out + (size_t)m * D) + lane;
#pragma unroll
            for (int j = 0; j < 4; ++j) orow[64 * j] = v[j];
        }
    }
#undef IN
#undef BOTH
#undef GRID_BAR
}

extern "C" void kernel_launch(void* const* d_in, const int* in_sizes, int n_in, void* d_out, int out_size, void* d_ws, size_t ws_size, hipStream_t stream) {
    static int grid = 0;
    if (grid == 0) {
        if (n_in != 26 || in_sizes[0] != M * D || out_size != M * D || ws_size < WS_END) { fprintf(stderr, "kernel_launch: unexpected shapes (n_in %d, in0 %d, out %d, ws %zu)\n", n_in, n_in > 0 ? in_sizes[0] : -1, out_size, ws_size); grid = -1; return; }
        int dev = 0, cus = 0, per_cu = 0;
        if (hipGetDevice(&dev) != hipSuccess || hipDeviceGetAttribute(&cus, hipDeviceAttributeMultiprocessorCount, dev) != hipSuccess) { grid = -1; return; }
        if (hipFuncSetAttribute((const void*)fwd, hipFuncAttributeMaxDynamicSharedMemorySize, LDS_BYTES) != hipSuccess) { fprintf(stderr, "kernel_launch: hipFuncSetAttribute failed\n"); grid = -1; return; }
        if (hipOccupancyMaxActiveBlocksPerMultiprocessor(&per_cu, (const void*)fwd, NWAVES * 64, LDS_BYTES) != hipSuccess || per_cu < 1) fprintf(stderr, "kernel_launch: occupancy query reports %d\n", per_cu);
        (void)hipGetLastError();
        grid = cus;
    }
    if (grid < 0) return;
    if (hipMemsetAsync((char*)d_ws + WS_CTL, 0, CTL_ZERO_BYTES, stream) != hipSuccess) return;
    Args a{};
    for (int i = 0; i < 26; ++i) a.in[i] = (const float*)d_in[i];
    a.out = (float*)d_out; a.ws = (unsigned char*)d_ws;
    if (N_LAUNCHES == 1) {
        a.ph_lo = 0; a.ph_hi = NPHASE; a.li = 0;
        hipLaunchKernelGGL(fwd, dim3(grid), dim3(NWAVES * 64), LDS_BYTES, stream, a);
    } else {
        for (int li = 0; li < NPHASE; ++li) { a.ph_lo = li; a.ph_hi = li + 1; a.li = li; hipLaunchKernelGGL(fwd, dim3(grid), dim3(NWAVES * 64), LDS_BYTES, stream, a); }
    }
}
```

```cpp
#include <hip/hip_runtime.h>
#include <cstdio>
#include <cstdint>
#include <cmath>

#define DI __device__ __forceinline__
#define LAS __attribute__((address_space(3)))
#define GAS __attribute__((address_space(1)))
typedef unsigned short bf16;
typedef short bf16x8 __attribute__((ext_vector_type(8)));
typedef short s16x4 __attribute__((ext_vector_type(4)));
typedef float f32x2 __attribute__((ext_vector_type(2)));
typedef float f32x4 __attribute__((ext_vector_type(4)));
typedef float f32x16 __attribute__((ext_vector_type(16)));
typedef unsigned u32x2 __attribute__((ext_vector_type(2)));
typedef unsigned u32x4 __attribute__((ext_vector_type(4)));
typedef GAS unsigned gu32;

#ifndef MK_N_LAUNCHES
#define MK_N_LAUNCHES 1
#endif

constexpr int BATCH = 4, SEQ = 4096, D = 1024, M = BATCH * SEQ, NMEM = 256;
constexpr int NIN = 3088;
constexpr int NU = 3072;
constexpr int UC_FQ = 0, UC_FK = 512, UC_FV = 1024, UC_MQ = 1536, UC_MK = 1792, UC_MV = 2048, UC_MO = 2560;
constexpr int NE = 32, TOPK = 4, LCAP = 16384;
constexpr int PROWS = M * TOPK + NE * 256;
constexpr float ALPHA = 1.189207115002721f;
constexpr float LOG2E = 1.4426950408889634f;
constexpr float LN_EPS = 1e-5f, RMS_EPS = 1e-6f;
constexpr int NPHASE = 14;
constexpr float WGU_SCALE = 32.f, WDN_SCALE = 64.f, X2_SCALE = 4.f, HID_SCALE = 4.f;
constexpr int N_LAUNCHES = MK_N_LAUNCHES;

constexpr size_t MiB = 1u << 20;
constexpr size_t WS_CTL = 0, CTL_ZERO_BYTES = 1 * MiB;
constexpr size_t WS_G = 1 * MiB;
constexpr size_t WS_FC2 = 2 * MiB;
constexpr size_t WS_GC = 2 * MiB + 512 * 1024;
constexpr size_t WS_NC = 3 * MiB;
constexpr size_t WS_NP = 3 * MiB + 256 * 1024;
constexpr size_t WS_TIDX = 3 * MiB + 512 * 1024;
constexpr size_t WS_TGATE = 3 * MiB + 768 * 1024;
constexpr size_t WS_TSLOT = 4 * MiB;
constexpr size_t WS_LIST = 5 * MiB;
constexpr size_t WS_MEMKV = 8 * MiB;
constexpr size_t WS_WIN = 16 * MiB, WS_WOUT = 22 * MiB, WS_WXQ = 24 * MiB, WS_WXO = 26 * MiB;
constexpr size_t WS_WGU = 32 * MiB, WS_WDN = 160 * MiB;
constexpr size_t WS_XB = 224 * MiB;
constexpr size_t WS_U = 256 * MiB;
constexpr size_t WS_MQ = 352 * MiB, WS_MK = 360 * MiB;
constexpr size_t WS_KVT = 368 * MiB;
constexpr size_t WS_CPT = 400 * MiB;
constexpr size_t WS_MIX = 432 * MiB;
constexpr size_t WS_Y1 = 464 * MiB;
constexpr size_t WS_X1B = 528 * MiB;
constexpr size_t WS_QX = 560 * MiB;
constexpr size_t WS_Y2 = 596 * MiB;
constexpr size_t WS_X2B = 660 * MiB;
constexpr size_t WS_HID = 692 * MiB;
constexpr size_t WS_YB = 836 * MiB;
constexpr size_t WS_END = 980 * MiB;
constexpr int CW_TMO = 0, CW_CODE = 1;
constexpr int CW_CNT = 1024;
constexpr int CW_BAR = 4096;

constexpr int RING_BYTES = 131072;
constexpr int LDSCTL_OFF = RING_BYTES, MISC_OFF = LDSCTL_OFF + 320;
constexpr int MOE_TB_OFF = LDSCTL_OFF + 1024;
constexpr int RT_OFF = LDSCTL_OFF + 2048;
constexpr int LDS_BYTES = 147456;
constexpr int NWAVES = 8;

#define RLX_AGENT __ATOMIC_RELAXED, __HIP_MEMORY_SCOPE_AGENT
DI float bf_lo(unsigned u) { return __uint_as_float(u << 16); }
DI float bf_hi(unsigned u) { return __uint_as_float(u & 0xffff0000u); }
DI float bf2f(short s) { return __uint_as_float(((unsigned)(unsigned short)s) << 16); }
typedef __bf16 bf16x2_t __attribute__((ext_vector_type(2)));
DI unsigned pk2(float lo, float hi) { f32x2 v = {lo, hi}; bf16x2_t b = __builtin_convertvector(v, bf16x2_t); return __builtin_bit_cast(unsigned, b); }
DI float wave_sum(float v) {
#pragma unroll
    for (int o = 1; o < 64; o <<= 1) v += __shfl_xor(v, o);
    return v;
}
DI float wave_max(float v) {
#pragma unroll
    for (int o = 1; o < 64; o <<= 1) v = fmaxf(v, __shfl_xor(v, o));
    return v;
}
DI float wave_scan_add(float v, int lane) {
#pragma unroll
    for (int o = 1; o < 64; o <<= 1) { const float t = __shfl_up(v, o); if (lane >= o) v += t; }
    return v;
}
DI float wave_scan_max(float v, int lane) {
#pragma unroll
    for (int o = 1; o < 64; o <<= 1) { const float t = __shfl_up(v, o); if (lane >= o) v = fmaxf(v, t); }
    return v;
}
DI float xhalf_sum(float v) { return v + __shfl_xor(v, 32); }
DI float xhalf_max(float v) { return fmaxf(v, __shfl_xor(v, 32)); }
DI float ex2(float x) { return __builtin_amdgcn_exp2f(x); }
DI float exp_fast(float x) { return __builtin_amdgcn_exp2f(x * LOG2E); }
DI float sigmoid_fast(float x) { return __builtin_amdgcn_rcpf(1.f + exp_fast(-x)); }
DI float log_sigmoid_acc(float x) { return fminf(x, 0.f) - log1pf(expf(-fabsf(x))); }
DI f32x16 mfma32(bf16x8 a, bf16x8 b, f32x16 c) { return __builtin_amdgcn_mfma_f32_32x32x16_bf16(a, b, c, 0, 0, 0); }
DI f32x4 mfma16(bf16x8 a, bf16x8 b, f32x4 c) { return __builtin_amdgcn_mfma_f32_16x16x32_bf16(a, b, c, 0, 0, 0); }
typedef short v4i16_t __attribute__((ext_vector_type(4)));
DI s16x4 tr_read(const LAS unsigned char* p) { return __builtin_bit_cast(s16x4, __builtin_amdgcn_ds_read_tr16_b64_v4i16((LAS v4i16_t*)p)); }
DI bf16x8 cat8(s16x4 lo, s16x4 hi) { return __builtin_shufflevector(lo, hi, 0, 1, 2, 3, 4, 5, 6, 7); }
typedef int v8i32 __attribute__((ext_vector_type(8)));
typedef int v4i32 __attribute__((ext_vector_type(4)));
DI unsigned pk4_fp8(float a, float b, float c, float d) { int w = 0; w = __builtin_amdgcn_cvt_pk_fp8_f32(a, b, w, false); w = __builtin_amdgcn_cvt_pk_fp8_f32(c, d, w, true); return (unsigned)w; }
DI int crow(int r, int hi) { return (r & 3) + 8 * (r >> 2) + 4 * hi; }
DI bf16x8 pack8(const f32x16& x, int s) {
    u32x4 p;
    p.x = pk2(x[8 * s + 0], x[8 * s + 1]); p.y = pk2(x[8 * s + 2], x[8 * s + 3]); p.z = pk2(x[8 * s + 4], x[8 * s + 5]); p.w = pk2(x[8 * s + 6], x[8 * s + 7]);
    return __builtin_bit_cast(bf16x8, p);
}

namespace pg8 {
constexpr int BM = 256, BK = 64, HALF = 128, HTB = HALF * BK * 2, STAGE_BYTES = 8 * HTB, NXCD = 8, WGM = 8;
__host__ __device__ __forceinline__ int lds_byte(int r, int c) { const int st = (r >> 4) * 2 + (c >> 5), rr = r & 15, cc = c & 31, ob = rr * 64 + cc * 2; return st * 1024 + (ob ^ (((ob >> 9) & 1) << 5)); }
__host__ __device__ __forceinline__ void stage_rc(int b, int& R, int& C) { const int st = b / 1024, sb = b % 1024, swz = sb ^ (((sb >> 9) & 1) << 5); R = (st >> 1) * 16 + swz / 64; C = (st & 1) * 32 + (swz % 64) / 2; }
__host__ __device__ __forceinline__ int perm32(int rho) { const int n = rho >> 4, i = rho & 15; return 8 * (i >> 2) + 4 * n + (i & 3); }

struct Unit { int pm, pn, e, nvalid; const char* A; const char* B; const int* list; };

struct StaticSched {
    const char* A; const char* B; int K, nM, nN, nwg, G, c;
    DI void init(const void* A_, const void* B_, int M_, int N_, int K_, int G_, int c_) { A = (const char*)A_; B = (const char*)B_; K = K_; nM = M_ / BM; nN = N_ / BM; nwg = nM * nN; G = G_; c = c_; }
    DI bool next(int i, Unit& u) const {
        const long L = (long)i * G + c; if (L >= nwg) return false;
        int wgid = (int)L; { const int q = nwg / NXCD, r = nwg % NXCD, xcd = wgid % NXCD, off = wgid / NXCD; wgid = (xcd < r ? xcd * (q + 1) : r * (q + 1) + (xcd - r) * q) + off; }
        const int nig = WGM * nN, gid = wgid / nig, fm = gid * WGM, gsz = (nM - fm) < WGM ? (nM - fm) : WGM;
        u.pm = fm + ((wgid % nig) % gsz); u.pn = (wgid % nig) / gsz; u.e = 0; u.nvalid = BM; u.list = nullptr;
        u.A = A + (size_t)u.pm * BM * K * 2; u.B = B + (size_t)u.pn * BM * K * 2; return true;
    }
};
struct MoeSched {
    const char* A; const char* B; const int* list; const LAS int* tb; int K, NT, nwg, G, c; size_t bexp; bool gather;
    DI bool next(int i, Unit& u) const {
        const long L = (long)i * G + c; if (L >= nwg) return false;
        int wgid = (int)L; { const int q = nwg / NXCD, r = nwg % NXCD, xcd = wgid % NXCD, off = wgid / NXCD; wgid = (xcd < r ? xcd * (q + 1) : r * (q + 1) + (xcd - r) * q) + off; }
        const int g = wgid / NT, nt = wgid % NT;
        int e = 0;
#pragma unroll
        for (int j = 1; j < 32; ++j) e += (tb[j] <= g) ? 1 : 0;
        e = __builtin_amdgcn_readfirstlane(e);
        const int mt = g - __builtin_amdgcn_readfirstlane(tb[e]);
        u.pm = g; u.pn = nt; u.e = e; u.nvalid = __builtin_amdgcn_readfirstlane(tb[40 + e]) - mt * BM; u.list = list + (size_t)e * LCAP + mt * BM;
        u.A = gather ? A : A + (size_t)g * BM * K * 2; u.B = B + (size_t)e * bexp + (size_t)nt * BM * K * 2; return true;
    }
};

template <bool GATHER> DI void a_offsets(const Unit& u, int K, unsigned (&v)[2][2]) {
    int R[2], C[2];
#pragma unroll
    for (int i = 0; i < 2; ++i) stage_rc((int)threadIdx.x * 16 + i * 8192, R[i], C[i]);
#pragma unroll
    for (int h = 0; h < 2; ++h)
#pragma unroll
        for (int i = 0; i < 2; ++i) {
            const int row = h * HALF + R[i];
            if constexpr (GATHER) { const int rc = row < u.nvalid ? row : u.nvalid - 1; const int tok = u.list[rc]; v[h][i] = (unsigned)(tok * K + C[i]) * 2u; }
            else v[h][i] = (unsigned)(row * K + C[i]) * 2u;
        }
}

struct EpiBf16 {
    static constexpr bool PERM = true;
    bf16* O; int ldc; const float* bias; int bias_estride; float scale;
    DI void operator()(const f32x4 (&acc)[2][2][4][2], const Unit& u, int wr, int wc, int fr, int fq) const {
        const int row0 = u.pm * BM + wr * 64 + fr; const int col0 = u.pn * BM + wc * 32 + 8 * fq;
        f32x4 bv[2][2];
#pragma unroll
        for (int bj = 0; bj < 2; ++bj)
#pragma unroll
            for (int n = 0; n < 2; ++n) bv[bj][n] = bias ? *(const f32x4*)(bias + (size_t)u.e * bias_estride + col0 + bj * HALF + 4 * n) : (f32x4){0.f, 0.f, 0.f, 0.f};
#pragma unroll
        for (int ai = 0; ai < 2; ++ai)
#pragma unroll
            for (int m = 0; m < 4; ++m) { bf16* rowp = O + (size_t)(row0 + ai * HALF + m * 16) * ldc + col0;
#pragma unroll
                for (int bj = 0; bj < 2; ++bj) { const f32x4 v0 = acc[ai][bj][m][0] * scale + bv[bj][0], v1 = acc[ai][bj][m][1] * scale + bv[bj][1];
                    u32x4 w; w.x = pk2(v0[0], v0[1]); w.y = pk2(v0[2], v0[3]); w.z = pk2(v1[0], v1[1]); w.w = pk2(v1[2], v1[3]);
                    *(u32x4*)(rowp + bj * HALF) = w; } }
    }
};
struct EpiResF32 {
    static constexpr bool PERM = false;
    const float* base; float* out; int ldc; float alpha;
    DI void operator()(const f32x4 (&acc)[2][2][4][2], const Unit& u, int wr, int wc, int fr, int fq) const {
        const int col0 = u.pn * BM + wc * 32 + 4 * fq;
#pragma unroll
        for (int ai = 0; ai < 2; ++ai)
#pragma unroll
            for (int m = 0; m < 4; ++m) { const size_t off = (size_t)(u.pm * BM + ai * HALF + wr * 64 + m * 16 + fr) * ldc + col0;
#pragma unroll
                for (int bj = 0; bj < 2; ++bj)
#pragma unroll
                    for (int n = 0; n < 2; ++n) { const f32x4 bs = *(const f32x4*)(base + off + bj * HALF + n * 16); *(f32x4*)(out + off + bj * HALF + n * 16) = bs * alpha + acc[ai][bj][m][n]; } }
    }
};
struct EpiSwiglu {
    static constexpr bool PERM = true;
    unsigned char* O; const float* bias; float scale, oscale;
    DI void operator()(const f32x4 (&acc)[2][2][4][2], const Unit& u, int wr, int wc, int fr, int fq) const {
        const int row0 = u.pm * BM + wr * 64 + fr; const int j0 = wc * 32 + 8 * fq; const int col0 = u.pn * HALF + j0;
        const float* bg = bias + (size_t)u.e * 2048 + col0; const float* bl = bg + 1024;
        f32x4 bgv[2], blv[2];
#pragma unroll
        for (int n = 0; n < 2; ++n) { bgv[n] = *(const f32x4*)(bg + 4 * n); blv[n] = *(const f32x4*)(bl + 4 * n); }
#pragma unroll
        for (int ai = 0; ai < 2; ++ai)
#pragma unroll
            for (int m = 0; m < 4; ++m) { unsigned char* rowp = O + (size_t)(row0 + ai * HALF + m * 16) * 1024 + col0;
                float o[8];
#pragma unroll
                for (int n = 0; n < 2; ++n) { const f32x4 g = acc[ai][0][m][n] * scale + bgv[n], l = acc[ai][1][m][n] * scale + blv[n];
#pragma unroll
                    for (int q = 0; q < 4; ++q) { const float gg = fminf(g[q], 7.0f), ll = fminf(fmaxf(l[q], -7.0f), 7.0f);
                        o[4 * n + q] = gg * __builtin_amdgcn_rcpf(1.f + ex2(gg * (-1.702f * LOG2E))) * (ll + 1.f) * oscale; } }
                u32x2 w; w.x = pk4_fp8(o[0], o[1], o[2], o[3]); w.y = pk4_fp8(o[4], o[5], o[6], o[7]);
                *(u32x2*)rowp = w; }
    }
};

template <class Epi, class Sched, bool GATHER, bool ALIGN_EPI, bool FP8 = false>
DI void gemm_phase(LAS unsigned char* lds, const int K, const Sched& S, const Epi& E) {
    const int tid = threadIdx.x, wid = __builtin_amdgcn_readfirstlane(tid >> 6), lane = tid & 63, wr = wid >> 2, wc = wid & 3, fr = lane & 15, fq = lane >> 4;
    const int nt = K / BK;
    unsigned voffB[2];
#pragma unroll
    for (int i = 0; i < 2; ++i) { int R, C; stage_rc(tid * 16 + i * 8192, R, C); const int Rb = Epi::PERM ? ((R & ~31) + perm32(R & 31)) : R; voffB[i] = (unsigned)(Rb * K + C) * 2u; }
    const size_t kstep = (size_t)(BK * 2);
    const size_t hstep = (size_t)HALF * K * 2;
    const unsigned ldsw = (unsigned)wid * 1024u;
    const int aoff = lds_byte(wr * 64 + fr, fq * 8), boff = lds_byte(wc * 32 + fr, fq * 8);
#define PG8_SA(b, h) (((b) * 2 + (h)) * HTB)
#define PG8_SB(b, h) ((4 + (b) * 2 + (h)) * HTB)
#define PG8_STAGE(bufoff, gbase, voff) do { _Pragma("unroll") for (int _i = 0; _i < 2; ++_i) { unsigned _o = (voff)[_i]; asm volatile("" : "+v"(_o));   \
        __builtin_amdgcn_global_load_lds((const unsigned*)((const char*)(gbase) + _o), (LAS unsigned*)(lds + (bufoff) + ldsw + _i * 8192), 16, 0, 0); } } while (0)
#define PG8_LDA(dst, b, h) do { _Pragma("unroll") for (int m = 0; m < 4; ++m) _Pragma("unroll") for (int k = 0; k < 2; ++k) dst[m][k] = *(const LAS bf16x8*)(lds + PG8_SA(b, h) + aoff + m * 2048 + k * 1024); } while (0)
#define PG8_LDB(dst, b, h) do { _Pragma("unroll") for (int n = 0; n < 2; ++n) _Pragma("unroll") for (int k = 0; k < 2; ++k) dst[n][k] = *(const LAS bf16x8*)(lds + PG8_SB(b, h) + boff + n * 2048 + k * 1024); } while (0)
#define PG8_CAT(x) __builtin_shufflevector(__builtin_bit_cast(v4i32, x[0]), __builtin_bit_cast(v4i32, x[1]), 0, 1, 2, 3, 4, 5, 6, 7)
#define PG8_MMA(ai, bj, At, Bt) do { __builtin_amdgcn_s_setprio(1); _Pragma("unroll") for (int m = 0; m < 4; ++m) _Pragma("unroll") for (int n = 0; n < 2; ++n) { \
        if constexpr (FP8) { const v8i32 _a = PG8_CAT(Bt[n]), _b = PG8_CAT(At[m]); asm volatile("v_mfma_scale_f32_16x16x128_f8f6f4 %0, %1, %2, %0, %3, %3 op_sel_hi:[0,0,0]" : "+v"(acc[ai][bj][m][n]) : "v"(_a), "v"(_b), "v"(sc1)); } \
        else { _Pragma("unroll") for (int k = 0; k < 2; ++k) acc[ai][bj][m][n] = __builtin_amdgcn_mfma_f32_16x16x32_bf16(Bt[n][k], At[m][k], acc[ai][bj][m][n], 0, 0, 0); } } __builtin_amdgcn_s_setprio(0); } while (0)
#define PG8_WAIT_V(n) asm volatile("s_waitcnt vmcnt(" #n ")" ::: "memory")
#define PG8_WAIT_L(n) asm volatile("s_waitcnt lgkmcnt(" #n ")" ::: "memory")
#define PG8_BAR __builtin_amdgcn_s_barrier()
#define PG8_SCHED __builtin_amdgcn_sched_barrier(0)
    Unit cur, nxt; int ui = 0;
    if (!S.next(0, cur)) return;
    const int sc1 = 0x7f7f7f7f;
    unsigned vAc[2][2], vAn[2][2];
    a_offsets<GATHER>(cur, K, vAc);
    f32x4 acc[2][2][4][2];
#pragma unroll
    for (int a = 0; a < 2; ++a)
#pragma unroll
        for (int b = 0; b < 2; ++b)
#pragma unroll
            for (int m = 0; m < 4; ++m)
#pragma unroll
                for (int n = 0; n < 2; ++n) acc[a][b][m][n] = (f32x4){0.f, 0.f, 0.f, 0.f};
    bf16x8 At[4][2], B0[2][2], B1[2][2];
    const char* cA = cur.A; const char* cB = cur.B;
    PG8_STAGE(PG8_SB(0, 0), cB, voffB); PG8_STAGE(PG8_SB(0, 1), cB + hstep, voffB); PG8_STAGE(PG8_SA(0, 0), cA, vAc[0]); PG8_STAGE(PG8_SA(0, 1), cA, vAc[1]);
    if (wr == 1) PG8_BAR;
    PG8_WAIT_V(2); PG8_BAR;
    PG8_STAGE(PG8_SB(1, 0), cB + kstep, voffB); PG8_STAGE(PG8_SA(1, 0), cA + kstep, vAc[0]); PG8_STAGE(PG8_SB(1, 1), cB + hstep + kstep, voffB);
    PG8_WAIT_V(6); PG8_BAR;
    for (;;) {
        const bool has_next = S.next(ui + 1, nxt);
        if constexpr (GATHER) {
            if (has_next) a_offsets<GATHER>(nxt, K, vAn);
            else {
#pragma unroll
                for (int h = 0; h < 2; ++h)
#pragma unroll
                    for (int i = 0; i < 2; ++i) vAn[h][i] = vAc[h][i]; }
        }
        const char* nA = has_next ? nxt.A : cA; const char* nB = has_next ? nxt.B : cB;
#pragma unroll 1
        for (int t = 0; t < nt; t += 2) {
            const bool last = (t == nt - 2);
            const char* a1 = cA + (size_t)(t + 1) * kstep;
            const char* a2 = last ? nA : cA + (size_t)(t + 2) * kstep; const char* b2 = last ? nB : cB + (size_t)(t + 2) * kstep;
            const char* a3 = a2 + kstep; const char* b3 = b2 + kstep;
            unsigned v2[2][2];
#pragma unroll
            for (int h = 0; h < 2; ++h)
#pragma unroll
                for (int i = 0; i < 2; ++i) v2[h][i] = GATHER ? (last ? vAn[h][i] : vAc[h][i]) : vAc[h][i];
            PG8_LDB(B0, 0, 0); PG8_LDB(B1, 0, 1); PG8_SCHED; PG8_LDA(At, 0, 0); PG8_STAGE(PG8_SA(1, 1), a1, vAc[1]);
            PG8_WAIT_V(8); PG8_WAIT_L(0); PG8_BAR; PG8_MMA(0, 0, At, B0); PG8_MMA(0, 1, At, B1); PG8_BAR; PG8_SCHED;
            PG8_LDA(At, 0, 1); PG8_STAGE(PG8_SB(0, 0), b2, voffB); PG8_STAGE(PG8_SB(0, 1), b2 + hstep, voffB); PG8_STAGE(PG8_SA(0, 0), a2, v2[0]);
            PG8_WAIT_V(8); PG8_WAIT_L(0); PG8_BAR; PG8_MMA(1, 0, At, B0); PG8_MMA(1, 1, At, B1); PG8_BAR; PG8_SCHED;
            PG8_LDB(B0, 1, 0); PG8_LDB(B1, 1, 1); PG8_SCHED; PG8_LDA(At, 1, 0); PG8_STAGE(PG8_SA(0, 1), a2, v2[1]);
            PG8_WAIT_V(8); PG8_WAIT_L(0); PG8_BAR; PG8_MMA(0, 0, At, B0); PG8_MMA(0, 1, At, B1); PG8_BAR; PG8_SCHED;
            PG8_LDA(At, 1, 1); PG8_STAGE(PG8_SB(1, 0), b3, voffB); PG8_STAGE(PG8_SB(1, 1), b3 + hstep, voffB); PG8_STAGE(PG8_SA(1, 0), a3, v2[0]);
            PG8_WAIT_V(8); PG8_WAIT_L(0); PG8_BAR; PG8_MMA(1, 0, At, B0); PG8_MMA(1, 1, At, B1); PG8_BAR; PG8_SCHED;
        }
        if constexpr (FP8) asm volatile("s_nop 15\n\ts_nop 15" ::: "memory");
        if constexpr (ALIGN_EPI) { if (wr == 0) PG8_BAR; }
        E(acc, cur, wr, wc, fr, fq);
        if (!has_next) break;
#pragma unroll
        for (int a = 0; a < 2; ++a)
#pragma unroll
            for (int b = 0; b < 2; ++b)
#pragma unroll
                for (int m = 0; m < 4; ++m)
#pragma unroll
                    for (int n = 0; n < 2; ++n) acc[a][b][m][n] = (f32x4){0.f, 0.f, 0.f, 0.f};
        cur = nxt; cA = nA; cB = nB; ++ui;
        if constexpr (GATHER) {
#pragma unroll
            for (int h = 0; h < 2; ++h)
#pragma unroll
                for (int i = 0; i < 2; ++i) vAc[h][i] = vAn[h][i]; }
        if constexpr (ALIGN_EPI) { if (wr == 1) PG8_BAR; }
    }
    PG8_WAIT_V(0);
    if constexpr (!ALIGN_EPI) { if (wr == 0) PG8_BAR; }
    PG8_BAR;
#undef PG8_SA
#undef PG8_SB
#undef PG8_STAGE
#undef PG8_LDA
#undef PG8_LDB
#undef PG8_MMA
#undef PG8_CAT
#undef PG8_WAIT_V
#undef PG8_WAIT_L
#undef PG8_BAR
#undef PG8_SCHED
}
}

#define XB_TMO      128
#define XB_XCNT(j)  (256  + 64 * (j))
#define XB_XSUB(j)  (1280 + 64 * (j))
#define XB_XGEN(j)  (2304 + 64 * (j))
#define XB_TOP      3328
#define XB_TOPGEN   3392
#define XCD_BAR_WORDS 3456
#define XB_SPIN_CAP (1u << 18)
DI unsigned xb_ld(unsigned* p)              { return __hip_atomic_load(p, __ATOMIC_RELAXED, __HIP_MEMORY_SCOPE_AGENT); }
DI unsigned xb_add(unsigned* p, unsigned v) { return __hip_atomic_fetch_add(p, v, __ATOMIC_RELAXED, __HIP_MEMORY_SCOPE_AGENT); }
DI unsigned xb_xcc_id() { return (unsigned)__builtin_amdgcn_s_getreg((3 << 11) | 20) & 0xFu; }
#define XB_SPIN(cond, bar) do { unsigned _sp = 0; while (cond) { __builtin_amdgcn_s_sleep(1); \
    if ((++_sp & 255u) == 0u) { if (xb_ld(&(bar)[XB_TMO])) break; if (_sp > XB_SPIN_CAP) { atomicAdd(&(bar)[XB_TMO], 1u); break; } } } } while (0)
struct XcdBarrier { unsigned* bar; unsigned x; volatile LAS unsigned* st; };
DI XcdBarrier xcd_barrier_post(unsigned* bar, volatile LAS unsigned* st) {
    XcdBarrier b; b.bar = bar; b.x = xb_xcc_id(); b.st = st;
    if (threadIdx.x == 0) (void)xb_add(&bar[XB_XCNT(b.x)], 1u);
    return b;
}
DI void xcd_barrier_complete(unsigned* bar, unsigned x, unsigned& nloc, unsigned& nx) {
    const unsigned G = gridDim.x * gridDim.y * gridDim.z;
    unsigned sum, cnt, mine, sp = 0u;
    for (;;) {
        sum = 0u; cnt = 0u; mine = 0u;
#pragma unroll
        for (unsigned j = 0; j < 16; ++j) { const unsigned c = xb_ld(&bar[XB_XCNT(j)]); sum += c; cnt += (c > 0u) ? 1u : 0u; mine = (j == x) ? c : mine; }
        if (sum == G) break;
        __builtin_amdgcn_s_sleep(1);
        if ((++sp & 255u) == 0u) { if (xb_ld(&bar[XB_TMO])) break; if (sp > XB_SPIN_CAP) { atomicAdd(&bar[XB_TMO], 1u); break; } }
    }
    nloc = mine > 0u ? mine : 1u; nx = cnt > 0u ? cnt : 1u;
}
DI void xcd_barrier(const XcdBarrier& b) {
    asm volatile("s_waitcnt vmcnt(0)" ::: "memory");
    __syncthreads();
    if (threadIdx.x == 0) {
        unsigned* bar = b.bar;
        __builtin_amdgcn_s_waitcnt(0);
        unsigned nloc = b.st[0], nx = b.st[1];
        if (nloc == 0u) { xcd_barrier_complete(bar, b.x, nloc, nx); b.st[0] = nloc; b.st[1] = nx; }
        const unsigned old = xb_add(&bar[XB_XSUB(b.x)], 1u);
        const unsigned gen = old / nloc;
        if (old + 1u == (gen + 1u) * nloc) {
            __builtin_amdgcn_fence(__ATOMIC_RELEASE, "agent");
            asm volatile("s_waitcnt vmcnt(0)" ::: "memory");
            const unsigned og = xb_add(&bar[XB_TOP], 1u);
            const unsigned tg = og / nx;
            if (og + 1u == (tg + 1u) * nx) xb_add(&bar[XB_TOPGEN], 1u);
            else XB_SPIN(xb_ld(&bar[XB_TOPGEN]) == tg, bar);
            __builtin_amdgcn_fence(__ATOMIC_ACQUIRE, "agent");
            xb_add(&bar[XB_XGEN(b.x)], 1u);
            asm volatile("s_waitcnt vmcnt(0)" ::: "memory");
        } else {
            XB_SPIN(xb_ld(&bar[XB_XGEN(b.x)]) == gen, bar);
            __builtin_amdgcn_fence(__ATOMIC_ACQUIRE, "agent");
            asm volatile("s_waitcnt vmcnt(0)" ::: "memory");
        }
    }
    __syncthreads();
}

DI void p0_transpose_item(const float* W, int ldw, int K, bf16* WT, int src_n0, int dst_n0, int k0, LAS float* scr, int lane) {
#pragma unroll 8
    for (int i = 0; i < 32; ++i) { const int kk = 2 * i + (lane >> 5); scr[kk * 33 + (lane & 31)] = W[(size_t)(k0 + kk) * ldw + src_n0 + (lane & 31)]; }
    asm volatile("s_waitcnt lgkmcnt(0)" ::: "memory");
    const int c = lane & 7;
#pragma unroll
    for (int j = 0; j < 4; ++j) { const int n = (lane >> 3) + 8 * j; const LAS float* s = scr + (8 * c) * 33 + n;
        u32x4 o; o.x = pk2(s[0 * 33], s[1 * 33]); o.y = pk2(s[2 * 33], s[3 * 33]); o.z = pk2(s[4 * 33], s[5 * 33]); o.w = pk2(s[6 * 33], s[7 * 33]);
        *(u32x4*)(WT + (size_t)(dst_n0 + n) * K + k0 + 8 * c) = o; }
    asm volatile("s_waitcnt lgkmcnt(0)" ::: "memory");
}

DI void p0_transpose_fp8(const float* W, int ldw, unsigned char* WT, int kbytes, int src_n0, int dst_n0, int k0, float scale, LAS unsigned* scr, int lane) {
    const int kq = lane >> 3, nq = lane & 7;
    f32x4 v[16];
#pragma unroll
    for (int i = 0; i < 16; ++i) { const int k = 32 * (i >> 2) + 4 * kq + (i & 3); v[i] = *(const f32x4*)(W + (size_t)(k0 + k) * ldw + src_n0 + 4 * nq); }
#pragma unroll
    for (int g = 0; g < 4; ++g)
#pragma unroll
        for (int c = 0; c < 4; ++c) scr[(4 * nq + c) * 33 + 8 * g + kq] = pk4_fp8(v[4 * g][c] * scale, v[4 * g + 1][c] * scale, v[4 * g + 2][c] * scale, v[4 * g + 3][c] * scale);
    asm volatile("s_waitcnt lgkmcnt(0)" ::: "memory");
    const int ch = lane & 7;
#pragma unroll
    for (int j = 0; j < 4; ++j) { const int n = (lane >> 3) + 8 * j; const LAS unsigned* s = scr + n * 33 + 4 * ch;
        u32x4 o; o.x = s[0]; o.y = s[1]; o.z = s[2]; o.w = s[3];
        *(u32x4*)(WT + (size_t)(dst_n0 + n) * kbytes + k0 + 16 * ch) = o; }
    asm volatile("s_waitcnt lgkmcnt(0)" ::: "memory");
}

DI void ln_row(f32x4 (&v)[4], const float* g, const float* bta, int lane) {
    float s = 0.f;
#pragma unroll
    for (int j = 0; j < 4; ++j) s += (v[j].x + v[j].y) + (v[j].z + v[j].w);
    const float mean = wave_sum(s) * (1.f / D); float s2 = 0.f;
#pragma unroll
    for (int j = 0; j < 4; ++j) { v[j] = v[j] - mean; s2 += (v[j].x * v[j].x + v[j].y * v[j].y) + (v[j].z * v[j].z + v[j].w * v[j].w); }
    const float rstd = 1.f / sqrtf(wave_sum(s2) * (1.f / D) + LN_EPS);
#pragma unroll
    for (int j = 0; j < 4; ++j) { const f32x4 gg = *(const f32x4*)(g + 4 * lane + 256 * j), bb = *(const f32x4*)(bta + 4 * lane + 256 * j); v[j] = v[j] * rstd * gg + bb; }
}
DI void store_row_bf16(bf16* orow, const f32x4 (&v)[4], int lane) {
    u32x2* o8 = (u32x2*)orow + lane;
#pragma unroll
    for (int j = 0; j < 4; ++j) { u32x2 w; w.x = pk2(v[j].x, v[j].y); w.y = pk2(v[j].z, v[j].w); o8[64 * j] = w; }
}

DI void store_row_fp8(unsigned char* orow, const f32x4 (&v)[4], float scale, int lane) {
    unsigned* o4 = (unsigned*)orow + lane;
#pragma unroll
    for (int j = 0; j < 4; ++j) o4[64 * j] = pk4_fp8(v[j].x * scale, v[j].y * scale, v[j].z * scale, v[j].w * scale);
}

DI void fox_unit(int b, int h8, int qb, const bf16* U, const float* Fc2, const float* fox_g, bf16* MIX, LAS unsigned char* lds) {
    const int tid = threadIdx.x, lane = tid & 63, wave = __builtin_amdgcn_readfirstlane(tid >> 6);
    const int r = lane & 31, h = lane >> 5, i16 = lane & 15, q4 = i16 >> 2, p4 = i16 & 3, blk = (lane >> 4) & 1;
    const int tok0 = b * SEQ, q0 = qb * 256, qrow = q0 + wave * 32 + r;
    const float C2 = 0.125f * LOG2E;
    bf16x8 qf[4];
    { const bf16* qp = U + (size_t)(tok0 + qrow) * NU + UC_FQ + h8 * 64 + 8 * h;
#pragma unroll
      for (int d0 = 0; d0 < 4; ++d0) qf[d0] = *(const bf16x8*)(qp + 16 * d0); }
    float m = -1e30f, l = 0.f; f32x16 oT[2];
#pragma unroll
    for (int i = 0; i < 16; ++i) { oT[0][i] = 0.f; oT[1][i] = 0.f; }
    LAS unsigned char* Ks = lds; LAS unsigned char* Vs = lds + 9216; LAS float* nb = (LAS float*)(lds + 18432);
    const int NT = 4 * qb + 4;
    const float* fc = Fc2 + (size_t)(b * 8 + h8) * SEQ;
    for (int t = 0; t < NT; ++t) {
        __syncthreads();
        { const int row = tid >> 3, pc = tid & 7; const bf16* gp = U + (size_t)(tok0 + 64 * t + row) * NU + h8 * 64 + pc * 8;
          const u32x4 kv = *(const u32x4*)(gp + UC_FK), vv = *(const u32x4*)(gp + UC_FV);
          *(LAS u32x4*)(Ks + row * 144 + pc * 16) = kv; *(LAS u32x4*)(Vs + row * 144 + pc * 16) = vv; }
        if (tid < 64) nb[tid] = fc[64 * t + tid];
        __syncthreads();
        f32x16 p[2];
#pragma unroll
        for (int hb = 0; hb < 2; ++hb) {
            f32x16 a;
#pragma unroll
            for (int i = 0; i < 16; ++i) a[i] = 0.f;
#pragma unroll
            for (int d0 = 0; d0 < 4; ++d0) { const bf16x8 kf = *(const LAS bf16x8*)(Ks + (32 * hb + r) * 144 + (16 * d0 + 8 * h) * 2); a = mfma32(kf, qf[d0], a); }
#pragma unroll
            for (int g = 0; g < 4; ++g) { const f32x4 bb = *(const LAS f32x4*)(nb + 32 * hb + 8 * g + 4 * h);
#pragma unroll
                for (int e = 0; e < 4; ++e) a[4 * g + e] = a[4 * g + e] * C2 + bb[e]; }
            p[hb] = a;
        }
        if (t >= NT - 4) {
#pragma unroll
            for (int hb = 0; hb < 2; ++hb)
#pragma unroll
                for (int i = 0; i < 16; ++i) { const int kv = 64 * t + 32 * hb + crow(i, h); if (kv > qrow) p[hb][i] = -INFINITY; }
        }
        float mx = p[0][0];
#pragma unroll
        for (int i = 1; i < 16; ++i) mx = fmaxf(mx, p[0][i]);
#pragma unroll
        for (int i = 0; i < 16; ++i) mx = fmaxf(mx, p[1][i]);
        mx = xhalf_max(mx);
        const float mn = fmaxf(m, mx), alpha = ex2(m - mn); m = mn;
        float rs = 0.f;
#pragma unroll
        for (int hb = 0; hb < 2; ++hb)
#pragma unroll
            for (int i = 0; i < 16; ++i) { const float e = ex2(p[hb][i] - mn); p[hb][i] = e; rs += e; }
        l = l * alpha + rs;
#pragma unroll
        for (int i = 0; i < 16; ++i) { oT[0][i] *= alpha; oT[1][i] *= alpha; }
        bf16x8 pf[2][2];
#pragma unroll
        for (int hb = 0; hb < 2; ++hb)
#pragma unroll
            for (int s = 0; s < 2; ++s) pf[hb][s] = pack8(p[hb], s);
#pragma unroll
        for (int d0 = 0; d0 < 2; ++d0)
#pragma unroll
            for (int hb = 0; hb < 2; ++hb)
#pragma unroll
                for (int s = 0; s < 2; ++s) {
                    const LAS unsigned char* vp = Vs + (32 * hb + 16 * s + 4 * h + q4) * 144 + (32 * d0 + 16 * blk + 4 * p4) * 2;
                    const s16x4 lo = tr_read(vp), hi = tr_read(vp + 8 * 144);
                    oT[d0] = mfma32(cat8(lo, hi), pf[hb][s], oT[d0]);
                }
    }
    l = xhalf_sum(l);
    const float inv = 1.f / l;
    float ss = 0.f;
#pragma unroll
    for (int d0 = 0; d0 < 2; ++d0)
#pragma unroll
        for (int i = 0; i < 16; ++i) { const float o = oT[d0][i] * inv; oT[d0][i] = o; ss += o * o; }
    ss = xhalf_sum(ss);
    const float rr = 1.f / sqrtf(ss * (1.f / 64.f) + RMS_EPS);
    bf16* op = MIX + (size_t)(tok0 + qrow) * D + h8 * 64;
#pragma unroll
    for (int d0 = 0; d0 < 2; ++d0)
#pragma unroll
        for (int g = 0; g < 4; ++g) { const int d = 32 * d0 + 8 * g + 4 * h; const f32x4 gn = *(const f32x4*)(fox_g + h8 * 64 + d);
            u32x2 w; w.x = pk2(oT[d0][4 * g] * rr * gn.x, oT[d0][4 * g + 1] * rr * gn.y); w.y = pk2(oT[d0][4 * g + 2] * rr * gn.z, oT[d0][4 * g + 3] * rr * gn.w);
            *(u32x2*)(op + d) = w; }
}

DI void m1_unit(int bh, int cg, const bf16* U, const float* G, const float* conv_w, bf16* Mq, bf16* Mk, float* KvT, float* Nc, float* Gc, float* Mloc, LAS unsigned char* lds) {
    const int tid = threadIdx.x, lane = tid & 63, wave = __builtin_amdgcn_readfirstlane(tid >> 6);
    const int r = lane & 31, h = lane >> 5, i16 = lane & 15, q4 = i16 >> 2, p4 = i16 & 3, blk = (lane >> 4) & 1;
    const int b = bh >> 2, hh = bh & 3, s0 = cg * 256;
    LAS float* wa = (LAS float*)lds;
    LAS unsigned char* ksb = lds + 1024;
    LAS unsigned char* vsb = lds + 1024 + 36864;
    __syncthreads();
    if (wave < 4) {
        const int c = cg * 4 + wave, tok = b * SEQ + c * 64 + lane;
        const float lf = G[(size_t)tok * 16 + 12 + hh], li = G[(size_t)tok * 16 + 8 + hh];
        const float bsc = wave_scan_add(lf, lane);
        const float g = __shfl(bsc, 63);
        const float a = g - bsc + li;
        const float ml = wave_max(a);
        wa[wave * 64 + lane] = expf(a - ml);
        if (lane == 0) { Gc[bh * 64 + c] = g; Mloc[bh * 64 + c] = ml; }
    }
    __syncthreads();
#pragma unroll 2
    for (int i = 0; i < 8; ++i) {
        const int id = tid + 512 * i, d8 = id & 7, qk = (id >> 3) & 1, t = id >> 4;
        const int ucol = (qk ? UC_MK : UC_MQ) + hh * 64 + 8 * d8, ccol = (qk ? 256 : 0) + hh * 64 + 8 * d8;
        float acc[8];
#pragma unroll
        for (int e = 0; e < 8; ++e) acc[e] = 0.f;
#pragma unroll
        for (int j = 0; j < 4; ++j) {
            const int ts = s0 + t - 3 + j;
            if (ts >= 0) {
                const u32x4 x = *(const u32x4*)(U + (size_t)(b * SEQ + ts) * NU + ucol);
                const f32x4 w0 = *(const f32x4*)(conv_w + j * 512 + ccol), w1 = *(const f32x4*)(conv_w + j * 512 + ccol + 4);
                acc[0] += bf_lo(x.x) * w0.x; acc[1] += bf_hi(x.x) * w0.y; acc[2] += bf_lo(x.y) * w0.z; acc[3] += bf_hi(x.y) * w0.w;
                acc[4] += bf_lo(x.z) * w1.x; acc[5] += bf_hi(x.z) * w1.y; acc[6] += bf_lo(x.w) * w1.z; acc[7] += bf_hi(x.w) * w1.w;
            }
        }
#pragma unroll
        for (int e = 0; e < 8; ++e) acc[e] = acc[e] / (1.f + expf(-acc[e]));
        const size_t orow = ((size_t)bh * SEQ + s0 + t) * 64 + 8 * d8;
        if (qk == 0) {
            u32x4 w; w.x = pk2(acc[0], acc[1]); w.y = pk2(acc[2], acc[3]); w.z = pk2(acc[4], acc[5]); w.w = pk2(acc[6], acc[7]);
            *(u32x4*)(Mq + orow) = w;
        } else {
#pragma unroll
            for (int e = 0; e < 8; ++e) acc[e] *= 0.125f;
            u32x4 w; w.x = pk2(acc[0], acc[1]); w.y = pk2(acc[2], acc[3]); w.z = pk2(acc[4], acc[5]); w.w = pk2(acc[6], acc[7]);
            *(u32x4*)(Mk + orow) = w;
            const float ww = wa[t];
            u32x4 x; x.x = pk2(acc[0] * ww, acc[1] * ww); x.y = pk2(acc[2] * ww, acc[3] * ww); x.z = pk2(acc[4] * ww, acc[5] * ww); x.w = pk2(acc[6] * ww, acc[7] * ww);
            *(LAS u32x4*)(ksb + (t >> 6) * 9216 + (t & 63) * 144 + d8 * 16) = x;
        }
    }
#pragma unroll
    for (int i = 0; i < 8; ++i) { const int id = tid + 512 * i, pc = id & 15, t = id >> 4;
        const u32x4 v = *(const u32x4*)(U + (size_t)(b * SEQ + s0 + t) * NU + UC_MV + hh * 128 + pc * 8);
        *(LAS u32x4*)(vsb + (t >> 6) * 17408 + (t & 63) * 272 + pc * 16) = v; }
    __syncthreads();
    {
        const int cl = wave >> 1, eh = wave & 1, c = cg * 4 + cl;
        const LAS unsigned char* vs = vsb + cl * 17408; const LAS unsigned char* ks = ksb + cl * 9216;
        f32x16 acc[2][2];
#pragma unroll
        for (int a = 0; a < 2; ++a)
#pragma unroll
            for (int bb = 0; bb < 2; ++bb)
#pragma unroll
                for (int i = 0; i < 16; ++i) acc[a][bb][i] = 0.f;
#pragma unroll
        for (int k4 = 0; k4 < 4; ++k4) {
            bf16x8 af[2], bfr[2];
#pragma unroll
            for (int eb = 0; eb < 2; ++eb) { const LAS unsigned char* pp = vs + (16 * k4 + 8 * h + q4) * 272 + (64 * eh + 32 * eb + 16 * blk + 4 * p4) * 2; af[eb] = cat8(tr_read(pp), tr_read(pp + 4 * 272)); }
#pragma unroll
            for (int db = 0; db < 2; ++db) { const LAS unsigned char* pp = ks + (16 * k4 + 8 * h + q4) * 144 + (32 * db + 16 * blk + 4 * p4) * 2; bfr[db] = cat8(tr_read(pp), tr_read(pp + 4 * 144)); }
#pragma unroll
            for (int eb = 0; eb < 2; ++eb)
#pragma unroll
                for (int db = 0; db < 2; ++db) acc[eb][db] = mfma32(af[eb], bfr[db], acc[eb][db]);
        }
        float* op = KvT + (size_t)(bh * 64 + c) * 8192;
#pragma unroll
        for (int eb = 0; eb < 2; ++eb)
#pragma unroll
            for (int db = 0; db < 2; ++db)
#pragma unroll
                for (int i = 0; i < 16; ++i) op[(64 * eh + 32 * eb + crow(i, h)) * 64 + 32 * db + r] = acc[eb][db][i];
    }
    if (tid < 256) { const int cl = tid >> 6, d = tid & 63; const LAS unsigned char* ks = ksb + cl * 9216 + d * 2; float s = 0.f;
#pragma unroll 8
        for (int t = 0; t < 64; ++t) s += __uint_as_float(((unsigned)*(const LAS unsigned short*)(ks + t * 144)) << 16);
        Nc[(size_t)(bh * 64 + cg * 4 + cl) * 64 + d] = s; }
}

DI void m3_unit(int bh, int cg, const bf16* U, const float* G, const bf16* Mq, const bf16* Mk, const bf16* CpT, const float* Np, const float* Mp, const float* mlstm_g, bf16* MIX, LAS unsigned char* lds) {
    const int tid = threadIdx.x, lane = tid & 63, wave = __builtin_amdgcn_readfirstlane(tid >> 6);
    const int r = lane & 31, h = lane >> 5, i16 = lane & 15, q4 = i16 >> 2, p4 = i16 & 3, blk = (lane >> 4) & 1;
    const int b = bh >> 2, hh = bh & 3, cl = wave >> 1, th = wave & 1, c = cg * 4 + cl;
    const int tokc = b * SEQ + c * 64;
    const LAS unsigned char* Vs = lds + cl * 17408;
    LAS float* wsf = (LAS float*)(lds + 69632 + wave * 1024);
    __syncthreads();
#pragma unroll
    for (int i = 0; i < 8; ++i) { const int id = tid + 512 * i, pc = id & 15, t = id >> 4;
        const u32x4 v = *(const u32x4*)(U + (size_t)(b * SEQ + cg * 256 + t) * NU + UC_MV + hh * 128 + pc * 8);
        *(LAS u32x4*)(lds + (t >> 6) * 17408 + (t & 63) * 272 + pc * 16) = v; }
    const float mprev = Mp[bh * 64 + c];
    {
        const float lf = G[(size_t)(tokc + lane) * 16 + 12 + hh], li = G[(size_t)(tokc + lane) * 16 + 8 + hh];
        const float bsc = wave_scan_add(lf, lane);
        const float pm = wave_scan_max(li - bsc, lane);
        wsf[lane] = bsc; wsf[64 + lane] = li; wsf[128 + lane] = bsc + fmaxf(mprev, pm); wsf[192 + lane] = Np[(size_t)(bh * 64 + c) * 64 + lane];
    }
    __syncthreads();
    const int tl = 32 * th + r;
    const float bt = wsf[tl], mtt = wsf[128 + tl];
    const float winter = expf(bt + mprev - mtt);
    bf16x8 qf[4];
    { const bf16* qp = Mq + ((size_t)bh * SEQ + c * 64 + tl) * 64 + 8 * h;
#pragma unroll
      for (int ks = 0; ks < 4; ++ks) qf[ks] = *(const bf16x8*)(qp + 16 * ks); }
    float qn = 0.f;
#pragma unroll
    for (int ks = 0; ks < 4; ++ks)
#pragma unroll
        for (int j = 0; j < 8; ++j) qn += bf2f(qf[ks][j]) * wsf[192 + 16 * ks + 8 * h + j];
    qn = xhalf_sum(qn);
    f32x16 accT[4];
#pragma unroll
    for (int eb = 0; eb < 4; ++eb) {
        f32x16 a;
#pragma unroll
        for (int i = 0; i < 16; ++i) a[i] = 0.f;
#pragma unroll
        for (int ks = 0; ks < 4; ++ks) { const bf16x8 cf = *(const bf16x8*)(CpT + ((size_t)(bh * 64 + c) * 128 + 32 * eb + r) * 64 + 16 * ks + 8 * h); a = mfma32(cf, qf[ks], a); }
#pragma unroll
        for (int i = 0; i < 16; ++i) a[i] *= winter;
        accT[eb] = a;
    }
    float psum = 0.f; f32x16 pT[2];
#pragma unroll
    for (int sb = 0; sb < 2; ++sb) {
        f32x16 a;
#pragma unroll
        for (int i = 0; i < 16; ++i) a[i] = 0.f;
#pragma unroll
        for (int ks = 0; ks < 4; ++ks) { const bf16x8 kf = *(const bf16x8*)(Mk + ((size_t)bh * SEQ + c * 64 + 32 * sb + r) * 64 + 16 * ks + 8 * h); a = mfma32(kf, qf[ks], a); }
#pragma unroll
        for (int g = 0; g < 4; ++g) { const f32x4 b4 = *(const LAS f32x4*)(wsf + 32 * sb + 8 * g + 4 * h), l4 = *(const LAS f32x4*)(wsf + 64 + 32 * sb + 8 * g + 4 * h);
#pragma unroll
            for (int e = 0; e < 4; ++e) { const int s = 32 * sb + 8 * g + 4 * h + e; const float w = (s <= tl) ? expf(bt - b4[e] + l4[e] - mtt) * a[4 * g + e] : 0.f; a[4 * g + e] = w; psum += w; } }
        pT[sb] = a;
    }
    psum = xhalf_sum(psum);
#pragma unroll
    for (int eb = 0; eb < 4; ++eb)
#pragma unroll
        for (int sb = 0; sb < 2; ++sb)
#pragma unroll
            for (int s2 = 0; s2 < 2; ++s2) {
                const LAS unsigned char* vp = Vs + (32 * sb + 16 * s2 + 4 * h + q4) * 272 + (32 * eb + 16 * blk + 4 * p4) * 2;
                const s16x4 lo = tr_read(vp), hi = tr_read(vp + 8 * 272);
                accT[eb] = mfma32(cat8(lo, hi), pack8(pT[sb], s2), accT[eb]);
            }
    const float den = winter * qn + psum;
    const float hs = 1.f / fmaxf(fabsf(den), expf(-mtt));
    float ss = 0.f;
#pragma unroll
    for (int eb = 0; eb < 4; ++eb)
#pragma unroll
        for (int i = 0; i < 16; ++i) { const float v = accT[eb][i] * hs; accT[eb][i] = v; ss += v * v; }
    ss = xhalf_sum(ss);
    const float rr = 1.f / sqrtf(ss * (1.f / 128.f) + RMS_EPS);
    const int tok = tokc + tl;
#pragma unroll
    for (int eb = 0; eb < 4; ++eb)
#pragma unroll
        for (int g = 0; g < 4; ++g) { const int e = 32 * eb + 8 * g + 4 * h;
            const f32x4 gn = *(const f32x4*)(mlstm_g + hh * 128 + e);
            const u32x2 mo = *(const u32x2*)(U + (size_t)tok * NU + UC_MO + hh * 128 + e);
            const float o0 = accT[eb][4 * g] * rr * gn.x * sigmoid_fast(bf_lo(mo.x)), o1 = accT[eb][4 * g + 1] * rr * gn.y * sigmoid_fast(bf_hi(mo.x));
            const float o2 = accT[eb][4 * g + 2] * rr * gn.z * sigmoid_fast(bf_lo(mo.y)), o3 = accT[eb][4 * g + 3] * rr * gn.w * sigmoid_fast(bf_hi(mo.y));
            u32x2 w; w.x = pk2(o0, o1); w.y = pk2(o2, o3);
            *(u32x2*)(MIX + (size_t)tok * D + 512 + hh * 128 + e) = w; }
}

DI void xattn_unit(int b, int hx, int qb, bf16* QX, const bf16* KVx, LAS unsigned char* lds) {
    const int tid = threadIdx.x, lane = tid & 63, wave = __builtin_amdgcn_readfirstlane(tid >> 6);
    const int r = lane & 31, h = lane >> 5, i16 = lane & 15, q4 = i16 >> 2, p4 = i16 & 3, blk = (lane >> 4) & 1;
    const int tok = b * SEQ + qb * 256 + wave * 32 + r;
    bf16x8 qf[16];
    { const bf16* qp = QX + (size_t)tok * D + hx * 256 + 8 * h;
#pragma unroll
      for (int ks = 0; ks < 16; ++ks) qf[ks] = *(const bf16x8*)(qp + 16 * ks); }
    f32x16 sT[8];
    LAS unsigned char* Kx = lds; LAS unsigned char* Vx = lds + 33792;
#pragma unroll
    for (int kt = 0; kt < 4; ++kt) {
        __syncthreads();
#pragma unroll
        for (int i = 0; i < 4; ++i) { const int id = tid + 512 * i, row = id >> 5, pc = id & 31;
            const u32x4 v = *(const u32x4*)(KVx + (size_t)(b * NMEM + 64 * kt + row) * 2048 + hx * 256 + pc * 8);
            *(LAS u32x4*)(Kx + row * 528 + pc * 16) = v; }
        __syncthreads();
#pragma unroll
        for (int mb = 0; mb < 2; ++mb) {
            f32x16 a;
#pragma unroll
            for (int i = 0; i < 16; ++i) a[i] = 0.f;
#pragma unroll
            for (int ks = 0; ks < 16; ++ks) { const bf16x8 kf = *(const LAS bf16x8*)(Kx + (32 * mb + r) * 528 + (16 * ks + 8 * h) * 2); a = mfma32(kf, qf[ks], a); }
            sT[2 * kt + mb] = a;
        }
    }
    const float C2X = 0.0625f * LOG2E;
    float mx = -INFINITY;
#pragma unroll
    for (int j = 0; j < 8; ++j)
#pragma unroll
        for (int i = 0; i < 16; ++i) mx = fmaxf(mx, sT[j][i]);
    mx = xhalf_max(mx);
    const float mb2 = mx * C2X;
    float lsum = 0.f;
#pragma unroll
    for (int j = 0; j < 8; ++j)
#pragma unroll
        for (int i = 0; i < 16; ++i) { const float e = ex2(sT[j][i] * C2X - mb2); sT[j][i] = e; lsum += e; }
    lsum = xhalf_sum(lsum);
    const float inv = 1.f / lsum;
    bf16x8 pf[8][2];
#pragma unroll
    for (int j = 0; j < 8; ++j)
#pragma unroll
        for (int s = 0; s < 2; ++s) pf[j][s] = pack8(sT[j], s);
#pragma unroll
    for (int vh = 0; vh < 2; ++vh) {
        __syncthreads();
#pragma unroll
        for (int i = 0; i < 8; ++i) { const int id = tid + 512 * i, row = id >> 4, pc = id & 15;
            const u32x4 v = *(const u32x4*)(KVx + (size_t)(b * NMEM + row) * 2048 + 1024 + hx * 256 + 128 * vh + pc * 8);
            *(LAS u32x4*)(Vx + row * 272 + pc * 16) = v; }
        __syncthreads();
#pragma unroll
        for (int eb = 0; eb < 4; ++eb) {
            f32x16 acc;
#pragma unroll
            for (int i = 0; i < 16; ++i) acc[i] = 0.f;
#pragma unroll
            for (int j = 0; j < 8; ++j)
#pragma unroll
                for (int s = 0; s < 2; ++s) {
                    const LAS unsigned char* vp = Vx + (32 * j + 16 * s + 4 * h + q4) * 272 + (32 * eb + 16 * blk + 4 * p4) * 2;
                    const s16x4 lo = tr_read(vp), hi = tr_read(vp + 8 * 272);
                    acc = mfma32(cat8(lo, hi), pf[j][s], acc);
                }
#pragma unroll
            for (int g = 0; g < 4; ++g) { const int d = 128 * vh + 32 * eb + 8 * g + 4 * h;
                u32x2 w; w.x = pk2(acc[4 * g] * inv, acc[4 * g + 1] * inv); w.y = pk2(acc[4 * g + 2] * inv, acc[4 * g + 3] * inv);
                *(u32x2*)(QX + (size_t)tok * D + hx * 256 + d) = w; }
        }
    }
}

DI void moe_tables(LAS int* tb, gu32* ctl, int tid) {
    __syncthreads();
    if (tid < 32) tb[40 + tid] = (int)__hip_atomic_load(ctl + CW_CNT + 64 * tid, RLX_AGENT);
    __syncthreads();
    if (tid == 0) { int s = 0; for (int e = 0; e < 32; ++e) { tb[e] = s; s += (tb[40 + e] + 255) >> 8; } tb[32] = s; }
    __syncthreads();
}

struct Args { const float* in[26]; float* out; unsigned char* ws; int ph_lo, ph_hi, li, pad; };

__global__ void __launch_bounds__(NWAVES * 64, 2) fwd(Args args) {
    extern __shared__ __attribute__((aligned(16))) unsigned char lds_raw[];
    LAS unsigned char* lds = (LAS unsigned char*)lds_raw;
    volatile LAS unsigned* MISC = (volatile LAS unsigned*)(lds + MISC_OFF);
    const int tid = threadIdx.x, lane = tid & 63, wave = __builtin_amdgcn_readfirstlane(tid >> 6);
    const int G = gridDim.x, bx = blockIdx.x;
    const int vcu = (G % 8 == 0) ? (bx % 8) * (G / 8) + bx / 8 : bx;
    unsigned char* ws = args.ws;
    gu32* ctl = (gu32*)(ws + WS_CTL);
    const float* x = args.in[0]; const float* mem = args.in[1]; const float* w_in = args.in[2]; const float* fox_f_bias = args.in[3];
    const float* conv_w = args.in[4]; const float* i_bias = args.in[5]; const float* f_bias = args.in[6]; const float* fox_g = args.in[7];
    const float* mlstm_g = args.in[8]; const float* w_out = args.in[9]; const float* ln1_g = args.in[10]; const float* ln1_b = args.in[11];
    const float* w_xq = args.in[12]; const float* w_xk = args.in[13]; const float* w_xv = args.in[14]; const float* w_xo = args.in[15];
    const float* ln2_g = args.in[16]; const float* ln2_b = args.in[17]; const float* w_router = args.in[18]; const float* b_router = args.in[19];
    const float* w_gu = args.in[20]; const float* b_gu = args.in[21]; const float* w_dn = args.in[22]; const float* b_dn = args.in[23];
    const float* ln3_g = args.in[24]; const float* ln3_b = args.in[25];
    float* out = args.out;
    float* Gt = (float*)(ws + WS_G); float* Fc2 = (float*)(ws + WS_FC2);
    float* Gc = (float*)(ws + WS_GC); float* Mloc = Gc + 1024; float* Mp = Gc + 2048;
    float* Nc = (float*)(ws + WS_NC); float* Np = (float*)(ws + WS_NP);
    int* Tidx = (int*)(ws + WS_TIDX); float* Tgate = (float*)(ws + WS_TGATE); int* Tslot = (int*)(ws + WS_TSLOT); int* List = (int*)(ws + WS_LIST);
    bf16* KVx = (bf16*)(ws + WS_MEMKV);
    bf16* Win_t = (bf16*)(ws + WS_WIN); bf16* Wout_t = (bf16*)(ws + WS_WOUT); bf16* Wxq_t = (bf16*)(ws + WS_WXQ); bf16* Wxo_t = (bf16*)(ws + WS_WXO);
    unsigned char* Wgu8 = ws + WS_WGU; unsigned char* Wdn8 = ws + WS_WDN;
    bf16* XB = (bf16*)(ws + WS_XB); bf16* U = (bf16*)(ws + WS_U); bf16* Mq = (bf16*)(ws + WS_MQ); bf16* Mk = (bf16*)(ws + WS_MK);
    float* KvT = (float*)(ws + WS_KVT); bf16* CpT = (bf16*)(ws + WS_CPT); bf16* MIX = (bf16*)(ws + WS_MIX);
    float* Y1 = (float*)(ws + WS_Y1); bf16* X1B = (bf16*)(ws + WS_X1B); bf16* QX = (bf16*)(ws + WS_QX);
    float* Y2 = (float*)(ws + WS_Y2); unsigned char* X2F8 = ws + WS_X2B; unsigned char* HID8 = ws + WS_HID; bf16* YB = (bf16*)(ws + WS_YB);

    for (int u = tid; u < (LDS_BYTES - LDSCTL_OFF) / 4; u += NWAVES * 64) ((LAS unsigned*)(lds + LDSCTL_OFF))[u] = 0u;
    __syncthreads();
    XcdBarrier bar; bar.bar = (unsigned*)(ctl + CW_BAR); bar.x = 0; bar.st = nullptr;
    if (N_LAUNCHES == 1) bar = xcd_barrier_post((unsigned*)(ctl + CW_BAR), MISC + 8);
#define GRID_BAR() do { if (N_LAUNCHES == 1) xcd_barrier(bar); } while (0)
    const int lo = args.ph_lo, hi = args.ph_hi;
#ifndef PH_MASK
#define PH_MASK 0xFFFF
#endif
#define IN(k) (((PH_MASK >> (k)) & 1) && lo <= (k) && (k) < hi)
#define BOTH(k) (IN(k) && IN((k) + 1))
#ifndef REP_MASK
#define REP_MASK 0
#endif
#define REPS(k) (1 + ((REP_MASK >> (k)) & 1))
#define END_PHASE(k) do { if (BOTH(k) || rep + 1 < REPS(k)) GRID_BAR(); } while (0)

    if (IN(0)) for (int rep = 0; rep < REPS(0); ++rep) {
        {
            LAS float* wg = (LAS float*)lds;
            for (int idx = tid; idx < 1024 * 16; idx += 512) { const int k = idx >> 4, c = idx & 15; const int col = c < 8 ? 1536 + c : 2568 + (c - 8);
                const int j = k >> 8, ln = (k & 255) >> 2, i = k & 3; wg[((((j * 4 + i) * 4 + (c >> 2)) * 64 + ln) << 2) + (c & 3)] = w_in[(size_t)k * NIN + col]; }
            __syncthreads();
            for (int m = bx * 8 + wave; m < M; m += G * 8) {
                asm volatile("" ::: "memory");
                const f32x4* xr = (const f32x4*)(x + (size_t)m * D) + lane;
                f32x4 v[4];
#pragma unroll
                for (int j = 0; j < 4; ++j) v[j] = xr[64 * j];
                store_row_bf16(XB + (size_t)m * D, v, lane);
                float acc[16];
#pragma unroll
                for (int c = 0; c < 16; ++c) acc[c] = 0.f;
#pragma unroll
                for (int j = 0; j < 4; ++j)
#pragma unroll
                    for (int i = 0; i < 4; ++i) { const LAS f32x4* wp = (const LAS f32x4*)wg + ((j * 4 + i) * 4) * 64 + lane; const float xv = v[j][i];
#pragma unroll
                        for (int c4 = 0; c4 < 4; ++c4) { const f32x4 w = wp[c4 * 64]; acc[4 * c4] += xv * w.x; acc[4 * c4 + 1] += xv * w.y; acc[4 * c4 + 2] += xv * w.z; acc[4 * c4 + 3] += xv * w.w; } }
#define TR_STEP(HALFN, XORM) { const bool up = (lane & (XORM)) != 0; _Pragma("unroll") for (int i = 0; i < (HALFN); ++i) { const float keep = up ? acc[(HALFN) + i] : acc[i], send = up ? acc[i] : acc[(HALFN) + i]; acc[i] = keep + __shfl_xor(send, (XORM)); } }
                TR_STEP(8, 8) TR_STEP(4, 4) TR_STEP(2, 2) TR_STEP(1, 1)
#undef TR_STEP
                float mine = acc[0]; mine += __shfl_xor(mine, 16); mine += __shfl_xor(mine, 32);
                if (lane < 16) {
                    float o;
                    if (lane < 8) o = log_sigmoid_acc(mine + fox_f_bias[lane]);
                    else if (lane < 12) o = mine + i_bias[lane - 8];
                    else o = log_sigmoid_acc(mine + f_bias[lane - 12]);
                    Gt[(size_t)m * 16 + lane] = o;
                }
            }
            __syncthreads();
        }
        {
            LAS unsigned char* As = lds; LAS unsigned char* Bs = lds + 17408;
            for (int tile = bx; tile < 256; tile += G) {
                const int rt = tile >> 4, ct = tile & 15;
                const float* W = ct < 8 ? w_xk : w_xv; const int col0 = 128 * (ct & 7);
                f32x4 acc[4];
#pragma unroll
                for (int rb = 0; rb < 4; ++rb) acc[rb] = (f32x4){0.f, 0.f, 0.f, 0.f};
                for (int k0 = 0; k0 < 1024; k0 += 128) {
                    __syncthreads();
#pragma unroll
                    for (int i = 0; i < 4; ++i) { const int p = tid + 512 * i, row = p >> 5, c4 = p & 31;
                        const f32x4 a = *(const f32x4*)(mem + (size_t)(64 * rt + row) * D + k0 + 4 * c4);
                        u32x2 w; w.x = pk2(a.x, a.y); w.y = pk2(a.z, a.w); *(LAS u32x2*)(As + row * 272 + c4 * 8) = w; }
#pragma unroll
                    for (int i = 0; i < 8; ++i) { const int p = tid + 512 * i, k = p >> 5, c4 = p & 31;
                        const f32x4 a = *(const f32x4*)(W + (size_t)(k0 + k) * D + col0 + 4 * c4);
                        LAS unsigned short* bp = (LAS unsigned short*)(Bs + (4 * c4) * 272 + k * 2);
                        const unsigned w0 = pk2(a.x, a.y), w1 = pk2(a.z, a.w);
                        bp[0] = (unsigned short)(w0 & 0xffffu); bp[136] = (unsigned short)(w0 >> 16); bp[272] = (unsigned short)(w1 & 0xffffu); bp[408] = (unsigned short)(w1 >> 16); }
                    __syncthreads();
#pragma unroll
                    for (int kk = 0; kk < 4; ++kk) {
                        const bf16x8 bfr = *(const LAS bf16x8*)(Bs + (16 * wave + (lane & 15)) * 272 + (32 * kk + 8 * (lane >> 4)) * 2);
#pragma unroll
                        for (int rb = 0; rb < 4; ++rb) { const bf16x8 afr = *(const LAS bf16x8*)(As + (16 * rb + (lane & 15)) * 272 + (32 * kk + 8 * (lane >> 4)) * 2); acc[rb] = mfma16(afr, bfr, acc[rb]); }
                    }
                }
#pragma unroll
                for (int rb = 0; rb < 4; ++rb)
#pragma unroll
                    for (int j = 0; j < 4; ++j) { const int row = 64 * rt + 16 * rb + 4 * (lane >> 4) + j, col = 128 * ct + 16 * wave + (lane & 15);
                        KVx[(size_t)row * 2048 + col] = (bf16)(pk2(acc[rb][j], 0.f) & 0xffffu); }
            }
            __syncthreads();
        }
        {
            LAS float* scr = (LAS float*)(lds + wave * 16384);
            const int gw = vcu * NWAVES + wave, NGW = G * NWAVES;
            constexpr int I_GU = 32 * 8 * 64, I_DN = 32 * 8 * 32, I_IN = 16 * 96, I_SQ = 16 * 32;
            constexpr int NITEMS = I_GU + I_DN + I_IN + 3 * I_SQ;
            for (int it = gw; it < NITEMS; it += NGW) {
                int q = it;
                if (q < I_GU) { const int e = q >> 9, rr = q & 511, kb = rr >> 6, nb = rr & 63, n0 = 32 * nb; const int bj = n0 >> 10, rem = n0 & 1023, pn = rem >> 7, j0 = rem & 127;
                    p0_transpose_fp8(w_gu + (size_t)e * 1024 * 2048, 2048, Wgu8 + (size_t)e * 2048 * 1024, 1024, n0, 256 * pn + 128 * bj + j0, 128 * kb, WGU_SCALE, (LAS unsigned*)scr, lane); continue; }
                q -= I_GU;
                if (q < I_DN) { const int e = q >> 8, rr = q & 255, kb = rr >> 5, nb = rr & 31;
                    p0_transpose_fp8(w_dn + (size_t)e * 1024 * 1024, 1024, Wdn8 + (size_t)e * 1024 * 1024, 1024, 32 * nb, 32 * nb, 128 * kb, WDN_SCALE, (LAS unsigned*)scr, lane); continue; }
                q -= I_DN;
                if (q < I_IN) { const int kb = q / 96, nb = q % 96, dn0 = 32 * nb; const int sn0 = dn0 < 1536 ? dn0 : (dn0 < 2560 ? dn0 + 8 : dn0 + 16);
                    p0_transpose_item(w_in, NIN, 1024, Win_t, sn0, dn0, 64 * kb, scr, lane); continue; }
                q -= I_IN;
                { const int which = q / I_SQ, rr = q % I_SQ, kb = rr >> 5, nb = rr & 31;
                  const float* W = which == 0 ? w_out : (which == 1 ? w_xq : w_xo); bf16* WT = which == 0 ? Wout_t : (which == 1 ? Wxq_t : Wxo_t);
                  p0_transpose_item(W, 1024, 1024, WT, 32 * nb, 32 * nb, 64 * kb, scr, lane); }
            }
        }
        END_PHASE(0);
    }

    if (IN(1)) for (int rep = 0; rep < REPS(1); ++rep) {
        pg8::StaticSched S; S.init(XB, Win_t, M, NU, D, G, bx);
        pg8::EpiBf16 E{U, NU, nullptr, 0, 1.f};
        pg8::gemm_phase<pg8::EpiBf16, pg8::StaticSched, false, true>(lds, D, S, E);
        END_PHASE(1);
    }

    if (IN(2)) for (int rep = 0; rep < REPS(2); ++rep) {
        for (int u = bx; u < 256; u += G) m1_unit(u >> 4, u & 15, U, Gt, conv_w, Mq, Mk, KvT, Nc, Gc, Mloc, lds);
        __syncthreads();
        for (int sq = bx; sq < 32; sq += G) {
            const int b8 = sq >> 3, h8 = sq & 7; LAS float* wt = (LAS float*)lds;
            float v[8]; float run = 0.f;
#pragma unroll
            for (int i = 0; i < 8; ++i) { run += Gt[(size_t)(b8 * SEQ + 8 * tid + i) * 16 + h8]; v[i] = run; }
            const float incl = wave_scan_add(run, lane);
            if (lane == 63) wt[wave] = incl;
            __syncthreads();
            float off = incl - run;
            for (int w = 0; w < wave; ++w) off += wt[w];
#pragma unroll
            for (int i = 0; i < 8; ++i) Fc2[(size_t)sq * SEQ + 8 * tid + i] = -(off + v[i]) * LOG2E;
            __syncthreads();
        }
        END_PHASE(2);
    }

    if (IN(3)) for (int rep = 0; rep < REPS(3); ++rep) {
        LAS float* sg = (LAS float*)lds;
        for (int ch = bx; ch < 256; ch += G) {
            const int bh = ch >> 4, part = ch & 15, idx = 512 * part + tid;
            __syncthreads();
            if (tid < 64) { sg[tid] = Gc[bh * 64 + tid]; sg[64 + tid] = Mloc[bh * 64 + tid]; }
            __syncthreads();
            if (tid == 0) { float mm = 0.f;
                for (int c = 0; c < 64; ++c) { const float g = sg[c], mc = sg[64 + c]; if (part == 0) Mp[bh * 64 + c] = mm; const float mn = fmaxf(g + mm, mc); sg[128 + c] = expf(g + mm - mn); sg[192 + c] = expf(mc - mn); mm = mn; } }
            __syncthreads();
            float C = 0.f;
            const float* kp = KvT + (size_t)bh * 64 * 8192 + idx; bf16* cp = CpT + (size_t)bh * 64 * 8192 + idx;
#pragma unroll 8
            for (int c = 0; c < 64; ++c) { cp[(size_t)c * 8192] = (bf16)(pk2(C, 0.f) & 0xffffu); C = sg[128 + c] * C + sg[192 + c] * kp[(size_t)c * 8192]; }
            if (part == 0 && tid < 64) { float n = 0.f;
#pragma unroll 8
                for (int c = 0; c < 64; ++c) { Np[(size_t)(bh * 64 + c) * 64 + tid] = n; n = sg[128 + c] * n + sg[192 + c] * Nc[(size_t)(bh * 64 + c) * 64 + tid]; } }
        }
        END_PHASE(3);
    }

    if (IN(4)) for (int rep = 0; rep < REPS(4); ++rep) {
        for (int pr = vcu; pr < 256; pr += G) { const int bh8 = pr >> 3, s = pr & 7;
            fox_unit(bh8 >> 3, bh8 & 7, 15 - s, U, Fc2, fox_g, MIX, lds);
            fox_unit(bh8 >> 3, bh8 & 7, s, U, Fc2, fox_g, MIX, lds); }
        for (int u = bx; u < 256; u += G) m3_unit(u >> 4, u & 15, U, Gt, Mq, Mk, CpT, Np, Mp, mlstm_g, MIX, lds);
        END_PHASE(4);
    }

    if (IN(5)) for (int rep = 0; rep < REPS(5); ++rep) {
        pg8::StaticSched S; S.init(MIX, Wout_t, M, D, D, G, bx);
        pg8::EpiResF32 E{x, Y1, D, ALPHA};
        pg8::gemm_phase<pg8::EpiResF32, pg8::StaticSched, false, false>(lds, D, S, E);
        END_PHASE(5);
    }

    if (IN(6)) for (int rep = 0; rep < REPS(6); ++rep) {
        for (int m = bx * 8 + wave; m < M; m += G * 8) {
            f32x4* yr = (f32x4*)(Y1 + (size_t)m * D) + lane; f32x4 v[4];
#pragma unroll
            for (int j = 0; j < 4; ++j) v[j] = yr[64 * j];
            ln_row(v, ln1_g, ln1_b, lane);
#pragma unroll
            for (int j = 0; j < 4; ++j) yr[64 * j] = v[j];
            store_row_bf16(X1B + (size_t)m * D, v, lane);
        }
        END_PHASE(6);
    }

    if (IN(7)) for (int rep = 0; rep < REPS(7); ++rep) {
        pg8::StaticSched S; S.init(X1B, Wxq_t, M, D, D, G, bx);
        pg8::EpiBf16 E{QX, D, nullptr, 0, 1.f};
        pg8::gemm_phase<pg8::EpiBf16, pg8::StaticSched, false, false>(lds, D, S, E);
        END_PHASE(7);
    }

    if (IN(8)) for (int rep = 0; rep < REPS(8); ++rep) {
        for (int u = vcu; u < 256; u += G) xattn_unit(u >> 6, (u >> 4) & 3, u & 15, QX, KVx, lds);
        END_PHASE(8);
    }

    if (IN(9)) for (int rep = 0; rep < REPS(9); ++rep) {
        pg8::StaticSched S; S.init(QX, Wxo_t, M, D, D, G, bx);
        pg8::EpiResF32 E{Y1, Y2, D, ALPHA};
        pg8::gemm_phase<pg8::EpiResF32, pg8::StaticSched, false, false>(lds, D, S, E);
        END_PHASE(9);
    }

    if (IN(10)) for (int rep = 0; rep < REPS(10); ++rep) {
        LAS float* wrT = (LAS float*)lds;
        LAS int* hist = (LAS int*)(lds + RT_OFF); LAS int* ebase = hist + 32; LAS int* tokE = hist + 64; LAS int* tokR = hist + 320;
        __syncthreads();
        for (int idx = tid; idx < 1024 * 8; idx += 512) { const int k = idx >> 3, e4 = (idx & 7) * 4; const f32x4 w = *(const f32x4*)(w_router + k * 32 + e4);
            wrT[(e4 + 0) * 1024 + k] = w.x; wrT[(e4 + 1) * 1024 + k] = w.y; wrT[(e4 + 2) * 1024 + k] = w.z; wrT[(e4 + 3) * 1024 + k] = w.w; }
        if (tid < 32) hist[tid] = 0;
        __syncthreads();
        for (int grp = bx; grp < M / 64; grp += G) {
            for (int tl = wave; tl < 64; tl += 8) {
                const int tok = grp * 64 + tl;
                f32x4* yr = (f32x4*)(Y2 + (size_t)tok * D) + lane; f32x4 v[4];
#pragma unroll
                for (int j = 0; j < 4; ++j) v[j] = yr[64 * j];
                ln_row(v, ln2_g, ln2_b, lane);
#pragma unroll
                for (int j = 0; j < 4; ++j) yr[64 * j] = v[j];
                store_row_fp8(X2F8 + (size_t)tok * D, v, X2_SCALE, lane);
                float acc[32];
#pragma unroll
                for (int e = 0; e < 32; ++e) { float a = 0.f;
#pragma unroll
                    for (int j = 0; j < 4; ++j) { const f32x4 w = *(const LAS f32x4*)(wrT + e * 1024 + 256 * j + 4 * lane); a += (v[j].x * w.x + v[j].y * w.y) + (v[j].z * w.z + v[j].w * w.w); }
                    acc[e] = a; }
#define TR_STEP(HALFN, XORM) { const bool up = (lane & (XORM)) != 0; _Pragma("unroll") for (int i = 0; i < (HALFN); ++i) { const float keep = up ? acc[(HALFN) + i] : acc[i], send = up ? acc[i] : acc[(HALFN) + i]; acc[i] = keep + __shfl_xor(send, (XORM)); } }
                TR_STEP(16, 16) TR_STEP(8, 8) TR_STEP(4, 4) TR_STEP(2, 2) TR_STEP(1, 1)
#undef TR_STEP
                float lg = acc[0] + __shfl_xor(acc[0], 32);
                lg += b_router[lane & 31];
                float tv[4]; int ti[4]; float cur = lg;
#pragma unroll
                for (int k = 0; k < 4; ++k) {
                    float bv = cur; int bi = lane & 31;
#pragma unroll
                    for (int o = 1; o < 32; o <<= 1) { const float ov = __shfl_xor(bv, o); const int oi = __shfl_xor(bi, o); if (ov > bv || (ov == bv && oi < bi)) { bv = ov; bi = oi; } }
                    tv[k] = bv; ti[k] = bi; if ((lane & 31) == bi) cur = -INFINITY;
                }
                const float e1 = expf(tv[1] - tv[0]), e2 = expf(tv[2] - tv[0]), e3 = expf(tv[3] - tv[0]); const float isum = 1.f / (1.f + e1 + e2 + e3);
                if (lane == 0) {
                    const float gs[4] = {isum, e1 * isum, e2 * isum, e3 * isum};
#pragma unroll
                    for (int k = 0; k < 4; ++k) { const int rk = atomicAdd((int*)&hist[ti[k]], 1); tokE[tl * 4 + k] = ti[k]; tokR[tl * 4 + k] = rk; Tidx[tok * 4 + k] = ti[k]; Tgate[tok * 4 + k] = gs[k]; }
                }
            }
            __syncthreads();
            if (tid < 32) { const int c = hist[tid]; ebase[tid] = c ? (int)__hip_atomic_fetch_add(ctl + CW_CNT + 64 * tid, (unsigned)c, RLX_AGENT) : 0; hist[tid] = 0; }
            __syncthreads();
            if (tid < 256) { const int tl = tid >> 2, e = tokE[tid], slot = ebase[e] + tokR[tid]; List[(size_t)e * LCAP + slot] = grp * 64 + tl; Tslot[(grp * 64 + tl) * 4 + (tid & 3)] = slot; }
            __syncthreads();
        }
        END_PHASE(10);
    }

    if (IN(11)) for (int rep = 0; rep < REPS(11); ++rep) {
        LAS int* tb = (LAS int*)(lds + MOE_TB_OFF);
        moe_tables(tb, ctl, tid);
        pg8::MoeSched S; S.A = (const char*)X2F8; S.B = (const char*)Wgu8; S.list = List; S.tb = tb; S.K = 512; S.NT = 8; S.nwg = __builtin_amdgcn_readfirstlane(tb[32]) * 8; S.G = G; S.c = bx; S.bexp = (size_t)2048 * 1024; S.gather = true;
        pg8::EpiSwiglu E{HID8, b_gu, 1.f / (WGU_SCALE * X2_SCALE), HID_SCALE};
        pg8::gemm_phase<pg8::EpiSwiglu, pg8::MoeSched, true, true, true>(lds, 512, S, E);
        END_PHASE(11);
    }

    if (IN(12)) for (int rep = 0; rep < REPS(12); ++rep) {
        LAS int* tb = (LAS int*)(lds + MOE_TB_OFF);
        moe_tables(tb, ctl, tid);
        pg8::MoeSched S; S.A = (const char*)HID8; S.B = (const char*)Wdn8; S.list = List; S.tb = tb; S.K = 512; S.NT = 4; S.nwg = __builtin_amdgcn_readfirstlane(tb[32]) * 4; S.G = G; S.c = bx; S.bexp = (size_t)1024 * 1024; S.gather = false;
        pg8::EpiBf16 E{YB, D, b_dn, 1024, 1.f / (WDN_SCALE * HID_SCALE)};
        pg8::gemm_phase<pg8::EpiBf16, pg8::MoeSched, false, true, true>(lds, 512, S, E);
        END_PHASE(12);
    }

    if (IN(13)) for (int rep = 0; rep < REPS(13); ++rep) {
        LAS int* tb = (LAS int*)(lds + MOE_TB_OFF);
        moe_tables(tb, ctl, tid);
        for (int m = bx * 8 + wave; m < M; m += G * 8) {
            const f32x4* xr = (const f32x4*)(Y2 + (size_t)m * D) + lane; f32x4 v[4];
#pragma unroll
            for (int j = 0; j < 4; ++j) v[j] = xr[64 * j] * ALPHA;
#pragma unroll
            for (int k = 0; k < 4; ++k) {
                const int e = Tidx[m * 4 + k], slot = Tslot[m * 4 + k]; const float gk = Tgate[m * 4 + k];
                const u32x2* yr = (const u32x2*)(YB + ((size_t)tb[e] * 256 + slot) * D) + lane;
#pragma unroll
                for (int j = 0; j < 4; ++j) { const u32x2 w = yr[64 * j]; v[j].x += gk * bf_lo(w.x); v[j].y += gk * bf_hi(w.x); v[j].z += gk * bf_lo(w.y); v[j].w += gk * bf_hi(w.y); }
            }
            ln_row(v, ln3_g, ln3_b, lane);
            f32x4* orow = (f32x4*)(out + (size_t)m * D) + lane;
#pragma unroll
            for (int j = 0; j < 4; ++j) orow[64 * j] = v[j];
        }
        if (rep + 1 < REPS(13)) GRID_BAR();
    }
#undef IN
#undef BOTH
#undef GRID_BAR
}

extern "C" void kernel_launch(void* const* d_in, const int* in_sizes, int n_in, void* d_out, int out_size, void* d_ws, size_t ws_size, hipStream_t stream) {
    static int grid = 0;
    if (grid == 0) {
        if (n_in != 26 || in_sizes[0] != M * D || out_size != M * D || ws_size < WS_END) { fprintf(stderr, "kernel_launch: unexpected shapes (n_in %d, in0 %d, out %d, ws %zu)\n", n_in, n_in > 0 ? in_sizes[0] : -1, out_size, ws_size); grid = -1; return; }
        int dev = 0, cus = 0, per_cu = 0;
        if (hipGetDevice(&dev) != hipSuccess || hipDeviceGetAttribute(&cus, hipDeviceAttributeMultiprocessorCount, dev) != hipSuccess) { grid = -1; return; }
        if (hipFuncSetAttribute((const void*)fwd, hipFuncAttributeMaxDynamicSharedMemorySize, LDS_BYTES) != hipSuccess) { fprintf(stderr, "kernel_launch: hipFuncSetAttribute failed\n"); grid = -1; return; }
        if (hipOccupancyMaxActiveBlocksPerMultiprocessor(&per_cu, (const void*)fwd, NWAVES * 64, LDS_BYTES) != hipSuccess || per_cu < 1) fprintf(stderr, "kernel_launch: occupancy query reports %d\n", per_cu);
        (void)hipGetLastError();
        grid = cus;
    }
    if (grid < 0) return;
    if (hipMemsetAsync((char*)d_ws + WS_CTL, 0, CTL_ZERO_BYTES, stream) != hipSuccess) return;
    Args a{};
    for (int i = 0; i < 26; ++i) a.in[i] = (const float*)d_in[i];
    a.out = (float*)d_out; a.ws = (unsigned char*)d_ws;
    if (N_LAUNCHES == 1) {
        a.ph_lo = 0; a.ph_hi = NPHASE; a.li = 0;
        hipLaunchKernelGGL(fwd, dim3(grid), dim3(NWAVES * 64), LDS_BYTES, stream, a);
    } else {
        for (int li = 0; li < NPHASE; ++li) { a.ph_lo = li; a.ph_hi = li + 1; a.li = li; hipLaunchKernelGGL(fwd, dim3(grid), dim3(NWAVES * 64), LDS_BYTES, stream, a); }
    }
}
```

```cpp
#include <hip/hip_runtime.h>
#include <cstdio>
#include <cstdint>
#include <cmath>

#define DI __device__ __forceinline__
#define LAS __attribute__((address_space(3)))
#define GAS __attribute__((address_space(1)))
typedef unsigned short bf16;
typedef short bf16x8 __attribute__((ext_vector_type(8)));
typedef short s16x4 __attribute__((ext_vector_type(4)));
typedef float f32x2 __attribute__((ext_vector_type(2)));
typedef float f32x4 __attribute__((ext_vector_type(4)));
typedef float f32x16 __attribute__((ext_vector_type(16)));
typedef unsigned u32x2 __attribute__((ext_vector_type(2)));
typedef unsigned u32x4 __attribute__((ext_vector_type(4)));
typedef GAS unsigned gu32;

#ifndef MK_N_LAUNCHES
#define MK_N_LAUNCHES 1
#endif

constexpr int BATCH = 4, SEQ = 4096, D = 1024, M = BATCH * SEQ, NMEM = 256;
constexpr int NIN = 3088;
constexpr int NU = 3072;
constexpr int UC_FQ = 0, UC_FK = 512, UC_FV = 1024, UC_MQ = 1536, UC_MK = 1792, UC_MV = 2048, UC_MO = 2560;
constexpr int NE = 32, TOPK = 4, LCAP = 16384;
constexpr int PROWS = M * TOPK + NE * 256;
constexpr float ALPHA = 1.189207115002721f;
constexpr float LOG2E = 1.4426950408889634f;
constexpr float LN_EPS = 1e-5f, RMS_EPS = 1e-6f;
constexpr int NPHASE = 14;
constexpr float WGU_SCALE = 32.f, WDN_SCALE = 64.f, X2_SCALE = 4.f, HID_SCALE = 4.f;
constexpr int N_LAUNCHES = MK_N_LAUNCHES;

constexpr size_t MiB = 1u << 20;
constexpr size_t WS_CTL = 0, CTL_ZERO_BYTES = 1 * MiB;
constexpr size_t WS_G = 1 * MiB;
constexpr size_t WS_FC2 = 2 * MiB;
constexpr size_t WS_GC = 2 * MiB + 512 * 1024;
constexpr size_t WS_NC = 3 * MiB;
constexpr size_t WS_NP = 3 * MiB + 256 * 1024;
constexpr size_t WS_TIDX = 3 * MiB + 512 * 1024;
constexpr size_t WS_TGATE = 3 * MiB + 768 * 1024;
constexpr size_t WS_TSLOT = 4 * MiB;
constexpr size_t WS_LIST = 5 * MiB;
constexpr size_t WS_MEMKV = 8 * MiB;
constexpr size_t WS_WIN = 16 * MiB, WS_WOUT = 22 * MiB, WS_WXQ = 24 * MiB, WS_WXO = 26 * MiB;
constexpr size_t WS_WGU = 32 * MiB, WS_WDN = 160 * MiB;
constexpr size_t WS_XB = 224 * MiB;
constexpr size_t WS_U = 256 * MiB;
constexpr size_t WS_MQ = 352 * MiB, WS_MK = 360 * MiB;
constexpr size_t WS_KVT = 368 * MiB;
constexpr size_t WS_CPT = 400 * MiB;
constexpr size_t WS_MIX = 432 * MiB;
constexpr size_t WS_Y1 = 464 * MiB;
constexpr size_t WS_X1B = 528 * MiB;
constexpr size_t WS_QX = 560 * MiB;
constexpr size_t WS_Y2 = 596 * MiB;
constexpr size_t WS_X2B = 660 * MiB;
constexpr size_t WS_HID = 692 * MiB;
constexpr size_t WS_YB = 836 * MiB;
constexpr size_t WS_END = 980 * MiB;
constexpr int CW_TMO = 0, CW_CODE = 1;
constexpr int CW_CNT = 1024;
constexpr int CW_BAR = 4096;

constexpr int RING_BYTES = 131072;
constexpr int LDSCTL_OFF = RING_BYTES, MISC_OFF = LDSCTL_OFF + 320;
constexpr int MOE_TB_OFF = LDSCTL_OFF + 1024;
constexpr int RT_OFF = LDSCTL_OFF + 2048;
constexpr int LDS_BYTES = 147456;
constexpr int NWAVES = 8;

#define RLX_AGENT __ATOMIC_RELAXED, __HIP_MEMORY_SCOPE_AGENT
DI float bf_lo(unsigned u) { return __uint_as_float(u << 16); }
DI float bf_hi(unsigned u) { return __uint_as_float(u & 0xffff0000u); }
DI float bf2f(short s) { return __uint_as_float(((unsigned)(unsigned short)s) << 16); }
typedef __bf16 bf16x2_t __attribute__((ext_vector_type(2)));
DI unsigned pk2(float lo, float hi) { f32x2 v = {lo, hi}; bf16x2_t b = __builtin_convertvector(v, bf16x2_t); return __builtin_bit_cast(unsigned, b); }
DI float wave_sum(float v) {
#pragma unroll
    for (int o = 1; o < 64; o <<= 1) v += __shfl_xor(v, o);
    return v;
}
DI float wave_max(float v) {
#pragma unroll
    for (int o = 1; o < 64; o <<= 1) v = fmaxf(v, __shfl_xor(v, o));
    return v;
}
DI float wave_scan_add(float v, int lane) {
#pragma unroll
    for (int o = 1; o < 64; o <<= 1) { const float t = __shfl_up(v, o); if (lane >= o) v += t; }
    return v;
}
DI float wave_scan_max(float v, int lane) {
#pragma unroll
    for (int o = 1; o < 64; o <<= 1) { const float t = __shfl_up(v, o); if (lane >= o) v = fmaxf(v, t); }
    return v;
}
DI float xhalf_sum(float v) { return v + __shfl_xor(v, 32); }
DI float xhalf_max(float v) { return fmaxf(v, __shfl_xor(v, 32)); }
DI float ex2(float x) { return __builtin_amdgcn_exp2f(x); }
DI float exp_fast(float x) { return __builtin_amdgcn_exp2f(x * LOG2E); }
DI float sigmoid_fast(float x) { return __builtin_amdgcn_rcpf(1.f + exp_fast(-x)); }
DI float log_sigmoid_acc(float x) { return fminf(x, 0.f) - log1pf(expf(-fabsf(x))); }
DI f32x16 mfma32(bf16x8 a, bf16x8 b, f32x16 c) { return __builtin_amdgcn_mfma_f32_32x32x16_bf16(a, b, c, 0, 0, 0); }
DI f32x4 mfma16(bf16x8 a, bf16x8 b, f32x4 c) { return __builtin_amdgcn_mfma_f32_16x16x32_bf16(a, b, c, 0, 0, 0); }
typedef short v4i16_t __attribute__((ext_vector_type(4)));
DI s16x4 tr_read(const LAS unsigned char* p) { return __builtin_bit_cast(s16x4, __builtin_amdgcn_ds_read_tr16_b64_v4i16((LAS v4i16_t*)p)); }
DI bf16x8 cat8(s16x4 lo, s16x4 hi) { return __builtin_shufflevector(lo, hi, 0, 1, 2, 3, 4, 5, 6, 7); }
typedef int v8i32 __attribute__((ext_vector_type(8)));
typedef int v4i32 __attribute__((ext_vector_type(4)));
DI unsigned pk4_fp8(float a, float b, float c, float d) { int w = 0; w = __builtin_amdgcn_cvt_pk_fp8_f32(a, b, w, false); w = __builtin_amdgcn_cvt_pk_fp8_f32(c, d, w, true); return (unsigned)w; }
DI int crow(int r, int hi) { return (r & 3) + 8 * (r >> 2) + 4 * hi; }
DI bf16x8 pack8(const f32x16& x, int s) {
    u32x4 p;
    p.x = pk2(x[8 * s + 0], x[8 * s + 1]); p.y = pk2(x[8 * s + 2], x[8 * s + 3]); p.z = pk2(x[8 * s + 4], x[8 * s + 5]); p.w = pk2(x[8 * s + 6], x[8 * s + 7]);
    return __builtin_bit_cast(bf16x8, p);
}

namespace pg8 {
constexpr int BM = 256, BK = 64, HALF = 128, HTB = HALF * BK * 2, STAGE_BYTES = 8 * HTB, NXCD = 8, WGM = 8;
__host__ __device__ __forceinline__ int lds_byte(int r, int c) { const int st = (r >> 4) * 2 + (c >> 5), rr = r & 15, cc = c & 31, ob = rr * 64 + cc * 2; return st * 1024 + (ob ^ (((ob >> 9) & 1) << 5)); }
__host__ __device__ __forceinline__ void stage_rc(int b, int& R, int& C) { const int st = b / 1024, sb = b % 1024, swz = sb ^ (((sb >> 9) & 1) << 5); R = (st >> 1) * 16 + swz / 64; C = (st & 1) * 32 + (swz % 64) / 2; }
__host__ __device__ __forceinline__ int perm32(int rho) { const int n = rho >> 4, i = rho & 15; return 8 * (i >> 2) + 4 * n + (i & 3); }

struct Unit { int pm, pn, e, nvalid; const char* A; const char* B; const int* list; };

struct StaticSched {
    const char* A; const char* B; int K, nM, nN, nwg, G, c;
    DI void init(const void* A_, const void* B_, int M_, int N_, int K_, int G_, int c_) { A = (const char*)A_; B = (const char*)B_; K = K_; nM = M_ / BM; nN = N_ / BM; nwg = nM * nN; G = G_; c = c_; }
    DI bool next(int i, Unit& u) const {
        const long L = (long)i * G + c; if (L >= nwg) return false;
        int wgid = (int)L; { const int q = nwg / NXCD, r = nwg % NXCD, xcd = wgid % NXCD, off = wgid / NXCD; wgid = (xcd < r ? xcd * (q + 1) : r * (q + 1) + (xcd - r) * q) + off; }
        const int nig = WGM * nN, gid = wgid / nig, fm = gid * WGM, gsz = (nM - fm) < WGM ? (nM - fm) : WGM;
        u.pm = fm + ((wgid % nig) % gsz); u.pn = (wgid % nig) / gsz; u.e = 0; u.nvalid = BM; u.list = nullptr;
        u.A = A + (size_t)u.pm * BM * K * 2; u.B = B + (size_t)u.pn * BM * K * 2; return true;
    }
};
struct MoeSched {
    const char* A; const char* B; const int* list; const LAS int* tb; int K, NT, nwg, G, c; size_t bexp; bool gather;
    DI bool next(int i, Unit& u) const {
        const long L = (long)i * G + c; if (L >= nwg) return false;
        int wgid = (int)L; { const int q = nwg / NXCD, r = nwg % NXCD, xcd = wgid % NXCD, off = wgid / NXCD; wgid = (xcd < r ? xcd * (q + 1) : r * (q + 1) + (xcd - r) * q) + off; }
        const int g = wgid / NT, nt = wgid % NT;
        int e = 0;
#pragma unroll
        for (int j = 1; j < 32; ++j) e += (tb[j] <= g) ? 1 : 0;
        e = __builtin_amdgcn_readfirstlane(e);
        const int mt = g - __builtin_amdgcn_readfirstlane(tb[e]);
        u.pm = g; u.pn = nt; u.e = e; u.nvalid = __builtin_amdgcn_readfirstlane(tb[40 + e]) - mt * BM; u.list = list + (size_t)e * LCAP + mt * BM;
        u.A = gather ? A : A + (size_t)g * BM * K * 2; u.B = B + (size_t)e * bexp + (size_t)nt * BM * K * 2; return true;
    }
};

template <bool GATHER> DI void a_offsets(const Unit& u, int K, unsigned (&v)[2][2]) {
    int R[2], C[2];
#pragma unroll
    for (int i = 0; i < 2; ++i) stage_rc((int)threadIdx.x * 16 + i * 8192, R[i], C[i]);
#pragma unroll
    for (int h = 0; h < 2; ++h)
#pragma unroll
        for (int i = 0; i < 2; ++i) {
            const int row = h * HALF + R[i];
            if constexpr (GATHER) { const int rc = row < u.nvalid ? row : u.nvalid - 1; const int tok = u.list[rc]; v[h][i] = (unsigned)(tok * K + C[i]) * 2u; }
            else v[h][i] = (unsigned)(row * K + C[i]) * 2u;
        }
}

struct EpiBf16 {
    static constexpr bool PERM = true;
    bf16* O; int ldc; const float* bias; int bias_estride; float scale;
    DI void operator()(const f32x4 (&acc)[2][2][4][2], const Unit& u, int wr, int wc, int fr, int fq) const {
        const int row0 = u.pm * BM + wr * 64 + fr; const int col0 = u.pn * BM + wc * 32 + 8 * fq;
        f32x4 bv[2][2];
#pragma unroll
        for (int bj = 0; bj < 2; ++bj)
#pragma unroll
            for (int n = 0; n < 2; ++n) bv[bj][n] = bias ? *(const f32x4*)(bias + (size_t)u.e * bias_estride + col0 + bj * HALF + 4 * n) : (f32x4){0.f, 0.f, 0.f, 0.f};
#pragma unroll
        for (int ai = 0; ai < 2; ++ai)
#pragma unroll
            for (int m = 0; m < 4; ++m) { bf16* rowp = O + (size_t)(row0 + ai * HALF + m * 16) * ldc + col0;
#pragma unroll
                for (int bj = 0; bj < 2; ++bj) { const f32x4 v0 = acc[ai][bj][m][0] * scale + bv[bj][0], v1 = acc[ai][bj][m][1] * scale + bv[bj][1];
                    u32x4 w; w.x = pk2(v0[0], v0[1]); w.y = pk2(v0[2], v0[3]); w.z = pk2(v1[0], v1[1]); w.w = pk2(v1[2], v1[3]);
                    *(u32x4*)(rowp + bj * HALF) = w; } }
    }
};
struct EpiResF32 {
    static constexpr bool PERM = false;
    const float* base; float* out; int ldc; float alpha;
    DI void operator()(const f32x4 (&acc)[2][2][4][2], const Unit& u, int wr, int wc, int fr, int fq) const {
        const int col0 = u.pn * BM + wc * 32 + 4 * fq;
#pragma unroll
        for (int ai = 0; ai < 2; ++ai)
#pragma unroll
            for (int m = 0; m < 4; ++m) { const size_t off = (size_t)(u.pm * BM + ai * HALF + wr * 64 + m * 16 + fr) * ldc + col0;
#pragma unroll
                for (int bj = 0; bj < 2; ++bj)
#pragma unroll
                    for (int n = 0; n < 2; ++n) { const f32x4 bs = *(const f32x4*)(base + off + bj * HALF + n * 16); *(f32x4*)(out + off + bj * HALF + n * 16) = bs * alpha + acc[ai][bj][m][n]; } }
    }
};
struct EpiResBf16 {
    static constexpr bool PERM = true;
    const bf16* base; bf16* out; int ldc; float alpha;
    DI void operator()(const f32x4 (&acc)[2][2][4][2], const Unit& u, int wr, int wc, int fr, int fq) const {
        const int row0 = u.pm * BM + wr * 64 + fr; const int col0 = u.pn * BM + wc * 32 + 8 * fq;
#pragma unroll
        for (int ai = 0; ai < 2; ++ai)
#pragma unroll
            for (int m = 0; m < 4; ++m) { const size_t off = (size_t)(row0 + ai * HALF + m * 16) * ldc + col0;
#pragma unroll
                for (int bj = 0; bj < 2; ++bj) { const u32x4 b = *(const u32x4*)(base + off + bj * HALF); const f32x4 a0 = acc[ai][bj][m][0], a1 = acc[ai][bj][m][1];
                    u32x4 w; w.x = pk2(bf_lo(b.x) * alpha + a0[0], bf_hi(b.x) * alpha + a0[1]); w.y = pk2(bf_lo(b.y) * alpha + a0[2], bf_hi(b.y) * alpha + a0[3]);
                    w.z = pk2(bf_lo(b.z) * alpha + a1[0], bf_hi(b.z) * alpha + a1[1]); w.w = pk2(bf_lo(b.w) * alpha + a1[2], bf_hi(b.w) * alpha + a1[3]);
                    *(u32x4*)(out + off + bj * HALF) = w; } }
    }
};
struct EpiSwiglu {
    static constexpr bool PERM = true;
    unsigned char* O; const float* bias; float scale, oscale;
    DI void operator()(const f32x4 (&acc)[2][2][4][2], const Unit& u, int wr, int wc, int fr, int fq) const {
        const int row0 = u.pm * BM + wr * 64 + fr; const int j0 = wc * 32 + 8 * fq; const int col0 = u.pn * HALF + j0;
        const float* bg = bias + (size_t)u.e * 2048 + col0; const float* bl = bg + 1024;
        f32x4 bgv[2], blv[2];
#pragma unroll
        for (int n = 0; n < 2; ++n) { bgv[n] = *(const f32x4*)(bg + 4 * n); blv[n] = *(const f32x4*)(bl + 4 * n); }
#pragma unroll
        for (int ai = 0; ai < 2; ++ai)
#pragma unroll
            for (int m = 0; m < 4; ++m) { unsigned char* rowp = O + (size_t)(row0 + ai * HALF + m * 16) * 1024 + col0;
                float o[8];
#pragma unroll
                for (int n = 0; n < 2; ++n) { const f32x4 g = acc[ai][0][m][n] * scale + bgv[n], l = acc[ai][1][m][n] * scale + blv[n];
#pragma unroll
                    for (int q = 0; q < 4; ++q) { const float gg = fminf(g[q], 7.0f), ll = fminf(fmaxf(l[q], -7.0f), 7.0f);
                        o[4 * n + q] = gg * __builtin_amdgcn_rcpf(1.f + ex2(gg * (-1.702f * LOG2E))) * (ll + 1.f) * oscale; } }
                u32x2 w; w.x = pk4_fp8(o[0], o[1], o[2], o[3]); w.y = pk4_fp8(o[4], o[5], o[6], o[7]);
                *(u32x2*)rowp = w; }
    }
};

template <class Epi, class Sched, bool GATHER, bool ALIGN_EPI, bool FP8 = false>
DI void gemm_phase(LAS unsigned char* lds, const int K, const Sched& S, const Epi& E) {
    const int tid = threadIdx.x, wid = __builtin_amdgcn_readfirstlane(tid >> 6), lane = tid & 63, wr = wid >> 2, wc = wid & 3, fr = lane & 15, fq = lane >> 4;
    const int nt = K / BK;
    unsigned voffB[2];
#pragma unroll
    for (int i = 0; i < 2; ++i) { int R, C; stage_rc(tid * 16 + i * 8192, R, C); const int Rb = Epi::PERM ? ((R & ~31) + perm32(R & 31)) : R; voffB[i] = (unsigned)(Rb * K + C) * 2u; }
    const size_t kstep = (size_t)(BK * 2);
    const size_t hstep = (size_t)HALF * K * 2;
    const unsigned ldsw = (unsigned)wid * 1024u;
    const int aoff = lds_byte(wr * 64 + fr, fq * 8), boff = lds_byte(wc * 32 + fr, fq * 8);
#define PG8_SA(b, h) (((b) * 2 + (h)) * HTB)
#define PG8_SB(b, h) ((4 + (b) * 2 + (h)) * HTB)
#define PG8_STAGE(bufoff, gbase, voff) do { _Pragma("unroll") for (int _i = 0; _i < 2; ++_i) { unsigned _o = (voff)[_i]; asm volatile("" : "+v"(_o));   \
        __builtin_amdgcn_global_load_lds((const unsigned*)((const char*)(gbase) + _o), (LAS unsigned*)(lds + (bufoff) + ldsw + _i * 8192), 16, 0, 0); } } while (0)
#define PG8_LDA(dst, b, h) do { _Pragma("unroll") for (int m = 0; m < 4; ++m) _Pragma("unroll") for (int k = 0; k < 2; ++k) dst[m][k] = *(const LAS bf16x8*)(lds + PG8_SA(b, h) + aoff + m * 2048 + k * 1024); } while (0)
#define PG8_LDB(dst, b, h) do { _Pragma("unroll") for (int n = 0; n < 2; ++n) _Pragma("unroll") for (int k = 0; k < 2; ++k) dst[n][k] = *(const LAS bf16x8*)(lds + PG8_SB(b, h) + boff + n * 2048 + k * 1024); } while (0)
#define PG8_CAT(x) __builtin_shufflevector(__builtin_bit_cast(v4i32, x[0]), __builtin_bit_cast(v4i32, x[1]), 0, 1, 2, 3, 4, 5, 6, 7)
#define PG8_MMA(ai, bj, At, Bt) do { __builtin_amdgcn_s_setprio(1); _Pragma("unroll") for (int m = 0; m < 4; ++m) _Pragma("unroll") for (int n = 0; n < 2; ++n) { \
        if constexpr (FP8) { const v8i32 _a = PG8_CAT(Bt[n]), _b = PG8_CAT(At[m]); asm volatile("v_mfma_scale_f32_16x16x128_f8f6f4 %0, %1, %2, %0, %3, %3 op_sel_hi:[0,0,0]" : "+v"(acc[ai][bj][m][n]) : "v"(_a), "v"(_b), "v"(sc1)); } \
        else { _Pragma("unroll") for (int k = 0; k < 2; ++k) acc[ai][bj][m][n] = __builtin_amdgcn_mfma_f32_16x16x32_bf16(Bt[n][k], At[m][k], acc[ai][bj][m][n], 0, 0, 0); } } __builtin_amdgcn_s_setprio(0); } while (0)
#define PG8_WAIT_V(n) asm volatile("s_waitcnt vmcnt(" #n ")" ::: "memory")
#define PG8_WAIT_L(n) asm volatile("s_waitcnt lgkmcnt(" #n ")" ::: "memory")
#define PG8_BAR __builtin_amdgcn_s_barrier()
#define PG8_SCHED __builtin_amdgcn_sched_barrier(0)
    Unit cur, nxt; int ui = 0;
    if (!S.next(0, cur)) return;
    const int sc1 = 0x7f7f7f7f;
    unsigned vAc[2][2], vAn[2][2];
    a_offsets<GATHER>(cur, K, vAc);
    f32x4 acc[2][2][4][2];
#pragma unroll
    for (int a = 0; a < 2; ++a)
#pragma unroll
        for (int b = 0; b < 2; ++b)
#pragma unroll
            for (int m = 0; m < 4; ++m)
#pragma unroll
                for (int n = 0; n < 2; ++n) acc[a][b][m][n] = (f32x4){0.f, 0.f, 0.f, 0.f};
    bf16x8 At[4][2], B0[2][2], B1[2][2];
    const char* cA = cur.A; const char* cB = cur.B;
    PG8_STAGE(PG8_SB(0, 0), cB, voffB); PG8_STAGE(PG8_SB(0, 1), cB + hstep, voffB); PG8_STAGE(PG8_SA(0, 0), cA, vAc[0]); PG8_STAGE(PG8_SA(0, 1), cA, vAc[1]);
    if (wr == 1) PG8_BAR;
    PG8_WAIT_V(2); PG8_BAR;
    PG8_STAGE(PG8_SB(1, 0), cB + kstep, voffB); PG8_STAGE(PG8_SA(1, 0), cA + kstep, vAc[0]); PG8_STAGE(PG8_SB(1, 1), cB + hstep + kstep, voffB);
    PG8_WAIT_V(6); PG8_BAR;
    for (;;) {
        const bool has_next = S.next(ui + 1, nxt);
        if constexpr (GATHER) {
            if (has_next) a_offsets<GATHER>(nxt, K, vAn);
            else {
#pragma unroll
                for (int h = 0; h < 2; ++h)
#pragma unroll
                    for (int i = 0; i < 2; ++i) vAn[h][i] = vAc[h][i]; }
        }
        const char* nA = has_next ? nxt.A : cA; const char* nB = has_next ? nxt.B : cB;
#pragma unroll 1
        for (int t = 0; t < nt; t += 2) {
            const bool last = (t == nt - 2);
            const char* a1 = cA + (size_t)(t + 1) * kstep;
            const char* a2 = last ? nA : cA + (size_t)(t + 2) * kstep; const char* b2 = last ? nB : cB + (size_t)(t + 2) * kstep;
            const char* a3 = a2 + kstep; const char* b3 = b2 + kstep;
            unsigned v2[2][2];
#pragma unroll
            for (int h = 0; h < 2; ++h)
#pragma unroll
                for (int i = 0; i < 2; ++i) v2[h][i] = GATHER ? (last ? vAn[h][i] : vAc[h][i]) : vAc[h][i];
            PG8_LDB(B0, 0, 0); PG8_LDB(B1, 0, 1); PG8_SCHED; PG8_LDA(At, 0, 0); PG8_STAGE(PG8_SA(1, 1), a1, vAc[1]);
            PG8_WAIT_V(8); PG8_WAIT_L(0); PG8_BAR; PG8_MMA(0, 0, At, B0); PG8_MMA(0, 1, At, B1); PG8_BAR; PG8_SCHED;
            PG8_LDA(At, 0, 1); PG8_STAGE(PG8_SB(0, 0), b2, voffB); PG8_STAGE(PG8_SB(0, 1), b2 + hstep, voffB); PG8_STAGE(PG8_SA(0, 0), a2, v2[0]);
            PG8_WAIT_V(8); PG8_WAIT_L(0); PG8_BAR; PG8_MMA(1, 0, At, B0); PG8_MMA(1, 1, At, B1); PG8_BAR; PG8_SCHED;
            PG8_LDB(B0, 1, 0); PG8_LDB(B1, 1, 1); PG8_SCHED; PG8_LDA(At, 1, 0); PG8_STAGE(PG8_SA(0, 1), a2, v2[1]);
            PG8_WAIT_V(8); PG8_WAIT_L(0); PG8_BAR; PG8_MMA(0, 0, At, B0); PG8_MMA(0, 1, At, B1); PG8_BAR; PG8_SCHED;
            PG8_LDA(At, 1, 1); PG8_STAGE(PG8_SB(1, 0), b3, voffB); PG8_STAGE(PG8_SB(1, 1), b3 + hstep, voffB); PG8_STAGE(PG8_SA(1, 0), a3, v2[0]);
            PG8_WAIT_V(8); PG8_WAIT_L(0); PG8_BAR; PG8_MMA(1, 0, At, B0); PG8_MMA(1, 1, At, B1); PG8_BAR; PG8_SCHED;
        }
        if constexpr (FP8) asm volatile("s_nop 15\n\ts_nop 15" ::: "memory");
        if constexpr (ALIGN_EPI) { if (wr == 0) PG8_BAR; }
        E(acc, cur, wr, wc, fr, fq);
        if (!has_next) break;
#pragma unroll
        for (int a = 0; a < 2; ++a)
#pragma unroll
            for (int b = 0; b < 2; ++b)
#pragma unroll
                for (int m = 0; m < 4; ++m)
#pragma unroll
                    for (int n = 0; n < 2; ++n) acc[a][b][m][n] = (f32x4){0.f, 0.f, 0.f, 0.f};
        cur = nxt; cA = nA; cB = nB; ++ui;
        if constexpr (GATHER) {
#pragma unroll
            for (int h = 0; h < 2; ++h)
#pragma unroll
                for (int i = 0; i < 2; ++i) vAc[h][i] = vAn[h][i]; }
        if constexpr (ALIGN_EPI) { if (wr == 1) PG8_BAR; }
    }
    PG8_WAIT_V(0);
    if constexpr (!ALIGN_EPI) { if (wr == 0) PG8_BAR; }
    PG8_BAR;
#undef PG8_SA
#undef PG8_SB
#undef PG8_STAGE
#undef PG8_LDA
#undef PG8_LDB
#undef PG8_MMA
#undef PG8_CAT
#undef PG8_WAIT_V
#undef PG8_WAIT_L
#undef PG8_BAR
#undef PG8_SCHED
}
}

#define XB_TMO      128
#define XB_XCNT(j)  (256  + 64 * (j))
#define XB_XSUB(j)  (1280 + 64 * (j))
#define XB_XGEN(j)  (2304 + 64 * (j))
#define XB_TOP      3328
#define XB_TOPGEN   3392
#define XCD_BAR_WORDS 3456
#define XB_SPIN_CAP (1u << 18)
DI unsigned xb_ld(unsigned* p)              { return __hip_atomic_load(p, __ATOMIC_RELAXED, __HIP_MEMORY_SCOPE_AGENT); }
DI unsigned xb_add(unsigned* p, unsigned v) { return __hip_atomic_fetch_add(p, v, __ATOMIC_RELAXED, __HIP_MEMORY_SCOPE_AGENT); }
DI unsigned xb_xcc_id() { return (unsigned)__builtin_amdgcn_s_getreg((3 << 11) | 20) & 0xFu; }
#define XB_SPIN(cond, bar) do { unsigned _sp = 0; while (cond) { __builtin_amdgcn_s_sleep(1); \
    if ((++_sp & 255u) == 0u) { if (xb_ld(&(bar)[XB_TMO])) break; if (_sp > XB_SPIN_CAP) { atomicAdd(&(bar)[XB_TMO], 1u); break; } } } } while (0)
struct XcdBarrier { unsigned* bar; unsigned x; volatile LAS unsigned* st; };
DI XcdBarrier xcd_barrier_post(unsigned* bar, volatile LAS unsigned* st) {
    XcdBarrier b; b.bar = bar; b.x = xb_xcc_id(); b.st = st;
    if (threadIdx.x == 0) (void)xb_add(&bar[XB_XCNT(b.x)], 1u);
    return b;
}
DI void xcd_barrier_complete(unsigned* bar, unsigned x, unsigned& nloc, unsigned& nx) {
    const unsigned G = gridDim.x * gridDim.y * gridDim.z;
    unsigned sum, cnt, mine, sp = 0u;
    for (;;) {
        sum = 0u; cnt = 0u; mine = 0u;
#pragma unroll
        for (unsigned j = 0; j < 16; ++j) { const unsigned c = xb_ld(&bar[XB_XCNT(j)]); sum += c; cnt += (c > 0u) ? 1u : 0u; mine = (j == x) ? c : mine; }
        if (sum == G) break;
        __builtin_amdgcn_s_sleep(1);
        if ((++sp & 255u) == 0u) { if (xb_ld(&bar[XB_TMO])) break; if (sp > XB_SPIN_CAP) { atomicAdd(&bar[XB_TMO], 1u); break; } }
    }
    nloc = mine > 0u ? mine : 1u; nx = cnt > 0u ? cnt : 1u;
}
DI void xcd_barrier(const XcdBarrier& b) {
    asm volatile("s_waitcnt vmcnt(0)" ::: "memory");
    __syncthreads();
    if (threadIdx.x == 0) {
        unsigned* bar = b.bar;
        __builtin_amdgcn_s_waitcnt(0);
        unsigned nloc = b.st[0], nx = b.st[1];
        if (nloc == 0u) { xcd_barrier_complete(bar, b.x, nloc, nx); b.st[0] = nloc; b.st[1] = nx; }
        const unsigned old = xb_add(&bar[XB_XSUB(b.x)], 1u);
        const unsigned gen = old / nloc;
        if (old + 1u == (gen + 1u) * nloc) {
            __builtin_amdgcn_fence(__ATOMIC_RELEASE, "agent");
            asm volatile("s_waitcnt vmcnt(0)" ::: "memory");
            const unsigned og = xb_add(&bar[XB_TOP], 1u);
            const unsigned tg = og / nx;
            if (og + 1u == (tg + 1u) * nx) xb_add(&bar[XB_TOPGEN], 1u);
            else XB_SPIN(xb_ld(&bar[XB_TOPGEN]) == tg, bar);
            __builtin_amdgcn_fence(__ATOMIC_ACQUIRE, "agent");
            xb_add(&bar[XB_XGEN(b.x)], 1u);
            asm volatile("s_waitcnt vmcnt(0)" ::: "memory");
        } else {
            XB_SPIN(xb_ld(&bar[XB_XGEN(b.x)]) == gen, bar);
            __builtin_amdgcn_fence(__ATOMIC_ACQUIRE, "agent");
            asm volatile("s_waitcnt vmcnt(0)" ::: "memory");
        }
    }
    __syncthreads();
}

DI void p0_transpose_item(const float* W, int ldw, int K, bf16* WT, int src_n0, int dst_n0, int k0, LAS float* scr, int lane) {
#pragma unroll 8
    for (int i = 0; i < 32; ++i) { const int kk = 2 * i + (lane >> 5); scr[kk * 33 + (lane & 31)] = W[(size_t)(k0 + kk) * ldw + src_n0 + (lane & 31)]; }
    asm volatile("s_waitcnt lgkmcnt(0)" ::: "memory");
    const int c = lane & 7;
#pragma unroll
    for (int j = 0; j < 4; ++j) { const int n = (lane >> 3) + 8 * j; const LAS float* s = scr + (8 * c) * 33 + n;
        u32x4 o; o.x = pk2(s[0 * 33], s[1 * 33]); o.y = pk2(s[2 * 33], s[3 * 33]); o.z = pk2(s[4 * 33], s[5 * 33]); o.w = pk2(s[6 * 33], s[7 * 33]);
        *(u32x4*)(WT + (size_t)(dst_n0 + n) * K + k0 + 8 * c) = o; }
    asm volatile("s_waitcnt lgkmcnt(0)" ::: "memory");
}

DI void p0_transpose_fp8(const float* W, int ldw, unsigned char* WT, int kbytes, int src_n0, int dst_n0, int k0, float scale, LAS unsigned* scr, int lane) {
    const int kq = lane >> 3, nq = lane & 7;
    f32x4 v[16];
#pragma unroll
    for (int i = 0; i < 16; ++i) { const int k = 32 * (i >> 2) + 4 * kq + (i & 3); v[i] = *(const f32x4*)(W + (size_t)(k0 + k) * ldw + src_n0 + 4 * nq); }
#pragma unroll
    for (int g = 0; g < 4; ++g)
#pragma unroll
        for (int c = 0; c < 4; ++c) scr[(4 * nq + c) * 33 + 8 * g + kq] = pk4_fp8(v[4 * g][c] * scale, v[4 * g + 1][c] * scale, v[4 * g + 2][c] * scale, v[4 * g + 3][c] * scale);
    asm volatile("s_waitcnt lgkmcnt(0)" ::: "memory");
    const int ch = lane & 7;
#pragma unroll
    for (int j = 0; j < 4; ++j) { const int n = (lane >> 3) + 8 * j; const LAS unsigned* s = scr + n * 33 + 4 * ch;
        u32x4 o; o.x = s[0]; o.y = s[1]; o.z = s[2]; o.w = s[3];
        *(u32x4*)(WT + (size_t)(dst_n0 + n) * kbytes + k0 + 16 * ch) = o; }
    asm volatile("s_waitcnt lgkmcnt(0)" ::: "memory");
}

DI void ln_row(f32x4 (&v)[4], const float* g, const float* bta, int lane) {
    float s = 0.f;
#pragma unroll
    for (int j = 0; j < 4; ++j) s += (v[j].x + v[j].y) + (v[j].z + v[j].w);
    const float mean = wave_sum(s) * (1.f / D); float s2 = 0.f;
#pragma unroll
    for (int j = 0; j < 4; ++j) { v[j] = v[j] - mean; s2 += (v[j].x * v[j].x + v[j].y * v[j].y) + (v[j].z * v[j].z + v[j].w * v[j].w); }
    const float rstd = 1.f / sqrtf(wave_sum(s2) * (1.f / D) + LN_EPS);
#pragma unroll
    for (int j = 0; j < 4; ++j) { const f32x4 gg = *(const f32x4*)(g + 4 * lane + 256 * j), bb = *(const f32x4*)(bta + 4 * lane + 256 * j); v[j] = v[j] * rstd * gg + bb; }
}
DI void store_row_bf16(bf16* orow, const f32x4 (&v)[4], int lane) {
    u32x2* o8 = (u32x2*)orow + lane;
#pragma unroll
    for (int j = 0; j < 4; ++j) { u32x2 w; w.x = pk2(v[j].x, v[j].y); w.y = pk2(v[j].z, v[j].w); o8[64 * j] = w; }
}

DI void load_row_bf16(const bf16* irow, f32x4 (&v)[4], int lane) {
    const u32x2* i8 = (const u32x2*)irow + lane;
#pragma unroll
    for (int j = 0; j < 4; ++j) { const u32x2 w = i8[64 * j]; v[j] = (f32x4){bf_lo(w.x), bf_hi(w.x), bf_lo(w.y), bf_hi(w.y)}; }
}
DI void store_row_fp8(unsigned char* orow, const f32x4 (&v)[4], float scale, int lane) {
    unsigned* o4 = (unsigned*)orow + lane;
#pragma unroll
    for (int j = 0; j < 4; ++j) o4[64 * j] = pk4_fp8(v[j].x * scale, v[j].y * scale, v[j].z * scale, v[j].w * scale);
}

DI void fox_unit(int b, int h8, int qb, const bf16* U, const float* Fc2, const float* fox_g, bf16* MIX, LAS unsigned char* lds) {
    const int tid = threadIdx.x, lane = tid & 63, wave = __builtin_amdgcn_readfirstlane(tid >> 6);
    const int r = lane & 31, h = lane >> 5, i16 = lane & 15, q4 = i16 >> 2, p4 = i16 & 3, blk = (lane >> 4) & 1;
    const int tok0 = b * SEQ, q0 = qb * 256, qrow = q0 + wave * 32 + r;
    const float C2 = 0.125f * LOG2E;
    bf16x8 qf[4];
    { const bf16* qp = U + (size_t)(tok0 + qrow) * NU + UC_FQ + h8 * 64 + 8 * h;
#pragma unroll
      for (int d0 = 0; d0 < 4; ++d0) qf[d0] = *(const bf16x8*)(qp + 16 * d0); }
    float m = -1e30f, l = 0.f; f32x16 oT[2];
#pragma unroll
    for (int i = 0; i < 16; ++i) { oT[0][i] = 0.f; oT[1][i] = 0.f; }
    LAS unsigned char* Ks = lds; LAS unsigned char* Vs = lds + 9216; LAS float* nb = (LAS float*)(lds + 18432);
    const int NT = 4 * qb + 4;
    const float* fc = Fc2 + (size_t)(b * 8 + h8) * SEQ;
    for (int t = 0; t < NT; ++t) {
        __syncthreads();
        { const int row = tid >> 3, pc = tid & 7; const bf16* gp = U + (size_t)(tok0 + 64 * t + row) * NU + h8 * 64 + pc * 8;
          const u32x4 kv = *(const u32x4*)(gp + UC_FK), vv = *(const u32x4*)(gp + UC_FV);
          *(LAS u32x4*)(Ks + row * 144 + pc * 16) = kv; *(LAS u32x4*)(Vs + row * 144 + pc * 16) = vv; }
        if (tid < 64) nb[tid] = fc[64 * t + tid];
        __syncthreads();
        f32x16 p[2];
#pragma unroll
        for (int hb = 0; hb < 2; ++hb) {
            f32x16 a;
#pragma unroll
            for (int i = 0; i < 16; ++i) a[i] = 0.f;
#pragma unroll
            for (int d0 = 0; d0 < 4; ++d0) { const bf16x8 kf = *(const LAS bf16x8*)(Ks + (32 * hb + r) * 144 + (16 * d0 + 8 * h) * 2); a = mfma32(kf, qf[d0], a); }
#pragma unroll
            for (int g = 0; g < 4; ++g) { const f32x4 bb = *(const LAS f32x4*)(nb + 32 * hb + 8 * g + 4 * h);
#pragma unroll
                for (int e = 0; e < 4; ++e) a[4 * g + e] = a[4 * g + e] * C2 + bb[e]; }
            p[hb] = a;
        }
        if (t >= NT - 4) {
#pragma unroll
            for (int hb = 0; hb < 2; ++hb)
#pragma unroll
                for (int i = 0; i < 16; ++i) { const int kv = 64 * t + 32 * hb + crow(i, h); if (kv > qrow) p[hb][i] = -INFINITY; }
        }
        float mx = p[0][0];
#pragma unroll
        for (int i = 1; i < 16; ++i) mx = fmaxf(mx, p[0][i]);
#pragma unroll
        for (int i = 0; i < 16; ++i) mx = fmaxf(mx, p[1][i]);
        mx = xhalf_max(mx);
        const float mn = fmaxf(m, mx), alpha = ex2(m - mn); m = mn;
        float rs = 0.f;
#pragma unroll
        for (int hb = 0; hb < 2; ++hb)
#pragma unroll
            for (int i = 0; i < 16; ++i) { const float e = ex2(p[hb][i] - mn); p[hb][i] = e; rs += e; }
        l = l * alpha + rs;
#pragma unroll
        for (int i = 0; i < 16; ++i) { oT[0][i] *= alpha; oT[1][i] *= alpha; }
        bf16x8 pf[2][2];
#pragma unroll
        for (int hb = 0; hb < 2; ++hb)
#pragma unroll
            for (int s = 0; s < 2; ++s) pf[hb][s] = pack8(p[hb], s);
#pragma unroll
        for (int d0 = 0; d0 < 2; ++d0)
#pragma unroll
            for (int hb = 0; hb < 2; ++hb)
#pragma unroll
                for (int s = 0; s < 2; ++s) {
                    const LAS unsigned char* vp = Vs + (32 * hb + 16 * s + 4 * h + q4) * 144 + (32 * d0 + 16 * blk + 4 * p4) * 2;
                    const s16x4 lo = tr_read(vp), hi = tr_read(vp + 8 * 144);
                    oT[d0] = mfma32(cat8(lo, hi), pf[hb][s], oT[d0]);
                }
    }
    l = xhalf_sum(l);
    const float inv = 1.f / l;
    float ss = 0.f;
#pragma unroll
    for (int d0 = 0; d0 < 2; ++d0)
#pragma unroll
        for (int i = 0; i < 16; ++i) { const float o = oT[d0][i] * inv; oT[d0][i] = o; ss += o * o; }
    ss = xhalf_sum(ss);
    const float rr = 1.f / sqrtf(ss * (1.f / 64.f) + RMS_EPS);
    bf16* op = MIX + (size_t)(tok0 + qrow) * D + h8 * 64;
#pragma unroll
    for (int d0 = 0; d0 < 2; ++d0)
#pragma unroll
        for (int g = 0; g < 4; ++g) { const int d = 32 * d0 + 8 * g + 4 * h; const f32x4 gn = *(const f32x4*)(fox_g + h8 * 64 + d);
            u32x2 w; w.x = pk2(oT[d0][4 * g] * rr * gn.x, oT[d0][4 * g + 1] * rr * gn.y); w.y = pk2(oT[d0][4 * g + 2] * rr * gn.z, oT[d0][4 * g + 3] * rr * gn.w);
            *(u32x2*)(op + d) = w; }
}

DI void m1_unit(int bh, int cg, const bf16* U, const float* G, const float* conv_w, bf16* Mq, bf16* Mk, float* KvT, float* Nc, float* Gc, float* Mloc, LAS unsigned char* lds) {
    const int tid = threadIdx.x, lane = tid & 63, wave = __builtin_amdgcn_readfirstlane(tid >> 6);
    const int r = lane & 31, h = lane >> 5, i16 = lane & 15, q4 = i16 >> 2, p4 = i16 & 3, blk = (lane >> 4) & 1;
    const int b = bh >> 2, hh = bh & 3, s0 = cg * 256;
    LAS float* wa = (LAS float*)lds;
    LAS unsigned char* ksb = lds + 1024;
    LAS unsigned char* vsb = lds + 1024 + 36864;
    __syncthreads();
    if (wave < 4) {
        const int c = cg * 4 + wave, tok = b * SEQ + c * 64 + lane;
        const float lf = G[(size_t)tok * 16 + 12 + hh], li = G[(size_t)tok * 16 + 8 + hh];
        const float bsc = wave_scan_add(lf, lane);
        const float g = __shfl(bsc, 63);
        const float a = g - bsc + li;
        const float ml = wave_max(a);
        wa[wave * 64 + lane] = expf(a - ml);
        if (lane == 0) { Gc[bh * 64 + c] = g; Mloc[bh * 64 + c] = ml; }
    }
    __syncthreads();
#pragma unroll 2
    for (int i = 0; i < 8; ++i) {
        const int id = tid + 512 * i, d8 = id & 7, qk = (id >> 3) & 1, t = id >> 4;
        const int ucol = (qk ? UC_MK : UC_MQ) + hh * 64 + 8 * d8, ccol = (qk ? 256 : 0) + hh * 64 + 8 * d8;
        float acc[8];
#pragma unroll
        for (int e = 0; e < 8; ++e) acc[e] = 0.f;
#pragma unroll
        for (int j = 0; j < 4; ++j) {
            const int ts = s0 + t - 3 + j;
            if (ts >= 0) {
                const u32x4 x = *(const u32x4*)(U + (size_t)(b * SEQ + ts) * NU + ucol);
                const f32x4 w0 = *(const f32x4*)(conv_w + j * 512 + ccol), w1 = *(const f32x4*)(conv_w + j * 512 + ccol + 4);
                acc[0] += bf_lo(x.x) * w0.x; acc[1] += bf_hi(x.x) * w0.y; acc[2] += bf_lo(x.y) * w0.z; acc[3] += bf_hi(x.y) * w0.w;
                acc[4] += bf_lo(x.z) * w1.x; acc[5] += bf_hi(x.z) * w1.y; acc[6] += bf_lo(x.w) * w1.z; acc[7] += bf_hi(x.w) * w1.w;
            }
        }
#pragma unroll
        for (int e = 0; e < 8; ++e) acc[e] = acc[e] / (1.f + expf(-acc[e]));
        const size_t orow = ((size_t)bh * SEQ + s0 + t) * 64 + 8 * d8;
        if (qk == 0) {
            u32x4 w; w.x = pk2(acc[0], acc[1]); w.y = pk2(acc[2], acc[3]); w.z = pk2(acc[4], acc[5]); w.w = pk2(acc[6], acc[7]);
            *(u32x4*)(Mq + orow) = w;
        } else {
#pragma unroll
            for (int e = 0; e < 8; ++e) acc[e] *= 0.125f;
            u32x4 w; w.x = pk2(acc[0], acc[1]); w.y = pk2(acc[2], acc[3]); w.z = pk2(acc[4], acc[5]); w.w = pk2(acc[6], acc[7]);
            *(u32x4*)(Mk + orow) = w;
            const float ww = wa[t];
            u32x4 x; x.x = pk2(acc[0] * ww, acc[1] * ww); x.y = pk2(acc[2] * ww, acc[3] * ww); x.z = pk2(acc[4] * ww, acc[5] * ww); x.w = pk2(acc[6] * ww, acc[7] * ww);
            *(LAS u32x4*)(ksb + (t >> 6) * 9216 + (t & 63) * 144 + d8 * 16) = x;
        }
    }
#pragma unroll
    for (int i = 0; i < 8; ++i) { const int id = tid + 512 * i, pc = id & 15, t = id >> 4;
        const u32x4 v = *(const u32x4*)(U + (size_t)(b * SEQ + s0 + t) * NU + UC_MV + hh * 128 + pc * 8);
        *(LAS u32x4*)(vsb + (t >> 6) * 17408 + (t & 63) * 272 + pc * 16) = v; }
    __syncthreads();
    {
        const int cl = wave >> 1, eh = wave & 1, c = cg * 4 + cl;
        const LAS unsigned char* vs = vsb + cl * 17408; const LAS unsigned char* ks = ksb + cl * 9216;
        f32x16 acc[2][2];
#pragma unroll
        for (int a = 0; a < 2; ++a)
#pragma unroll
            for (int bb = 0; bb < 2; ++bb)
#pragma unroll
                for (int i = 0; i < 16; ++i) acc[a][bb][i] = 0.f;
#pragma unroll
        for (int k4 = 0; k4 < 4; ++k4) {
            bf16x8 af[2], bfr[2];
#pragma unroll
            for (int eb = 0; eb < 2; ++eb) { const LAS unsigned char* pp = vs + (16 * k4 + 8 * h + q4) * 272 + (64 * eh + 32 * eb + 16 * blk + 4 * p4) * 2; af[eb] = cat8(tr_read(pp), tr_read(pp + 4 * 272)); }
#pragma unroll
            for (int db = 0; db < 2; ++db) { const LAS unsigned char* pp = ks + (16 * k4 + 8 * h + q4) * 144 + (32 * db + 16 * blk + 4 * p4) * 2; bfr[db] = cat8(tr_read(pp), tr_read(pp + 4 * 144)); }
#pragma unroll
            for (int eb = 0; eb < 2; ++eb)
#pragma unroll
                for (int db = 0; db < 2; ++db) acc[eb][db] = mfma32(af[eb], bfr[db], acc[eb][db]);
        }
        float* op = KvT + (size_t)(bh * 64 + c) * 8192;
#pragma unroll
        for (int eb = 0; eb < 2; ++eb)
#pragma unroll
            for (int db = 0; db < 2; ++db)
#pragma unroll
                for (int i = 0; i < 16; ++i) op[(64 * eh + 32 * eb + crow(i, h)) * 64 + 32 * db + r] = acc[eb][db][i];
    }
    if (tid < 256) { const int cl = tid >> 6, d = tid & 63; const LAS unsigned char* ks = ksb + cl * 9216 + d * 2; float s = 0.f;
#pragma unroll 8
        for (int t = 0; t < 64; ++t) s += __uint_as_float(((unsigned)*(const LAS unsigned short*)(ks + t * 144)) << 16);
        Nc[(size_t)(bh * 64 + cg * 4 + cl) * 64 + d] = s; }
}

DI void m3_unit(int bh, int cg, const bf16* U, const float* G, const bf16* Mq, const bf16* Mk, const bf16* CpT, const float* Np, const float* Mp, const float* mlstm_g, bf16* MIX, LAS unsigned char* lds) {
    const int tid = threadIdx.x, lane = tid & 63, wave = __builtin_amdgcn_readfirstlane(tid >> 6);
    const int r = lane & 31, h = lane >> 5, i16 = lane & 15, q4 = i16 >> 2, p4 = i16 & 3, blk = (lane >> 4) & 1;
    const int b = bh >> 2, hh = bh & 3, cl = wave >> 1, th = wave & 1, c = cg * 4 + cl;
    const int tokc = b * SEQ + c * 64;
    const LAS unsigned char* Vs = lds + cl * 17408;
    LAS float* wsf = (LAS float*)(lds + 69632 + wave * 1024);
    __syncthreads();
#pragma unroll
    for (int i = 0; i < 8; ++i) { const int id = tid + 512 * i, pc = id & 15, t = id >> 4;
        const u32x4 v = *(const u32x4*)(U + (size_t)(b * SEQ + cg * 256 + t) * NU + UC_MV + hh * 128 + pc * 8);
        *(LAS u32x4*)(lds + (t >> 6) * 17408 + (t & 63) * 272 + pc * 16) = v; }
    const float mprev = Mp[bh * 64 + c];
    {
        const float lf = G[(size_t)(tokc + lane) * 16 + 12 + hh], li = G[(size_t)(tokc + lane) * 16 + 8 + hh];
        const float bsc = wave_scan_add(lf, lane);
        const float pm = wave_scan_max(li - bsc, lane);
        wsf[lane] = bsc; wsf[64 + lane] = li; wsf[128 + lane] = bsc + fmaxf(mprev, pm); wsf[192 + lane] = Np[(size_t)(bh * 64 + c) * 64 + lane];
    }
    __syncthreads();
    const int tl = 32 * th + r;
    const float bt = wsf[tl], mtt = wsf[128 + tl];
    const float winter = expf(bt + mprev - mtt);
    bf16x8 qf[4];
    { const bf16* qp = Mq + ((size_t)bh * SEQ + c * 64 + tl) * 64 + 8 * h;
#pragma unroll
      for (int ks = 0; ks < 4; ++ks) qf[ks] = *(const bf16x8*)(qp + 16 * ks); }
    float qn = 0.f;
#pragma unroll
    for (int ks = 0; ks < 4; ++ks)
#pragma unroll
        for (int j = 0; j < 8; ++j) qn += bf2f(qf[ks][j]) * wsf[192 + 16 * ks + 8 * h + j];
    qn = xhalf_sum(qn);
    f32x16 accT[4];
#pragma unroll
    for (int eb = 0; eb < 4; ++eb) {
        f32x16 a;
#pragma unroll
        for (int i = 0; i < 16; ++i) a[i] = 0.f;
#pragma unroll
        for (int ks = 0; ks < 4; ++ks) { const bf16x8 cf = *(const bf16x8*)(CpT + ((size_t)(bh * 64 + c) * 128 + 32 * eb + r) * 64 + 16 * ks + 8 * h); a = mfma32(cf, qf[ks], a); }
#pragma unroll
        for (int i = 0; i < 16; ++i) a[i] *= winter;
        accT[eb] = a;
    }
    float psum = 0.f; f32x16 pT[2];
#pragma unroll
    for (int sb = 0; sb < 2; ++sb) {
        f32x16 a;
#pragma unroll
        for (int i = 0; i < 16; ++i) a[i] = 0.f;
#pragma unroll
        for (int ks = 0; ks < 4; ++ks) { const bf16x8 kf = *(const bf16x8*)(Mk + ((size_t)bh * SEQ + c * 64 + 32 * sb + r) * 64 + 16 * ks + 8 * h); a = mfma32(kf, qf[ks], a); }
#pragma unroll
        for (int g = 0; g < 4; ++g) { const f32x4 b4 = *(const LAS f32x4*)(wsf + 32 * sb + 8 * g + 4 * h), l4 = *(const LAS f32x4*)(wsf + 64 + 32 * sb + 8 * g + 4 * h);
#pragma unroll
            for (int e = 0; e < 4; ++e) { const int s = 32 * sb + 8 * g + 4 * h + e; const float w = (s <= tl) ? expf(bt - b4[e] + l4[e] - mtt) * a[4 * g + e] : 0.f; a[4 * g + e] = w; psum += w; } }
        pT[sb] = a;
    }
    psum = xhalf_sum(psum);
#pragma unroll
    for (int eb = 0; eb < 4; ++eb)
#pragma unroll
        for (int sb = 0; sb < 2; ++sb)
#pragma unroll
            for (int s2 = 0; s2 < 2; ++s2) {
                const LAS unsigned char* vp = Vs + (32 * sb + 16 * s2 + 4 * h + q4) * 272 + (32 * eb + 16 * blk + 4 * p4) * 2;
                const s16x4 lo = tr_read(vp), hi = tr_read(vp + 8 * 272);
                accT[eb] = mfma32(cat8(lo, hi), pack8(pT[sb], s2), accT[eb]);
            }
    const float den = winter * qn + psum;
    const float hs = 1.f / fmaxf(fabsf(den), expf(-mtt));
    float ss = 0.f;
#pragma unroll
    for (int eb = 0; eb < 4; ++eb)
#pragma unroll
        for (int i = 0; i < 16; ++i) { const float v = accT[eb][i] * hs; accT[eb][i] = v; ss += v * v; }
    ss = xhalf_sum(ss);
    const float rr = 1.f / sqrtf(ss * (1.f / 128.f) + RMS_EPS);
    const int tok = tokc + tl;
#pragma unroll
    for (int eb = 0; eb < 4; ++eb)
#pragma unroll
        for (int g = 0; g < 4; ++g) { const int e = 32 * eb + 8 * g + 4 * h;
            const f32x4 gn = *(const f32x4*)(mlstm_g + hh * 128 + e);
            const u32x2 mo = *(const u32x2*)(U + (size_t)tok * NU + UC_MO + hh * 128 + e);
            const float o0 = accT[eb][4 * g] * rr * gn.x * sigmoid_fast(bf_lo(mo.x)), o1 = accT[eb][4 * g + 1] * rr * gn.y * sigmoid_fast(bf_hi(mo.x));
            const float o2 = accT[eb][4 * g + 2] * rr * gn.z * sigmoid_fast(bf_lo(mo.y)), o3 = accT[eb][4 * g + 3] * rr * gn.w * sigmoid_fast(bf_hi(mo.y));
            u32x2 w; w.x = pk2(o0, o1); w.y = pk2(o2, o3);
            *(u32x2*)(MIX + (size_t)tok * D + 512 + hh * 128 + e) = w; }
}

DI void xattn_unit(int b, int hx, int qb, bf16* QX, const bf16* KVx, LAS unsigned char* lds) {
    const int tid = threadIdx.x, lane = tid & 63, wave = __builtin_amdgcn_readfirstlane(tid >> 6);
    const int r = lane & 31, h = lane >> 5, i16 = lane & 15, q4 = i16 >> 2, p4 = i16 & 3, blk = (lane >> 4) & 1;
    const int tok = b * SEQ + qb * 256 + wave * 32 + r;
    bf16x8 qf[16];
    { const bf16* qp = QX + (size_t)tok * D + hx * 256 + 8 * h;
#pragma unroll
      for (int ks = 0; ks < 16; ++ks) qf[ks] = *(const bf16x8*)(qp + 16 * ks); }
    f32x16 sT[8];
    LAS unsigned char* Kx = lds; LAS unsigned char* Vx = lds + 33792;
#pragma unroll
    for (int kt = 0; kt < 4; ++kt) {
        __syncthreads();
#pragma unroll
        for (int i = 0; i < 4; ++i) { const int id = tid + 512 * i, row = id >> 5, pc = id & 31;
            const u32x4 v = *(const u32x4*)(KVx + (size_t)(b * NMEM + 64 * kt + row) * 2048 + hx * 256 + pc * 8);
            *(LAS u32x4*)(Kx + row * 528 + pc * 16) = v; }
        __syncthreads();
#pragma unroll
        for (int mb = 0; mb < 2; ++mb) {
            f32x16 a;
#pragma unroll
            for (int i = 0; i < 16; ++i) a[i] = 0.f;
#pragma unroll
            for (int ks = 0; ks < 16; ++ks) { const bf16x8 kf = *(const LAS bf16x8*)(Kx + (32 * mb + r) * 528 + (16 * ks + 8 * h) * 2); a = mfma32(kf, qf[ks], a); }
            sT[2 * kt + mb] = a;
        }
    }
    const float C2X = 0.0625f * LOG2E;
    float mx = -INFINITY;
#pragma unroll
    for (int j = 0; j < 8; ++j)
#pragma unroll
        for (int i = 0; i < 16; ++i) mx = fmaxf(mx, sT[j][i]);
    mx = xhalf_max(mx);
    const float mb2 = mx * C2X;
    float lsum = 0.f;
#pragma unroll
    for (int j = 0; j < 8; ++j)
#pragma unroll
        for (int i = 0; i < 16; ++i) { const float e = ex2(sT[j][i] * C2X - mb2); sT[j][i] = e; lsum += e; }
    lsum = xhalf_sum(lsum);
    const float inv = 1.f / lsum;
    bf16x8 pf[8][2];
#pragma unroll
    for (int j = 0; j < 8; ++j)
#pragma unroll
        for (int s = 0; s < 2; ++s) pf[j][s] = pack8(sT[j], s);
#pragma unroll
    for (int vh = 0; vh < 2; ++vh) {
        __syncthreads();
#pragma unroll
        for (int i = 0; i < 8; ++i) { const int id = tid + 512 * i, row = id >> 4, pc = id & 15;
            const u32x4 v = *(const u32x4*)(KVx + (size_t)(b * NMEM + row) * 2048 + 1024 + hx * 256 + 128 * vh + pc * 8);
            *(LAS u32x4*)(Vx + row * 272 + pc * 16) = v; }
        __syncthreads();
#pragma unroll
        for (int eb = 0; eb < 4; ++eb) {
            f32x16 acc;
#pragma unroll
            for (int i = 0; i < 16; ++i) acc[i] = 0.f;
#pragma unroll
            for (int j = 0; j < 8; ++j)
#pragma unroll
                for (int s = 0; s < 2; ++s) {
                    const LAS unsigned char* vp = Vx + (32 * j + 16 * s + 4 * h + q4) * 272 + (32 * eb + 16 * blk + 4 * p4) * 2;
                    const s16x4 lo = tr_read(vp), hi = tr_read(vp + 8 * 272);
                    acc = mfma32(cat8(lo, hi), pf[j][s], acc);
                }
#pragma unroll
            for (int g = 0; g < 4; ++g) { const int d = 128 * vh + 32 * eb + 8 * g + 4 * h;
                u32x2 w; w.x = pk2(acc[4 * g] * inv, acc[4 * g + 1] * inv); w.y = pk2(acc[4 * g + 2] * inv, acc[4 * g + 3] * inv);
                *(u32x2*)(QX + (size_t)tok * D + hx * 256 + d) = w; }
        }
    }
}

DI void moe_tables(LAS int* tb, gu32* ctl, int tid) {
    __syncthreads();
    if (tid < 32) tb[40 + tid] = (int)__hip_atomic_load(ctl + CW_CNT + 64 * tid, RLX_AGENT);
    __syncthreads();
    if (tid == 0) { int s = 0; for (int e = 0; e < 32; ++e) { tb[e] = s; s += (tb[40 + e] + 255) >> 8; } tb[32] = s; }
    __syncthreads();
}

struct Args { const float* in[26]; float* out; unsigned char* ws; int ph_lo, ph_hi, li, pad; };

__global__ void __launch_bounds__(NWAVES * 64, 2) fwd(Args args) {
    extern __shared__ __attribute__((aligned(16))) unsigned char lds_raw[];
    LAS unsigned char* lds = (LAS unsigned char*)lds_raw;
    volatile LAS unsigned* MISC = (volatile LAS unsigned*)(lds + MISC_OFF);
    const int tid = threadIdx.x, lane = tid & 63, wave = __builtin_amdgcn_readfirstlane(tid >> 6);
    const int G = gridDim.x, bx = blockIdx.x;
    const int vcu = (G % 8 == 0) ? (bx % 8) * (G / 8) + bx / 8 : bx;
    unsigned char* ws = args.ws;
    gu32* ctl = (gu32*)(ws + WS_CTL);
    const float* x = args.in[0]; const float* mem = args.in[1]; const float* w_in = args.in[2]; const float* fox_f_bias = args.in[3];
    const float* conv_w = args.in[4]; const float* i_bias = args.in[5]; const float* f_bias = args.in[6]; const float* fox_g = args.in[7];
    const float* mlstm_g = args.in[8]; const float* w_out = args.in[9]; const float* ln1_g = args.in[10]; const float* ln1_b = args.in[11];
    const float* w_xq = args.in[12]; const float* w_xk = args.in[13]; const float* w_xv = args.in[14]; const float* w_xo = args.in[15];
    const float* ln2_g = args.in[16]; const float* ln2_b = args.in[17]; const float* w_router = args.in[18]; const float* b_router = args.in[19];
    const float* w_gu = args.in[20]; const float* b_gu = args.in[21]; const float* w_dn = args.in[22]; const float* b_dn = args.in[23];
    const float* ln3_g = args.in[24]; const float* ln3_b = args.in[25];
    float* out = args.out;
    float* Gt = (float*)(ws + WS_G); float* Fc2 = (float*)(ws + WS_FC2);
    float* Gc = (float*)(ws + WS_GC); float* Mloc = Gc + 1024; float* Mp = Gc + 2048;
    float* Nc = (float*)(ws + WS_NC); float* Np = (float*)(ws + WS_NP);
    int* Tidx = (int*)(ws + WS_TIDX); float* Tgate = (float*)(ws + WS_TGATE); int* Tslot = (int*)(ws + WS_TSLOT); int* List = (int*)(ws + WS_LIST);
    bf16* KVx = (bf16*)(ws + WS_MEMKV);
    bf16* Win_t = (bf16*)(ws + WS_WIN); bf16* Wout_t = (bf16*)(ws + WS_WOUT); bf16* Wxq_t = (bf16*)(ws + WS_WXQ); bf16* Wxo_t = (bf16*)(ws + WS_WXO);
    unsigned char* Wgu8 = ws + WS_WGU; unsigned char* Wdn8 = ws + WS_WDN;
    bf16* XB = (bf16*)(ws + WS_XB); bf16* U = (bf16*)(ws + WS_U); bf16* Mq = (bf16*)(ws + WS_MQ); bf16* Mk = (bf16*)(ws + WS_MK);
    float* KvT = (float*)(ws + WS_KVT); bf16* CpT = (bf16*)(ws + WS_CPT); bf16* MIX = (bf16*)(ws + WS_MIX);
    bf16* Y1 = (bf16*)(ws + WS_Y1); bf16* X2B = (bf16*)(ws + WS_Y1 + 32 * MiB); bf16* X1B = (bf16*)(ws + WS_X1B); bf16* QX = (bf16*)(ws + WS_QX);
    bf16* Y2 = (bf16*)(ws + WS_Y2); unsigned char* X2F8 = ws + WS_X2B; unsigned char* HID8 = ws + WS_HID; bf16* YB = (bf16*)(ws + WS_YB);

    for (int u = tid; u < (LDS_BYTES - LDSCTL_OFF) / 4; u += NWAVES * 64) ((LAS unsigned*)(lds + LDSCTL_OFF))[u] = 0u;
    __syncthreads();
    XcdBarrier bar; bar.bar = (unsigned*)(ctl + CW_BAR); bar.x = 0; bar.st = nullptr;
    if (N_LAUNCHES == 1) bar = xcd_barrier_post((unsigned*)(ctl + CW_BAR), MISC + 8);
#define GRID_BAR() do { if (N_LAUNCHES == 1) xcd_barrier(bar); } while (0)
    const int lo = args.ph_lo, hi = args.ph_hi;
#ifndef PH_MASK
#define PH_MASK 0xFFFF
#endif
#define IN(k) (((PH_MASK >> (k)) & 1) && lo <= (k) && (k) < hi)
#define BOTH(k) (IN(k) && IN((k) + 1))
#ifndef REP_MASK
#define REP_MASK 0
#endif
#define REPS(k) (1 + ((REP_MASK >> (k)) & 1))
#define END_PHASE(k) do { if (BOTH(k) || rep + 1 < REPS(k)) GRID_BAR(); } while (0)

    if (IN(0)) for (int rep = 0; rep < REPS(0); ++rep) {
        {
            LAS float* wg = (LAS float*)lds;
            for (int idx = tid; idx < 1024 * 16; idx += 512) { const int k = idx >> 4, c = idx & 15; const int col = c < 8 ? 1536 + c : 2568 + (c - 8);
                const int j = k >> 8, ln = (k & 255) >> 2, i = k & 3; wg[((((j * 4 + i) * 4 + (c >> 2)) * 64 + ln) << 2) + (c & 3)] = w_in[(size_t)k * NIN + col]; }
            __syncthreads();
            for (int m = bx * 8 + wave; m < M; m += G * 8) {
                asm volatile("" ::: "memory");
                const f32x4* xr = (const f32x4*)(x + (size_t)m * D) + lane;
                f32x4 v[4];
#pragma unroll
                for (int j = 0; j < 4; ++j) v[j] = xr[64 * j];
                store_row_bf16(XB + (size_t)m * D, v, lane);
                float acc[16];
#pragma unroll
                for (int c = 0; c < 16; ++c) acc[c] = 0.f;
#pragma unroll
                for (int j = 0; j < 4; ++j)
#pragma unroll
                    for (int i = 0; i < 4; ++i) { const LAS f32x4* wp = (const LAS f32x4*)wg + ((j * 4 + i) * 4) * 64 + lane; const float xv = v[j][i];
#pragma unroll
                        for (int c4 = 0; c4 < 4; ++c4) { const f32x4 w = wp[c4 * 64]; acc[4 * c4] += xv * w.x; acc[4 * c4 + 1] += xv * w.y; acc[4 * c4 + 2] += xv * w.z; acc[4 * c4 + 3] += xv * w.w; } }
#define TR_STEP(HALFN, XORM) { const bool up = (lane & (XORM)) != 0; _Pragma("unroll") for (int i = 0; i < (HALFN); ++i) { const float keep = up ? acc[(HALFN) + i] : acc[i], send = up ? acc[i] : acc[(HALFN) + i]; acc[i] = keep + __shfl_xor(send, (XORM)); } }
                TR_STEP(8, 8) TR_STEP(4, 4) TR_STEP(2, 2) TR_STEP(1, 1)
#undef TR_STEP
                float mine = acc[0]; mine += __shfl_xor(mine, 16); mine += __shfl_xor(mine, 32);
                if (lane < 16) {
                    float o;
                    if (lane < 8) o = log_sigmoid_acc(mine + fox_f_bias[lane]);
                    else if (lane < 12) o = mine + i_bias[lane - 8];
                    else o = log_sigmoid_acc(mine + f_bias[lane - 12]);
                    Gt[(size_t)m * 16 + lane] = o;
                }
            }
            __syncthreads();
        }
        {
            LAS unsigned char* As = lds; LAS unsigned char* Bs = lds + 17408;
            for (int tile = bx; tile < 256; tile += G) {
                const int rt = tile >> 4, ct = tile & 15;
                const float* W = ct < 8 ? w_xk : w_xv; const int col0 = 128 * (ct & 7);
                f32x4 acc[4];
#pragma unroll
                for (int rb = 0; rb < 4; ++rb) acc[rb] = (f32x4){0.f, 0.f, 0.f, 0.f};
                for (int k0 = 0; k0 < 1024; k0 += 128) {
                    __syncthreads();
#pragma unroll
                    for (int i = 0; i < 4; ++i) { const int p = tid + 512 * i, row = p >> 5, c4 = p & 31;
                        const f32x4 a = *(const f32x4*)(mem + (size_t)(64 * rt + row) * D + k0 + 4 * c4);
                        u32x2 w; w.x = pk2(a.x, a.y); w.y = pk2(a.z, a.w); *(LAS u32x2*)(As + row * 272 + c4 * 8) = w; }
#pragma unroll
                    for (int i = 0; i < 8; ++i) { const int p = tid + 512 * i, k = p >> 5, c4 = p & 31;
                        const f32x4 a = *(const f32x4*)(W + (size_t)(k0 + k) * D + col0 + 4 * c4);
                        LAS unsigned short* bp = (LAS unsigned short*)(Bs + (4 * c4) * 272 + k * 2);
                        const unsigned w0 = pk2(a.x, a.y), w1 = pk2(a.z, a.w);
                        bp[0] = (unsigned short)(w0 & 0xffffu); bp[136] = (unsigned short)(w0 >> 16); bp[272] = (unsigned short)(w1 & 0xffffu); bp[408] = (unsigned short)(w1 >> 16); }
                    __syncthreads();
#pragma unroll
                    for (int kk = 0; kk < 4; ++kk) {
                        const bf16x8 bfr = *(const LAS bf16x8*)(Bs + (16 * wave + (lane & 15)) * 272 + (32 * kk + 8 * (lane >> 4)) * 2);
#pragma unroll
                        for (int rb = 0; rb < 4; ++rb) { const bf16x8 afr = *(const LAS bf16x8*)(As + (16 * rb + (lane & 15)) * 272 + (32 * kk + 8 * (lane >> 4)) * 2); acc[rb] = mfma16(afr, bfr, acc[rb]); }
                    }
                }
#pragma unroll
                for (int rb = 0; rb < 4; ++rb)
#pragma unroll
                    for (int j = 0; j < 4; ++j) { const int row = 64 * rt + 16 * rb + 4 * (lane >> 4) + j, col = 128 * ct + 16 * wave + (lane & 15);
                        KVx[(size_t)row * 2048 + col] = (bf16)(pk2(acc[rb][j], 0.f) & 0xffffu); }
            }
            __syncthreads();
        }
        {
            LAS float* scr = (LAS float*)(lds + wave * 16384);
            const int gw = vcu * NWAVES + wave, NGW = G * NWAVES;
            constexpr int I_GU = 32 * 8 * 64, I_DN = 32 * 8 * 32, I_IN = 16 * 96, I_SQ = 16 * 32;
            constexpr int NITEMS = I_GU + I_DN + I_IN + 3 * I_SQ;
            for (int it = gw; it < NITEMS; it += NGW) {
                int q = it;
                if (q < I_GU) { const int e = q >> 9, rr = q & 511, kb = rr >> 6, nb = rr & 63, n0 = 32 * nb; const int bj = n0 >> 10, rem = n0 & 1023, pn = rem >> 7, j0 = rem & 127;
                    p0_transpose_fp8(w_gu + (size_t)e * 1024 * 2048, 2048, Wgu8 + (size_t)e * 2048 * 1024, 1024, n0, 256 * pn + 128 * bj + j0, 128 * kb, WGU_SCALE, (LAS unsigned*)scr, lane); continue; }
                q -= I_GU;
                if (q < I_DN) { const int e = q >> 8, rr = q & 255, kb = rr >> 5, nb = rr & 31;
                    p0_transpose_fp8(w_dn + (size_t)e * 1024 * 1024, 1024, Wdn8 + (size_t)e * 1024 * 1024, 1024, 32 * nb, 32 * nb, 128 * kb, WDN_SCALE, (LAS unsigned*)scr, lane); continue; }
                q -= I_DN;
                if (q < I_IN) { const int kb = q / 96, nb = q % 96, dn0 = 32 * nb; const int sn0 = dn0 < 1536 ? dn0 : (dn0 < 2560 ? dn0 + 8 : dn0 + 16);
                    p0_transpose_item(w_in, NIN, 1024, Win_t, sn0, dn0, 64 * kb, scr, lane); continue; }
                q -= I_IN;
                { const int which = q / I_SQ, rr = q % I_SQ, kb = rr >> 5, nb = rr & 31;
                  const float* W = which == 0 ? w_out : (which == 1 ? w_xq : w_xo); bf16* WT = which == 0 ? Wout_t : (which == 1 ? Wxq_t : Wxo_t);
                  p0_transpose_item(W, 1024, 1024, WT, 32 * nb, 32 * nb, 64 * kb, scr, lane); }
            }
        }
        END_PHASE(0);
    }

    if (IN(1)) for (int rep = 0; rep < REPS(1); ++rep) {
        pg8::StaticSched S; S.init(XB, Win_t, M, NU, D, G, bx);
        pg8::EpiBf16 E{U, NU, nullptr, 0, 1.f};
        pg8::gemm_phase<pg8::EpiBf16, pg8::StaticSched, false, true>(lds, D, S, E);
        END_PHASE(1);
    }

    if (IN(2)) for (int rep = 0; rep < REPS(2); ++rep) {
        for (int u = bx; u < 256; u += G) m1_unit(u >> 4, u & 15, U, Gt, conv_w, Mq, Mk, KvT, Nc, Gc, Mloc, lds);
        __syncthreads();
        for (int sq = bx; sq < 32; sq += G) {
            const int b8 = sq >> 3, h8 = sq & 7; LAS float* wt = (LAS float*)lds;
            float v[8]; float run = 0.f;
#pragma unroll
            for (int i = 0; i < 8; ++i) { run += Gt[(size_t)(b8 * SEQ + 8 * tid + i) * 16 + h8]; v[i] = run; }
            const float incl = wave_scan_add(run, lane);
            if (lane == 63) wt[wave] = incl;
            __syncthreads();
            float off = incl - run;
            for (int w = 0; w < wave; ++w) off += wt[w];
#pragma unroll
            for (int i = 0; i < 8; ++i) Fc2[(size_t)sq * SEQ + 8 * tid + i] = -(off + v[i]) * LOG2E;
            __syncthreads();
        }
        END_PHASE(2);
    }

    if (IN(3)) for (int rep = 0; rep < REPS(3); ++rep) {
        LAS float* sg = (LAS float*)lds;
        for (int ch = bx; ch < 256; ch += G) {
            const int bh = ch >> 4, part = ch & 15, idx = 512 * part + tid;
            __syncthreads();
            if (tid < 64) { sg[tid] = Gc[bh * 64 + tid]; sg[64 + tid] = Mloc[bh * 64 + tid]; }
            __syncthreads();
            if (tid == 0) { float mm = 0.f;
                for (int c = 0; c < 64; ++c) { const float g = sg[c], mc = sg[64 + c]; if (part == 0) Mp[bh * 64 + c] = mm; const float mn = fmaxf(g + mm, mc); sg[128 + c] = expf(g + mm - mn); sg[192 + c] = expf(mc - mn); mm = mn; } }
            __syncthreads();
            float C = 0.f;
            const float* kp = KvT + (size_t)bh * 64 * 8192 + idx; bf16* cp = CpT + (size_t)bh * 64 * 8192 + idx;
            float kvv[64];
#pragma unroll
            for (int c = 0; c < 64; ++c) kvv[c] = kp[(size_t)c * 8192];
#pragma unroll
            for (int c = 0; c < 64; ++c) { cp[(size_t)c * 8192] = (bf16)(pk2(C, 0.f) & 0xffffu); C = sg[128 + c] * C + sg[192 + c] * kvv[c]; }
            if (part == 0 && tid < 64) { float n = 0.f;
#pragma unroll 8
                for (int c = 0; c < 64; ++c) { Np[(size_t)(bh * 64 + c) * 64 + tid] = n; n = sg[128 + c] * n + sg[192 + c] * Nc[(size_t)(bh * 64 + c) * 64 + tid]; } }
        }
        END_PHASE(3);
    }

    if (IN(4)) for (int rep = 0; rep < REPS(4); ++rep) {
        for (int pr = vcu; pr < 256; pr += G) { const int bh8 = pr >> 3, s = pr & 7;
            fox_unit(bh8 >> 3, bh8 & 7, 15 - s, U, Fc2, fox_g, MIX, lds);
            fox_unit(bh8 >> 3, bh8 & 7, s, U, Fc2, fox_g, MIX, lds); }
        for (int u = bx; u < 256; u += G) m3_unit(u >> 4, u & 15, U, Gt, Mq, Mk, CpT, Np, Mp, mlstm_g, MIX, lds);
        END_PHASE(4);
    }

    if (IN(5)) for (int rep = 0; rep < REPS(5); ++rep) {
        pg8::StaticSched S; S.init(MIX, Wout_t, M, D, D, G, bx);
        pg8::EpiResBf16 E{XB, Y1, D, ALPHA};
        pg8::gemm_phase<pg8::EpiResBf16, pg8::StaticSched, false, false>(lds, D, S, E);
        END_PHASE(5);
    }

    if (IN(6)) for (int rep = 0; rep < REPS(6); ++rep) {
        for (int m = bx * 8 + wave; m < M; m += G * 8) {
            f32x4 v[4];
            load_row_bf16(Y1 + (size_t)m * D, v, lane);
            ln_row(v, ln1_g, ln1_b, lane);
            store_row_bf16(X1B + (size_t)m * D, v, lane);
        }
        END_PHASE(6);
    }

    if (IN(7)) for (int rep = 0; rep < REPS(7); ++rep) {
        pg8::StaticSched S; S.init(X1B, Wxq_t, M, D, D, G, bx);
        pg8::EpiBf16 E{QX, D, nullptr, 0, 1.f};
        pg8::gemm_phase<pg8::EpiBf16, pg8::StaticSched, false, false>(lds, D, S, E);
        END_PHASE(7);
    }

    if (IN(8)) for (int rep = 0; rep < REPS(8); ++rep) {
        for (int u = vcu; u < 256; u += G) xattn_unit(u >> 6, (u >> 4) & 3, u & 15, QX, KVx, lds);
        END_PHASE(8);
    }

    if (IN(9)) for (int rep = 0; rep < REPS(9); ++rep) {
        pg8::StaticSched S; S.init(QX, Wxo_t, M, D, D, G, bx);
        pg8::EpiResBf16 E{X1B, Y2, D, ALPHA};
        pg8::gemm_phase<pg8::EpiResBf16, pg8::StaticSched, false, false>(lds, D, S, E);
        END_PHASE(9);
    }

    if (IN(10)) for (int rep = 0; rep < REPS(10); ++rep) {
        LAS float* wrT = (LAS float*)lds;
        LAS int* hist = (LAS int*)(lds + RT_OFF); LAS int* ebase = hist + 32; LAS int* tokE = hist + 64; LAS int* tokR = hist + 320;
        __syncthreads();
        for (int idx = tid; idx < 1024 * 8; idx += 512) { const int k = idx >> 3, e4 = (idx & 7) * 4; const f32x4 w = *(const f32x4*)(w_router + k * 32 + e4);
            wrT[(e4 + 0) * 1024 + k] = w.x; wrT[(e4 + 1) * 1024 + k] = w.y; wrT[(e4 + 2) * 1024 + k] = w.z; wrT[(e4 + 3) * 1024 + k] = w.w; }
        if (tid < 32) hist[tid] = 0;
        __syncthreads();
        for (int grp = bx; grp < M / 64; grp += G) {
            for (int tl = wave; tl < 64; tl += 8) {
                const int tok = grp * 64 + tl;
                f32x4 v[4];
                load_row_bf16(Y2 + (size_t)tok * D, v, lane);
                ln_row(v, ln2_g, ln2_b, lane);
                store_row_bf16(X2B + (size_t)tok * D, v, lane);
                store_row_fp8(X2F8 + (size_t)tok * D, v, X2_SCALE, lane);
                float acc[32];
#pragma unroll
                for (int e = 0; e < 32; ++e) { float a = 0.f;
#pragma unroll
                    for (int j = 0; j < 4; ++j) { const f32x4 w = *(const LAS f32x4*)(wrT + e * 1024 + 256 * j + 4 * lane); a += (v[j].x * w.x + v[j].y * w.y) + (v[j].z * w.z + v[j].w * w.w); }
                    acc[e] = a; }
#define TR_STEP(HALFN, XORM) { const bool up = (lane & (XORM)) != 0; _Pragma("unroll") for (int i = 0; i < (HALFN); ++i) { const float keep = up ? acc[(HALFN) + i] : acc[i], send = up ? acc[i] : acc[(HALFN) + i]; acc[i] = keep + __shfl_xor(send, (XORM)); } }
                TR_STEP(16, 16) TR_STEP(8, 8) TR_STEP(4, 4) TR_STEP(2, 2) TR_STEP(1, 1)
#undef TR_STEP
                float lg = acc[0] + __shfl_xor(acc[0], 32);
                lg += b_router[lane & 31];
                float tv[4]; int ti[4]; float cur = lg;
#pragma unroll
                for (int k = 0; k < 4; ++k) {
                    float bv = cur; int bi = lane & 31;
#pragma unroll
                    for (int o = 1; o < 32; o <<= 1) { const float ov = __shfl_xor(bv, o); const int oi = __shfl_xor(bi, o); if (ov > bv || (ov == bv && oi < bi)) { bv = ov; bi = oi; } }
                    tv[k] = bv; ti[k] = bi; if ((lane & 31) == bi) cur = -INFINITY;
                }
                const float e1 = expf(tv[1] - tv[0]), e2 = expf(tv[2] - tv[0]), e3 = expf(tv[3] - tv[0]); const float isum = 1.f / (1.f + e1 + e2 + e3);
                if (lane == 0) {
                    const float gs[4] = {isum, e1 * isum, e2 * isum, e3 * isum};
#pragma unroll
                    for (int k = 0; k < 4; ++k) { const int rk = atomicAdd((int*)&hist[ti[k]], 1); tokE[tl * 4 + k] = ti[k]; tokR[tl * 4 + k] = rk; Tidx[tok * 4 + k] = ti[k]; Tgate[tok * 4 + k] = gs[k]; }
                }
            }
            __syncthreads();
            if (tid < 32) { const int c = hist[tid]; ebase[tid] = c ? (int)__hip_atomic_fetch_add(ctl + CW_CNT + 64 * tid, (unsigned)c, RLX_AGENT) : 0; hist[tid] = 0; }
            __syncthreads();
            if (tid < 256) { const int tl = tid >> 2, e = tokE[tid], slot = ebase[e] + tokR[tid]; List[(size_t)e * LCAP + slot] = grp * 64 + tl; Tslot[(grp * 64 + tl) * 4 + (tid & 3)] = slot; }
            __syncthreads();
        }
        END_PHASE(10);
    }

    if (IN(11)) for (int rep = 0; rep < REPS(11); ++rep) {
        LAS int* tb = (LAS int*)(lds + MOE_TB_OFF);
        moe_tables(tb, ctl, tid);
        pg8::MoeSched S; S.A = (const char*)X2F8; S.B = (const char*)Wgu8; S.list = List; S.tb = tb; S.K = 512; S.NT = 8; S.nwg = __builtin_amdgcn_readfirstlane(tb[32]) * 8; S.G = G; S.c = bx; S.bexp = (size_t)2048 * 1024; S.gather = true;
        pg8::EpiSwiglu E{HID8, b_gu, 1.f / (WGU_SCALE * X2_SCALE), HID_SCALE};
        pg8::gemm_phase<pg8::EpiSwiglu, pg8::MoeSched, true, true, true>(lds, 512, S, E);
        END_PHASE(11);
    }

    if (IN(12)) for (int rep = 0; rep < REPS(12); ++rep) {
        LAS int* tb = (LAS int*)(lds + MOE_TB_OFF);
        moe_tables(tb, ctl, tid);
        pg8::MoeSched S; S.A = (const char*)HID8; S.B = (const char*)Wdn8; S.list = List; S.tb = tb; S.K = 512; S.NT = 4; S.nwg = __builtin_amdgcn_readfirstlane(tb[32]) * 4; S.G = G; S.c = bx; S.bexp = (size_t)1024 * 1024; S.gather = false;
        pg8::EpiBf16 E{YB, D, b_dn, 1024, 1.f / (WDN_SCALE * HID_SCALE)};
        pg8::gemm_phase<pg8::EpiBf16, pg8::MoeSched, false, true, true>(lds, 512, S, E);
        END_PHASE(12);
    }

    if (IN(13)) for (int rep = 0; rep < REPS(13); ++rep) {
        LAS int* tb = (LAS int*)(lds + MOE_TB_OFF);
        moe_tables(tb, ctl, tid);
        for (int m0 = (bx * 8 + wave) * 2; m0 < M; m0 += G * 16) {
            int rowi = 0; float gk = 0.f;
            if (lane < 8) { const int q = (m0 + (lane >> 2)) * 4 + (lane & 3); const int e = Tidx[q]; rowi = tb[e] * 256 + Tslot[q]; gk = Tgate[q]; }
            f32x4 v[2][4]; u32x2 y[2][4][4]; float gg[2][4];
#pragma unroll
            for (int t = 0; t < 2; ++t) {
                const u32x2* xr = (const u32x2*)(X2B + (size_t)(m0 + t) * D) + lane;
#pragma unroll
                for (int j = 0; j < 4; ++j) { const u32x2 w = xr[64 * j]; v[t][j] = (f32x4){bf_lo(w.x), bf_hi(w.x), bf_lo(w.y), bf_hi(w.y)}; }
#pragma unroll
                for (int k = 0; k < 4; ++k) { const int rk = __shfl(rowi, 4 * t + k); gg[t][k] = __shfl(gk, 4 * t + k);
                    const u32x2* yr = (const u32x2*)(YB + (size_t)rk * D) + lane;
#pragma unroll
                    for (int j = 0; j < 4; ++j) y[t][k][j] = yr[64 * j]; }
            }
#pragma unroll
            for (int t = 0; t < 2; ++t) {
#pragma unroll
                for (int j = 0; j < 4; ++j) v[t][j] = v[t][j] * ALPHA;
#pragma unroll
                for (int k = 0; k < 4; ++k)
#pragma unroll
                    for (int j = 0; j < 4; ++j) { const u32x2 w = y[t][k][j]; const float g1 = gg[t][k]; v[t][j].x += g1 * bf_lo(w.x); v[t][j].y += g1 * bf_hi(w.x); v[t][j].z += g1 * bf_lo(w.y); v[t][j].w += g1 * bf_hi(w.y); }
                ln_row(v[t], ln3_g, ln3_b, lane);
                f32x4* orow = (f32x4*)(out + (size_t)(m0 + t) * D) + lane;
#pragma unroll
                for (int j = 0; j < 4; ++j) orow[64 * j] = v[t][j];
            }
        }
        if (rep + 1 < REPS(13)) GRID_BAR();
    }
#undef IN
#undef BOTH
#undef GRID_BAR
}

extern "C" void kernel_launch(void* const* d_in, const int* in_sizes, int n_in, void* d_out, int out_size, void* d_ws, size_t ws_size, hipStream_t stream) {
    static int grid = 0;
    if (grid == 0) {
        if (n_in != 26 || in_sizes[0] != M * D || out_size != M * D || ws_size < WS_END) { fprintf(stderr, "kernel_launch: unexpected shapes (n_in %d, in0 %d, out %d, ws %zu)\n", n_in, n_in > 0 ? in_sizes[0] : -1, out_size, ws_size); grid = -1; return; }
        int dev = 0, cus = 0, per_cu = 0;
        if (hipGetDevice(&dev) != hipSuccess || hipDeviceGetAttribute(&cus, hipDeviceAttributeMultiprocessorCount, dev) != hipSuccess) { grid = -1; return; }
        if (hipFuncSetAttribute((const void*)fwd, hipFuncAttributeMaxDynamicSharedMemorySize, LDS_BYTES) != hipSuccess) { fprintf(stderr, "kernel_launch: hipFuncSetAttribute failed\n"); grid = -1; return; }
        if (hipOccupancyMaxActiveBlocksPerMultiprocessor(&per_cu, (const void*)fwd, NWAVES * 64, LDS_BYTES) != hipSuccess || per_cu < 1) fprintf(stderr, "kernel_launch: occupancy query reports %d\n", per_cu);
        (void)hipGetLastError();
        grid = cus;
    }
    if (grid < 0) return;
    if (hipMemsetAsync((char*)d_ws + WS_CTL, 0, CTL_ZERO_BYTES, stream) != hipSuccess) return;
    Args a{};
    for (int i = 0; i < 26; ++i) a.in[i] = (const float*)d_in[i];
    a.out = (float*)d_out; a.ws = (unsigned char*)d_ws;
    if (N_LAUNCHES == 1) {
        a.ph_lo = 0; a.ph_hi = NPHASE; a.li = 0;
        hipLaunchKernelGGL(fwd, dim3(grid), dim3(NWAVES * 64), LDS_BYTES, stream, a);
    } else {
        for (int li = 0; li < NPHASE; ++li) { a.ph_lo = li; a.ph_hi = li + 1; a.li = li; hipLaunchKernelGGL(fwd, dim3(grid), dim3(NWAVES * 64), LDS_BYTES, stream, a); }
    }
}
```

```cpp
#include <hip/hip_runtime.h>
#include <cstdio>
#include <cstdint>
#include <cmath>

#define DI __device__ __forceinline__
#define LAS __attribute__((address_space(3)))
#define GAS __attribute__((address_space(1)))
typedef unsigned short bf16;
typedef short bf16x8 __attribute__((ext_vector_type(8)));
typedef short s16x4 __attribute__((ext_vector_type(4)));
typedef float f32x2 __attribute__((ext_vector_type(2)));
typedef float f32x4 __attribute__((ext_vector_type(4)));
typedef float f32x16 __attribute__((ext_vector_type(16)));
typedef unsigned u32x2 __attribute__((ext_vector_type(2)));
typedef unsigned u32x4 __attribute__((ext_vector_type(4)));
typedef GAS unsigned gu32;

#ifndef MK_N_LAUNCHES
#define MK_N_LAUNCHES 1
#endif

constexpr int BATCH = 4, SEQ = 4096, D = 1024, M = BATCH * SEQ, NMEM = 256;
constexpr int NIN = 3088;
constexpr int NU = 3072;
constexpr int UC_FQ = 0, UC_FK = 512, UC_FV = 1024, UC_MQ = 1536, UC_MK = 1792, UC_MV = 2048, UC_MO = 2560;
constexpr int NE = 32, TOPK = 4, LCAP = 16384;
constexpr int PROWS = M * TOPK + NE * 256;
constexpr float ALPHA = 1.189207115002721f;
constexpr float LOG2E = 1.4426950408889634f;
constexpr float LN_EPS = 1e-5f, RMS_EPS = 1e-6f;
constexpr int NPHASE = 14;
constexpr float WGU_SCALE = 32.f, WDN_SCALE = 64.f, X2_SCALE = 4.f, HID_SCALE = 4.f;
constexpr int N_LAUNCHES = MK_N_LAUNCHES;

constexpr size_t MiB = 1u << 20;
constexpr size_t WS_CTL = 0, CTL_ZERO_BYTES = 1 * MiB;
constexpr size_t WS_G = 1 * MiB;
constexpr size_t WS_FC2 = 2 * MiB;
constexpr size_t WS_GC = 2 * MiB + 512 * 1024;
constexpr size_t WS_NC = 3 * MiB;
constexpr size_t WS_NP = 3 * MiB + 256 * 1024;
constexpr size_t WS_TIDX = 3 * MiB + 512 * 1024;
constexpr size_t WS_TGATE = 3 * MiB + 768 * 1024;
constexpr size_t WS_TSLOT = 4 * MiB;
constexpr size_t WS_LIST = 5 * MiB;
constexpr size_t WS_MEMKV = 8 * MiB;
constexpr size_t WS_WIN = 16 * MiB, WS_WOUT = 22 * MiB, WS_WXQ = 24 * MiB, WS_WXO = 26 * MiB;
constexpr size_t WS_WGU = 32 * MiB, WS_WDN = 160 * MiB;
constexpr size_t WS_XB = 224 * MiB;
constexpr size_t WS_U = 256 * MiB;
constexpr size_t WS_MQ = 352 * MiB, WS_MK = 360 * MiB;
constexpr size_t WS_KVT = 368 * MiB;
constexpr size_t WS_CPT = 400 * MiB;
constexpr size_t WS_MIX = 432 * MiB;
constexpr size_t WS_Y1 = 464 * MiB;
constexpr size_t WS_X1B = 528 * MiB;
constexpr size_t WS_QX = 560 * MiB;
constexpr size_t WS_Y2 = 596 * MiB;
constexpr size_t WS_X2B = 660 * MiB;
constexpr size_t WS_HID = 692 * MiB;
constexpr size_t WS_YB = 836 * MiB;
constexpr size_t WS_END = 980 * MiB;
constexpr int CW_TMO = 0, CW_CODE = 1;
constexpr int CW_CNT = 1024;
constexpr int CW_BAR = 4096;

constexpr int RING_BYTES = 131072;
constexpr int LDSCTL_OFF = RING_BYTES, MISC_OFF = LDSCTL_OFF + 320;
constexpr int MOE_TB_OFF = LDSCTL_OFF + 1024;
constexpr int RT_OFF = LDSCTL_OFF + 2048;
constexpr int LDS_BYTES = 147456;
constexpr int NWAVES = 8;

#define RLX_AGENT __ATOMIC_RELAXED, __HIP_MEMORY_SCOPE_AGENT
DI float bf_lo(unsigned u) { return __uint_as_float(u << 16); }
DI float bf_hi(unsigned u) { return __uint_as_float(u & 0xffff0000u); }
DI float bf2f(short s) { return __uint_as_float(((unsigned)(unsigned short)s) << 16); }
typedef __bf16 bf16x2_t __attribute__((ext_vector_type(2)));
DI unsigned pk2(float lo, float hi) { f32x2 v = {lo, hi}; bf16x2_t b = __builtin_convertvector(v, bf16x2_t); return __builtin_bit_cast(unsigned, b); }
DI float wave_sum(float v) {
#pragma unroll
    for (int o = 1; o < 64; o <<= 1) v += __shfl_xor(v, o);
    return v;
}
DI float wave_max(float v) {
#pragma unroll
    for (int o = 1; o < 64; o <<= 1) v = fmaxf(v, __shfl_xor(v, o));
    return v;
}
DI float wave_scan_add(float v, int lane) {
#pragma unroll
    for (int o = 1; o < 64; o <<= 1) { const float t = __shfl_up(v, o); if (lane >= o) v += t; }
    return v;
}
DI float wave_scan_max(float v, int lane) {
#pragma unroll
    for (int o = 1; o < 64; o <<= 1) { const float t = __shfl_up(v, o); if (lane >= o) v = fmaxf(v, t); }
    return v;
}
DI float xhalf_sum(float v) { return v + __shfl_xor(v, 32); }
DI float xhalf_max(float v) { return fmaxf(v, __shfl_xor(v, 32)); }
DI float ex2(float x) { return __builtin_amdgcn_exp2f(x); }
DI float exp_fast(float x) { return __builtin_amdgcn_exp2f(x * LOG2E); }
DI float sigmoid_fast(float x) { return __builtin_amdgcn_rcpf(1.f + exp_fast(-x)); }
DI float log_sigmoid_acc(float x) { return fminf(x, 0.f) - log1pf(expf(-fabsf(x))); }
DI f32x16 mfma32(bf16x8 a, bf16x8 b, f32x16 c) { return __builtin_amdgcn_mfma_f32_32x32x16_bf16(a, b, c, 0, 0, 0); }
DI f32x4 mfma16(bf16x8 a, bf16x8 b, f32x4 c) { return __builtin_amdgcn_mfma_f32_16x16x32_bf16(a, b, c, 0, 0, 0); }
typedef short v4i16_t __attribute__((ext_vector_type(4)));
DI s16x4 tr_read(const LAS unsigned char* p) { return __builtin_bit_cast(s16x4, __builtin_amdgcn_ds_read_tr16_b64_v4i16((LAS v4i16_t*)p)); }
DI bf16x8 cat8(s16x4 lo, s16x4 hi) { return __builtin_shufflevector(lo, hi, 0, 1, 2, 3, 4, 5, 6, 7); }
typedef int v8i32 __attribute__((ext_vector_type(8)));
typedef int v4i32 __attribute__((ext_vector_type(4)));
DI unsigned pk4_fp8(float a, float b, float c, float d) { int w = 0; w = __builtin_amdgcn_cvt_pk_fp8_f32(a, b, w, false); w = __builtin_amdgcn_cvt_pk_fp8_f32(c, d, w, true); return (unsigned)w; }
DI int crow(int r, int hi) { return (r & 3) + 8 * (r >> 2) + 4 * hi; }
DI bf16x8 pack8(const f32x16& x, int s) {
    u32x4 p;
    p.x = pk2(x[8 * s + 0], x[8 * s + 1]); p.y = pk2(x[8 * s + 2], x[8 * s + 3]); p.z = pk2(x[8 * s + 4], x[8 * s + 5]); p.w = pk2(x[8 * s + 6], x[8 * s + 7]);
    return __builtin_bit_cast(bf16x8, p);
}

namespace pg8 {
constexpr int BM = 256, BK = 64, HALF = 128, HTB = HALF * BK * 2, STAGE_BYTES = 8 * HTB, NXCD = 8, WGM = 8;
__host__ __device__ __forceinline__ int lds_byte(int r, int c) { const int st = (r >> 4) * 2 + (c >> 5), rr = r & 15, cc = c & 31, ob = rr * 64 + cc * 2; return st * 1024 + (ob ^ (((ob >> 9) & 1) << 5)); }
__host__ __device__ __forceinline__ void stage_rc(int b, int& R, int& C) { const int st = b / 1024, sb = b % 1024, swz = sb ^ (((sb >> 9) & 1) << 5); R = (st >> 1) * 16 + swz / 64; C = (st & 1) * 32 + (swz % 64) / 2; }
__host__ __device__ __forceinline__ int perm32(int rho) { const int n = rho >> 4, i = rho & 15; return 8 * (i >> 2) + 4 * n + (i & 3); }

struct Unit { int pm, pn, e, nvalid; const char* A; const char* B; const int* list; };

struct StaticSched {
    const char* A; const char* B; int K, nM, nN, nwg, G, c;
    DI void init(const void* A_, const void* B_, int M_, int N_, int K_, int G_, int c_) { A = (const char*)A_; B = (const char*)B_; K = K_; nM = M_ / BM; nN = N_ / BM; nwg = nM * nN; G = G_; c = c_; }
    DI bool next(int i, Unit& u) const {
        const long L = (long)i * G + c; if (L >= nwg) return false;
        int wgid = (int)L; { const int q = nwg / NXCD, r = nwg % NXCD, xcd = wgid % NXCD, off = wgid / NXCD; wgid = (xcd < r ? xcd * (q + 1) : r * (q + 1) + (xcd - r) * q) + off; }
        const int nig = WGM * nN, gid = wgid / nig, fm = gid * WGM, gsz = (nM - fm) < WGM ? (nM - fm) : WGM;
        u.pm = fm + ((wgid % nig) % gsz); u.pn = (wgid % nig) / gsz; u.e = 0; u.nvalid = BM; u.list = nullptr;
        u.A = A + (size_t)u.pm * BM * K * 2; u.B = B + (size_t)u.pn * BM * K * 2; return true;
    }
};
struct MoeSched {
    const char* A; const char* B; const int* list; const LAS int* tb; int K, NT, nwg, G, c; size_t bexp; bool gather;
    DI bool next(int i, Unit& u) const {
        const long L = (long)i * G + c; if (L >= nwg) return false;
        int wgid = (int)L; { const int q = nwg / NXCD, r = nwg % NXCD, xcd = wgid % NXCD, off = wgid / NXCD; wgid = (xcd < r ? xcd * (q + 1) : r * (q + 1) + (xcd - r) * q) + off; }
        const int g = wgid / NT, nt = wgid % NT;
        int e = 0;
#pragma unroll
        for (int j = 1; j < 32; ++j) e += (tb[j] <= g) ? 1 : 0;
        e = __builtin_amdgcn_readfirstlane(e);
        const int mt = g - __builtin_amdgcn_readfirstlane(tb[e]);
        u.pm = g; u.pn = nt; u.e = e; u.nvalid = __builtin_amdgcn_readfirstlane(tb[40 + e]) - mt * BM; u.list = list + (size_t)e * LCAP + mt * BM;
        u.A = gather ? A : A + (size_t)g * BM * K * 2; u.B = B + (size_t)e * bexp + (size_t)nt * BM * K * 2; return true;
    }
};

template <bool GATHER> DI void a_offsets(const Unit& u, int K, unsigned (&v)[2][2]) {
    int R[2], C[2];
#pragma unroll
    for (int i = 0; i < 2; ++i) stage_rc((int)threadIdx.x * 16 + i * 8192, R[i], C[i]);
#pragma unroll
    for (int h = 0; h < 2; ++h)
#pragma unroll
        for (int i = 0; i < 2; ++i) {
            const int row = h * HALF + R[i];
            if constexpr (GATHER) { const int rc = row < u.nvalid ? row : u.nvalid - 1; const int tok = u.list[rc]; v[h][i] = (unsigned)(tok * K + C[i]) * 2u; }
            else v[h][i] = (unsigned)(row * K + C[i]) * 2u;
        }
}

struct EpiBf16 {
    static constexpr bool PERM = true;
    bf16* O; int ldc; const float* bias; int bias_estride; float scale;
    DI void operator()(const f32x4 (&acc)[2][2][4][2], const Unit& u, int wr, int wc, int fr, int fq) const {
        const int row0 = u.pm * BM + wr * 64 + fr; const int col0 = u.pn * BM + wc * 32 + 8 * fq;
        f32x4 bv[2][2];
#pragma unroll
        for (int bj = 0; bj < 2; ++bj)
#pragma unroll
            for (int n = 0; n < 2; ++n) bv[bj][n] = bias ? *(const f32x4*)(bias + (size_t)u.e * bias_estride + col0 + bj * HALF + 4 * n) : (f32x4){0.f, 0.f, 0.f, 0.f};
#pragma unroll
        for (int ai = 0; ai < 2; ++ai)
#pragma unroll
            for (int m = 0; m < 4; ++m) { bf16* rowp = O + (size_t)(row0 + ai * HALF + m * 16) * ldc + col0;
#pragma unroll
                for (int bj = 0; bj < 2; ++bj) { const f32x4 v0 = acc[ai][bj][m][0] * scale + bv[bj][0], v1 = acc[ai][bj][m][1] * scale + bv[bj][1];
                    u32x4 w; w.x = pk2(v0[0], v0[1]); w.y = pk2(v0[2], v0[3]); w.z = pk2(v1[0], v1[1]); w.w = pk2(v1[2], v1[3]);
                    *(u32x4*)(rowp + bj * HALF) = w; } }
    }
};
struct EpiResF32 {
    static constexpr bool PERM = false;
    const float* base; float* out; int ldc; float alpha;
    DI void operator()(const f32x4 (&acc)[2][2][4][2], const Unit& u, int wr, int wc, int fr, int fq) const {
        const int col0 = u.pn * BM + wc * 32 + 4 * fq;
#pragma unroll
        for (int ai = 0; ai < 2; ++ai)
#pragma unroll
            for (int m = 0; m < 4; ++m) { const size_t off = (size_t)(u.pm * BM + ai * HALF + wr * 64 + m * 16 + fr) * ldc + col0;
#pragma unroll
                for (int bj = 0; bj < 2; ++bj)
#pragma unroll
                    for (int n = 0; n < 2; ++n) { const f32x4 bs = *(const f32x4*)(base + off + bj * HALF + n * 16); *(f32x4*)(out + off + bj * HALF + n * 16) = bs * alpha + acc[ai][bj][m][n]; } }
    }
};
struct EpiResBf16 {
    static constexpr bool PERM = true;
    const bf16* base; bf16* out; int ldc; float alpha;
    DI void operator()(const f32x4 (&acc)[2][2][4][2], const Unit& u, int wr, int wc, int fr, int fq) const {
        const int row0 = u.pm * BM + wr * 64 + fr; const int col0 = u.pn * BM + wc * 32 + 8 * fq;
#pragma unroll
        for (int ai = 0; ai < 2; ++ai)
#pragma unroll
            for (int m = 0; m < 4; ++m) { const size_t off = (size_t)(row0 + ai * HALF + m * 16) * ldc + col0;
#pragma unroll
                for (int bj = 0; bj < 2; ++bj) { const u32x4 b = *(const u32x4*)(base + off + bj * HALF); const f32x4 a0 = acc[ai][bj][m][0], a1 = acc[ai][bj][m][1];
                    u32x4 w; w.x = pk2(bf_lo(b.x) * alpha + a0[0], bf_hi(b.x) * alpha + a0[1]); w.y = pk2(bf_lo(b.y) * alpha + a0[2], bf_hi(b.y) * alpha + a0[3]);
                    w.z = pk2(bf_lo(b.z) * alpha + a1[0], bf_hi(b.z) * alpha + a1[1]); w.w = pk2(bf_lo(b.w) * alpha + a1[2], bf_hi(b.w) * alpha + a1[3]);
                    *(u32x4*)(out + off + bj * HALF) = w; } }
    }
};
struct EpiSwiglu {
    static constexpr bool PERM = true;
    unsigned char* O; const float* bias; float scale, oscale;
    DI void operator()(const f32x4 (&acc)[2][2][4][2], const Unit& u, int wr, int wc, int fr, int fq) const {
        const int row0 = u.pm * BM + wr * 64 + fr; const int j0 = wc * 32 + 8 * fq; const int col0 = u.pn * HALF + j0;
        const float* bg = bias + (size_t)u.e * 2048 + col0; const float* bl = bg + 1024;
        f32x4 bgv[2], blv[2];
#pragma unroll
        for (int n = 0; n < 2; ++n) { bgv[n] = *(const f32x4*)(bg + 4 * n); blv[n] = *(const f32x4*)(bl + 4 * n); }
#pragma unroll
        for (int ai = 0; ai < 2; ++ai)
#pragma unroll
            for (int m = 0; m < 4; ++m) { unsigned char* rowp = O + (size_t)(row0 + ai * HALF + m * 16) * 1024 + col0;
                float o[8];
#pragma unroll
                for (int n = 0; n < 2; ++n) { const f32x4 g = acc[ai][0][m][n] * scale + bgv[n], l = acc[ai][1][m][n] * scale + blv[n];
#pragma unroll
                    for (int q = 0; q < 4; ++q) { const float gg = fminf(g[q], 7.0f), ll = fminf(fmaxf(l[q], -7.0f), 7.0f);
                        o[4 * n + q] = gg * __builtin_amdgcn_rcpf(1.f + ex2(gg * (-1.702f * LOG2E))) * (ll + 1.f) * oscale; } }
                u32x2 w; w.x = pk4_fp8(o[0], o[1], o[2], o[3]); w.y = pk4_fp8(o[4], o[5], o[6], o[7]);
                *(u32x2*)rowp = w; }
    }
};

template <class Epi, class Sched, bool GATHER, bool ALIGN_EPI, bool FP8 = false>
DI void gemm_phase(LAS unsigned char* lds, const int K, const Sched& S, const Epi& E) {
    const int tid = threadIdx.x, wid = __builtin_amdgcn_readfirstlane(tid >> 6), lane = tid & 63, wr = wid >> 2, wc = wid & 3, fr = lane & 15, fq = lane >> 4;
    const int nt = K / BK;
    unsigned voffB[2];
#pragma unroll
    for (int i = 0; i < 2; ++i) { int R, C; stage_rc(tid * 16 + i * 8192, R, C); const int Rb = Epi::PERM ? ((R & ~31) + perm32(R & 31)) : R; voffB[i] = (unsigned)(Rb * K + C) * 2u; }
    const size_t kstep = (size_t)(BK * 2);
    const size_t hstep = (size_t)HALF * K * 2;
    const unsigned ldsw = (unsigned)wid * 1024u;
    const int aoff = lds_byte(wr * 64 + fr, fq * 8), boff = lds_byte(wc * 32 + fr, fq * 8);
#define PG8_SA(b, h) (((b) * 2 + (h)) * HTB)
#define PG8_SB(b, h) ((4 + (b) * 2 + (h)) * HTB)
#define PG8_STAGE(bufoff, gbase, voff) do { _Pragma("unroll") for (int _i = 0; _i < 2; ++_i) { unsigned _o = (voff)[_i]; asm volatile("" : "+v"(_o));   \
        __builtin_amdgcn_global_load_lds((const unsigned*)((const char*)(gbase) + _o), (LAS unsigned*)(lds + (bufoff) + ldsw + _i * 8192), 16, 0, 0); } } while (0)
#define PG8_LDA(dst, b, h) do { _Pragma("unroll") for (int m = 0; m < 4; ++m) _Pragma("unroll") for (int k = 0; k < 2; ++k) dst[m][k] = *(const LAS bf16x8*)(lds + PG8_SA(b, h) + aoff + m * 2048 + k * 1024); } while (0)
#define PG8_LDB(dst, b, h) do { _Pragma("unroll") for (int n = 0; n < 2; ++n) _Pragma("unroll") for (int k = 0; k < 2; ++k) dst[n][k] = *(const LAS bf16x8*)(lds + PG8_SB(b, h) + boff + n * 2048 + k * 1024); } while (0)
#define PG8_CAT(x) __builtin_shufflevector(__builtin_bit_cast(v4i32, x[0]), __builtin_bit_cast(v4i32, x[1]), 0, 1, 2, 3, 4, 5, 6, 7)
#define PG8_MMA(ai, bj, At, Bt) do { __builtin_amdgcn_s_setprio(1); _Pragma("unroll") for (int m = 0; m < 4; ++m) _Pragma("unroll") for (int n = 0; n < 2; ++n) { \
        if constexpr (FP8) { const v8i32 _a = PG8_CAT(Bt[n]), _b = PG8_CAT(At[m]); asm volatile("v_mfma_scale_f32_16x16x128_f8f6f4 %0, %1, %2, %0, %3, %3 op_sel_hi:[0,0,0]" : "+v"(acc[ai][bj][m][n]) : "v"(_a), "v"(_b), "v"(sc1)); } \
        else { _Pragma("unroll") for (int k = 0; k < 2; ++k) acc[ai][bj][m][n] = __builtin_amdgcn_mfma_f32_16x16x32_bf16(Bt[n][k], At[m][k], acc[ai][bj][m][n], 0, 0, 0); } } __builtin_amdgcn_s_setprio(0); } while (0)
#define PG8_WAIT_V(n) asm volatile("s_waitcnt vmcnt(" #n ")" ::: "memory")
#define PG8_WAIT_L(n) asm volatile("s_waitcnt lgkmcnt(" #n ")" ::: "memory")
#define PG8_BAR __builtin_amdgcn_s_barrier()
#define PG8_SCHED __builtin_amdgcn_sched_barrier(0)
    Unit cur, nxt; int ui = 0;
    if (!S.next(0, cur)) return;
    const int sc1 = 0x7f7f7f7f;
    unsigned vAc[2][2], vAn[2][2];
    a_offsets<GATHER>(cur, K, vAc);
    f32x4 acc[2][2][4][2];
#pragma unroll
    for (int a = 0; a < 2; ++a)
#pragma unroll
        for (int b = 0; b < 2; ++b)
#pragma unroll
            for (int m = 0; m < 4; ++m)
#pragma unroll
                for (int n = 0; n < 2; ++n) acc[a][b][m][n] = (f32x4){0.f, 0.f, 0.f, 0.f};
    bf16x8 At[4][2], B0[2][2], B1[2][2];
    const char* cA = cur.A; const char* cB = cur.B;
    PG8_STAGE(PG8_SB(0, 0), cB, voffB); PG8_STAGE(PG8_SB(0, 1), cB + hstep, voffB); PG8_STAGE(PG8_SA(0, 0), cA, vAc[0]); PG8_STAGE(PG8_SA(0, 1), cA, vAc[1]);
    if (wr == 1) PG8_BAR;
    PG8_WAIT_V(2); PG8_BAR;
    PG8_STAGE(PG8_SB(1, 0), cB + kstep, voffB); PG8_STAGE(PG8_SA(1, 0), cA + kstep, vAc[0]); PG8_STAGE(PG8_SB(1, 1), cB + hstep + kstep, voffB);
    PG8_WAIT_V(6); PG8_BAR;
    for (;;) {
        const bool has_next = S.next(ui + 1, nxt);
        if constexpr (GATHER) {
            if (has_next) a_offsets<GATHER>(nxt, K, vAn);
            else {
#pragma unroll
                for (int h = 0; h < 2; ++h)
#pragma unroll
                    for (int i = 0; i < 2; ++i) vAn[h][i] = vAc[h][i]; }
        }
        const char* nA = has_next ? nxt.A : cA; const char* nB = has_next ? nxt.B : cB;
#pragma unroll 1
        for (int t = 0; t < nt; t += 2) {
            const bool last = (t == nt - 2);
            const char* a1 = cA + (size_t)(t + 1) * kstep;
            const char* a2 = last ? nA : cA + (size_t)(t + 2) * kstep; const char* b2 = last ? nB : cB + (size_t)(t + 2) * kstep;
            const char* a3 = a2 + kstep; const char* b3 = b2 + kstep;
            unsigned v2[2][2];
#pragma unroll
            for (int h = 0; h < 2; ++h)
#pragma unroll
                for (int i = 0; i < 2; ++i) v2[h][i] = GATHER ? (last ? vAn[h][i] : vAc[h][i]) : vAc[h][i];
            PG8_LDB(B0, 0, 0); PG8_LDB(B1, 0, 1); PG8_SCHED; PG8_LDA(At, 0, 0); PG8_STAGE(PG8_SA(1, 1), a1, vAc[1]);
            PG8_WAIT_V(8); PG8_WAIT_L(0); PG8_BAR; PG8_MMA(0, 0, At, B0); PG8_MMA(0, 1, At, B1); PG8_BAR; PG8_SCHED;
            PG8_LDA(At, 0, 1); PG8_STAGE(PG8_SB(0, 0), b2, voffB); PG8_STAGE(PG8_SB(0, 1), b2 + hstep, voffB); PG8_STAGE(PG8_SA(0, 0), a2, v2[0]);
            PG8_WAIT_V(8); PG8_WAIT_L(0); PG8_BAR; PG8_MMA(1, 0, At, B0); PG8_MMA(1, 1, At, B1); PG8_BAR; PG8_SCHED;
            PG8_LDB(B0, 1, 0); PG8_LDB(B1, 1, 1); PG8_SCHED; PG8_LDA(At, 1, 0); PG8_STAGE(PG8_SA(0, 1), a2, v2[1]);
            PG8_WAIT_V(8); PG8_WAIT_L(0); PG8_BAR; PG8_MMA(0, 0, At, B0); PG8_MMA(0, 1, At, B1); PG8_BAR; PG8_SCHED;
            PG8_LDA(At, 1, 1); PG8_STAGE(PG8_SB(1, 0), b3, voffB); PG8_STAGE(PG8_SB(1, 1), b3 + hstep, voffB); PG8_STAGE(PG8_SA(1, 0), a3, v2[0]);
            PG8_WAIT_V(8); PG8_WAIT_L(0); PG8_BAR; PG8_MMA(1, 0, At, B0); PG8_MMA(1, 1, At, B1); PG8_BAR; PG8_SCHED;
        }
        if constexpr (FP8) asm volatile("s_nop 15\n\ts_nop 15" ::: "memory");
        if constexpr (ALIGN_EPI) { if (wr == 0) PG8_BAR; }
        E(acc, cur, wr, wc, fr, fq);
        if (!has_next) break;
#pragma unroll
        for (int a = 0; a < 2; ++a)
#pragma unroll
            for (int b = 0; b < 2; ++b)
#pragma unroll
                for (int m = 0; m < 4; ++m)
#pragma unroll
                    for (int n = 0; n < 2; ++n) acc[a][b][m][n] = (f32x4){0.f, 0.f, 0.f, 0.f};
        cur = nxt; cA = nA; cB = nB; ++ui;
        if constexpr (GATHER) {
#pragma unroll
            for (int h = 0; h < 2; ++h)
#pragma unroll
                for (int i = 0; i < 2; ++i) vAc[h][i] = vAn[h][i]; }
        if constexpr (ALIGN_EPI) { if (wr == 1) PG8_BAR; }
    }
    PG8_WAIT_V(0);
    if constexpr (!ALIGN_EPI) { if (wr == 0) PG8_BAR; }
    PG8_BAR;
#undef PG8_SA
#undef PG8_SB
#undef PG8_STAGE
#undef PG8_LDA
#undef PG8_LDB
#undef PG8_MMA
#undef PG8_CAT
#undef PG8_WAIT_V
#undef PG8_WAIT_L
#undef PG8_BAR
#undef PG8_SCHED
}
}

#define XB_TMO      128
#define XB_XCNT(j)  (256  + 64 * (j))
#define XB_XSUB(j)  (1280 + 64 * (j))
#define XB_XGEN(j)  (2304 + 64 * (j))
#define XB_TOP      3328
#define XB_TOPGEN   3392
#define XCD_BAR_WORDS 3456
#define XB_SPIN_CAP (1u << 18)
DI unsigned xb_ld(unsigned* p)              { return __hip_atomic_load(p, __ATOMIC_RELAXED, __HIP_MEMORY_SCOPE_AGENT); }
DI unsigned xb_add(unsigned* p, unsigned v) { return __hip_atomic_fetch_add(p, v, __ATOMIC_RELAXED, __HIP_MEMORY_SCOPE_AGENT); }
DI unsigned xb_xcc_id() { return (unsigned)__builtin_amdgcn_s_getreg((3 << 11) | 20) & 0xFu; }
#define XB_SPIN(cond, bar) do { unsigned _sp = 0; while (cond) { __builtin_amdgcn_s_sleep(1); \
    if ((++_sp & 255u) == 0u) { if (xb_ld(&(bar)[XB_TMO])) break; if (_sp > XB_SPIN_CAP) { atomicAdd(&(bar)[XB_TMO], 1u); break; } } } } while (0)
struct XcdBarrier { unsigned* bar; unsigned x; volatile LAS unsigned* st; };
DI XcdBarrier xcd_barrier_post(unsigned* bar, volatile LAS unsigned* st) {
    XcdBarrier b; b.bar = bar; b.x = xb_xcc_id(); b.st = st;
    if (threadIdx.x == 0) (void)xb_add(&bar[XB_XCNT(b.x)], 1u);
    return b;
}
DI void xcd_barrier_complete(unsigned* bar, unsigned x, unsigned& nloc, unsigned& nx) {
    const unsigned G = gridDim.x * gridDim.y * gridDim.z;
    unsigned sum, cnt, mine, sp = 0u;
    for (;;) {
        sum = 0u; cnt = 0u; mine = 0u;
#pragma unroll
        for (unsigned j = 0; j < 16; ++j) { const unsigned c = xb_ld(&bar[XB_XCNT(j)]); sum += c; cnt += (c > 0u) ? 1u : 0u; mine = (j == x) ? c : mine; }
        if (sum == G) break;
        __builtin_amdgcn_s_sleep(1);
        if ((++sp & 255u) == 0u) { if (xb_ld(&bar[XB_TMO])) break; if (sp > XB_SPIN_CAP) { atomicAdd(&bar[XB_TMO], 1u); break; } }
    }
    nloc = mine > 0u ? mine : 1u; nx = cnt > 0u ? cnt : 1u;
}
DI void xcd_barrier(const XcdBarrier& b) {
    asm volatile("s_waitcnt vmcnt(0)" ::: "memory");
    __syncthreads();
    if (threadIdx.x == 0) {
        unsigned* bar = b.bar;
        __builtin_amdgcn_s_waitcnt(0);
        unsigned nloc = b.st[0], nx = b.st[1];
        if (nloc == 0u) { xcd_barrier_complete(bar, b.x, nloc, nx); b.st[0] = nloc; b.st[1] = nx; }
        const unsigned old = xb_add(&bar[XB_XSUB(b.x)], 1u);
        const unsigned gen = old / nloc;
        if (old + 1u == (gen + 1u) * nloc) {
            __builtin_amdgcn_fence(__ATOMIC_RELEASE, "agent");
            asm volatile("s_waitcnt vmcnt(0)" ::: "memory");
            const unsigned og = xb_add(&bar[XB_TOP], 1u);
            const unsigned tg = og / nx;
            if (og + 1u == (tg + 1u) * nx) xb_add(&bar[XB_TOPGEN], 1u);
            else XB_SPIN(xb_ld(&bar[XB_TOPGEN]) == tg, bar);
            __builtin_amdgcn_fence(__ATOMIC_ACQUIRE, "agent");
            xb_add(&bar[XB_XGEN(b.x)], 1u);
            asm volatile("s_waitcnt vmcnt(0)" ::: "memory");
        } else {
            XB_SPIN(xb_ld(&bar[XB_XGEN(b.x)]) == gen, bar);
            __builtin_amdgcn_fence(__ATOMIC_ACQUIRE, "agent");
            asm volatile("s_waitcnt vmcnt(0)" ::: "memory");
        }
    }
    __syncthreads();
}

DI void p0_transpose_item(const float* W, int ldw, int K, bf16* WT, int src_n0, int dst_n0, int k0, LAS float* scr, int lane) {
#pragma unroll 8
    for (int i = 0; i < 32; ++i) { const int kk = 2 * i + (lane >> 5); scr[kk * 33 + (lane & 31)] = W[(size_t)(k0 + kk) * ldw + src_n0 + (lane & 31)]; }
    asm volatile("s_waitcnt lgkmcnt(0)" ::: "memory");
    const int c = lane & 7;
#pragma unroll
    for (int j = 0; j < 4; ++j) { const int n = (lane >> 3) + 8 * j; const LAS float* s = scr + (8 * c) * 33 + n;
        u32x4 o; o.x = pk2(s[0 * 33], s[1 * 33]); o.y = pk2(s[2 * 33], s[3 * 33]); o.z = pk2(s[4 * 33], s[5 * 33]); o.w = pk2(s[6 * 33], s[7 * 33]);
        *(u32x4*)(WT + (size_t)(dst_n0 + n) * K + k0 + 8 * c) = o; }
    asm volatile("s_waitcnt lgkmcnt(0)" ::: "memory");
}

DI void p0_transpose_fp8(const float* W, int ldw, unsigned char* WT, int kbytes, int src_n0, int dst_n0, int k0, float scale, LAS unsigned* scr, int lane) {
    const int kq = lane >> 3, nq = lane & 7;
    f32x4 v[16];
#pragma unroll
    for (int i = 0; i < 16; ++i) { const int k = 32 * (i >> 2) + 4 * kq + (i & 3); v[i] = *(const f32x4*)(W + (size_t)(k0 + k) * ldw + src_n0 + 4 * nq); }
#pragma unroll
    for (int g = 0; g < 4; ++g)
#pragma unroll
        for (int c = 0; c < 4; ++c) scr[(4 * nq + c) * 33 + 8 * g + kq] = pk4_fp8(v[4 * g][c] * scale, v[4 * g + 1][c] * scale, v[4 * g + 2][c] * scale, v[4 * g + 3][c] * scale);
    asm volatile("s_waitcnt lgkmcnt(0)" ::: "memory");
    const int ch = lane & 7;
#pragma unroll
    for (int j = 0; j < 4; ++j) { const int n = (lane >> 3) + 8 * j; const LAS unsigned* s = scr + n * 33 + 4 * ch;
        u32x4 o; o.x = s[0]; o.y = s[1]; o.z = s[2]; o.w = s[3];
        *(u32x4*)(WT + (size_t)(dst_n0 + n) * kbytes + k0 + 16 * ch) = o; }
    asm volatile("s_waitcnt lgkmcnt(0)" ::: "memory");
}

DI void ln_row(f32x4 (&v)[4], const float* g, const float* bta, int lane) {
    float s = 0.f;
#pragma unroll
    for (int j = 0; j < 4; ++j) s += (v[j].x + v[j].y) + (v[j].z + v[j].w);
    const float mean = wave_sum(s) * (1.f / D); float s2 = 0.f;
#pragma unroll
    for (int j = 0; j < 4; ++j) { v[j] = v[j] - mean; s2 += (v[j].x * v[j].x + v[j].y * v[j].y) + (v[j].z * v[j].z + v[j].w * v[j].w); }
    const float rstd = 1.f / sqrtf(wave_sum(s2) * (1.f / D) + LN_EPS);
#pragma unroll
    for (int j = 0; j < 4; ++j) { const f32x4 gg = *(const f32x4*)(g + 4 * lane + 256 * j), bb = *(const f32x4*)(bta + 4 * lane + 256 * j); v[j] = v[j] * rstd * gg + bb; }
}
DI void store_row_bf16(bf16* orow, const f32x4 (&v)[4], int lane) {
    u32x2* o8 = (u32x2*)orow + lane;
#pragma unroll
    for (int j = 0; j < 4; ++j) { u32x2 w; w.x = pk2(v[j].x, v[j].y); w.y = pk2(v[j].z, v[j].w); o8[64 * j] = w; }
}

DI void load_row_bf16(const bf16* irow, f32x4 (&v)[4], int lane) {
    const u32x2* i8 = (const u32x2*)irow + lane;
#pragma unroll
    for (int j = 0; j < 4; ++j) { const u32x2 w = i8[64 * j]; v[j] = (f32x4){bf_lo(w.x), bf_hi(w.x), bf_lo(w.y), bf_hi(w.y)}; }
}
DI void store_row_fp8(unsigned char* orow, const f32x4 (&v)[4], float scale, int lane) {
    unsigned* o4 = (unsigned*)orow + lane;
#pragma unroll
    for (int j = 0; j < 4; ++j) o4[64 * j] = pk4_fp8(v[j].x * scale, v[j].y * scale, v[j].z * scale, v[j].w * scale);
}

constexpr float FOX_THR = 40.f;
DI void fox_unit(int b, int h8, int qb, const bf16* U, const float* Fc2, const float* Kmax, const float* fox_g, bf16* MIX, LAS unsigned char* lds) {
    const int tid = threadIdx.x, lane = tid & 63, wave = __builtin_amdgcn_readfirstlane(tid >> 6);
    const int r = lane & 31, h = lane >> 5, i16 = lane & 15, q4 = i16 >> 2, p4 = i16 & 3, blk = (lane >> 4) & 1;
    const int tok0 = b * SEQ, q0 = qb * 256, qrow = q0 + wave * 32 + r;
    const float C2 = 0.125f * LOG2E;
    bf16x8 qf[4];
    { const bf16* qp = U + (size_t)(tok0 + qrow) * NU + UC_FQ + h8 * 64 + 8 * h;
#pragma unroll
      for (int d0 = 0; d0 < 4; ++d0) qf[d0] = *(const bf16x8*)(qp + 16 * d0); }
    float qn2 = 0.f;
#pragma unroll
    for (int d0 = 0; d0 < 4; ++d0)
#pragma unroll
        for (int j = 0; j < 8; ++j) { const float f = bf2f(qf[d0][j]); qn2 += f * f; }
    qn2 = xhalf_sum(qn2);
    const float* fc = Fc2 + (size_t)(b * 8 + h8) * SEQ;
    const float qk_bound = sqrtf(wave_max(qn2)) * Kmax[b * 8 + h8] * C2 * 1.001f;
    const float nb_first = fc[q0];
    float m = -1e30f, l = 0.f; f32x16 oT[2];
#pragma unroll
    for (int i = 0; i < 16; ++i) { oT[0][i] = 0.f; oT[1][i] = 0.f; }
    LAS unsigned char* Ks = lds; LAS unsigned char* Vs = lds + 9216; LAS float* nb = (LAS float*)(lds + 18432);
    const int NT = 4 * qb + 4;
    bool active = true;
    for (int t = NT - 1; t >= 0; --t) {
        if (!__syncthreads_or(active ? 1 : 0)) break;
        { const int row = tid >> 3, pc = tid & 7; const bf16* gp = U + (size_t)(tok0 + 64 * t + row) * NU + h8 * 64 + pc * 8;
          const u32x4 kv = *(const u32x4*)(gp + UC_FK), vv = *(const u32x4*)(gp + UC_FV);
          *(LAS u32x4*)(Ks + row * 144 + pc * 16) = kv; *(LAS u32x4*)(Vs + row * 144 + pc * 16) = vv; }
        if (tid < 64) nb[tid] = fc[64 * t + tid] - nb_first;
        __syncthreads();
        if (active && 64 * t <= q0 + wave * 32 + 31) {
            f32x16 p[2];
#pragma unroll
            for (int hb = 0; hb < 2; ++hb) {
                f32x16 a;
#pragma unroll
                for (int i = 0; i < 16; ++i) a[i] = 0.f;
#pragma unroll
                for (int d0 = 0; d0 < 4; ++d0) { const bf16x8 kf = *(const LAS bf16x8*)(Ks + (32 * hb + r) * 144 + (16 * d0 + 8 * h) * 2); a = mfma32(kf, qf[d0], a); }
#pragma unroll
                for (int g = 0; g < 4; ++g) { const f32x4 bb = *(const LAS f32x4*)(nb + 32 * hb + 8 * g + 4 * h);
#pragma unroll
                    for (int e = 0; e < 4; ++e) a[4 * g + e] = a[4 * g + e] * C2 + bb[e]; }
                p[hb] = a;
            }
            if (t >= NT - 4) {
#pragma unroll
                for (int hb = 0; hb < 2; ++hb)
#pragma unroll
                    for (int i = 0; i < 16; ++i) { const int kv = 64 * t + 32 * hb + crow(i, h); if (kv > qrow) p[hb][i] = -INFINITY; }
            }
            float mx = p[0][0];
#pragma unroll
            for (int i = 1; i < 16; ++i) mx = fmaxf(mx, p[0][i]);
#pragma unroll
            for (int i = 0; i < 16; ++i) mx = fmaxf(mx, p[1][i]);
            mx = xhalf_max(mx);
            if (__any(mx > m)) {
                const float mn = fmaxf(m, mx), alpha = ex2(m - mn); m = mn; l *= alpha;
#pragma unroll
                for (int i = 0; i < 16; ++i) { oT[0][i] *= alpha; oT[1][i] *= alpha; }
            }
            float rs = 0.f;
#pragma unroll
            for (int hb = 0; hb < 2; ++hb)
#pragma unroll
                for (int i = 0; i < 16; ++i) { const float e = ex2(p[hb][i] - m); p[hb][i] = e; rs += e; }
            l += rs;
            bf16x8 pf[2][2];
#pragma unroll
            for (int hb = 0; hb < 2; ++hb)
#pragma unroll
                for (int s = 0; s < 2; ++s) pf[hb][s] = pack8(p[hb], s);
#pragma unroll
            for (int d0 = 0; d0 < 2; ++d0)
#pragma unroll
                for (int hb = 0; hb < 2; ++hb)
#pragma unroll
                    for (int s = 0; s < 2; ++s) {
                        const LAS unsigned char* vp = Vs + (32 * hb + 16 * s + 4 * h + q4) * 144 + (32 * d0 + 16 * blk + 4 * p4) * 2;
                        const s16x4 lo = tr_read(vp), hi = tr_read(vp + 8 * 144);
                        oT[d0] = mfma32(cat8(lo, hi), pf[hb][s], oT[d0]);
                    }
            if (t >= 1) { const float mmin = -wave_max(-m); active = (qk_bound + (fc[64 * t - 1] - nb_first) - mmin) > -FOX_THR; }
        }
    }
    l = xhalf_sum(l);
    const float inv = 1.f / l;
    float ss = 0.f;
#pragma unroll
    for (int d0 = 0; d0 < 2; ++d0)
#pragma unroll
        for (int i = 0; i < 16; ++i) { const float o = oT[d0][i] * inv; oT[d0][i] = o; ss += o * o; }
    ss = xhalf_sum(ss);
    const float rr = 1.f / sqrtf(ss * (1.f / 64.f) + RMS_EPS);
    bf16* op = MIX + (size_t)(tok0 + qrow) * D + h8 * 64;
#pragma unroll
    for (int d0 = 0; d0 < 2; ++d0)
#pragma unroll
        for (int g = 0; g < 4; ++g) { const int d = 32 * d0 + 8 * g + 4 * h; const f32x4 gn = *(const f32x4*)(fox_g + h8 * 64 + d);
            u32x2 w; w.x = pk2(oT[d0][4 * g] * rr * gn.x, oT[d0][4 * g + 1] * rr * gn.y); w.y = pk2(oT[d0][4 * g + 2] * rr * gn.z, oT[d0][4 * g + 3] * rr * gn.w);
            *(u32x2*)(op + d) = w; }
}

DI void m1_unit(int bh, int cg, const bf16* U, const float* G, const float* conv_w, bf16* Mq, bf16* Mk, float* KvT, float* Nc, float* Gc, float* Mloc, LAS unsigned char* lds) {
    const int tid = threadIdx.x, lane = tid & 63, wave = __builtin_amdgcn_readfirstlane(tid >> 6);
    const int r = lane & 31, h = lane >> 5, i16 = lane & 15, q4 = i16 >> 2, p4 = i16 & 3, blk = (lane >> 4) & 1;
    const int b = bh >> 2, hh = bh & 3, s0 = cg * 256;
    LAS float* wa = (LAS float*)lds;
    LAS unsigned char* ksb = lds + 1024;
    LAS unsigned char* vsb = lds + 1024 + 36864;
    __syncthreads();
    if (wave < 4) {
        const int c = cg * 4 + wave, tok = b * SEQ + c * 64 + lane;
        const float lf = G[(size_t)tok * 16 + 12 + hh], li = G[(size_t)tok * 16 + 8 + hh];
        const float bsc = wave_scan_add(lf, lane);
        const float g = __shfl(bsc, 63);
        const float a = g - bsc + li;
        const float ml = wave_max(a);
        wa[wave * 64 + lane] = expf(a - ml);
        if (lane == 0) { Gc[bh * 64 + c] = g; Mloc[bh * 64 + c] = ml; }
    }
    __syncthreads();
#pragma unroll 2
    for (int i = 0; i < 8; ++i) {
        const int id = tid + 512 * i, d8 = id & 7, qk = (id >> 3) & 1, t = id >> 4;
        const int ucol = (qk ? UC_MK : UC_MQ) + hh * 64 + 8 * d8, ccol = (qk ? 256 : 0) + hh * 64 + 8 * d8;
        float acc[8];
#pragma unroll
        for (int e = 0; e < 8; ++e) acc[e] = 0.f;
#pragma unroll
        for (int j = 0; j < 4; ++j) {
            const int ts = s0 + t - 3 + j;
            if (ts >= 0) {
                const u32x4 x = *(const u32x4*)(U + (size_t)(b * SEQ + ts) * NU + ucol);
                const f32x4 w0 = *(const f32x4*)(conv_w + j * 512 + ccol), w1 = *(const f32x4*)(conv_w + j * 512 + ccol + 4);
                acc[0] += bf_lo(x.x) * w0.x; acc[1] += bf_hi(x.x) * w0.y; acc[2] += bf_lo(x.y) * w0.z; acc[3] += bf_hi(x.y) * w0.w;
                acc[4] += bf_lo(x.z) * w1.x; acc[5] += bf_hi(x.z) * w1.y; acc[6] += bf_lo(x.w) * w1.z; acc[7] += bf_hi(x.w) * w1.w;
            }
        }
#pragma unroll
        for (int e = 0; e < 8; ++e) acc[e] = acc[e] / (1.f + expf(-acc[e]));
        const size_t orow = ((size_t)bh * SEQ + s0 + t) * 64 + 8 * d8;
        if (qk == 0) {
            u32x4 w; w.x = pk2(acc[0], acc[1]); w.y = pk2(acc[2], acc[3]); w.z = pk2(acc[4], acc[5]); w.w = pk2(acc[6], acc[7]);
            *(u32x4*)(Mq + orow) = w;
        } else {
#pragma unroll
            for (int e = 0; e < 8; ++e) acc[e] *= 0.125f;
            u32x4 w; w.x = pk2(acc[0], acc[1]); w.y = pk2(acc[2], acc[3]); w.z = pk2(acc[4], acc[5]); w.w = pk2(acc[6], acc[7]);
            *(u32x4*)(Mk + orow) = w;
            const float ww = wa[t];
            u32x4 x; x.x = pk2(acc[0] * ww, acc[1] * ww); x.y = pk2(acc[2] * ww, acc[3] * ww); x.z = pk2(acc[4] * ww, acc[5] * ww); x.w = pk2(acc[6] * ww, acc[7] * ww);
            *(LAS u32x4*)(ksb + (t >> 6) * 9216 + (t & 63) * 144 + d8 * 16) = x;
        }
    }
#pragma unroll
    for (int i = 0; i < 8; ++i) { const int id = tid + 512 * i, pc = id & 15, t = id >> 4;
        const u32x4 v = *(const u32x4*)(U + (size_t)(b * SEQ + s0 + t) * NU + UC_MV + hh * 128 + pc * 8);
        *(LAS u32x4*)(vsb + (t >> 6) * 17408 + (t & 63) * 272 + pc * 16) = v; }
    __syncthreads();
    {
        const int cl = wave >> 1, eh = wave & 1, c = cg * 4 + cl;
        const LAS unsigned char* vs = vsb + cl * 17408; const LAS unsigned char* ks = ksb + cl * 9216;
        f32x16 acc[2][2];
#pragma unroll
        for (int a = 0; a < 2; ++a)
#pragma unroll
            for (int bb = 0; bb < 2; ++bb)
#pragma unroll
                for (int i = 0; i < 16; ++i) acc[a][bb][i] = 0.f;
#pragma unroll
        for (int k4 = 0; k4 < 4; ++k4) {
            bf16x8 af[2], bfr[2];
#pragma unroll
            for (int eb = 0; eb < 2; ++eb) { const LAS unsigned char* pp = vs + (16 * k4 + 8 * h + q4) * 272 + (64 * eh + 32 * eb + 16 * blk + 4 * p4) * 2; af[eb] = cat8(tr_read(pp), tr_read(pp + 4 * 272)); }
#pragma unroll
            for (int db = 0; db < 2; ++db) { const LAS unsigned char* pp = ks + (16 * k4 + 8 * h + q4) * 144 + (32 * db + 16 * blk + 4 * p4) * 2; bfr[db] = cat8(tr_read(pp), tr_read(pp + 4 * 144)); }
#pragma unroll
            for (int eb = 0; eb < 2; ++eb)
#pragma unroll
                for (int db = 0; db < 2; ++db) acc[eb][db] = mfma32(af[eb], bfr[db], acc[eb][db]);
        }
        float* op = KvT + (size_t)(bh * 64 + c) * 8192;
#pragma unroll
        for (int eb = 0; eb < 2; ++eb)
#pragma unroll
            for (int db = 0; db < 2; ++db)
#pragma unroll
                for (int i = 0; i < 16; ++i) op[(64 * eh + 32 * eb + crow(i, h)) * 64 + 32 * db + r] = acc[eb][db][i];
    }
    if (tid < 256) { const int cl = tid >> 6, d = tid & 63; const LAS unsigned char* ks = ksb + cl * 9216 + d * 2; float s = 0.f;
#pragma unroll 8
        for (int t = 0; t < 64; ++t) s += __uint_as_float(((unsigned)*(const LAS unsigned short*)(ks + t * 144)) << 16);
        Nc[(size_t)(bh * 64 + cg * 4 + cl) * 64 + d] = s; }
}

DI void m3_unit(int bh, int cg, const bf16* U, const float* G, const bf16* Mq, const bf16* Mk, const bf16* CpT, const float* Np, const float* Mp, const float* mlstm_g, bf16* MIX, LAS unsigned char* lds) {
    const int tid = threadIdx.x, lane = tid & 63, wave = __builtin_amdgcn_readfirstlane(tid >> 6);
    const int r = lane & 31, h = lane >> 5, i16 = lane & 15, q4 = i16 >> 2, p4 = i16 & 3, blk = (lane >> 4) & 1;
    const int b = bh >> 2, hh = bh & 3, cl = wave >> 1, th = wave & 1, c = cg * 4 + cl;
    const int tokc = b * SEQ + c * 64;
    const LAS unsigned char* Vs = lds + cl * 17408;
    LAS float* wsf = (LAS float*)(lds + 69632 + wave * 1024);
    __syncthreads();
#pragma unroll
    for (int i = 0; i < 8; ++i) { const int id = tid + 512 * i, pc = id & 15, t = id >> 4;
        const u32x4 v = *(const u32x4*)(U + (size_t)(b * SEQ + cg * 256 + t) * NU + UC_MV + hh * 128 + pc * 8);
        *(LAS u32x4*)(lds + (t >> 6) * 17408 + (t & 63) * 272 + pc * 16) = v; }
    const float mprev = Mp[bh * 64 + c];
    {
        const float lf = G[(size_t)(tokc + lane) * 16 + 12 + hh], li = G[(size_t)(tokc + lane) * 16 + 8 + hh];
        const float bsc = wave_scan_add(lf, lane);
        const float pm = wave_scan_max(li - bsc, lane);
        wsf[lane] = bsc; wsf[64 + lane] = li; wsf[128 + lane] = bsc + fmaxf(mprev, pm); wsf[192 + lane] = Np[(size_t)(bh * 64 + c) * 64 + lane];
    }
    __syncthreads();
    const int tl = 32 * th + r;
    const float bt = wsf[tl], mtt = wsf[128 + tl];
    const float winter = expf(bt + mprev - mtt);
    bf16x8 qf[4];
    { const bf16* qp = Mq + ((size_t)bh * SEQ + c * 64 + tl) * 64 + 8 * h;
#pragma unroll
      for (int ks = 0; ks < 4; ++ks) qf[ks] = *(const bf16x8*)(qp + 16 * ks); }
    float qn = 0.f;
#pragma unroll
    for (int ks = 0; ks < 4; ++ks)
#pragma unroll
        for (int j = 0; j < 8; ++j) qn += bf2f(qf[ks][j]) * wsf[192 + 16 * ks + 8 * h + j];
    qn = xhalf_sum(qn);
    f32x16 accT[4];
#pragma unroll
    for (int eb = 0; eb < 4; ++eb) {
        f32x16 a;
#pragma unroll
        for (int i = 0; i < 16; ++i) a[i] = 0.f;
#pragma unroll
        for (int ks = 0; ks < 4; ++ks) { const bf16x8 cf = *(const bf16x8*)(CpT + ((size_t)(bh * 64 + c) * 128 + 32 * eb + r) * 64 + 16 * ks + 8 * h); a = mfma32(cf, qf[ks], a); }
#pragma unroll
        for (int i = 0; i < 16; ++i) a[i] *= winter;
        accT[eb] = a;
    }
    float psum = 0.f; f32x16 pT[2];
#pragma unroll
    for (int sb = 0; sb < 2; ++sb) {
        f32x16 a;
#pragma unroll
        for (int i = 0; i < 16; ++i) a[i] = 0.f;
#pragma unroll
        for (int ks = 0; ks < 4; ++ks) { const bf16x8 kf = *(const bf16x8*)(Mk + ((size_t)bh * SEQ + c * 64 + 32 * sb + r) * 64 + 16 * ks + 8 * h); a = mfma32(kf, qf[ks], a); }
#pragma unroll
        for (int g = 0; g < 4; ++g) { const f32x4 b4 = *(const LAS f32x4*)(wsf + 32 * sb + 8 * g + 4 * h), l4 = *(const LAS f32x4*)(wsf + 64 + 32 * sb + 8 * g + 4 * h);
#pragma unroll
            for (int e = 0; e < 4; ++e) { const int s = 32 * sb + 8 * g + 4 * h + e; const float w = (s <= tl) ? expf(bt - b4[e] + l4[e] - mtt) * a[4 * g + e] : 0.f; a[4 * g + e] = w; psum += w; } }
        pT[sb] = a;
    }
    psum = xhalf_sum(psum);
#pragma unroll
    for (int eb = 0; eb < 4; ++eb)
#pragma unroll
        for (int sb = 0; sb < 2; ++sb)
#pragma unroll
            for (int s2 = 0; s2 < 2; ++s2) {
                const LAS unsigned char* vp = Vs + (32 * sb + 16 * s2 + 4 * h + q4) * 272 + (32 * eb + 16 * blk + 4 * p4) * 2;
                const s16x4 lo = tr_read(vp), hi = tr_read(vp + 8 * 272);
                accT[eb] = mfma32(cat8(lo, hi), pack8(pT[sb], s2), accT[eb]);
            }
    const float den = winter * qn + psum;
    const float hs = 1.f / fmaxf(fabsf(den), expf(-mtt));
    float ss = 0.f;
#pragma unroll
    for (int eb = 0; eb < 4; ++eb)
#pragma unroll
        for (int i = 0; i < 16; ++i) { const float v = accT[eb][i] * hs; accT[eb][i] = v; ss += v * v; }
    ss = xhalf_sum(ss);
    const float rr = 1.f / sqrtf(ss * (1.f / 128.f) + RMS_EPS);
    const int tok = tokc + tl;
#pragma unroll
    for (int eb = 0; eb < 4; ++eb)
#pragma unroll
        for (int g = 0; g < 4; ++g) { const int e = 32 * eb + 8 * g + 4 * h;
            const f32x4 gn = *(const f32x4*)(mlstm_g + hh * 128 + e);
            const u32x2 mo = *(const u32x2*)(U + (size_t)tok * NU + UC_MO + hh * 128 + e);
            const float o0 = accT[eb][4 * g] * rr * gn.x * sigmoid_fast(bf_lo(mo.x)), o1 = accT[eb][4 * g + 1] * rr * gn.y * sigmoid_fast(bf_hi(mo.x));
            const float o2 = accT[eb][4 * g + 2] * rr * gn.z * sigmoid_fast(bf_lo(mo.y)), o3 = accT[eb][4 * g + 3] * rr * gn.w * sigmoid_fast(bf_hi(mo.y));
            u32x2 w; w.x = pk2(o0, o1); w.y = pk2(o2, o3);
            *(u32x2*)(MIX + (size_t)tok * D + 512 + hh * 128 + e) = w; }
}

DI void xattn_unit(int b, int hx, int qb, bf16* QX, const bf16* KVx, LAS unsigned char* lds) {
    const int tid = threadIdx.x, lane = tid & 63, wave = __builtin_amdgcn_readfirstlane(tid >> 6);
    const int r = lane & 31, h = lane >> 5, i16 = lane & 15, q4 = i16 >> 2, p4 = i16 & 3, blk = (lane >> 4) & 1;
    const int tok = b * SEQ + qb * 256 + wave * 32 + r;
    bf16x8 qf[16];
    { const bf16* qp = QX + (size_t)tok * D + hx * 256 + 8 * h;
#pragma unroll
      for (int ks = 0; ks < 16; ++ks) qf[ks] = *(const bf16x8*)(qp + 16 * ks); }
    f32x16 sT[8];
    LAS unsigned char* Kx = lds; LAS unsigned char* Vx = lds + 33792;
#pragma unroll
    for (int kt = 0; kt < 4; ++kt) {
        __syncthreads();
#pragma unroll
        for (int i = 0; i < 4; ++i) { const int id = tid + 512 * i, row = id >> 5, pc = id & 31;
            const u32x4 v = *(const u32x4*)(KVx + (size_t)(b * NMEM + 64 * kt + row) * 2048 + hx * 256 + pc * 8);
            *(LAS u32x4*)(Kx + row * 528 + pc * 16) = v; }
        __syncthreads();
#pragma unroll
        for (int mb = 0; mb < 2; ++mb) {
            f32x16 a;
#pragma unroll
            for (int i = 0; i < 16; ++i) a[i] = 0.f;
#pragma unroll
            for (int ks = 0; ks < 16; ++ks) { const bf16x8 kf = *(const LAS bf16x8*)(Kx + (32 * mb + r) * 528 + (16 * ks + 8 * h) * 2); a = mfma32(kf, qf[ks], a); }
            sT[2 * kt + mb] = a;
        }
    }
    const float C2X = 0.0625f * LOG2E;
    float mx = -INFINITY;
#pragma unroll
    for (int j = 0; j < 8; ++j)
#pragma unroll
        for (int i = 0; i < 16; ++i) mx = fmaxf(mx, sT[j][i]);
    mx = xhalf_max(mx);
    const float mb2 = mx * C2X;
    float lsum = 0.f;
#pragma unroll
    for (int j = 0; j < 8; ++j)
#pragma unroll
        for (int i = 0; i < 16; ++i) { const float e = ex2(sT[j][i] * C2X - mb2); sT[j][i] = e; lsum += e; }
    lsum = xhalf_sum(lsum);
    const float inv = 1.f / lsum;
    bf16x8 pf[8][2];
#pragma unroll
    for (int j = 0; j < 8; ++j)
#pragma unroll
        for (int s = 0; s < 2; ++s) pf[j][s] = pack8(sT[j], s);
#pragma unroll
    for (int vh = 0; vh < 2; ++vh) {
        __syncthreads();
#pragma unroll
        for (int i = 0; i < 8; ++i) { const int id = tid + 512 * i, row = id >> 4, pc = id & 15;
            const u32x4 v = *(const u32x4*)(KVx + (size_t)(b * NMEM + row) * 2048 + 1024 + hx * 256 + 128 * vh + pc * 8);
            *(LAS u32x4*)(Vx + row * 272 + pc * 16) = v; }
        __syncthreads();
#pragma unroll
        for (int eb = 0; eb < 4; ++eb) {
            f32x16 acc;
#pragma unroll
            for (int i = 0; i < 16; ++i) acc[i] = 0.f;
#pragma unroll
            for (int j = 0; j < 8; ++j)
#pragma unroll
                for (int s = 0; s < 2; ++s) {
                    const LAS unsigned char* vp = Vx + (32 * j + 16 * s + 4 * h + q4) * 272 + (32 * eb + 16 * blk + 4 * p4) * 2;
                    const s16x4 lo = tr_read(vp), hi = tr_read(vp + 8 * 272);
                    acc = mfma32(cat8(lo, hi), pf[j][s], acc);
                }
#pragma unroll
            for (int g = 0; g < 4; ++g) { const int d = 128 * vh + 32 * eb + 8 * g + 4 * h;
                u32x2 w; w.x = pk2(acc[4 * g] * inv, acc[4 * g + 1] * inv); w.y = pk2(acc[4 * g + 2] * inv, acc[4 * g + 3] * inv);
                *(u32x2*)(QX + (size_t)tok * D + hx * 256 + d) = w; }
        }
    }
}

DI void moe_tables(LAS int* tb, gu32* ctl, int tid) {
    __syncthreads();
    if (tid < 32) tb[40 + tid] = (int)__hip_atomic_load(ctl + CW_CNT + 64 * tid, RLX_AGENT);
    __syncthreads();
    if (tid == 0) { int s = 0; for (int e = 0; e < 32; ++e) { tb[e] = s; s += (tb[40 + e] + 255) >> 8; } tb[32] = s; }
    __syncthreads();
}

struct Args { const float* in[26]; float* out; unsigned char* ws; int ph_lo, ph_hi, li, pad; };

__global__ void __launch_bounds__(NWAVES * 64, 2) fwd(Args args) {
    extern __shared__ __attribute__((aligned(16))) unsigned char lds_raw[];
    LAS unsigned char* lds = (LAS unsigned char*)lds_raw;
    volatile LAS unsigned* MISC = (volatile LAS unsigned*)(lds + MISC_OFF);
    const int tid = threadIdx.x, lane = tid & 63, wave = __builtin_amdgcn_readfirstlane(tid >> 6);
    const int G = gridDim.x, bx = blockIdx.x;
    const int vcu = (G % 8 == 0) ? (bx % 8) * (G / 8) + bx / 8 : bx;
    unsigned char* ws = args.ws;
    gu32* ctl = (gu32*)(ws + WS_CTL);
    const float* x = args.in[0]; const float* mem = args.in[1]; const float* w_in = args.in[2]; const float* fox_f_bias = args.in[3];
    const float* conv_w = args.in[4]; const float* i_bias = args.in[5]; const float* f_bias = args.in[6]; const float* fox_g = args.in[7];
    const float* mlstm_g = args.in[8]; const float* w_out = args.in[9]; const float* ln1_g = args.in[10]; const float* ln1_b = args.in[11];
    const float* w_xq = args.in[12]; const float* w_xk = args.in[13]; const float* w_xv = args.in[14]; const float* w_xo = args.in[15];
    const float* ln2_g = args.in[16]; const float* ln2_b = args.in[17]; const float* w_router = args.in[18]; const float* b_router = args.in[19];
    const float* w_gu = args.in[20]; const float* b_gu = args.in[21]; const float* w_dn = args.in[22]; const float* b_dn = args.in[23];
    const float* ln3_g = args.in[24]; const float* ln3_b = args.in[25];
    float* out = args.out;
    float* Gt = (float*)(ws + WS_G); float* Fc2 = (float*)(ws + WS_FC2);
    float* Gc = (float*)(ws + WS_GC); float* Mloc = Gc + 1024; float* Mp = Gc + 2048; float* Kmax = Gc + 3072;
    float* Nc = (float*)(ws + WS_NC); float* Np = (float*)(ws + WS_NP);
    int* Tidx = (int*)(ws + WS_TIDX); float* Tgate = (float*)(ws + WS_TGATE); int* Tslot = (int*)(ws + WS_TSLOT); int* List = (int*)(ws + WS_LIST);
    bf16* KVx = (bf16*)(ws + WS_MEMKV);
    bf16* Win_t = (bf16*)(ws + WS_WIN); bf16* Wout_t = (bf16*)(ws + WS_WOUT); bf16* Wxq_t = (bf16*)(ws + WS_WXQ); bf16* Wxo_t = (bf16*)(ws + WS_WXO);
    unsigned char* Wgu8 = ws + WS_WGU; unsigned char* Wdn8 = ws + WS_WDN;
    bf16* XB = (bf16*)(ws + WS_XB); bf16* U = (bf16*)(ws + WS_U); bf16* Mq = (bf16*)(ws + WS_MQ); bf16* Mk = (bf16*)(ws + WS_MK);
    float* KvT = (float*)(ws + WS_KVT); bf16* CpT = (bf16*)(ws + WS_CPT); bf16* MIX = (bf16*)(ws + WS_MIX);
    bf16* Y1 = (bf16*)(ws + WS_Y1); bf16* X2B = (bf16*)(ws + WS_Y1 + 32 * MiB); bf16* X1B = (bf16*)(ws + WS_X1B); bf16* QX = (bf16*)(ws + WS_QX);
    bf16* Y2 = (bf16*)(ws + WS_Y2); unsigned char* X2F8 = ws + WS_X2B; unsigned char* HID8 = ws + WS_HID; bf16* YB = (bf16*)(ws + WS_YB);

    for (int u = tid; u < (LDS_BYTES - LDSCTL_OFF) / 4; u += NWAVES * 64) ((LAS unsigned*)(lds + LDSCTL_OFF))[u] = 0u;
    __syncthreads();
    XcdBarrier bar; bar.bar = (unsigned*)(ctl + CW_BAR); bar.x = 0; bar.st = nullptr;
    if (N_LAUNCHES == 1) bar = xcd_barrier_post((unsigned*)(ctl + CW_BAR), MISC + 8);
#define GRID_BAR() do { if (N_LAUNCHES == 1) xcd_barrier(bar); } while (0)
    const int lo = args.ph_lo, hi = args.ph_hi;
#ifndef PH_MASK
#define PH_MASK 0xFFFF
#endif
#define IN(k) (((PH_MASK >> (k)) & 1) && lo <= (k) && (k) < hi)
#define BOTH(k) (IN(k) && IN((k) + 1))
#ifndef REP_MASK
#define REP_MASK 0
#endif
#define REPS(k) (1 + ((REP_MASK >> (k)) & 1))
#define END_PHASE(k) do { if (BOTH(k) || rep + 1 < REPS(k)) GRID_BAR(); } while (0)

    if (IN(0)) for (int rep = 0; rep < REPS(0); ++rep) {
        {
            LAS float* wg = (LAS float*)lds;
            for (int idx = tid; idx < 1024 * 16; idx += 512) { const int k = idx >> 4, c = idx & 15; const int col = c < 8 ? 1536 + c : 2568 + (c - 8);
                const int j = k >> 8, ln = (k & 255) >> 2, i = k & 3; wg[((((j * 4 + i) * 4 + (c >> 2)) * 64 + ln) << 2) + (c & 3)] = w_in[(size_t)k * NIN + col]; }
            __syncthreads();
            for (int m = bx * 8 + wave; m < M; m += G * 8) {
                asm volatile("" ::: "memory");
                const f32x4* xr = (const f32x4*)(x + (size_t)m * D) + lane;
                f32x4 v[4];
#pragma unroll
                for (int j = 0; j < 4; ++j) v[j] = xr[64 * j];
                store_row_bf16(XB + (size_t)m * D, v, lane);
                float acc[16];
#pragma unroll
                for (int c = 0; c < 16; ++c) acc[c] = 0.f;
#pragma unroll
                for (int j = 0; j < 4; ++j)
#pragma unroll
                    for (int i = 0; i < 4; ++i) { const LAS f32x4* wp = (const LAS f32x4*)wg + ((j * 4 + i) * 4) * 64 + lane; const float xv = v[j][i];
#pragma unroll
                        for (int c4 = 0; c4 < 4; ++c4) { const f32x4 w = wp[c4 * 64]; acc[4 * c4] += xv * w.x; acc[4 * c4 + 1] += xv * w.y; acc[4 * c4 + 2] += xv * w.z; acc[4 * c4 + 3] += xv * w.w; } }
#define TR_STEP(HALFN, XORM) { const bool up = (lane & (XORM)) != 0; _Pragma("unroll") for (int i = 0; i < (HALFN); ++i) { const float keep = up ? acc[(HALFN) + i] : acc[i], send = up ? acc[i] : acc[(HALFN) + i]; acc[i] = keep + __shfl_xor(send, (XORM)); } }
                TR_STEP(8, 8) TR_STEP(4, 4) TR_STEP(2, 2) TR_STEP(1, 1)
#undef TR_STEP
                float mine = acc[0]; mine += __shfl_xor(mine, 16); mine += __shfl_xor(mine, 32);
                if (lane < 16) {
                    float o;
                    if (lane < 8) o = log_sigmoid_acc(mine + fox_f_bias[lane]);
                    else if (lane < 12) o = mine + i_bias[lane - 8];
                    else o = log_sigmoid_acc(mine + f_bias[lane - 12]);
                    Gt[(size_t)m * 16 + lane] = o;
                }
            }
            __syncthreads();
        }
        {
            LAS unsigned char* As = lds; LAS unsigned char* Bs = lds + 17408;
            for (int tile = bx; tile < 256; tile += G) {
                const int rt = tile >> 4, ct = tile & 15;
                const float* W = ct < 8 ? w_xk : w_xv; const int col0 = 128 * (ct & 7);
                f32x4 acc[4];
#pragma unroll
                for (int rb = 0; rb < 4; ++rb) acc[rb] = (f32x4){0.f, 0.f, 0.f, 0.f};
                for (int k0 = 0; k0 < 1024; k0 += 128) {
                    __syncthreads();
#pragma unroll
                    for (int i = 0; i < 4; ++i) { const int p = tid + 512 * i, row = p >> 5, c4 = p & 31;
                        const f32x4 a = *(const f32x4*)(mem + (size_t)(64 * rt + row) * D + k0 + 4 * c4);
                        u32x2 w; w.x = pk2(a.x, a.y); w.y = pk2(a.z, a.w); *(LAS u32x2*)(As + row * 272 + c4 * 8) = w; }
#pragma unroll
                    for (int i = 0; i < 8; ++i) { const int p = tid + 512 * i, k = p >> 5, c4 = p & 31;
                        const f32x4 a = *(const f32x4*)(W + (size_t)(k0 + k) * D + col0 + 4 * c4);
                        LAS unsigned short* bp = (LAS unsigned short*)(Bs + (4 * c4) * 272 + k * 2);
                        const unsigned w0 = pk2(a.x, a.y), w1 = pk2(a.z, a.w);
                        bp[0] = (unsigned short)(w0 & 0xffffu); bp[136] = (unsigned short)(w0 >> 16); bp[272] = (unsigned short)(w1 & 0xffffu); bp[408] = (unsigned short)(w1 >> 16); }
                    __syncthreads();
#pragma unroll
                    for (int kk = 0; kk < 4; ++kk) {
                        const bf16x8 bfr = *(const LAS bf16x8*)(Bs + (16 * wave + (lane & 15)) * 272 + (32 * kk + 8 * (lane >> 4)) * 2);
#pragma unroll
                        for (int rb = 0; rb < 4; ++rb) { const bf16x8 afr = *(const LAS bf16x8*)(As + (16 * rb + (lane & 15)) * 272 + (32 * kk + 8 * (lane >> 4)) * 2); acc[rb] = mfma16(afr, bfr, acc[rb]); }
                    }
                }
#pragma unroll
                for (int rb = 0; rb < 4; ++rb)
#pragma unroll
                    for (int j = 0; j < 4; ++j) { const int row = 64 * rt + 16 * rb + 4 * (lane >> 4) + j, col = 128 * ct + 16 * wave + (lane & 15);
                        KVx[(size_t)row * 2048 + col] = (bf16)(pk2(acc[rb][j], 0.f) & 0xffffu); }
            }
            __syncthreads();
        }
        {
            LAS float* scr = (LAS float*)(lds + wave * 16384);
            const int gw = vcu * NWAVES + wave, NGW = G * NWAVES;
            constexpr int I_GU = 32 * 8 * 64, I_DN = 32 * 8 * 32, I_IN = 16 * 96, I_SQ = 16 * 32;
            constexpr int NITEMS = I_GU + I_DN + I_IN + 3 * I_SQ;
            for (int it = gw; it < NITEMS; it += NGW) {
                int q = it;
                if (q < I_GU) { const int e = q >> 9, rr = q & 511, kb = rr >> 6, nb = rr & 63, n0 = 32 * nb; const int bj = n0 >> 10, rem = n0 & 1023, pn = rem >> 7, j0 = rem & 127;
                    p0_transpose_fp8(w_gu + (size_t)e * 1024 * 2048, 2048, Wgu8 + (size_t)e * 2048 * 1024, 1024, n0, 256 * pn + 128 * bj + j0, 128 * kb, WGU_SCALE, (LAS unsigned*)scr, lane); continue; }
                q -= I_GU;
                if (q < I_DN) { const int e = q >> 8, rr = q & 255, kb = rr >> 5, nb = rr & 31;
                    p0_transpose_fp8(w_dn + (size_t)e * 1024 * 1024, 1024, Wdn8 + (size_t)e * 1024 * 1024, 1024, 32 * nb, 32 * nb, 128 * kb, WDN_SCALE, (LAS unsigned*)scr, lane); continue; }
                q -= I_DN;
                if (q < I_IN) { const int kb = q / 96, nb = q % 96, dn0 = 32 * nb; const int sn0 = dn0 < 1536 ? dn0 : (dn0 < 2560 ? dn0 + 8 : dn0 + 16);
                    p0_transpose_item(w_in, NIN, 1024, Win_t, sn0, dn0, 64 * kb, scr, lane); continue; }
                q -= I_IN;
                { const int which = q / I_SQ, rr = q % I_SQ, kb = rr >> 5, nb = rr & 31;
                  const float* W = which == 0 ? w_out : (which == 1 ? w_xq : w_xo); bf16* WT = which == 0 ? Wout_t : (which == 1 ? Wxq_t : Wxo_t);
                  p0_transpose_item(W, 1024, 1024, WT, 32 * nb, 32 * nb, 64 * kb, scr, lane); }
            }
        }
        END_PHASE(0);
    }

    if (IN(1)) for (int rep = 0; rep < REPS(1); ++rep) {
        pg8::StaticSched S; S.init(XB, Win_t, M, NU, D, G, bx);
        pg8::EpiBf16 E{U, NU, nullptr, 0, 1.f};
        pg8::gemm_phase<pg8::EpiBf16, pg8::StaticSched, false, true>(lds, D, S, E);
        END_PHASE(1);
    }

    if (IN(2)) for (int rep = 0; rep < REPS(2); ++rep) {
        for (int u = bx; u < 256; u += G) m1_unit(u >> 4, u & 15, U, Gt, conv_w, Mq, Mk, KvT, Nc, Gc, Mloc, lds);
        __syncthreads();
        for (int sq = bx; sq < 32; sq += G) {
            const int b8 = sq >> 3, h8 = sq & 7; LAS float* wt = (LAS float*)lds;
            float v[8]; float run = 0.f;
#pragma unroll
            for (int i = 0; i < 8; ++i) { run += Gt[(size_t)(b8 * SEQ + 8 * tid + i) * 16 + h8]; v[i] = run; }
            const float incl = wave_scan_add(run, lane);
            if (lane == 63) wt[wave] = incl;
            __syncthreads();
            float off = incl - run;
            for (int w = 0; w < wave; ++w) off += wt[w];
#pragma unroll
            for (int i = 0; i < 8; ++i) Fc2[(size_t)sq * SEQ + 8 * tid + i] = -(off + v[i]) * LOG2E;
            float kn = 0.f;
#pragma unroll
            for (int i = 0; i < 8; ++i) { const u32x4* kp = (const u32x4*)(U + (size_t)(b8 * SEQ + 8 * tid + i) * NU + UC_FK + h8 * 64); float s2 = 0.f;
#pragma unroll
                for (int c = 0; c < 8; ++c) { const u32x4 w = kp[c]; s2 += bf_lo(w.x) * bf_lo(w.x) + bf_hi(w.x) * bf_hi(w.x) + bf_lo(w.y) * bf_lo(w.y) + bf_hi(w.y) * bf_hi(w.y) + bf_lo(w.z) * bf_lo(w.z) + bf_hi(w.z) * bf_hi(w.z) + bf_lo(w.w) * bf_lo(w.w) + bf_hi(w.w) * bf_hi(w.w); }
                kn = fmaxf(kn, s2); }
            kn = wave_max(kn);
            __syncthreads();
            if (lane == 0) wt[8 + wave] = kn;
            __syncthreads();
            if (tid == 0) { float mxk = wt[8]; for (int w = 1; w < 8; ++w) mxk = fmaxf(mxk, wt[8 + w]); Kmax[sq] = sqrtf(mxk); }
            __syncthreads();
        }
        END_PHASE(2);
    }

    if (IN(3)) for (int rep = 0; rep < REPS(3); ++rep) {
        LAS float* sg = (LAS float*)lds;
        for (int ch = bx; ch < 256; ch += G) {
            const int bh = ch >> 4, part = ch & 15, idx = 512 * part + tid;
            __syncthreads();
            if (tid < 64) { sg[tid] = Gc[bh * 64 + tid]; sg[64 + tid] = Mloc[bh * 64 + tid]; }
            __syncthreads();
            if (tid == 0) { float mm = 0.f;
                for (int c = 0; c < 64; ++c) { const float g = sg[c], mc = sg[64 + c]; if (part == 0) Mp[bh * 64 + c] = mm; const float mn = fmaxf(g + mm, mc); sg[128 + c] = expf(g + mm - mn); sg[192 + c] = expf(mc - mn); mm = mn; } }
            __syncthreads();
            float C = 0.f;
            const float* kp = KvT + (size_t)bh * 64 * 8192 + idx; bf16* cp = CpT + (size_t)bh * 64 * 8192 + idx;
            float kvv[64];
#pragma unroll
            for (int c = 0; c < 64; ++c) kvv[c] = kp[(size_t)c * 8192];
#pragma unroll
            for (int c = 0; c < 64; ++c) { cp[(size_t)c * 8192] = (bf16)(pk2(C, 0.f) & 0xffffu); C = sg[128 + c] * C + sg[192 + c] * kvv[c]; }
            if (part == 0 && tid < 64) { float n = 0.f;
#pragma unroll 8
                for (int c = 0; c < 64; ++c) { Np[(size_t)(bh * 64 + c) * 64 + tid] = n; n = sg[128 + c] * n + sg[192 + c] * Nc[(size_t)(bh * 64 + c) * 64 + tid]; } }
        }
        END_PHASE(3);
    }

    if (IN(4)) for (int rep = 0; rep < REPS(4); ++rep) {
        for (int pr = vcu; pr < 256; pr += G) { const int bh8 = pr >> 3, s = pr & 7;
            fox_unit(bh8 >> 3, bh8 & 7, 15 - s, U, Fc2, Kmax, fox_g, MIX, lds);
            fox_unit(bh8 >> 3, bh8 & 7, s, U, Fc2, Kmax, fox_g, MIX, lds); }
        for (int u = bx; u < 256; u += G) m3_unit(u >> 4, u & 15, U, Gt, Mq, Mk, CpT, Np, Mp, mlstm_g, MIX, lds);
        END_PHASE(4);
    }

    if (IN(5)) for (int rep = 0; rep < REPS(5); ++rep) {
        pg8::StaticSched S; S.init(MIX, Wout_t, M, D, D, G, bx);
        pg8::EpiResBf16 E{XB, Y1, D, ALPHA};
        pg8::gemm_phase<pg8::EpiResBf16, pg8::StaticSched, false, false>(lds, D, S, E);
        END_PHASE(5);
    }

    if (IN(6)) for (int rep = 0; rep < REPS(6); ++rep) {
        for (int m = bx * 8 + wave; m < M; m += G * 8) {
            f32x4 v[4];
            load_row_bf16(Y1 + (size_t)m * D, v, lane);
            ln_row(v, ln1_g, ln1_b, lane);
            store_row_bf16(X1B + (size_t)m * D, v, lane);
        }
        END_PHASE(6);
    }

    if (IN(7)) for (int rep = 0; rep < REPS(7); ++rep) {
        pg8::StaticSched S; S.init(X1B, Wxq_t, M, D, D, G, bx);
        pg8::EpiBf16 E{QX, D, nullptr, 0, 1.f};
        pg8::gemm_phase<pg8::EpiBf16, pg8::StaticSched, false, false>(lds, D, S, E);
        END_PHASE(7);
    }

    if (IN(8)) for (int rep = 0; rep < REPS(8); ++rep) {
        for (int u = vcu; u < 256; u += G) xattn_unit(u >> 6, (u >> 4) & 3, u & 15, QX, KVx, lds);
        END_PHASE(8);
    }

    if (IN(9)) for (int rep = 0; rep < REPS(9); ++rep) {
        pg8::StaticSched S; S.init(QX, Wxo_t, M, D, D, G, bx);
        pg8::EpiResBf16 E{X1B, Y2, D, ALPHA};
        pg8::gemm_phase<pg8::EpiResBf16, pg8::StaticSched, false, false>(lds, D, S, E);
        END_PHASE(9);
    }

    if (IN(10)) for (int rep = 0; rep < REPS(10); ++rep) {
        LAS float* wrT = (LAS float*)lds;
        LAS int* hist = (LAS int*)(lds + RT_OFF); LAS int* ebase = hist + 32; LAS int* tokE = hist + 64; LAS int* tokR = hist + 320;
        __syncthreads();
        for (int idx = tid; idx < 1024 * 8; idx += 512) { const int k = idx >> 3, e4 = (idx & 7) * 4; const f32x4 w = *(const f32x4*)(w_router + k * 32 + e4);
            wrT[(e4 + 0) * 1024 + k] = w.x; wrT[(e4 + 1) * 1024 + k] = w.y; wrT[(e4 + 2) * 1024 + k] = w.z; wrT[(e4 + 3) * 1024 + k] = w.w; }
        if (tid < 32) hist[tid] = 0;
        __syncthreads();
        for (int grp = bx; grp < M / 64; grp += G) {
            for (int tl = wave; tl < 64; tl += 8) {
                const int tok = grp * 64 + tl;
                f32x4 v[4];
                load_row_bf16(Y2 + (size_t)tok * D, v, lane);
                ln_row(v, ln2_g, ln2_b, lane);
                store_row_bf16(X2B + (size_t)tok * D, v, lane);
                store_row_fp8(X2F8 + (size_t)tok * D, v, X2_SCALE, lane);
                float acc[32];
#pragma unroll
                for (int e = 0; e < 32; ++e) { float a = 0.f;
#pragma unroll
                    for (int j = 0; j < 4; ++j) { const f32x4 w = *(const LAS f32x4*)(wrT + e * 1024 + 256 * j + 4 * lane); a += (v[j].x * w.x + v[j].y * w.y) + (v[j].z * w.z + v[j].w * w.w); }
                    acc[e] = a; }
#define TR_STEP(HALFN, XORM) { const bool up = (lane & (XORM)) != 0; _Pragma("unroll") for (int i = 0; i < (HALFN); ++i) { const float keep = up ? acc[(HALFN) + i] : acc[i], send = up ? acc[i] : acc[(HALFN) + i]; acc[i] = keep + __shfl_xor(send, (XORM)); } }
                TR_STEP(16, 16) TR_STEP(8, 8) TR_STEP(4, 4) TR_STEP(2, 2) TR_STEP(1, 1)
#undef TR_STEP
                float lg = acc[0] + __shfl_xor(acc[0], 32);
                lg += b_router[lane & 31];
                float tv[4]; int ti[4]; float cur = lg;
#pragma unroll
                for (int k = 0; k < 4; ++k) {
                    float bv = cur; int bi = lane & 31;
#pragma unroll
                    for (int o = 1; o < 32; o <<= 1) { const float ov = __shfl_xor(bv, o); const int oi = __shfl_xor(bi, o); if (ov > bv || (ov == bv && oi < bi)) { bv = ov; bi = oi; } }
                    tv[k] = bv; ti[k] = bi; if ((lane & 31) == bi) cur = -INFINITY;
                }
                const float e1 = expf(tv[1] - tv[0]), e2 = expf(tv[2] - tv[0]), e3 = expf(tv[3] - tv[0]); const float isum = 1.f / (1.f + e1 + e2 + e3);
                if (lane == 0) {
                    const float gs[4] = {isum, e1 * isum, e2 * isum, e3 * isum};
#pragma unroll
                    for (int k = 0; k < 4; ++k) { const int rk = atomicAdd((int*)&hist[ti[k]], 1); tokE[tl * 4 + k] = ti[k]; tokR[tl * 4 + k] = rk; Tidx[tok * 4 + k] = ti[k]; Tgate[tok * 4 + k] = gs[k]; }
                }
            }
            __syncthreads();
            if (tid < 32) { const int c = hist[tid]; ebase[tid] = c ? (int)__hip_atomic_fetch_add(ctl + CW_CNT + 64 * tid, (unsigned)c, RLX_AGENT) : 0; hist[tid] = 0; }
            __syncthreads();
            if (tid < 256) { const int tl = tid >> 2, e = tokE[tid], slot = ebase[e] + tokR[tid]; List[(size_t)e * LCAP + slot] = grp * 64 + tl; Tslot[(grp * 64 + tl) * 4 + (tid & 3)] = slot; }
            __syncthreads();
        }
        END_PHASE(10);
    }

    if (IN(11)) for (int rep = 0; rep < REPS(11); ++rep) {
        LAS int* tb = (LAS int*)(lds + MOE_TB_OFF);
        moe_tables(tb, ctl, tid);
        pg8::MoeSched S; S.A = (const char*)X2F8; S.B = (const char*)Wgu8; S.list = List; S.tb = tb; S.K = 512; S.NT = 8; S.nwg = __builtin_amdgcn_readfirstlane(tb[32]) * 8; S.G = G; S.c = bx; S.bexp = (size_t)2048 * 1024; S.gather = true;
        pg8::EpiSwiglu E{HID8, b_gu, 1.f / (WGU_SCALE * X2_SCALE), HID_SCALE};
        pg8::gemm_phase<pg8::EpiSwiglu, pg8::MoeSched, true, true, true>(lds, 512, S, E);
        END_PHASE(11);
    }

    if (IN(12)) for (int rep = 0; rep < REPS(12); ++rep) {
        LAS int* tb = (LAS int*)(lds + MOE_TB_OFF);
        moe_tables(tb, ctl, tid);
        pg8::MoeSched S; S.A = (const char*)HID8; S.B = (const char*)Wdn8; S.list = List; S.tb = tb; S.K = 512; S.NT = 4; S.nwg = __builtin_amdgcn_readfirstlane(tb[32]) * 4; S.G = G; S.c = bx; S.bexp = (size_t)1024 * 1024; S.gather = false;
        pg8::EpiBf16 E{YB, D, b_dn, 1024, 1.f / (WDN_SCALE * HID_SCALE)};
        pg8::gemm_phase<pg8::EpiBf16, pg8::MoeSched, false, true, true>(lds, 512, S, E);
        END_PHASE(12);
    }

    if (IN(13)) for (int rep = 0; rep < REPS(13); ++rep) {
        LAS int* tb = (LAS int*)(lds + MOE_TB_OFF);
        moe_tables(tb, ctl, tid);
        for (int m0 = (bx * 8 + wave) * 2; m0 < M; m0 += G * 16) {
            int rowi = 0; float gk = 0.f;
            if (lane < 8) { const int q = (m0 + (lane >> 2)) * 4 + (lane & 3); const int e = Tidx[q]; rowi = tb[e] * 256 + Tslot[q]; gk = Tgate[q]; }
            f32x4 v[2][4]; u32x2 y[2][4][4]; float gg[2][4];
#pragma unroll
            for (int t = 0; t < 2; ++t) {
                const u32x2* xr = (const u32x2*)(X2B + (size_t)(m0 + t) * D) + lane;
#pragma unroll
                for (int j = 0; j < 4; ++j) { const u32x2 w = xr[64 * j]; v[t][j] = (f32x4){bf_lo(w.x), bf_hi(w.x), bf_lo(w.y), bf_hi(w.y)}; }
#pragma unroll
                for (int k = 0; k < 4; ++k) { const int rk = __shfl(rowi, 4 * t + k); gg[t][k] = __shfl(gk, 4 * t + k);
                    const u32x2* yr = (const u32x2*)(YB + (size_t)rk * D) + lane;
#pragma unroll
                    for (int j = 0; j < 4; ++j) y[t][k][j] = yr[64 * j]; }
            }
#pragma unroll
            for (int t = 0; t < 2; ++t) {
#pragma unroll
                for (int j = 0; j < 4; ++j) v[t][j] = v[t][j] * ALPHA;
#pragma unroll
                for (int k = 0; k < 4; ++k)
#pragma unroll
                    for (int j = 0; j < 4; ++j) { const u32x2 w = y[t][k][j]; const float g1 = gg[t][k]; v[t][j].x += g1 * bf_lo(w.x); v[t][j].y += g1 * bf_hi(w.x); v[t][j].z += g1 * bf_lo(w.y); v[t][j].w += g1 * bf_hi(w.y); }
                ln_row(v[t], ln3_g, ln3_b, lane);
                f32x4* orow = (f32x4*)(out + (size_t)(m0 + t) * D) + lane;
#pragma unroll
                for (int j = 0; j < 4; ++j) orow[64 * j] = v[t][j];
            }
        }
        if (rep + 1 < REPS(13)) GRID_BAR();
    }
#undef IN
#undef BOTH
#undef GRID_BAR
}

extern "C" void kernel_launch(void* const* d_in, const int* in_sizes, int n_in, void* d_out, int out_size, void* d_ws, size_t ws_size, hipStream_t stream) {
    static int grid = 0;
    if (grid == 0) {
        if (n_in != 26 || in_sizes[0] != M * D || out_size != M * D || ws_size < WS_END) { fprintf(stderr, "kernel_launch: unexpected shapes (n_in %d, in0 %d, out %d, ws %zu)\n", n_in, n_in > 0 ? in_sizes[0] : -1, out_size, ws_size); grid = -1; return; }
        int dev = 0, cus = 0, per_cu = 0;
        if (hipGetDevice(&dev) != hipSuccess || hipDeviceGetAttribute(&cus, hipDeviceAttributeMultiprocessorCount, dev) != hipSuccess) { grid = -1; return; }
        if (hipFuncSetAttribute((const void*)fwd, hipFuncAttributeMaxDynamicSharedMemorySize, LDS_BYTES) != hipSuccess) { fprintf(stderr, "kernel_launch: hipFuncSetAttribute failed\n"); grid = -1; return; }
        if (hipOccupancyMaxActiveBlocksPerMultiprocessor(&per_cu, (const void*)fwd, NWAVES * 64, LDS_BYTES) != hipSuccess || per_cu < 1) fprintf(stderr, "kernel_launch: occupancy query reports %d\n", per_cu);
        (void)hipGetLastError();
        grid = cus;
    }
    if (grid < 0) return;
    if (hipMemsetAsync((char*)d_ws + WS_CTL, 0, CTL_ZERO_BYTES, stream) != hipSuccess) return;
    Args a{};
    for (int i = 0; i < 26; ++i) a.in[i] = (const float*)d_in[i];
    a.out = (float*)d_out; a.ws = (unsigned char*)d_ws;
    if (N_LAUNCHES == 1) {
        a.ph_lo = 0; a.ph_hi = NPHASE; a.li = 0;
        hipLaunchKernelGGL(fwd, dim3(grid), dim3(NWAVES * 64), LDS_BYTES, stream, a);
    } else {
        for (int li = 0; li < NPHASE; ++li) { a.ph_lo = li; a.ph_hi = li + 1; a.li = li; hipLaunchKernelGGL(fwd, dim3(grid), dim3(NWAVES * 64), LDS_BYTES, stream, a); }
    }
}
```

```cpp
#include <hip/hip_runtime.h>
#include <cstdio>
#include <cstdint>
#include <cmath>

#define DI __device__ __forceinline__
#define LAS __attribute__((address_space(3)))
#define GAS __attribute__((address_space(1)))
typedef unsigned short bf16;
typedef short bf16x8 __attribute__((ext_vector_type(8)));
typedef short s16x4 __attribute__((ext_vector_type(4)));
typedef float f32x2 __attribute__((ext_vector_type(2)));
typedef float f32x4 __attribute__((ext_vector_type(4)));
typedef float f32x16 __attribute__((ext_vector_type(16)));
typedef unsigned u32x2 __attribute__((ext_vector_type(2)));
typedef unsigned u32x4 __attribute__((ext_vector_type(4)));
typedef GAS unsigned gu32;

#ifndef MK_N_LAUNCHES
#define MK_N_LAUNCHES 1
#endif

constexpr int BATCH = 4, SEQ = 4096, D = 1024, M = BATCH * SEQ, NMEM = 256;
constexpr int NIN = 3088;
constexpr int NU = 3072;
constexpr int UC_FQ = 0, UC_FK = 512, UC_FV = 1024, UC_MQ = 1536, UC_MK = 1792, UC_MV = 2048, UC_MO = 2560;
constexpr int NE = 32, TOPK = 4, LCAP = 16384;
constexpr int PROWS = M * TOPK + NE * 256;
constexpr float ALPHA = 1.189207115002721f;
constexpr float LOG2E = 1.4426950408889634f;
constexpr float LN_EPS = 1e-5f, RMS_EPS = 1e-6f;
constexpr int NPHASE = 14;
constexpr float WGU_SCALE = 32.f, WDN_SCALE = 64.f, X2_SCALE = 4.f, HID_SCALE = 4.f;
constexpr int N_LAUNCHES = MK_N_LAUNCHES;

constexpr size_t MiB = 1u << 20;
constexpr size_t WS_CTL = 0, CTL_ZERO_BYTES = 1 * MiB;
constexpr size_t WS_G = 1 * MiB;
constexpr size_t WS_FC2 = 2 * MiB;
constexpr size_t WS_GC = 2 * MiB + 512 * 1024;
constexpr size_t WS_NC = 3 * MiB;
constexpr size_t WS_NP = 3 * MiB + 256 * 1024;
constexpr size_t WS_TIDX = 3 * MiB + 512 * 1024;
constexpr size_t WS_TGATE = 3 * MiB + 768 * 1024;
constexpr size_t WS_TSLOT = 4 * MiB;
constexpr size_t WS_LIST = 5 * MiB;
constexpr size_t WS_MEMKV = 8 * MiB;
constexpr size_t WS_WIN = 16 * MiB, WS_WOUT = 22 * MiB, WS_WXQ = 24 * MiB, WS_WXO = 26 * MiB;
constexpr size_t WS_WGU = 32 * MiB, WS_WDN = 160 * MiB;
constexpr size_t WS_XB = 224 * MiB;
constexpr size_t WS_U = 256 * MiB;
constexpr size_t WS_MQ = 352 * MiB, WS_MK = 360 * MiB;
constexpr size_t WS_KVT = 368 * MiB;
constexpr size_t WS_CPT = 400 * MiB;
constexpr size_t WS_MIX = 432 * MiB;
constexpr size_t WS_Y1 = 464 * MiB;
constexpr size_t WS_X1B = 528 * MiB;
constexpr size_t WS_QX = 560 * MiB;
constexpr size_t WS_Y2 = 596 * MiB;
constexpr size_t WS_X2B = 660 * MiB;
constexpr size_t WS_HID = 692 * MiB;
constexpr size_t WS_YB = 836 * MiB;
constexpr size_t WS_END = 980 * MiB;
constexpr int CW_TMO = 0, CW_CODE = 1;
constexpr int CW_CNT = 1024;
constexpr int CW_BAR = 4096;

constexpr int RING_BYTES = 131072;
constexpr int LDSCTL_OFF = RING_BYTES, MISC_OFF = LDSCTL_OFF + 320;
constexpr int MOE_TB_OFF = LDSCTL_OFF + 1024;
constexpr int RT_OFF = LDSCTL_OFF + 2048;
constexpr int LDS_BYTES = 147456;
constexpr int NWAVES = 8;

#define RLX_AGENT __ATOMIC_RELAXED, __HIP_MEMORY_SCOPE_AGENT
DI float bf_lo(unsigned u) { return __uint_as_float(u << 16); }
DI float bf_hi(unsigned u) { return __uint_as_float(u & 0xffff0000u); }
DI float bf2f(short s) { return __uint_as_float(((unsigned)(unsigned short)s) << 16); }
typedef __bf16 bf16x2_t __attribute__((ext_vector_type(2)));
DI unsigned pk2(float lo, float hi) { f32x2 v = {lo, hi}; bf16x2_t b = __builtin_convertvector(v, bf16x2_t); return __builtin_bit_cast(unsigned, b); }
DI float wave_sum(float v) {
#pragma unroll
    for (int o = 1; o < 64; o <<= 1) v += __shfl_xor(v, o);
    return v;
}
DI float wave_max(float v) {
#pragma unroll
    for (int o = 1; o < 64; o <<= 1) v = fmaxf(v, __shfl_xor(v, o));
    return v;
}
DI float wave_scan_add(float v, int lane) {
#pragma unroll
    for (int o = 1; o < 64; o <<= 1) { const float t = __shfl_up(v, o); if (lane >= o) v += t; }
    return v;
}
DI float wave_scan_max(float v, int lane) {
#pragma unroll
    for (int o = 1; o < 64; o <<= 1) { const float t = __shfl_up(v, o); if (lane >= o) v = fmaxf(v, t); }
    return v;
}
DI float xhalf_sum(float v) { return v + __shfl_xor(v, 32); }
DI float xhalf_max(float v) { return fmaxf(v, __shfl_xor(v, 32)); }
DI float ex2(float x) { return __builtin_amdgcn_exp2f(x); }
DI float exp_fast(float x) { return __builtin_amdgcn_exp2f(x * LOG2E); }
DI float sigmoid_fast(float x) { return __builtin_amdgcn_rcpf(1.f + exp_fast(-x)); }
DI float log_sigmoid_acc(float x) { return fminf(x, 0.f) - log1pf(expf(-fabsf(x))); }
DI f32x16 mfma32(bf16x8 a, bf16x8 b, f32x16 c) { return __builtin_amdgcn_mfma_f32_32x32x16_bf16(a, b, c, 0, 0, 0); }
DI f32x4 mfma16(bf16x8 a, bf16x8 b, f32x4 c) { return __builtin_amdgcn_mfma_f32_16x16x32_bf16(a, b, c, 0, 0, 0); }
typedef short v4i16_t __attribute__((ext_vector_type(4)));
DI s16x4 tr_read(const LAS unsigned char* p) { return __builtin_bit_cast(s16x4, __builtin_amdgcn_ds_read_tr16_b64_v4i16((LAS v4i16_t*)p)); }
DI bf16x8 cat8(s16x4 lo, s16x4 hi) { return __builtin_shufflevector(lo, hi, 0, 1, 2, 3, 4, 5, 6, 7); }
typedef int v8i32 __attribute__((ext_vector_type(8)));
typedef int v4i32 __attribute__((ext_vector_type(4)));
DI unsigned pk4_fp8(float a, float b, float c, float d) { int w = 0; w = __builtin_amdgcn_cvt_pk_fp8_f32(a, b, w, false); w = __builtin_amdgcn_cvt_pk_fp8_f32(c, d, w, true); return (unsigned)w; }
DI int crow(int r, int hi) { return (r & 3) + 8 * (r >> 2) + 4 * hi; }
DI bf16x8 pack8(const f32x16& x, int s) {
    u32x4 p;
    p.x = pk2(x[8 * s + 0], x[8 * s + 1]); p.y = pk2(x[8 * s + 2], x[8 * s + 3]); p.z = pk2(x[8 * s + 4], x[8 * s + 5]); p.w = pk2(x[8 * s + 6], x[8 * s + 7]);
    return __builtin_bit_cast(bf16x8, p);
}

namespace pg8 {
constexpr int BM = 256, BK = 64, HALF = 128, HTB = HALF * BK * 2, STAGE_BYTES = 8 * HTB, NXCD = 8, WGM = 8;
__host__ __device__ __forceinline__ int lds_byte(int r, int c) { const int st = (r >> 4) * 2 + (c >> 5), rr = r & 15, cc = c & 31, ob = rr * 64 + cc * 2; return st * 1024 + (ob ^ (((ob >> 9) & 1) << 5)); }
__host__ __device__ __forceinline__ void stage_rc(int b, int& R, int& C) { const int st = b / 1024, sb = b % 1024, swz = sb ^ (((sb >> 9) & 1) << 5); R = (st >> 1) * 16 + swz / 64; C = (st & 1) * 32 + (swz % 64) / 2; }
__host__ __device__ __forceinline__ int perm32(int rho) { const int n = rho >> 4, i = rho & 15; return 8 * (i >> 2) + 4 * n + (i & 3); }

struct Unit { int pm, pn, e, nvalid; const char* A; const char* B; const int* list; };

struct StaticSched {
    const char* A; const char* B; int K, nM, nN, nwg, G, c;
    DI void init(const void* A_, const void* B_, int M_, int N_, int K_, int G_, int c_) { A = (const char*)A_; B = (const char*)B_; K = K_; nM = M_ / BM; nN = N_ / BM; nwg = nM * nN; G = G_; c = c_; }
    DI bool next(int i, Unit& u) const {
        const long L = (long)i * G + c; if (L >= nwg) return false;
        int wgid = (int)L; { const int q = nwg / NXCD, r = nwg % NXCD, xcd = wgid % NXCD, off = wgid / NXCD; wgid = (xcd < r ? xcd * (q + 1) : r * (q + 1) + (xcd - r) * q) + off; }
        const int nig = WGM * nN, gid = wgid / nig, fm = gid * WGM, gsz = (nM - fm) < WGM ? (nM - fm) : WGM;
        u.pm = fm + ((wgid % nig) % gsz); u.pn = (wgid % nig) / gsz; u.e = 0; u.nvalid = BM; u.list = nullptr;
        u.A = A + (size_t)u.pm * BM * K * 2; u.B = B + (size_t)u.pn * BM * K * 2; return true;
    }
};
struct MoeSched {
    const char* A; const char* B; const int* list; const LAS int* tb; int K, NT, nwg, G, c; size_t bexp; bool gather;
    DI bool next(int i, Unit& u) const {
        const long L = (long)i * G + c; if (L >= nwg) return false;
        int wgid = (int)L; { const int q = nwg / NXCD, r = nwg % NXCD, xcd = wgid % NXCD, off = wgid / NXCD; wgid = (xcd < r ? xcd * (q + 1) : r * (q + 1) + (xcd - r) * q) + off; }
        const int g = wgid / NT, nt = wgid % NT;
        int e = 0;
#pragma unroll
        for (int j = 1; j < 32; ++j) e += (tb[j] <= g) ? 1 : 0;
        e = __builtin_amdgcn_readfirstlane(e);
        const int mt = g - __builtin_amdgcn_readfirstlane(tb[e]);
        u.pm = g; u.pn = nt; u.e = e; u.nvalid = __builtin_amdgcn_readfirstlane(tb[40 + e]) - mt * BM; u.list = list + (size_t)e * LCAP + mt * BM;
        u.A = gather ? A : A + (size_t)g * BM * K * 2; u.B = B + (size_t)e * bexp + (size_t)nt * BM * K * 2; return true;
    }
};

template <bool GATHER> DI void a_offsets(const Unit& u, int K, unsigned (&v)[2][2]) {
    int R[2], C[2];
#pragma unroll
    for (int i = 0; i < 2; ++i) stage_rc((int)threadIdx.x * 16 + i * 8192, R[i], C[i]);
#pragma unroll
    for (int h = 0; h < 2; ++h)
#pragma unroll
        for (int i = 0; i < 2; ++i) {
            const int row = h * HALF + R[i];
            if constexpr (GATHER) { const int rc = row < u.nvalid ? row : u.nvalid - 1; const int tok = u.list[rc]; v[h][i] = (unsigned)(tok * K + C[i]) * 2u; }
            else v[h][i] = (unsigned)(row * K + C[i]) * 2u;
        }
}

struct EpiBf16 {
    static constexpr bool PERM = true;
    bf16* O; int ldc; const float* bias; int bias_estride; float scale;
    DI void operator()(const f32x4 (&acc)[2][2][4][2], const Unit& u, int wr, int wc, int fr, int fq) const {
        const int row0 = u.pm * BM + wr * 64 + fr; const int col0 = u.pn * BM + wc * 32 + 8 * fq;
        f32x4 bv[2][2];
#pragma unroll
        for (int bj = 0; bj < 2; ++bj)
#pragma unroll
            for (int n = 0; n < 2; ++n) bv[bj][n] = bias ? *(const f32x4*)(bias + (size_t)u.e * bias_estride + col0 + bj * HALF + 4 * n) : (f32x4){0.f, 0.f, 0.f, 0.f};
#pragma unroll
        for (int ai = 0; ai < 2; ++ai)
#pragma unroll
            for (int m = 0; m < 4; ++m) { bf16* rowp = O + (size_t)(row0 + ai * HALF + m * 16) * ldc + col0;
#pragma unroll
                for (int bj = 0; bj < 2; ++bj) { const f32x4 v0 = acc[ai][bj][m][0] * scale + bv[bj][0], v1 = acc[ai][bj][m][1] * scale + bv[bj][1];
                    u32x4 w; w.x = pk2(v0[0], v0[1]); w.y = pk2(v0[2], v0[3]); w.z = pk2(v1[0], v1[1]); w.w = pk2(v1[2], v1[3]);
                    *(u32x4*)(rowp + bj * HALF) = w; } }
    }
};
struct EpiResF32 {
    static constexpr bool PERM = false;
    const float* base; float* out; int ldc; float alpha;
    DI void operator()(const f32x4 (&acc)[2][2][4][2], const Unit& u, int wr, int wc, int fr, int fq) const {
        const int col0 = u.pn * BM + wc * 32 + 4 * fq;
#pragma unroll
        for (int ai = 0; ai < 2; ++ai)
#pragma unroll
            for (int m = 0; m < 4; ++m) { const size_t off = (size_t)(u.pm * BM + ai * HALF + wr * 64 + m * 16 + fr) * ldc + col0;
#pragma unroll
                for (int bj = 0; bj < 2; ++bj)
#pragma unroll
                    for (int n = 0; n < 2; ++n) { const f32x4 bs = *(const f32x4*)(base + off + bj * HALF + n * 16); *(f32x4*)(out + off + bj * HALF + n * 16) = bs * alpha + acc[ai][bj][m][n]; } }
    }
};
struct EpiResBf16 {
    static constexpr bool PERM = true;
    const bf16* base; bf16* out; int ldc; float alpha;
    DI void operator()(const f32x4 (&acc)[2][2][4][2], const Unit& u, int wr, int wc, int fr, int fq) const {
        const int row0 = u.pm * BM + wr * 64 + fr; const int col0 = u.pn * BM + wc * 32 + 8 * fq;
#pragma unroll
        for (int ai = 0; ai < 2; ++ai)
#pragma unroll
            for (int m = 0; m < 4; ++m) { const size_t off = (size_t)(row0 + ai * HALF + m * 16) * ldc + col0;
#pragma unroll
                for (int bj = 0; bj < 2; ++bj) { const u32x4 b = *(const u32x4*)(base + off + bj * HALF); const f32x4 a0 = acc[ai][bj][m][0], a1 = acc[ai][bj][m][1];
                    u32x4 w; w.x = pk2(bf_lo(b.x) * alpha + a0[0], bf_hi(b.x) * alpha + a0[1]); w.y = pk2(bf_lo(b.y) * alpha + a0[2], bf_hi(b.y) * alpha + a0[3]);
                    w.z = pk2(bf_lo(b.z) * alpha + a1[0], bf_hi(b.z) * alpha + a1[1]); w.w = pk2(bf_lo(b.w) * alpha + a1[2], bf_hi(b.w) * alpha + a1[3]);
                    *(u32x4*)(out + off + bj * HALF) = w; } }
    }
};
struct EpiSwiglu {
    static constexpr bool PERM = true;
    unsigned char* O; const float* bias; float scale, oscale;
    DI void operator()(const f32x4 (&acc)[2][2][4][2], const Unit& u, int wr, int wc, int fr, int fq) const {
        const int row0 = u.pm * BM + wr * 64 + fr; const int j0 = wc * 32 + 8 * fq; const int col0 = u.pn * HALF + j0;
        const float* bg = bias + (size_t)u.e * 2048 + col0; const float* bl = bg + 1024;
        f32x4 bgv[2], blv[2];
#pragma unroll
        for (int n = 0; n < 2; ++n) { bgv[n] = *(const f32x4*)(bg + 4 * n); blv[n] = *(const f32x4*)(bl + 4 * n); }
#pragma unroll
        for (int ai = 0; ai < 2; ++ai)
#pragma unroll
            for (int m = 0; m < 4; ++m) { unsigned char* rowp = O + (size_t)(row0 + ai * HALF + m * 16) * 1024 + col0;
                float o[8];
#pragma unroll
                for (int n = 0; n < 2; ++n) { const f32x4 g = acc[ai][0][m][n] * scale + bgv[n], l = acc[ai][1][m][n] * scale + blv[n];
#pragma unroll
                    for (int q = 0; q < 4; ++q) { const float gg = fminf(g[q], 7.0f), ll = fminf(fmaxf(l[q], -7.0f), 7.0f);
                        o[4 * n + q] = gg * __builtin_amdgcn_rcpf(1.f + ex2(gg * (-1.702f * LOG2E))) * (ll + 1.f) * oscale; } }
                u32x2 w; w.x = pk4_fp8(o[0], o[1], o[2], o[3]); w.y = pk4_fp8(o[4], o[5], o[6], o[7]);
                *(u32x2*)rowp = w; }
    }
};

template <class Epi, class Sched, bool GATHER, bool ALIGN_EPI, bool FP8 = false>
DI void gemm_phase(LAS unsigned char* lds, const int K, const Sched& S, const Epi& E) {
    const int tid = threadIdx.x, wid = __builtin_amdgcn_readfirstlane(tid >> 6), lane = tid & 63, wr = wid >> 2, wc = wid & 3, fr = lane & 15, fq = lane >> 4;
    const int nt = K / BK;
    unsigned voffB[2];
#pragma unroll
    for (int i = 0; i < 2; ++i) { int R, C; stage_rc(tid * 16 + i * 8192, R, C); const int Rb = Epi::PERM ? ((R & ~31) + perm32(R & 31)) : R; voffB[i] = (unsigned)(Rb * K + C) * 2u; }
    const size_t kstep = (size_t)(BK * 2);
    const size_t hstep = (size_t)HALF * K * 2;
    const unsigned ldsw = (unsigned)wid * 1024u;
    const int aoff = lds_byte(wr * 64 + fr, fq * 8), boff = lds_byte(wc * 32 + fr, fq * 8);
#define PG8_SA(b, h) (((b) * 2 + (h)) * HTB)
#define PG8_SB(b, h) ((4 + (b) * 2 + (h)) * HTB)
#define PG8_STAGE(bufoff, gbase, voff) do { _Pragma("unroll") for (int _i = 0; _i < 2; ++_i) { unsigned _o = (voff)[_i]; asm volatile("" : "+v"(_o));   \
        __builtin_amdgcn_global_load_lds((const unsigned*)((const char*)(gbase) + _o), (LAS unsigned*)(lds + (bufoff) + ldsw + _i * 8192), 16, 0, 0); } } while (0)
#define PG8_LDA(dst, b, h) do { _Pragma("unroll") for (int m = 0; m < 4; ++m) _Pragma("unroll") for (int k = 0; k < 2; ++k) dst[m][k] = *(const LAS bf16x8*)(lds + PG8_SA(b, h) + aoff + m * 2048 + k * 1024); } while (0)
#define PG8_LDB(dst, b, h) do { _Pragma("unroll") for (int n = 0; n < 2; ++n) _Pragma("unroll") for (int k = 0; k < 2; ++k) dst[n][k] = *(const LAS bf16x8*)(lds + PG8_SB(b, h) + boff + n * 2048 + k * 1024); } while (0)
#define PG8_CAT(x) __builtin_shufflevector(__builtin_bit_cast(v4i32, x[0]), __builtin_bit_cast(v4i32, x[1]), 0, 1, 2, 3, 4, 5, 6, 7)
#define PG8_MMA(ai, bj, At, Bt) do { __builtin_amdgcn_s_setprio(1); _Pragma("unroll") for (int m = 0; m < 4; ++m) _Pragma("unroll") for (int n = 0; n < 2; ++n) { \
        if constexpr (FP8) { const v8i32 _a = PG8_CAT(Bt[n]), _b = PG8_CAT(At[m]); asm volatile("v_mfma_scale_f32_16x16x128_f8f6f4 %0, %1, %2, %0, %3, %3 op_sel_hi:[0,0,0]" : "+v"(acc[ai][bj][m][n]) : "v"(_a), "v"(_b), "v"(sc1)); } \
        else { _Pragma("unroll") for (int k = 0; k < 2; ++k) acc[ai][bj][m][n] = __builtin_amdgcn_mfma_f32_16x16x32_bf16(Bt[n][k], At[m][k], acc[ai][bj][m][n], 0, 0, 0); } } __builtin_amdgcn_s_setprio(0); } while (0)
#define PG8_WAIT_V(n) asm volatile("s_waitcnt vmcnt(" #n ")" ::: "memory")
#define PG8_WAIT_L(n) asm volatile("s_waitcnt lgkmcnt(" #n ")" ::: "memory")
#define PG8_BAR __builtin_amdgcn_s_barrier()
#define PG8_SCHED __builtin_amdgcn_sched_barrier(0)
    Unit cur, nxt; int ui = 0;
    if (!S.next(0, cur)) return;
    const int sc1 = 0x7f7f7f7f;
    unsigned vAc[2][2], vAn[2][2];
    a_offsets<GATHER>(cur, K, vAc);
    f32x4 acc[2][2][4][2];
#pragma unroll
    for (int a = 0; a < 2; ++a)
#pragma unroll
        for (int b = 0; b < 2; ++b)
#pragma unroll
            for (int m = 0; m < 4; ++m)
#pragma unroll
                for (int n = 0; n < 2; ++n) acc[a][b][m][n] = (f32x4){0.f, 0.f, 0.f, 0.f};
    bf16x8 At[4][2], B0[2][2], B1[2][2];
    const char* cA = cur.A; const char* cB = cur.B;
    PG8_STAGE(PG8_SB(0, 0), cB, voffB); PG8_STAGE(PG8_SB(0, 1), cB + hstep, voffB); PG8_STAGE(PG8_SA(0, 0), cA, vAc[0]); PG8_STAGE(PG8_SA(0, 1), cA, vAc[1]);
    if (wr == 1) PG8_BAR;
    PG8_WAIT_V(2); PG8_BAR;
    PG8_STAGE(PG8_SB(1, 0), cB + kstep, voffB); PG8_STAGE(PG8_SA(1, 0), cA + kstep, vAc[0]); PG8_STAGE(PG8_SB(1, 1), cB + hstep + kstep, voffB);
    PG8_WAIT_V(6); PG8_BAR;
    for (;;) {
        const bool has_next = S.next(ui + 1, nxt);
        if constexpr (GATHER) {
            if (has_next) a_offsets<GATHER>(nxt, K, vAn);
            else {
#pragma unroll
                for (int h = 0; h < 2; ++h)
#pragma unroll
                    for (int i = 0; i < 2; ++i) vAn[h][i] = vAc[h][i]; }
        }
        const char* nA = has_next ? nxt.A : cA; const char* nB = has_next ? nxt.B : cB;
#pragma unroll 1
        for (int t = 0; t < nt; t += 2) {
            const bool last = (t == nt - 2);
            const char* a1 = cA + (size_t)(t + 1) * kstep;
            const char* a2 = last ? nA : cA + (size_t)(t + 2) * kstep; const char* b2 = last ? nB : cB + (size_t)(t + 2) * kstep;
            const char* a3 = a2 + kstep; const char* b3 = b2 + kstep;
            unsigned v2[2][2];
#pragma unroll
            for (int h = 0; h < 2; ++h)
#pragma unroll
                for (int i = 0; i < 2; ++i) v2[h][i] = GATHER ? (last ? vAn[h][i] : vAc[h][i]) : vAc[h][i];
            PG8_LDB(B0, 0, 0); PG8_LDB(B1, 0, 1); PG8_SCHED; PG8_LDA(At, 0, 0); PG8_STAGE(PG8_SA(1, 1), a1, vAc[1]);
            PG8_WAIT_V(8); PG8_WAIT_L(0); PG8_BAR; PG8_MMA(0, 0, At, B0); PG8_MMA(0, 1, At, B1); PG8_BAR; PG8_SCHED;
            PG8_LDA(At, 0, 1); PG8_STAGE(PG8_SB(0, 0), b2, voffB); PG8_STAGE(PG8_SB(0, 1), b2 + hstep, voffB); PG8_STAGE(PG8_SA(0, 0), a2, v2[0]);
            PG8_WAIT_V(8); PG8_WAIT_L(0); PG8_BAR; PG8_MMA(1, 0, At, B0); PG8_MMA(1, 1, At, B1); PG8_BAR; PG8_SCHED;
            PG8_LDB(B0, 1, 0); PG8_LDB(B1, 1, 1); PG8_SCHED; PG8_LDA(At, 1, 0); PG8_STAGE(PG8_SA(0, 1), a2, v2[1]);
            PG8_WAIT_V(8); PG8_WAIT_L(0); PG8_BAR; PG8_MMA(0, 0, At, B0); PG8_MMA(0, 1, At, B1); PG8_BAR; PG8_SCHED;
            PG8_LDA(At, 1, 1); PG8_STAGE(PG8_SB(1, 0), b3, voffB); PG8_STAGE(PG8_SB(1, 1), b3 + hstep, voffB); PG8_STAGE(PG8_SA(1, 0), a3, v2[0]);
            PG8_WAIT_V(8); PG8_WAIT_L(0); PG8_BAR; PG8_MMA(1, 0, At, B0); PG8_MMA(1, 1, At, B1); PG8_BAR; PG8_SCHED;
        }
        if constexpr (FP8) asm volatile("s_nop 15\n\ts_nop 15" ::: "memory");
        if constexpr (ALIGN_EPI) { if (wr == 0) PG8_BAR; }
        E(acc, cur, wr, wc, fr, fq);
        if (!has_next) break;
#pragma unroll
        for (int a = 0; a < 2; ++a)
#pragma unroll
            for (int b = 0; b < 2; ++b)
#pragma unroll
                for (int m = 0; m < 4; ++m)
#pragma unroll
                    for (int n = 0; n < 2; ++n) acc[a][b][m][n] = (f32x4){0.f, 0.f, 0.f, 0.f};
        cur = nxt; cA = nA; cB = nB; ++ui;
        if constexpr (GATHER) {
#pragma unroll
            for (int h = 0; h < 2; ++h)
#pragma unroll
                for (int i = 0; i < 2; ++i) vAc[h][i] = vAn[h][i]; }
        if constexpr (ALIGN_EPI) { if (wr == 1) PG8_BAR; }
    }
    PG8_WAIT_V(0);
    if constexpr (!ALIGN_EPI) { if (wr == 0) PG8_BAR; }
    PG8_BAR;
#undef PG8_SA
#undef PG8_SB
#undef PG8_STAGE
#undef PG8_LDA
#undef PG8_LDB
#undef PG8_MMA
#undef PG8_CAT
#undef PG8_WAIT_V
#undef PG8_WAIT_L
#undef PG8_BAR
#undef PG8_SCHED
}
}

#define XB_TMO      128
#define XB_XCNT(j)  (256  + 64 * (j))
#define XB_XSUB(j)  (1280 + 64 * (j))
#define XB_XGEN(j)  (2304 + 64 * (j))
#define XB_TOP      3328
#define XB_TOPGEN   3392
#define XCD_BAR_WORDS 3456
#define XB_SPIN_CAP (1u << 18)
DI unsigned xb_ld(unsigned* p)              { return __hip_atomic_load(p, __ATOMIC_RELAXED, __HIP_MEMORY_SCOPE_AGENT); }
DI unsigned xb_add(unsigned* p, unsigned v) { return __hip_atomic_fetch_add(p, v, __ATOMIC_RELAXED, __HIP_MEMORY_SCOPE_AGENT); }
DI unsigned xb_xcc_id() { return (unsigned)__builtin_amdgcn_s_getreg((3 << 11) | 20) & 0xFu; }
#define XB_SPIN(cond, bar) do { unsigned _sp = 0; while (cond) { __builtin_amdgcn_s_sleep(1); \
    if ((++_sp & 255u) == 0u) { if (xb_ld(&(bar)[XB_TMO])) break; if (_sp > XB_SPIN_CAP) { atomicAdd(&(bar)[XB_TMO], 1u); break; } } } } while (0)
struct XcdBarrier { unsigned* bar; unsigned x; volatile LAS unsigned* st; };
DI XcdBarrier xcd_barrier_post(unsigned* bar, volatile LAS unsigned* st) {
    XcdBarrier b; b.bar = bar; b.x = xb_xcc_id(); b.st = st;
    if (threadIdx.x == 0) (void)xb_add(&bar[XB_XCNT(b.x)], 1u);
    return b;
}
DI void xcd_barrier_complete(unsigned* bar, unsigned x, unsigned& nloc, unsigned& nx) {
    const unsigned G = gridDim.x * gridDim.y * gridDim.z;
    unsigned sum, cnt, mine, sp = 0u;
    for (;;) {
        sum = 0u; cnt = 0u; mine = 0u;
#pragma unroll
        for (unsigned j = 0; j < 16; ++j) { const unsigned c = xb_ld(&bar[XB_XCNT(j)]); sum += c; cnt += (c > 0u) ? 1u : 0u; mine = (j == x) ? c : mine; }
        if (sum == G) break;
        __builtin_amdgcn_s_sleep(1);
        if ((++sp & 255u) == 0u) { if (xb_ld(&bar[XB_TMO])) break; if (sp > XB_SPIN_CAP) { atomicAdd(&bar[XB_TMO], 1u); break; } }
    }
    nloc = mine > 0u ? mine : 1u; nx = cnt > 0u ? cnt : 1u;
}
DI void xcd_barrier(const XcdBarrier& b) {
    asm volatile("s_waitcnt vmcnt(0)" ::: "memory");
    __syncthreads();
    if (threadIdx.x == 0) {
        unsigned* bar = b.bar;
        __builtin_amdgcn_s_waitcnt(0);
        unsigned nloc = b.st[0], nx = b.st[1];
        if (nloc == 0u) { xcd_barrier_complete(bar, b.x, nloc, nx); b.st[0] = nloc; b.st[1] = nx; }
        const unsigned old = xb_add(&bar[XB_XSUB(b.x)], 1u);
        const unsigned gen = old / nloc;
        if (old + 1u == (gen + 1u) * nloc) {
            __builtin_amdgcn_fence(__ATOMIC_RELEASE, "agent");
            asm volatile("s_waitcnt vmcnt(0)" ::: "memory");
            const unsigned og = xb_add(&bar[XB_TOP], 1u);
            const unsigned tg = og / nx;
            if (og + 1u == (tg + 1u) * nx) xb_add(&bar[XB_TOPGEN], 1u);
            else XB_SPIN(xb_ld(&bar[XB_TOPGEN]) == tg, bar);
            __builtin_amdgcn_fence(__ATOMIC_ACQUIRE, "agent");
            xb_add(&bar[XB_XGEN(b.x)], 1u);
            asm volatile("s_waitcnt vmcnt(0)" ::: "memory");
        } else {
            XB_SPIN(xb_ld(&bar[XB_XGEN(b.x)]) == gen, bar);
            __builtin_amdgcn_fence(__ATOMIC_ACQUIRE, "agent");
            asm volatile("s_waitcnt vmcnt(0)" ::: "memory");
        }
    }
    __syncthreads();
}

DI void p0_transpose_item(const float* W, int ldw, int K, bf16* WT, int src_n0, int dst_n0, int k0, LAS float* scr, int lane) {
#pragma unroll 8
    for (int i = 0; i < 32; ++i) { const int kk = 2 * i + (lane >> 5); scr[kk * 33 + (lane & 31)] = W[(size_t)(k0 + kk) * ldw + src_n0 + (lane & 31)]; }
    asm volatile("s_waitcnt lgkmcnt(0)" ::: "memory");
    const int c = lane & 7;
#pragma unroll
    for (int j = 0; j < 4; ++j) { const int n = (lane >> 3) + 8 * j; const LAS float* s = scr + (8 * c) * 33 + n;
        u32x4 o; o.x = pk2(s[0 * 33], s[1 * 33]); o.y = pk2(s[2 * 33], s[3 * 33]); o.z = pk2(s[4 * 33], s[5 * 33]); o.w = pk2(s[6 * 33], s[7 * 33]);
        *(u32x4*)(WT + (size_t)(dst_n0 + n) * K + k0 + 8 * c) = o; }
    asm volatile("s_waitcnt lgkmcnt(0)" ::: "memory");
}

DI void p0_transpose_fp8(const float* W, int ldw, unsigned char* WT, int kbytes, int src_n0, int dst_n0, int k0, float scale, LAS unsigned* scr, int lane) {
    const int kq = lane >> 3, nq = lane & 7;
    f32x4 v[16];
#pragma unroll
    for (int i = 0; i < 16; ++i) { const int k = 32 * (i >> 2) + 4 * kq + (i & 3); v[i] = *(const f32x4*)(W + (size_t)(k0 + k) * ldw + src_n0 + 4 * nq); }
#pragma unroll
    for (int g = 0; g < 4; ++g)
#pragma unroll
        for (int c = 0; c < 4; ++c) scr[(4 * nq + c) * 33 + 8 * g + kq] = pk4_fp8(v[4 * g][c] * scale, v[4 * g + 1][c] * scale, v[4 * g + 2][c] * scale, v[4 * g + 3][c] * scale);
    asm volatile("s_waitcnt lgkmcnt(0)" ::: "memory");
    const int ch = lane & 7;
#pragma unroll
    for (int j = 0; j < 4; ++j) { const int n = (lane >> 3) + 8 * j; const LAS unsigned* s = scr + n * 33 + 4 * ch;
        u32x4 o; o.x = s[0]; o.y = s[1]; o.z = s[2]; o.w = s[3];
        *(u32x4*)(WT + (size_t)(dst_n0 + n) * kbytes + k0 + 16 * ch) = o; }
    asm volatile("s_waitcnt lgkmcnt(0)" ::: "memory");
}

DI void ln_row(f32x4 (&v)[4], const float* g, const float* bta, int lane) {
    float s = 0.f;
#pragma unroll
    for (int j = 0; j < 4; ++j) s += (v[j].x + v[j].y) + (v[j].z + v[j].w);
    const float mean = wave_sum(s) * (1.f / D); float s2 = 0.f;
#pragma unroll
    for (int j = 0; j < 4; ++j) { v[j] = v[j] - mean; s2 += (v[j].x * v[j].x + v[j].y * v[j].y) + (v[j].z * v[j].z + v[j].w * v[j].w); }
    const float rstd = 1.f / sqrtf(wave_sum(s2) * (1.f / D) + LN_EPS);
#pragma unroll
    for (int j = 0; j < 4; ++j) { const f32x4 gg = *(const f32x4*)(g + 4 * lane + 256 * j), bb = *(const f32x4*)(bta + 4 * lane + 256 * j); v[j] = v[j] * rstd * gg + bb; }
}
DI void store_row_bf16(bf16* orow, const f32x4 (&v)[4], int lane) {
    u32x2* o8 = (u32x2*)orow + lane;
#pragma unroll
    for (int j = 0; j < 4; ++j) { u32x2 w; w.x = pk2(v[j].x, v[j].y); w.y = pk2(v[j].z, v[j].w); o8[64 * j] = w; }
}

DI void load_row_bf16(const bf16* irow, f32x4 (&v)[4], int lane) {
    const u32x2* i8 = (const u32x2*)irow + lane;
#pragma unroll
    for (int j = 0; j < 4; ++j) { const u32x2 w = i8[64 * j]; v[j] = (f32x4){bf_lo(w.x), bf_hi(w.x), bf_lo(w.y), bf_hi(w.y)}; }
}
DI void store_row_fp8(unsigned char* orow, const f32x4 (&v)[4], float scale, int lane) {
    unsigned* o4 = (unsigned*)orow + lane;
#pragma unroll
    for (int j = 0; j < 4; ++j) o4[64 * j] = pk4_fp8(v[j].x * scale, v[j].y * scale, v[j].z * scale, v[j].w * scale);
}

constexpr float FOX_THR = 40.f;
DI void fox_unit(int b, int h8, int qb, const bf16* U, const float* Fc2, const float* Kmax, const float* fox_g, bf16* MIX, LAS unsigned char* lds) {
    const int tid = threadIdx.x, lane = tid & 63, wave = __builtin_amdgcn_readfirstlane(tid >> 6);
    const int r = lane & 31, h = lane >> 5, i16 = lane & 15, q4 = i16 >> 2, p4 = i16 & 3, blk = (lane >> 4) & 1;
    const int tok0 = b * SEQ, q0 = qb * 256, qrow = q0 + wave * 32 + r;
    const float C2 = 0.125f * LOG2E;
    bf16x8 qf[4];
    { const bf16* qp = U + (size_t)(tok0 + qrow) * NU + UC_FQ + h8 * 64 + 8 * h;
#pragma unroll
      for (int d0 = 0; d0 < 4; ++d0) qf[d0] = *(const bf16x8*)(qp + 16 * d0); }
    float qn2 = 0.f;
#pragma unroll
    for (int d0 = 0; d0 < 4; ++d0)
#pragma unroll
        for (int j = 0; j < 8; ++j) { const float f = bf2f(qf[d0][j]); qn2 += f * f; }
    qn2 = xhalf_sum(qn2);
    const float* fc = Fc2 + (size_t)(b * 8 + h8) * SEQ;
    const float qk_bound = sqrtf(wave_max(qn2)) * Kmax[b * 8 + h8] * C2 * 1.001f;
    const float nb_first = fc[q0];
    float m = -1e30f, l = 0.f; f32x16 oT[2];
#pragma unroll
    for (int i = 0; i < 16; ++i) { oT[0][i] = 0.f; oT[1][i] = 0.f; }
    constexpr int FOXB = 18944;
    const int NT = 4 * qb + 4;
    bool active = true;
    const int srow = tid >> 3, spc = tid & 7;
    const bf16* gp0 = U + (size_t)(tok0 + srow) * NU + h8 * 64 + spc * 8;
    u32x4 kvr, vvr; float nbr = 0.f;
    { const bf16* gp = gp0 + (size_t)(64 * (NT - 1)) * NU; kvr = *(const u32x4*)(gp + UC_FK); vvr = *(const u32x4*)(gp + UC_FV); if (tid < 64) nbr = fc[64 * (NT - 1) + tid] - nb_first; }
    __syncthreads();
    *(LAS u32x4*)(lds + srow * 144 + spc * 16) = kvr; *(LAS u32x4*)(lds + 9216 + srow * 144 + spc * 16) = vvr; if (tid < 64) ((LAS float*)(lds + 18432))[tid] = nbr;
    __syncthreads();
    int cur = 0;
    for (int t = NT - 1; t >= 0; --t) {
        LAS unsigned char* Ks = lds + cur * FOXB; LAS unsigned char* Vs = Ks + 9216; LAS float* nb = (LAS float*)(Ks + 18432);
        if (t >= 1) { const bf16* gp = gp0 + (size_t)(64 * (t - 1)) * NU; kvr = *(const u32x4*)(gp + UC_FK); vvr = *(const u32x4*)(gp + UC_FV); if (tid < 64) nbr = fc[64 * (t - 1) + tid] - nb_first; }
        if (active && 64 * t <= q0 + wave * 32 + 31) {
            f32x16 p[2];
#pragma unroll
            for (int hb = 0; hb < 2; ++hb) {
                f32x16 a;
#pragma unroll
                for (int i = 0; i < 16; ++i) a[i] = 0.f;
#pragma unroll
                for (int d0 = 0; d0 < 4; ++d0) { const bf16x8 kf = *(const LAS bf16x8*)(Ks + (32 * hb + r) * 144 + (16 * d0 + 8 * h) * 2); a = mfma32(kf, qf[d0], a); }
#pragma unroll
                for (int g = 0; g < 4; ++g) { const f32x4 bb = *(const LAS f32x4*)(nb + 32 * hb + 8 * g + 4 * h);
#pragma unroll
                    for (int e = 0; e < 4; ++e) a[4 * g + e] = a[4 * g + e] * C2 + bb[e]; }
                p[hb] = a;
            }
            if (t >= NT - 4) {
#pragma unroll
                for (int hb = 0; hb < 2; ++hb)
#pragma unroll
                    for (int i = 0; i < 16; ++i) { const int kv = 64 * t + 32 * hb + crow(i, h); if (kv > qrow) p[hb][i] = -INFINITY; }
            }
            float mx = p[0][0];
#pragma unroll
            for (int i = 1; i < 16; ++i) mx = fmaxf(mx, p[0][i]);
#pragma unroll
            for (int i = 0; i < 16; ++i) mx = fmaxf(mx, p[1][i]);
            mx = xhalf_max(mx);
            if (__any(mx > m)) {
                const float mn = fmaxf(m, mx), alpha = ex2(m - mn); m = mn; l *= alpha;
#pragma unroll
                for (int i = 0; i < 16; ++i) { oT[0][i] *= alpha; oT[1][i] *= alpha; }
            }
            float rs = 0.f;
#pragma unroll
            for (int hb = 0; hb < 2; ++hb)
#pragma unroll
                for (int i = 0; i < 16; ++i) { const float e = ex2(p[hb][i] - m); p[hb][i] = e; rs += e; }
            l += rs;
            bf16x8 pf[2][2];
#pragma unroll
            for (int hb = 0; hb < 2; ++hb)
#pragma unroll
                for (int s = 0; s < 2; ++s) pf[hb][s] = pack8(p[hb], s);
#pragma unroll
            for (int d0 = 0; d0 < 2; ++d0)
#pragma unroll
                for (int hb = 0; hb < 2; ++hb)
#pragma unroll
                    for (int s = 0; s < 2; ++s) {
                        const LAS unsigned char* vp = Vs + (32 * hb + 16 * s + 4 * h + q4) * 144 + (32 * d0 + 16 * blk + 4 * p4) * 2;
                        const s16x4 lo = tr_read(vp), hi = tr_read(vp + 8 * 144);
                        oT[d0] = mfma32(cat8(lo, hi), pf[hb][s], oT[d0]);
                    }
            if (t >= 1) { const float mmin = -wave_max(-m); active = (qk_bound + (fc[64 * t - 1] - nb_first) - mmin) > -FOX_THR; }
        }
        cur ^= 1;
        { LAS unsigned char* Kn = lds + cur * FOXB; *(LAS u32x4*)(Kn + srow * 144 + spc * 16) = kvr; *(LAS u32x4*)(Kn + 9216 + srow * 144 + spc * 16) = vvr; if (tid < 64) ((LAS float*)(Kn + 18432))[tid] = nbr; }
        if (!__syncthreads_or(active ? 1 : 0)) break;
    }
    l = xhalf_sum(l);
    const float inv = 1.f / l;
    float ss = 0.f;
#pragma unroll
    for (int d0 = 0; d0 < 2; ++d0)
#pragma unroll
        for (int i = 0; i < 16; ++i) { const float o = oT[d0][i] * inv; oT[d0][i] = o; ss += o * o; }
    ss = xhalf_sum(ss);
    const float rr = 1.f / sqrtf(ss * (1.f / 64.f) + RMS_EPS);
    bf16* op = MIX + (size_t)(tok0 + qrow) * D + h8 * 64;
#pragma unroll
    for (int d0 = 0; d0 < 2; ++d0)
#pragma unroll
        for (int g = 0; g < 4; ++g) { const int d = 32 * d0 + 8 * g + 4 * h; const f32x4 gn = *(const f32x4*)(fox_g + h8 * 64 + d);
            u32x2 w; w.x = pk2(oT[d0][4 * g] * rr * gn.x, oT[d0][4 * g + 1] * rr * gn.y); w.y = pk2(oT[d0][4 * g + 2] * rr * gn.z, oT[d0][4 * g + 3] * rr * gn.w);
            *(u32x2*)(op + d) = w; }
}

DI void m1_unit(int bh, int cg, const bf16* U, const float* G, const float* conv_w, bf16* Mq, bf16* Mk, float* KvT, float* Nc, float* Gc, float* Mloc, LAS unsigned char* lds) {
    const int tid = threadIdx.x, lane = tid & 63, wave = __builtin_amdgcn_readfirstlane(tid >> 6);
    const int r = lane & 31, h = lane >> 5, i16 = lane & 15, q4 = i16 >> 2, p4 = i16 & 3, blk = (lane >> 4) & 1;
    const int b = bh >> 2, hh = bh & 3, s0 = cg * 256;
    LAS float* wa = (LAS float*)lds;
    LAS unsigned char* ksb = lds + 1024;
    LAS unsigned char* vsb = lds + 1024 + 36864;
    __syncthreads();
    if (wave < 4) {
        const int c = cg * 4 + wave, tok = b * SEQ + c * 64 + lane;
        const float lf = G[(size_t)tok * 16 + 12 + hh], li = G[(size_t)tok * 16 + 8 + hh];
        const float bsc = wave_scan_add(lf, lane);
        const float g = __shfl(bsc, 63);
        const float a = g - bsc + li;
        const float ml = wave_max(a);
        wa[wave * 64 + lane] = expf(a - ml);
        if (lane == 0) { Gc[bh * 64 + c] = g; Mloc[bh * 64 + c] = ml; }
    }
    __syncthreads();
#pragma unroll 2
    for (int i = 0; i < 8; ++i) {
        const int id = tid + 512 * i, d8 = id & 7, qk = (id >> 3) & 1, t = id >> 4;
        const int ucol = (qk ? UC_MK : UC_MQ) + hh * 64 + 8 * d8, ccol = (qk ? 256 : 0) + hh * 64 + 8 * d8;
        float acc[8];
#pragma unroll
        for (int e = 0; e < 8; ++e) acc[e] = 0.f;
#pragma unroll
        for (int j = 0; j < 4; ++j) {
            const int ts = s0 + t - 3 + j;
            if (ts >= 0) {
                const u32x4 x = *(const u32x4*)(U + (size_t)(b * SEQ + ts) * NU + ucol);
                const f32x4 w0 = *(const f32x4*)(conv_w + j * 512 + ccol), w1 = *(const f32x4*)(conv_w + j * 512 + ccol + 4);
                acc[0] += bf_lo(x.x) * w0.x; acc[1] += bf_hi(x.x) * w0.y; acc[2] += bf_lo(x.y) * w0.z; acc[3] += bf_hi(x.y) * w0.w;
                acc[4] += bf_lo(x.z) * w1.x; acc[5] += bf_hi(x.z) * w1.y; acc[6] += bf_lo(x.w) * w1.z; acc[7] += bf_hi(x.w) * w1.w;
            }
        }
#pragma unroll
        for (int e = 0; e < 8; ++e) acc[e] = acc[e] / (1.f + expf(-acc[e]));
        const size_t orow = ((size_t)bh * SEQ + s0 + t) * 64 + 8 * d8;
        if (qk == 0) {
            u32x4 w; w.x = pk2(acc[0], acc[1]); w.y = pk2(acc[2], acc[3]); w.z = pk2(acc[4], acc[5]); w.w = pk2(acc[6], acc[7]);
            *(u32x4*)(Mq + orow) = w;
        } else {
#pragma unroll
            for (int e = 0; e < 8; ++e) acc[e] *= 0.125f;
            u32x4 w; w.x = pk2(acc[0], acc[1]); w.y = pk2(acc[2], acc[3]); w.z = pk2(acc[4], acc[5]); w.w = pk2(acc[6], acc[7]);
            *(u32x4*)(Mk + orow) = w;
            const float ww = wa[t];
            u32x4 x; x.x = pk2(acc[0] * ww, acc[1] * ww); x.y = pk2(acc[2] * ww, acc[3] * ww); x.z = pk2(acc[4] * ww, acc[5] * ww); x.w = pk2(acc[6] * ww, acc[7] * ww);
            *(LAS u32x4*)(ksb + (t >> 6) * 9216 + (t & 63) * 144 + d8 * 16) = x;
        }
    }
#pragma unroll
    for (int i = 0; i < 8; ++i) { const int id = tid + 512 * i, pc = id & 15, t = id >> 4;
        const u32x4 v = *(const u32x4*)(U + (size_t)(b * SEQ + s0 + t) * NU + UC_MV + hh * 128 + pc * 8);
        *(LAS u32x4*)(vsb + (t >> 6) * 17408 + (t & 63) * 272 + pc * 16) = v; }
    __syncthreads();
    {
        const int cl = wave >> 1, eh = wave & 1, c = cg * 4 + cl;
        const LAS unsigned char* vs = vsb + cl * 17408; const LAS unsigned char* ks = ksb + cl * 9216;
        f32x16 acc[2][2];
#pragma unroll
        for (int a = 0; a < 2; ++a)
#pragma unroll
            for (int bb = 0; bb < 2; ++bb)
#pragma unroll
                for (int i = 0; i < 16; ++i) acc[a][bb][i] = 0.f;
#pragma unroll
        for (int k4 = 0; k4 < 4; ++k4) {
            bf16x8 af[2], bfr[2];
#pragma unroll
            for (int eb = 0; eb < 2; ++eb) { const LAS unsigned char* pp = vs + (16 * k4 + 8 * h + q4) * 272 + (64 * eh + 32 * eb + 16 * blk + 4 * p4) * 2; af[eb] = cat8(tr_read(pp), tr_read(pp + 4 * 272)); }
#pragma unroll
            for (int db = 0; db < 2; ++db) { const LAS unsigned char* pp = ks + (16 * k4 + 8 * h + q4) * 144 + (32 * db + 16 * blk + 4 * p4) * 2; bfr[db] = cat8(tr_read(pp), tr_read(pp + 4 * 144)); }
#pragma unroll
            for (int eb = 0; eb < 2; ++eb)
#pragma unroll
                for (int db = 0; db < 2; ++db) acc[eb][db] = mfma32(af[eb], bfr[db], acc[eb][db]);
        }
        float* op = KvT + (size_t)(bh * 64 + c) * 8192;
#pragma unroll
        for (int eb = 0; eb < 2; ++eb)
#pragma unroll
            for (int db = 0; db < 2; ++db)
#pragma unroll
                for (int i = 0; i < 16; ++i) op[(64 * eh + 32 * eb + crow(i, h)) * 64 + 32 * db + r] = acc[eb][db][i];
    }
    if (tid < 256) { const int cl = tid >> 6, d = tid & 63; const LAS unsigned char* ks = ksb + cl * 9216 + d * 2; float s = 0.f;
#pragma unroll 8
        for (int t = 0; t < 64; ++t) s += __uint_as_float(((unsigned)*(const LAS unsigned short*)(ks + t * 144)) << 16);
        Nc[(size_t)(bh * 64 + cg * 4 + cl) * 64 + d] = s; }
}

DI void m3_unit(int bh, int cg, const bf16* U, const float* G, const bf16* Mq, const bf16* Mk, const bf16* CpT, const float* Np, const float* Mp, const float* mlstm_g, bf16* MIX, LAS unsigned char* lds) {
    const int tid = threadIdx.x, lane = tid & 63, wave = __builtin_amdgcn_readfirstlane(tid >> 6);
    const int r = lane & 31, h = lane >> 5, i16 = lane & 15, q4 = i16 >> 2, p4 = i16 & 3, blk = (lane >> 4) & 1;
    const int b = bh >> 2, hh = bh & 3, cl = wave >> 1, th = wave & 1, c = cg * 4 + cl;
    const int tokc = b * SEQ + c * 64;
    const LAS unsigned char* Vs = lds + cl * 17408;
    LAS float* wsf = (LAS float*)(lds + 69632 + wave * 1024);
    __syncthreads();
#pragma unroll
    for (int i = 0; i < 8; ++i) { const int id = tid + 512 * i, pc = id & 15, t = id >> 4;
        const u32x4 v = *(const u32x4*)(U + (size_t)(b * SEQ + cg * 256 + t) * NU + UC_MV + hh * 128 + pc * 8);
        *(LAS u32x4*)(lds + (t >> 6) * 17408 + (t & 63) * 272 + pc * 16) = v; }
    const float mprev = Mp[bh * 64 + c];
    {
        const float lf = G[(size_t)(tokc + lane) * 16 + 12 + hh], li = G[(size_t)(tokc + lane) * 16 + 8 + hh];
        const float bsc = wave_scan_add(lf, lane);
        const float pm = wave_scan_max(li - bsc, lane);
        wsf[lane] = bsc; wsf[64 + lane] = li; wsf[128 + lane] = bsc + fmaxf(mprev, pm); wsf[192 + lane] = Np[(size_t)(bh * 64 + c) * 64 + lane];
    }
    __syncthreads();
    const int tl = 32 * th + r;
    const float bt = wsf[tl], mtt = wsf[128 + tl];
    const float winter = expf(bt + mprev - mtt);
    bf16x8 qf[4];
    { const bf16* qp = Mq + ((size_t)bh * SEQ + c * 64 + tl) * 64 + 8 * h;
#pragma unroll
      for (int ks = 0; ks < 4; ++ks) qf[ks] = *(const bf16x8*)(qp + 16 * ks); }
    float qn = 0.f;
#pragma unroll
    for (int ks = 0; ks < 4; ++ks)
#pragma unroll
        for (int j = 0; j < 8; ++j) qn += bf2f(qf[ks][j]) * wsf[192 + 16 * ks + 8 * h + j];
    qn = xhalf_sum(qn);
    f32x16 accT[4];
#pragma unroll
    for (int eb = 0; eb < 4; ++eb) {
        f32x16 a;
#pragma unroll
        for (int i = 0; i < 16; ++i) a[i] = 0.f;
#pragma unroll
        for (int ks = 0; ks < 4; ++ks) { const bf16x8 cf = *(const bf16x8*)(CpT + ((size_t)(bh * 64 + c) * 128 + 32 * eb + r) * 64 + 16 * ks + 8 * h); a = mfma32(cf, qf[ks], a); }
#pragma unroll
        for (int i = 0; i < 16; ++i) a[i] *= winter;
        accT[eb] = a;
    }
    float psum = 0.f; f32x16 pT[2];
#pragma unroll
    for (int sb = 0; sb < 2; ++sb) {
        f32x16 a;
#pragma unroll
        for (int i = 0; i < 16; ++i) a[i] = 0.f;
#pragma unroll
        for (int ks = 0; ks < 4; ++ks) { const bf16x8 kf = *(const bf16x8*)(Mk + ((size_t)bh * SEQ + c * 64 + 32 * sb + r) * 64 + 16 * ks + 8 * h); a = mfma32(kf, qf[ks], a); }
#pragma unroll
        for (int g = 0; g < 4; ++g) { const f32x4 b4 = *(const LAS f32x4*)(wsf + 32 * sb + 8 * g + 4 * h), l4 = *(const LAS f32x4*)(wsf + 64 + 32 * sb + 8 * g + 4 * h);
#pragma unroll
            for (int e = 0; e < 4; ++e) { const int s = 32 * sb + 8 * g + 4 * h + e; const float w = (s <= tl) ? expf(bt - b4[e] + l4[e] - mtt) * a[4 * g + e] : 0.f; a[4 * g + e] = w; psum += w; } }
        pT[sb] = a;
    }
    psum = xhalf_sum(psum);
#pragma unroll
    for (int eb = 0; eb < 4; ++eb)
#pragma unroll
        for (int sb = 0; sb < 2; ++sb)
#pragma unroll
            for (int s2 = 0; s2 < 2; ++s2) {
                const LAS unsigned char* vp = Vs + (32 * sb + 16 * s2 + 4 * h + q4) * 272 + (32 * eb + 16 * blk + 4 * p4) * 2;
                const s16x4 lo = tr_read(vp), hi = tr_read(vp + 8 * 272);
                accT[eb] = mfma32(cat8(lo, hi), pack8(pT[sb], s2), accT[eb]);
            }
    const float den = winter * qn + psum;
    const float hs = 1.f / fmaxf(fabsf(den), expf(-mtt));
    float ss = 0.f;
#pragma unroll
    for (int eb = 0; eb < 4; ++eb)
#pragma unroll
        for (int i = 0; i < 16; ++i) { const float v = accT[eb][i] * hs; accT[eb][i] = v; ss += v * v; }
    ss = xhalf_sum(ss);
    const float rr = 1.f / sqrtf(ss * (1.f / 128.f) + RMS_EPS);
    const int tok = tokc + tl;
#pragma unroll
    for (int eb = 0; eb < 4; ++eb)
#pragma unroll
        for (int g = 0; g < 4; ++g) { const int e = 32 * eb + 8 * g + 4 * h;
            const f32x4 gn = *(const f32x4*)(mlstm_g + hh * 128 + e);
            const u32x2 mo = *(const u32x2*)(U + (size_t)tok * NU + UC_MO + hh * 128 + e);
            const float o0 = accT[eb][4 * g] * rr * gn.x * sigmoid_fast(bf_lo(mo.x)), o1 = accT[eb][4 * g + 1] * rr * gn.y * sigmoid_fast(bf_hi(mo.x));
            const float o2 = accT[eb][4 * g + 2] * rr * gn.z * sigmoid_fast(bf_lo(mo.y)), o3 = accT[eb][4 * g + 3] * rr * gn.w * sigmoid_fast(bf_hi(mo.y));
            u32x2 w; w.x = pk2(o0, o1); w.y = pk2(o2, o3);
            *(u32x2*)(MIX + (size_t)tok * D + 512 + hh * 128 + e) = w; }
}

DI void xattn_unit(int b, int hx, int qb, bf16* QX, const bf16* KVx, LAS unsigned char* lds) {
    const int tid = threadIdx.x, lane = tid & 63, wave = __builtin_amdgcn_readfirstlane(tid >> 6);
    const int r = lane & 31, h = lane >> 5, i16 = lane & 15, q4 = i16 >> 2, p4 = i16 & 3, blk = (lane >> 4) & 1;
    const int tok = b * SEQ + qb * 256 + wave * 32 + r;
    bf16x8 qf[16];
    { const bf16* qp = QX + (size_t)tok * D + hx * 256 + 8 * h;
#pragma unroll
      for (int ks = 0; ks < 16; ++ks) qf[ks] = *(const bf16x8*)(qp + 16 * ks); }
    f32x16 sT[8];
    LAS unsigned char* Kx = lds; LAS unsigned char* Vx = lds + 33792;
#pragma unroll
    for (int kt = 0; kt < 4; ++kt) {
        __syncthreads();
#pragma unroll
        for (int i = 0; i < 4; ++i) { const int id = tid + 512 * i, row = id >> 5, pc = id & 31;
            const u32x4 v = *(const u32x4*)(KVx + (size_t)(b * NMEM + 64 * kt + row) * 2048 + hx * 256 + pc * 8);
            *(LAS u32x4*)(Kx + row * 528 + pc * 16) = v; }
        __syncthreads();
#pragma unroll
        for (int mb = 0; mb < 2; ++mb) {
            f32x16 a;
#pragma unroll
            for (int i = 0; i < 16; ++i) a[i] = 0.f;
#pragma unroll
            for (int ks = 0; ks < 16; ++ks) { const bf16x8 kf = *(const LAS bf16x8*)(Kx + (32 * mb + r) * 528 + (16 * ks + 8 * h) * 2); a = mfma32(kf, qf[ks], a); }
            sT[2 * kt + mb] = a;
        }
    }
    const float C2X = 0.0625f * LOG2E;
    float mx = -INFINITY;
#pragma unroll
    for (int j = 0; j < 8; ++j)
#pragma unroll
        for (int i = 0; i < 16; ++i) mx = fmaxf(mx, sT[j][i]);
    mx = xhalf_max(mx);
    const float mb2 = mx * C2X;
    float lsum = 0.f;
#pragma unroll
    for (int j = 0; j < 8; ++j)
#pragma unroll
        for (int i = 0; i < 16; ++i) { const float e = ex2(sT[j][i] * C2X - mb2); sT[j][i] = e; lsum += e; }
    lsum = xhalf_sum(lsum);
    const float inv = 1.f / lsum;
    bf16x8 pf[8][2];
#pragma unroll
    for (int j = 0; j < 8; ++j)
#pragma unroll
        for (int s = 0; s < 2; ++s) pf[j][s] = pack8(sT[j], s);
#pragma unroll
    for (int vh = 0; vh < 2; ++vh) {
        __syncthreads();
#pragma unroll
        for (int i = 0; i < 8; ++i) { const int id = tid + 512 * i, row = id >> 4, pc = id & 15;
            const u32x4 v = *(const u32x4*)(KVx + (size_t)(b * NMEM + row) * 2048 + 1024 + hx * 256 + 128 * vh + pc * 8);
            *(LAS u32x4*)(Vx + row * 272 + pc * 16) = v; }
        __syncthreads();
#pragma unroll
        for (int eb = 0; eb < 4; ++eb) {
            f32x16 acc;
#pragma unroll
            for (int i = 0; i < 16; ++i) acc[i] = 0.f;
#pragma unroll
            for (int j = 0; j < 8; ++j)
#pragma unroll
                for (int s = 0; s < 2; ++s) {
                    const LAS unsigned char* vp = Vx + (32 * j + 16 * s + 4 * h + q4) * 272 + (32 * eb + 16 * blk + 4 * p4) * 2;
                    const s16x4 lo = tr_read(vp), hi = tr_read(vp + 8 * 272);
                    acc = mfma32(cat8(lo, hi), pf[j][s], acc);
                }
#pragma unroll
            for (int g = 0; g < 4; ++g) { const int d = 128 * vh + 32 * eb + 8 * g + 4 * h;
                u32x2 w; w.x = pk2(acc[4 * g] * inv, acc[4 * g + 1] * inv); w.y = pk2(acc[4 * g + 2] * inv, acc[4 * g + 3] * inv);
                *(u32x2*)(QX + (size_t)tok * D + hx * 256 + d) = w; }
        }
    }
}

DI void moe_tables(LAS int* tb, gu32* ctl, int tid) {
    __syncthreads();
    if (tid < 32) tb[40 + tid] = (int)__hip_atomic_load(ctl + CW_CNT + 64 * tid, RLX_AGENT);
    __syncthreads();
    if (tid == 0) { int s = 0; for (int e = 0; e < 32; ++e) { tb[e] = s; s += (tb[40 + e] + 255) >> 8; } tb[32] = s; }
    __syncthreads();
}

struct Args { const float* in[26]; float* out; unsigned char* ws; int ph_lo, ph_hi, li, pad; };

__global__ void __launch_bounds__(NWAVES * 64, 2) fwd(Args args) {
    extern __shared__ __attribute__((aligned(16))) unsigned char lds_raw[];
    LAS unsigned char* lds = (LAS unsigned char*)lds_raw;
    volatile LAS unsigned* MISC = (volatile LAS unsigned*)(lds + MISC_OFF);
    const int tid = threadIdx.x, lane = tid & 63, wave = __builtin_amdgcn_readfirstlane(tid >> 6);
    const int G = gridDim.x, bx = blockIdx.x;
    const int vcu = (G % 8 == 0) ? (bx % 8) * (G / 8) + bx / 8 : bx;
    unsigned char* ws = args.ws;
    gu32* ctl = (gu32*)(ws + WS_CTL);
    const float* x = args.in[0]; const float* mem = args.in[1]; const float* w_in = args.in[2]; const float* fox_f_bias = args.in[3];
    const float* conv_w = args.in[4]; const float* i_bias = args.in[5]; const float* f_bias = args.in[6]; const float* fox_g = args.in[7];
    const float* mlstm_g = args.in[8]; const float* w_out = args.in[9]; const float* ln1_g = args.in[10]; const float* ln1_b = args.in[11];
    const float* w_xq = args.in[12]; const float* w_xk = args.in[13]; const float* w_xv = args.in[14]; const float* w_xo = args.in[15];
    const float* ln2_g = args.in[16]; const float* ln2_b = args.in[17]; const float* w_router = args.in[18]; const float* b_router = args.in[19];
    const float* w_gu = args.in[20]; const float* b_gu = args.in[21]; const float* w_dn = args.in[22]; const float* b_dn = args.in[23];
    const float* ln3_g = args.in[24]; const float* ln3_b = args.in[25];
    float* out = args.out;
    float* Gt = (float*)(ws + WS_G); float* Fc2 = (float*)(ws + WS_FC2);
    float* Gc = (float*)(ws + WS_GC); float* Mloc = Gc + 1024; float* Mp = Gc + 2048; float* Kmax = Gc + 3072;
    float* Nc = (float*)(ws + WS_NC); float* Np = (float*)(ws + WS_NP);
    int* Tidx = (int*)(ws + WS_TIDX); float* Tgate = (float*)(ws + WS_TGATE); int* Tslot = (int*)(ws + WS_TSLOT); int* List = (int*)(ws + WS_LIST);
    bf16* KVx = (bf16*)(ws + WS_MEMKV);
    bf16* Win_t = (bf16*)(ws + WS_WIN); bf16* Wout_t = (bf16*)(ws + WS_WOUT); bf16* Wxq_t = (bf16*)(ws + WS_WXQ); bf16* Wxo_t = (bf16*)(ws + WS_WXO);
    unsigned char* Wgu8 = ws + WS_WGU; unsigned char* Wdn8 = ws + WS_WDN;
    bf16* XB = (bf16*)(ws + WS_XB); bf16* U = (bf16*)(ws + WS_U); bf16* Mq = (bf16*)(ws + WS_MQ); bf16* Mk = (bf16*)(ws + WS_MK);
    float* KvT = (float*)(ws + WS_KVT); bf16* CpT = (bf16*)(ws + WS_CPT); bf16* MIX = (bf16*)(ws + WS_MIX);
    bf16* Y1 = (bf16*)(ws + WS_Y1); bf16* X2B = (bf16*)(ws + WS_Y1 + 32 * MiB); bf16* X1B = (bf16*)(ws + WS_X1B); bf16* QX = (bf16*)(ws + WS_QX);
    bf16* Y2 = (bf16*)(ws + WS_Y2); unsigned char* X2F8 = ws + WS_X2B; unsigned char* HID8 = ws + WS_HID; bf16* YB = (bf16*)(ws + WS_YB);

    for (int u = tid; u < (LDS_BYTES - LDSCTL_OFF) / 4; u += NWAVES * 64) ((LAS unsigned*)(lds + LDSCTL_OFF))[u] = 0u;
    __syncthreads();
    XcdBarrier bar; bar.bar = (unsigned*)(ctl + CW_BAR); bar.x = 0; bar.st = nullptr;
    if (N_LAUNCHES == 1) bar = xcd_barrier_post((unsigned*)(ctl + CW_BAR), MISC + 8);
#define GRID_BAR() do { if (N_LAUNCHES == 1) xcd_barrier(bar); } while (0)
    const int lo = args.ph_lo, hi = args.ph_hi;
#ifndef PH_MASK
#define PH_MASK 0xFFFF
#endif
#define IN(k) (((PH_MASK >> (k)) & 1) && lo <= (k) && (k) < hi)
#define BOTH(k) (IN(k) && IN((k) + 1))
#ifndef REP_MASK
#define REP_MASK 0
#endif
#define REPS(k) (1 + ((REP_MASK >> (k)) & 1))
#define END_PHASE(k) do { if (BOTH(k) || rep + 1 < REPS(k)) GRID_BAR(); } while (0)

    if (IN(0)) for (int rep = 0; rep < REPS(0); ++rep) {
        {
            LAS float* wg = (LAS float*)lds;
            for (int idx = tid; idx < 1024 * 16; idx += 512) { const int k = idx >> 4, c = idx & 15; const int col = c < 8 ? 1536 + c : 2568 + (c - 8);
                const int j = k >> 8, ln = (k & 255) >> 2, i = k & 3; wg[((((j * 4 + i) * 4 + (c >> 2)) * 64 + ln) << 2) + (c & 3)] = w_in[(size_t)k * NIN + col]; }
            __syncthreads();
            for (int m = bx * 8 + wave; m < M; m += G * 8) {
                asm volatile("" ::: "memory");
                const f32x4* xr = (const f32x4*)(x + (size_t)m * D) + lane;
                f32x4 v[4];
#pragma unroll
                for (int j = 0; j < 4; ++j) v[j] = xr[64 * j];
                store_row_bf16(XB + (size_t)m * D, v, lane);
                float acc[16];
#pragma unroll
                for (int c = 0; c < 16; ++c) acc[c] = 0.f;
#pragma unroll
                for (int j = 0; j < 4; ++j)
#pragma unroll
                    for (int i = 0; i < 4; ++i) { const LAS f32x4* wp = (const LAS f32x4*)wg + ((j * 4 + i) * 4) * 64 + lane; const float xv = v[j][i];
#pragma unroll
                        for (int c4 = 0; c4 < 4; ++c4) { const f32x4 w = wp[c4 * 64]; acc[4 * c4] += xv * w.x; acc[4 * c4 + 1] += xv * w.y; acc[4 * c4 + 2] += xv * w.z; acc[4 * c4 + 3] += xv * w.w; } }
#define TR_STEP(HALFN, XORM) { const bool up = (lane & (XORM)) != 0; _Pragma("unroll") for (int i = 0; i < (HALFN); ++i) { const float keep = up ? acc[(HALFN) + i] : acc[i], send = up ? acc[i] : acc[(HALFN) + i]; acc[i] = keep + __shfl_xor(send, (XORM)); } }
                TR_STEP(8, 8) TR_STEP(4, 4) TR_STEP(2, 2) TR_STEP(1, 1)
#undef TR_STEP
                float mine = acc[0]; mine += __shfl_xor(mine, 16); mine += __shfl_xor(mine, 32);
                if (lane < 16) {
                    float o;
                    if (lane < 8) o = log_sigmoid_acc(mine + fox_f_bias[lane]);
                    else if (lane < 12) o = mine + i_bias[lane - 8];
                    else o = log_sigmoid_acc(mine + f_bias[lane - 12]);
                    Gt[(size_t)m * 16 + lane] = o;
                }
            }
            __syncthreads();
        }
        {
            LAS unsigned char* As = lds; LAS unsigned char* Bs = lds + 17408;
            for (int tile = bx; tile < 256; tile += G) {
                const int rt = tile >> 4, ct = tile & 15;
                const float* W = ct < 8 ? w_xk : w_xv; const int col0 = 128 * (ct & 7);
                f32x4 acc[4];
#pragma unroll
                for (int rb = 0; rb < 4; ++rb) acc[rb] = (f32x4){0.f, 0.f, 0.f, 0.f};
                for (int k0 = 0; k0 < 1024; k0 += 128) {
                    __syncthreads();
#pragma unroll
                    for (int i = 0; i < 4; ++i) { const int p = tid + 512 * i, row = p >> 5, c4 = p & 31;
                        const f32x4 a = *(const f32x4*)(mem + (size_t)(64 * rt + row) * D + k0 + 4 * c4);
                        u32x2 w; w.x = pk2(a.x, a.y); w.y = pk2(a.z, a.w); *(LAS u32x2*)(As + row * 272 + c4 * 8) = w; }
#pragma unroll
                    for (int i = 0; i < 8; ++i) { const int p = tid + 512 * i, k = p >> 5, c4 = p & 31;
                        const f32x4 a = *(const f32x4*)(W + (size_t)(k0 + k) * D + col0 + 4 * c4);
                        LAS unsigned short* bp = (LAS unsigned short*)(Bs + (4 * c4) * 272 + k * 2);
                        const unsigned w0 = pk2(a.x, a.y), w1 = pk2(a.z, a.w);
                        bp[0] = (unsigned short)(w0 & 0xffffu); bp[136] = (unsigned short)(w0 >> 16); bp[272] = (unsigned short)(w1 & 0xffffu); bp[408] = (unsigned short)(w1 >> 16); }
                    __syncthreads();
#pragma unroll
                    for (int kk = 0; kk < 4; ++kk) {
                        const bf16x8 bfr = *(const LAS bf16x8*)(Bs + (16 * wave + (lane & 15)) * 272 + (32 * kk + 8 * (lane >> 4)) * 2);
#pragma unroll
                        for (int rb = 0; rb < 4; ++rb) { const bf16x8 afr = *(const LAS bf16x8*)(As + (16 * rb + (lane & 15)) * 272 + (32 * kk + 8 * (lane >> 4)) * 2); acc[rb] = mfma16(afr, bfr, acc[rb]); }
                    }
                }
#pragma unroll
                for (int rb = 0; rb < 4; ++rb)
#pragma unroll
                    for (int j = 0; j < 4; ++j) { const int row = 64 * rt + 16 * rb + 4 * (lane >> 4) + j, col = 128 * ct + 16 * wave + (lane & 15);
                        KVx[(size_t)row * 2048 + col] = (bf16)(pk2(acc[rb][j], 0.f) & 0xffffu); }
            }
            __syncthreads();
        }
        {
            LAS float* scr = (LAS float*)(lds + wave * 16384);
            const int gw = vcu * NWAVES + wave, NGW = G * NWAVES;
            constexpr int I_GU = 32 * 8 * 64, I_DN = 32 * 8 * 32, I_IN = 16 * 96, I_SQ = 16 * 32;
            constexpr int NITEMS = I_GU + I_DN + I_IN + 3 * I_SQ;
            for (int it = gw; it < NITEMS; it += NGW) {
                int q = it;
                if (q < I_GU) { const int e = q >> 9, rr = q & 511, kb = rr >> 6, nb = rr & 63, n0 = 32 * nb; const int bj = n0 >> 10, rem = n0 & 1023, pn = rem >> 7, j0 = rem & 127;
                    p0_transpose_fp8(w_gu + (size_t)e * 1024 * 2048, 2048, Wgu8 + (size_t)e * 2048 * 1024, 1024, n0, 256 * pn + 128 * bj + j0, 128 * kb, WGU_SCALE, (LAS unsigned*)scr, lane); continue; }
                q -= I_GU;
                if (q < I_DN) { const int e = q >> 8, rr = q & 255, kb = rr >> 5, nb = rr & 31;
                    p0_transpose_fp8(w_dn + (size_t)e * 1024 * 1024, 1024, Wdn8 + (size_t)e * 1024 * 1024, 1024, 32 * nb, 32 * nb, 128 * kb, WDN_SCALE, (LAS unsigned*)scr, lane); continue; }
                q -= I_DN;
                if (q < I_IN) { const int kb = q / 96, nb = q % 96, dn0 = 32 * nb; const int sn0 = dn0 < 1536 ? dn0 : (dn0 < 2560 ? dn0 + 8 : dn0 + 16);
                    p0_transpose_item(w_in, NIN, 1024, Win_t, sn0, dn0, 64 * kb, scr, lane); continue; }
                q -= I_IN;
                { const int which = q / I_SQ, rr = q % I_SQ, kb = rr >> 5, nb = rr & 31;
                  const float* W = which == 0 ? w_out : (which == 1 ? w_xq : w_xo); bf16* WT = which == 0 ? Wout_t : (which == 1 ? Wxq_t : Wxo_t);
                  p0_transpose_item(W, 1024, 1024, WT, 32 * nb, 32 * nb, 64 * kb, scr, lane); }
            }
        }
        END_PHASE(0);
    }

    if (IN(1)) for (int rep = 0; rep < REPS(1); ++rep) {
        pg8::StaticSched S; S.init(XB, Win_t, M, NU, D, G, bx);
        pg8::EpiBf16 E{U, NU, nullptr, 0, 1.f};
        pg8::gemm_phase<pg8::EpiBf16, pg8::StaticSched, false, true>(lds, D, S, E);
        END_PHASE(1);
    }

    if (IN(2)) for (int rep = 0; rep < REPS(2); ++rep) {
        for (int u = bx; u < 256; u += G) m1_unit(u >> 4, u & 15, U, Gt, conv_w, Mq, Mk, KvT, Nc, Gc, Mloc, lds);
        __syncthreads();
        for (int sq = bx; sq < 32; sq += G) {
            const int b8 = sq >> 3, h8 = sq & 7; LAS float* wt = (LAS float*)lds;
            float v[8]; float run = 0.f;
#pragma unroll
            for (int i = 0; i < 8; ++i) { run += Gt[(size_t)(b8 * SEQ + 8 * tid + i) * 16 + h8]; v[i] = run; }
            const float incl = wave_scan_add(run, lane);
            if (lane == 63) wt[wave] = incl;
            __syncthreads();
            float off = incl - run;
            for (int w = 0; w < wave; ++w) off += wt[w];
#pragma unroll
            for (int i = 0; i < 8; ++i) Fc2[(size_t)sq * SEQ + 8 * tid + i] = -(off + v[i]) * LOG2E;
            float kn = 0.f;
#pragma unroll
            for (int i = 0; i < 8; ++i) { const u32x4* kp = (const u32x4*)(U + (size_t)(b8 * SEQ + 8 * tid + i) * NU + UC_FK + h8 * 64); float s2 = 0.f;
#pragma unroll
                for (int c = 0; c < 8; ++c) { const u32x4 w = kp[c]; s2 += bf_lo(w.x) * bf_lo(w.x) + bf_hi(w.x) * bf_hi(w.x) + bf_lo(w.y) * bf_lo(w.y) + bf_hi(w.y) * bf_hi(w.y) + bf_lo(w.z) * bf_lo(w.z) + bf_hi(w.z) * bf_hi(w.z) + bf_lo(w.w) * bf_lo(w.w) + bf_hi(w.w) * bf_hi(w.w); }
                kn = fmaxf(kn, s2); }
            kn = wave_max(kn);
            __syncthreads();
            if (lane == 0) wt[8 + wave] = kn;
            __syncthreads();
            if (tid == 0) { float mxk = wt[8]; for (int w = 1; w < 8; ++w) mxk = fmaxf(mxk, wt[8 + w]); Kmax[sq] = sqrtf(mxk); }
            __syncthreads();
        }
        END_PHASE(2);
    }

    if (IN(3)) for (int rep = 0; rep < REPS(3); ++rep) {
        LAS float* sg = (LAS float*)lds;
        for (int ch = bx; ch < 256; ch += G) {
            const int bh = ch >> 4, part = ch & 15, idx = 512 * part + tid;
            __syncthreads();
            if (tid < 64) { sg[tid] = Gc[bh * 64 + tid]; sg[64 + tid] = Mloc[bh * 64 + tid]; }
            __syncthreads();
            if (tid == 0) { float mm = 0.f;
                for (int c = 0; c < 64; ++c) { const float g = sg[c], mc = sg[64 + c]; if (part == 0) Mp[bh * 64 + c] = mm; const float mn = fmaxf(g + mm, mc); sg[128 + c] = expf(g + mm - mn); sg[192 + c] = expf(mc - mn); mm = mn; } }
            __syncthreads();
            float C = 0.f;
            const float* kp = KvT + (size_t)bh * 64 * 8192 + idx; bf16* cp = CpT + (size_t)bh * 64 * 8192 + idx;
            float kvv[64];
#pragma unroll
            for (int c = 0; c < 64; ++c) kvv[c] = kp[(size_t)c * 8192];
#pragma unroll
            for (int c = 0; c < 64; ++c) { cp[(size_t)c * 8192] = (bf16)(pk2(C, 0.f) & 0xffffu); C = sg[128 + c] * C + sg[192 + c] * kvv[c]; }
            if (part == 0 && tid < 64) { float n = 0.f;
#pragma unroll 8
                for (int c = 0; c < 64; ++c) { Np[(size_t)(bh * 64 + c) * 64 + tid] = n; n = sg[128 + c] * n + sg[192 + c] * Nc[(size_t)(bh * 64 + c) * 64 + tid]; } }
        }
        END_PHASE(3);
    }

    if (IN(4)) for (int rep = 0; rep < REPS(4); ++rep) {
        for (int pr = vcu; pr < 256; pr += G) { const int bh8 = pr >> 3, s = pr & 7;
            fox_unit(bh8 >> 3, bh8 & 7, 15 - s, U, Fc2, Kmax, fox_g, MIX, lds);
            fox_unit(bh8 >> 3, bh8 & 7, s, U, Fc2, Kmax, fox_g, MIX, lds); }
        for (int u = bx; u < 256; u += G) m3_unit(u >> 4, u & 15, U, Gt, Mq, Mk, CpT, Np, Mp, mlstm_g, MIX, lds);
        END_PHASE(4);
    }

    if (IN(5)) for (int rep = 0; rep < REPS(5); ++rep) {
        pg8::StaticSched S; S.init(MIX, Wout_t, M, D, D, G, bx);
        pg8::EpiResBf16 E{XB, Y1, D, ALPHA};
        pg8::gemm_phase<pg8::EpiResBf16, pg8::StaticSched, false, false>(lds, D, S, E);
        END_PHASE(5);
    }

    if (IN(6)) for (int rep = 0; rep < REPS(6); ++rep) {
        for (int m = bx * 8 + wave; m < M; m += G * 8) {
            f32x4 v[4];
            load_row_bf16(Y1 + (size_t)m * D, v, lane);
            ln_row(v, ln1_g, ln1_b, lane);
            store_row_bf16(X1B + (size_t)m * D, v, lane);
        }
        END_PHASE(6);
    }

    if (IN(7)) for (int rep = 0; rep < REPS(7); ++rep) {
        pg8::StaticSched S; S.init(X1B, Wxq_t, M, D, D, G, bx);
        pg8::EpiBf16 E{QX, D, nullptr, 0, 1.f};
        pg8::gemm_phase<pg8::EpiBf16, pg8::StaticSched, false, false>(lds, D, S, E);
        END_PHASE(7);
    }

    if (IN(8)) for (int rep = 0; rep < REPS(8); ++rep) {
        for (int u = vcu; u < 256; u += G) xattn_unit(u >> 6, (u >> 4) & 3, u & 15, QX, KVx, lds);
        END_PHASE(8);
    }

    if (IN(9)) for (int rep = 0; rep < REPS(9); ++rep) {
        pg8::StaticSched S; S.init(QX, Wxo_t, M, D, D, G, bx);
        pg8::EpiResBf16 E{X1B, Y2, D, ALPHA};
        pg8::gemm_phase<pg8::EpiResBf16, pg8::StaticSched, false, false>(lds, D, S, E);
        END_PHASE(9);
    }

    if (IN(10)) for (int rep = 0; rep < REPS(10); ++rep) {
        LAS float* wrT = (LAS float*)lds;
        LAS int* hist = (LAS int*)(lds + RT_OFF); LAS int* ebase = hist + 32; LAS int* tokE = hist + 64; LAS int* tokR = hist + 320;
        __syncthreads();
        for (int idx = tid; idx < 1024 * 8; idx += 512) { const int k = idx >> 3, e4 = (idx & 7) * 4; const f32x4 w = *(const f32x4*)(w_router + k * 32 + e4);
            wrT[(e4 + 0) * 1024 + k] = w.x; wrT[(e4 + 1) * 1024 + k] = w.y; wrT[(e4 + 2) * 1024 + k] = w.z; wrT[(e4 + 3) * 1024 + k] = w.w; }
        if (tid < 32) hist[tid] = 0;
        __syncthreads();
        for (int grp = bx; grp < M / 64; grp += G) {
            for (int tl = wave; tl < 64; tl += 8) {
                const int tok = grp * 64 + tl;
                f32x4 v[4];
                load_row_bf16(Y2 + (size_t)tok * D, v, lane);
                ln_row(v, ln2_g, ln2_b, lane);
                store_row_bf16(X2B + (size_t)tok * D, v, lane);
                store_row_fp8(X2F8 + (size_t)tok * D, v, X2_SCALE, lane);
                float acc[32];
#pragma unroll
                for (int e = 0; e < 32; ++e) { float a = 0.f;
#pragma unroll
                    for (int j = 0; j < 4; ++j) { const f32x4 w = *(const LAS f32x4*)(wrT + e * 1024 + 256 * j + 4 * lane); a += (v[j].x * w.x + v[j].y * w.y) + (v[j].z * w.z + v[j].w * w.w); }
                    acc[e] = a; }
#define TR_STEP(HALFN, XORM) { const bool up = (lane & (XORM)) != 0; _Pragma("unroll") for (int i = 0; i < (HALFN); ++i) { const float keep = up ? acc[(HALFN) + i] : acc[i], send = up ? acc[i] : acc[(HALFN) + i]; acc[i] = keep + __shfl_xor(send, (XORM)); } }
                TR_STEP(16, 16) TR_STEP(8, 8) TR_STEP(4, 4) TR_STEP(2, 2) TR_STEP(1, 1)
#undef TR_STEP
                float lg = acc[0] + __shfl_xor(acc[0], 32);
                lg += b_router[lane & 31];
                float tv[4]; int ti[4]; float cur = lg;
#pragma unroll
                for (int k = 0; k < 4; ++k) {
                    float bv = cur; int bi = lane & 31;
#pragma unroll
                    for (int o = 1; o < 32; o <<= 1) { const float ov = __shfl_xor(bv, o); const int oi = __shfl_xor(bi, o); if (ov > bv || (ov == bv && oi < bi)) { bv = ov; bi = oi; } }
                    tv[k] = bv; ti[k] = bi; if ((lane & 31) == bi) cur = -INFINITY;
                }
                const float e1 = expf(tv[1] - tv[0]), e2 = expf(tv[2] - tv[0]), e3 = expf(tv[3] - tv[0]); const float isum = 1.f / (1.f + e1 + e2 + e3);
                if (lane == 0) {
                    const float gs[4] = {isum, e1 * isum, e2 * isum, e3 * isum};
#pragma unroll
                    for (int k = 0; k < 4; ++k) { const int rk = atomicAdd((int*)&hist[ti[k]], 1); tokE[tl * 4 + k] = ti[k]; tokR[tl * 4 + k] = rk; Tidx[tok * 4 + k] = ti[k]; Tgate[tok * 4 + k] = gs[k]; }
                }
            }
            __syncthreads();
            if (tid < 32) { const int c = hist[tid]; ebase[tid] = c ? (int)__hip_atomic_fetch_add(ctl + CW_CNT + 64 * tid, (unsigned)c, RLX_AGENT) : 0; hist[tid] = 0; }
            __syncthreads();
            if (tid < 256) { const int tl = tid >> 2, e = tokE[tid], slot = ebase[e] + tokR[tid]; List[(size_t)e * LCAP + slot] = grp * 64 + tl; Tslot[(grp * 64 + tl) * 4 + (tid & 3)] = slot; }
            __syncthreads();
        }
        END_PHASE(10);
    }

    if (IN(11)) for (int rep = 0; rep < REPS(11); ++rep) {
        LAS int* tb = (LAS int*)(lds + MOE_TB_OFF);
        moe_tables(tb, ctl, tid);
        pg8::MoeSched S; S.A = (const char*)X2F8; S.B = (const char*)Wgu8; S.list = List; S.tb = tb; S.K = 512; S.NT = 8; S.nwg = __builtin_amdgcn_readfirstlane(tb[32]) * 8; S.G = G; S.c = bx; S.bexp = (size_t)2048 * 1024; S.gather = true;
        pg8::EpiSwiglu E{HID8, b_gu, 1.f / (WGU_SCALE * X2_SCALE), HID_SCALE};
        pg8::gemm_phase<pg8::EpiSwiglu, pg8::MoeSched, true, true, true>(lds, 512, S, E);
        END_PHASE(11);
    }

    if (IN(12)) for (int rep = 0; rep < REPS(12); ++rep) {
        LAS int* tb = (LAS int*)(lds + MOE_TB_OFF);
        moe_tables(tb, ctl, tid);
        pg8::MoeSched S; S.A = (const char*)HID8; S.B = (const char*)Wdn8; S.list = List; S.tb = tb; S.K = 512; S.NT = 4; S.nwg = __builtin_amdgcn_readfirstlane(tb[32]) * 4; S.G = G; S.c = bx; S.bexp = (size_t)1024 * 1024; S.gather = false;
        pg8::EpiBf16 E{YB, D, b_dn, 1024, 1.f / (WDN_SCALE * HID_SCALE)};
        pg8::gemm_phase<pg8::EpiBf16, pg8::MoeSched, false, true, true>(lds, 512, S, E);
        END_PHASE(12);
    }

    if (IN(13)) for (int rep = 0; rep < REPS(13); ++rep) {
        LAS int* tb = (LAS int*)(lds + MOE_TB_OFF);
        moe_tables(tb, ctl, tid);
        for (int m0 = (bx * 8 + wave) * 2; m0 < M; m0 += G * 16) {
            int rowi = 0; float gk = 0.f;
            if (lane < 8) { const int q = (m0 + (lane >> 2)) * 4 + (lane & 3); const int e = Tidx[q]; rowi = tb[e] * 256 + Tslot[q]; gk = Tgate[q]; }
            f32x4 v[2][4]; u32x2 y[2][4][4]; float gg[2][4];
#pragma unroll
            for (int t = 0; t < 2; ++t) {
                const u32x2* xr = (const u32x2*)(X2B + (size_t)(m0 + t) * D) + lane;
#pragma unroll
                for (int j = 0; j < 4; ++j) { const u32x2 w = xr[64 * j]; v[t][j] = (f32x4){bf_lo(w.x), bf_hi(w.x), bf_lo(w.y), bf_hi(w.y)}; }
#pragma unroll
                for (int k = 0; k < 4; ++k) { const int rk = __shfl(rowi, 4 * t + k); gg[t][k] = __shfl(gk, 4 * t + k);
                    const u32x2* yr = (const u32x2*)(YB + (size_t)rk * D) + lane;
#pragma unroll
                    for (int j = 0; j < 4; ++j) y[t][k][j] = yr[64 * j]; }
            }
#pragma unroll
            for (int t = 0; t < 2; ++t) {
#pragma unroll
                for (int j = 0; j < 4; ++j) v[t][j] = v[t][j] * ALPHA;
#pragma unroll
                for (int k = 0; k < 4; ++k)
#pragma unroll
                    for (int j = 0; j < 4; ++j) { const u32x2 w = y[t][k][j]; const float g1 = gg[t][k]; v[t][j].x += g1 * bf_lo(w.x); v[t][j].y += g1 * bf_hi(w.x); v[t][j].z += g1 * bf_lo(w.y); v[t][j].w += g1 * bf_hi(w.y); }
                ln_row(v[t], ln3_g, ln3_b, lane);
                f32x4* orow = (f32x4*)(out + (size_t)(m0 + t) * D) + lane;
#pragma unroll
                for (int j = 0; j < 4; ++j) orow[64 * j] = v[t][j];
            }
        }
        if (rep + 1 < REPS(13)) GRID_BAR();
    }
#undef IN
#undef BOTH
#undef GRID_BAR
}

extern "C" void kernel_launch(void* const* d_in, const int* in_sizes, int n_in, void* d_out, int out_size, void* d_ws, size_t ws_size, hipStream_t stream) {
    static int grid = 0;
    if (grid == 0) {
        if (n_in != 26 || in_sizes[0] != M * D || out_size != M * D || ws_size < WS_END) { fprintf(stderr, "kernel_launch: unexpected shapes (n_in %d, in0 %d, out %d, ws %zu)\n", n_in, n_in > 0 ? in_sizes[0] : -1, out_size, ws_size); grid = -1; return; }
        int dev = 0, cus = 0, per_cu = 0;
        if (hipGetDevice(&dev) != hipSuccess || hipDeviceGetAttribute(&cus, hipDeviceAttributeMultiprocessorCount, dev) != hipSuccess) { grid = -1; return; }
        if (hipFuncSetAttribute((const void*)fwd, hipFuncAttributeMaxDynamicSharedMemorySize, LDS_BYTES) != hipSuccess) { fprintf(stderr, "kernel_launch: hipFuncSetAttribute failed\n"); grid = -1; return; }
        if (hipOccupancyMaxActiveBlocksPerMultiprocessor(&per_cu, (const void*)fwd, NWAVES * 64, LDS_BYTES) != hipSuccess || per_cu < 1) fprintf(stderr, "kernel_launch: occupancy query reports %d\n", per_cu);
        (void)hipGetLastError();
        grid = cus;
    }
    if (grid < 0) return;
    if (hipMemsetAsync((char*)d_ws + WS_CTL, 0, CTL_ZERO_BYTES, stream) != hipSuccess) return;
    Args a{};
    for (int i = 0; i < 26; ++i) a.in[i] = (const float*)d_in[i];
    a.out = (float*)d_out; a.ws = (unsigned char*)d_ws;
    if (N_LAUNCHES == 1) {
        a.ph_lo = 0; a.ph_hi = NPHASE; a.li = 0;
        hipLaunchKernelGGL(fwd, dim3(grid), dim3(NWAVES * 64), LDS_BYTES, stream, a);
    } else {
        for (int li = 0; li < NPHASE; ++li) { a.ph_lo = li; a.ph_hi = li + 1; a.li = li; hipLaunchKernelGGL(fwd, dim3(grid), dim3(NWAVES * 64), LDS_BYTES, stream, a); }
    }
}
```

```cpp
#include <hip/hip_runtime.h>
#include <cstdio>
#include <cstdint>
#include <cmath>

#define DI __device__ __forceinline__
#define LAS __attribute__((address_space(3)))
#define GAS __attribute__((address_space(1)))
typedef unsigned short bf16;
typedef short bf16x8 __attribute__((ext_vector_type(8)));
typedef short s16x4 __attribute__((ext_vector_type(4)));
typedef float f32x2 __attribute__((ext_vector_type(2)));
typedef float f32x4 __attribute__((ext_vector_type(4)));
typedef float f32x16 __attribute__((ext_vector_type(16)));
typedef unsigned u32x2 __attribute__((ext_vector_type(2)));
typedef unsigned u32x4 __attribute__((ext_vector_type(4)));
typedef GAS unsigned gu32;

#ifndef MK_N_LAUNCHES
#define MK_N_LAUNCHES 1
#endif

constexpr int BATCH = 4, SEQ = 4096, D = 1024, M = BATCH * SEQ, NMEM = 256;
constexpr int NIN = 3088;
constexpr int NU = 3072;
constexpr int UC_FQ = 0, UC_FK = 512, UC_FV = 1024, UC_MQ = 1536, UC_MK = 1792, UC_MV = 2048, UC_MO = 2560;
constexpr int NE = 32, TOPK = 4, LCAP = 16384;
constexpr int PROWS = M * TOPK + NE * 256;
constexpr float ALPHA = 1.189207115002721f;
constexpr float LOG2E = 1.4426950408889634f;
constexpr float LN_EPS = 1e-5f, RMS_EPS = 1e-6f;
constexpr int NPHASE = 14;
constexpr float WGU_SCALE = 32.f, WDN_SCALE = 64.f, X2_SCALE = 4.f, HID_SCALE = 4.f;
constexpr int N_LAUNCHES = MK_N_LAUNCHES;

constexpr size_t MiB = 1u << 20;
constexpr size_t WS_CTL = 0, CTL_ZERO_BYTES = 1 * MiB;
constexpr size_t WS_G = 1 * MiB;
constexpr size_t WS_FC2 = 2 * MiB;
constexpr size_t WS_GC = 2 * MiB + 512 * 1024;
constexpr size_t WS_NC = 3 * MiB;
constexpr size_t WS_NP = 3 * MiB + 256 * 1024;
constexpr size_t WS_TIDX = 3 * MiB + 512 * 1024;
constexpr size_t WS_TGATE = 3 * MiB + 768 * 1024;
constexpr size_t WS_TSLOT = 4 * MiB;
constexpr size_t WS_LIST = 5 * MiB;
constexpr size_t WS_MEMKV = 8 * MiB;
constexpr size_t WS_WIN = 16 * MiB, WS_WOUT = 22 * MiB, WS_WXQ = 24 * MiB, WS_WXO = 26 * MiB;
constexpr size_t WS_WGU = 32 * MiB, WS_WDN = 160 * MiB;
constexpr size_t WS_XB = 224 * MiB;
constexpr size_t WS_U = 256 * MiB;
constexpr size_t WS_MQ = 352 * MiB, WS_MK = 360 * MiB;
constexpr size_t WS_KVT = 368 * MiB;
constexpr size_t WS_CPT = 400 * MiB;
constexpr size_t WS_MIX = 432 * MiB;
constexpr size_t WS_Y1 = 464 * MiB;
constexpr size_t WS_X1B = 528 * MiB;
constexpr size_t WS_QX = 560 * MiB;
constexpr size_t WS_Y2 = 596 * MiB;
constexpr size_t WS_X2B = 660 * MiB;
constexpr size_t WS_HID = 692 * MiB;
constexpr size_t WS_YB = 836 * MiB;
constexpr size_t WS_END = 980 * MiB;
constexpr int CW_TMO = 0, CW_CODE = 1;
constexpr int CW_CNT = 1024;
constexpr int CW_BAR = 4096;
static_assert(CW_CNT + 64 * 31 < 3200 && 3200 + 32 <= CW_BAR, "CTL words: expert counts, key-norm words and the barrier region must not overlap");
constexpr int CW_KMAX = 3200;

constexpr int RING_BYTES = 131072;
constexpr int LDSCTL_OFF = RING_BYTES, MISC_OFF = LDSCTL_OFF + 320;
constexpr int MOE_TB_OFF = LDSCTL_OFF + 1024;
constexpr int RT_OFF = LDSCTL_OFF + 2048;
constexpr int LDS_BYTES = 147456;
constexpr int NWAVES = 8;

#define RLX_AGENT __ATOMIC_RELAXED, __HIP_MEMORY_SCOPE_AGENT
DI float bf_lo(unsigned u) { return __uint_as_float(u << 16); }
DI float bf_hi(unsigned u) { return __uint_as_float(u & 0xffff0000u); }
DI float bf2f(short s) { return __uint_as_float(((unsigned)(unsigned short)s) << 16); }
typedef __bf16 bf16x2_t __attribute__((ext_vector_type(2)));
DI unsigned pk2(float lo, float hi) { f32x2 v = {lo, hi}; bf16x2_t b = __builtin_convertvector(v, bf16x2_t); return __builtin_bit_cast(unsigned, b); }
DI float wave_sum(float v) {
#pragma unroll
    for (int o = 1; o < 64; o <<= 1) v += __shfl_xor(v, o);
    return v;
}
DI float wave_max(float v) {
#pragma unroll
    for (int o = 1; o < 64; o <<= 1) v = fmaxf(v, __shfl_xor(v, o));
    return v;
}
DI float wave_scan_add(float v, int lane) {
#pragma unroll
    for (int o = 1; o < 64; o <<= 1) { const float t = __shfl_up(v, o); if (lane >= o) v += t; }
    return v;
}
DI float wave_scan_max(float v, int lane) {
#pragma unroll
    for (int o = 1; o < 64; o <<= 1) { const float t = __shfl_up(v, o); if (lane >= o) v = fmaxf(v, t); }
    return v;
}
DI float xhalf_sum(float v) { return v + __shfl_xor(v, 32); }
DI float xhalf_max(float v) { return fmaxf(v, __shfl_xor(v, 32)); }
DI float ex2(float x) { return __builtin_amdgcn_exp2f(x); }
DI float exp_fast(float x) { return __builtin_amdgcn_exp2f(x * LOG2E); }
DI float sigmoid_fast(float x) { return __builtin_amdgcn_rcpf(1.f + exp_fast(-x)); }
DI float log_sigmoid_acc(float x) { return fminf(x, 0.f) - log1pf(expf(-fabsf(x))); }
DI f32x16 mfma32(bf16x8 a, bf16x8 b, f32x16 c) { return __builtin_amdgcn_mfma_f32_32x32x16_bf16(a, b, c, 0, 0, 0); }
DI f32x4 mfma16(bf16x8 a, bf16x8 b, f32x4 c) { return __builtin_amdgcn_mfma_f32_16x16x32_bf16(a, b, c, 0, 0, 0); }
typedef short v4i16_t __attribute__((ext_vector_type(4)));
DI s16x4 tr_read(const LAS unsigned char* p) { return __builtin_bit_cast(s16x4, __builtin_amdgcn_ds_read_tr16_b64_v4i16((LAS v4i16_t*)p)); }
DI bf16x8 cat8(s16x4 lo, s16x4 hi) { return __builtin_shufflevector(lo, hi, 0, 1, 2, 3, 4, 5, 6, 7); }
typedef int v8i32 __attribute__((ext_vector_type(8)));
typedef int v4i32 __attribute__((ext_vector_type(4)));
DI unsigned pk4_fp8(float a, float b, float c, float d) { int w = 0; w = __builtin_amdgcn_cvt_pk_fp8_f32(a, b, w, false); w = __builtin_amdgcn_cvt_pk_fp8_f32(c, d, w, true); return (unsigned)w; }
DI int crow(int r, int hi) { return (r & 3) + 8 * (r >> 2) + 4 * hi; }
DI bf16x8 pack8(const f32x16& x, int s) {
    u32x4 p;
    p.x = pk2(x[8 * s + 0], x[8 * s + 1]); p.y = pk2(x[8 * s + 2], x[8 * s + 3]); p.z = pk2(x[8 * s + 4], x[8 * s + 5]); p.w = pk2(x[8 * s + 6], x[8 * s + 7]);
    return __builtin_bit_cast(bf16x8, p);
}

namespace pg8 {
constexpr int BM = 256, BK = 64, HALF = 128, HTB = HALF * BK * 2, STAGE_BYTES = 8 * HTB, NXCD = 8, WGM = 8;
__host__ __device__ __forceinline__ int lds_byte(int r, int c) { const int st = (r >> 4) * 2 + (c >> 5), rr = r & 15, cc = c & 31, ob = rr * 64 + cc * 2; return st * 1024 + (ob ^ (((ob >> 9) & 1) << 5)); }
__host__ __device__ __forceinline__ void stage_rc(int b, int& R, int& C) { const int st = b / 1024, sb = b % 1024, swz = sb ^ (((sb >> 9) & 1) << 5); R = (st >> 1) * 16 + swz / 64; C = (st & 1) * 32 + (swz % 64) / 2; }
__host__ __device__ __forceinline__ int perm32(int rho) { const int n = rho >> 4, i = rho & 15; return 8 * (i >> 2) + 4 * n + (i & 3); }

struct Unit { int pm, pn, e, nvalid; const char* A; const char* B; const int* list; };

struct StaticSched {
    const char* A; const char* B; int K, nM, nN, nwg, G, c;
    DI void init(const void* A_, const void* B_, int M_, int N_, int K_, int G_, int c_) { A = (const char*)A_; B = (const char*)B_; K = K_; nM = M_ / BM; nN = N_ / BM; nwg = nM * nN; G = G_; c = c_; }
    DI bool next(int i, Unit& u) const {
        const long L = (long)i * G + c; if (L >= nwg) return false;
        int wgid = (int)L; { const int q = nwg / NXCD, r = nwg % NXCD, xcd = wgid % NXCD, off = wgid / NXCD; wgid = (xcd < r ? xcd * (q + 1) : r * (q + 1) + (xcd - r) * q) + off; }
        const int nig = WGM * nN, gid = wgid / nig, fm = gid * WGM, gsz = (nM - fm) < WGM ? (nM - fm) : WGM;
        u.pm = fm + ((wgid % nig) % gsz); u.pn = (wgid % nig) / gsz; u.e = 0; u.nvalid = BM; u.list = nullptr;
        u.A = A + (size_t)u.pm * BM * K * 2; u.B = B + (size_t)u.pn * BM * K * 2; return true;
    }
};
struct MoeSched {
    const char* A; const char* B; const int* list; const LAS int* tb; int K, NT, nwg, G, c; size_t bexp; bool gather;
    DI bool next(int i, Unit& u) const {
        const long L = (long)i * G + c; if (L >= nwg) return false;
        int wgid = (int)L; { const int q = nwg / NXCD, r = nwg % NXCD, xcd = wgid % NXCD, off = wgid / NXCD; wgid = (xcd < r ? xcd * (q + 1) : r * (q + 1) + (xcd - r) * q) + off; }
        const int g = wgid / NT, nt = wgid % NT;
        int e = 0;
#pragma unroll
        for (int j = 1; j < 32; ++j) e += (tb[j] <= g) ? 1 : 0;
        e = __builtin_amdgcn_readfirstlane(e);
        const int mt = g - __builtin_amdgcn_readfirstlane(tb[e]);
        u.pm = g; u.pn = nt; u.e = e; u.nvalid = __builtin_amdgcn_readfirstlane(tb[40 + e]) - mt * BM; u.list = list + (size_t)e * LCAP + mt * BM;
        u.A = gather ? A : A + (size_t)g * BM * K * 2; u.B = B + (size_t)e * bexp + (size_t)nt * BM * K * 2; return true;
    }
};

template <bool GATHER> DI void a_offsets(const Unit& u, int K, unsigned (&v)[2][2]) {
    int R[2], C[2];
#pragma unroll
    for (int i = 0; i < 2; ++i) stage_rc((int)threadIdx.x * 16 + i * 8192, R[i], C[i]);
#pragma unroll
    for (int h = 0; h < 2; ++h)
#pragma unroll
        for (int i = 0; i < 2; ++i) {
            const int row = h * HALF + R[i];
            if constexpr (GATHER) { const int rc = row < u.nvalid ? row : u.nvalid - 1; const int tok = u.list[rc]; v[h][i] = (unsigned)(tok * K + C[i]) * 2u; }
            else v[h][i] = (unsigned)(row * K + C[i]) * 2u;
        }
}

struct EpiBf16 {
    static constexpr bool PERM = true;
    bf16* O; int ldc; const float* bias; int bias_estride; float scale;
    DI void operator()(const f32x4 (&acc)[2][2][4][2], const Unit& u, int wr, int wc, int fr, int fq) const {
        const int row0 = u.pm * BM + wr * 64 + fr; const int col0 = u.pn * BM + wc * 32 + 8 * fq;
        f32x4 bv[2][2];
#pragma unroll
        for (int bj = 0; bj < 2; ++bj)
#pragma unroll
            for (int n = 0; n < 2; ++n) bv[bj][n] = bias ? *(const f32x4*)(bias + (size_t)u.e * bias_estride + col0 + bj * HALF + 4 * n) : (f32x4){0.f, 0.f, 0.f, 0.f};
#pragma unroll
        for (int ai = 0; ai < 2; ++ai)
#pragma unroll
            for (int m = 0; m < 4; ++m) { bf16* rowp = O + (size_t)(row0 + ai * HALF + m * 16) * ldc + col0;
#pragma unroll
                for (int bj = 0; bj < 2; ++bj) { const f32x4 v0 = acc[ai][bj][m][0] * scale + bv[bj][0], v1 = acc[ai][bj][m][1] * scale + bv[bj][1];
                    u32x4 w; w.x = pk2(v0[0], v0[1]); w.y = pk2(v0[2], v0[3]); w.z = pk2(v1[0], v1[1]); w.w = pk2(v1[2], v1[3]);
                    *(u32x4*)(rowp + bj * HALF) = w; } }
    }
};
struct EpiResF32 {
    static constexpr bool PERM = false;
    const float* base; float* out; int ldc; float alpha;
    DI void operator()(const f32x4 (&acc)[2][2][4][2], const Unit& u, int wr, int wc, int fr, int fq) const {
        const int col0 = u.pn * BM + wc * 32 + 4 * fq;
#pragma unroll
        for (int ai = 0; ai < 2; ++ai)
#pragma unroll
            for (int m = 0; m < 4; ++m) { const size_t off = (size_t)(u.pm * BM + ai * HALF + wr * 64 + m * 16 + fr) * ldc + col0;
#pragma unroll
                for (int bj = 0; bj < 2; ++bj)
#pragma unroll
                    for (int n = 0; n < 2; ++n) { const f32x4 bs = *(const f32x4*)(base + off + bj * HALF + n * 16); *(f32x4*)(out + off + bj * HALF + n * 16) = bs * alpha + acc[ai][bj][m][n]; } }
    }
};
struct EpiResBf16 {
    static constexpr bool PERM = true;
    const bf16* base; bf16* out; int ldc; float alpha;
    DI void operator()(const f32x4 (&acc)[2][2][4][2], const Unit& u, int wr, int wc, int fr, int fq) const {
        const int row0 = u.pm * BM + wr * 64 + fr; const int col0 = u.pn * BM + wc * 32 + 8 * fq;
#pragma unroll
        for (int ai = 0; ai < 2; ++ai)
#pragma unroll
            for (int m = 0; m < 4; ++m) { const size_t off = (size_t)(row0 + ai * HALF + m * 16) * ldc + col0;
#pragma unroll
                for (int bj = 0; bj < 2; ++bj) { const u32x4 b = *(const u32x4*)(base + off + bj * HALF); const f32x4 a0 = acc[ai][bj][m][0], a1 = acc[ai][bj][m][1];
                    u32x4 w; w.x = pk2(bf_lo(b.x) * alpha + a0[0], bf_hi(b.x) * alpha + a0[1]); w.y = pk2(bf_lo(b.y) * alpha + a0[2], bf_hi(b.y) * alpha + a0[3]);
                    w.z = pk2(bf_lo(b.z) * alpha + a1[0], bf_hi(b.z) * alpha + a1[1]); w.w = pk2(bf_lo(b.w) * alpha + a1[2], bf_hi(b.w) * alpha + a1[3]);
                    *(u32x4*)(out + off + bj * HALF) = w; } }
    }
};
struct EpiSwiglu {
    static constexpr bool PERM = true;
    unsigned char* O; const float* bias; float scale, oscale;
    DI void operator()(const f32x4 (&acc)[2][2][4][2], const Unit& u, int wr, int wc, int fr, int fq) const {
        const int row0 = u.pm * BM + wr * 64 + fr; const int j0 = wc * 32 + 8 * fq; const int col0 = u.pn * HALF + j0;
        const float* bg = bias + (size_t)u.e * 2048 + col0; const float* bl = bg + 1024;
        f32x4 bgv[2], blv[2];
#pragma unroll
        for (int n = 0; n < 2; ++n) { bgv[n] = *(const f32x4*)(bg + 4 * n); blv[n] = *(const f32x4*)(bl + 4 * n); }
#pragma unroll
        for (int ai = 0; ai < 2; ++ai)
#pragma unroll
            for (int m = 0; m < 4; ++m) { unsigned char* rowp = O + (size_t)(row0 + ai * HALF + m * 16) * 1024 + col0;
                float o[8];
#pragma unroll
                for (int n = 0; n < 2; ++n) { const f32x4 g = acc[ai][0][m][n] * scale + bgv[n], l = acc[ai][1][m][n] * scale + blv[n];
#pragma unroll
                    for (int q = 0; q < 4; ++q) { const float gg = fminf(g[q], 7.0f), ll = fminf(fmaxf(l[q], -7.0f), 7.0f);
                        o[4 * n + q] = gg * __builtin_amdgcn_rcpf(1.f + ex2(gg * (-1.702f * LOG2E))) * (ll + 1.f) * oscale; } }
                u32x2 w; w.x = pk4_fp8(o[0], o[1], o[2], o[3]); w.y = pk4_fp8(o[4], o[5], o[6], o[7]);
                *(u32x2*)rowp = w; }
    }
};

template <class Epi, class Sched, bool GATHER, bool ALIGN_EPI, bool FP8 = false>
DI void gemm_phase(LAS unsigned char* lds, const int K, const Sched& S, const Epi& E) {
    const int tid = threadIdx.x, wid = __builtin_amdgcn_readfirstlane(tid >> 6), lane = tid & 63, wr = wid >> 2, wc = wid & 3, fr = lane & 15, fq = lane >> 4;
    const int nt = K / BK;
    unsigned voffB[2];
#pragma unroll
    for (int i = 0; i < 2; ++i) { int R, C; stage_rc(tid * 16 + i * 8192, R, C); const int Rb = Epi::PERM ? ((R & ~31) + perm32(R & 31)) : R; voffB[i] = (unsigned)(Rb * K + C) * 2u; }
    const size_t kstep = (size_t)(BK * 2);
    const size_t hstep = (size_t)HALF * K * 2;
    const unsigned ldsw = (unsigned)wid * 1024u;
    const int aoff = lds_byte(wr * 64 + fr, fq * 8), boff = lds_byte(wc * 32 + fr, fq * 8);
#define PG8_SA(b, h) (((b) * 2 + (h)) * HTB)
#define PG8_SB(b, h) ((4 + (b) * 2 + (h)) * HTB)
#define PG8_STAGE(bufoff, gbase, voff) do { _Pragma("unroll") for (int _i = 0; _i < 2; ++_i) { unsigned _o = (voff)[_i]; asm volatile("" : "+v"(_o));   \
        __builtin_amdgcn_global_load_lds((const unsigned*)((const char*)(gbase) + _o), (LAS unsigned*)(lds + (bufoff) + ldsw + _i * 8192), 16, 0, 0); } } while (0)
#define PG8_LDA(dst, b, h) do { _Pragma("unroll") for (int m = 0; m < 4; ++m) _Pragma("unroll") for (int k = 0; k < 2; ++k) dst[m][k] = *(const LAS bf16x8*)(lds + PG8_SA(b, h) + aoff + m * 2048 + k * 1024); } while (0)
#define PG8_LDB(dst, b, h) do { _Pragma("unroll") for (int n = 0; n < 2; ++n) _Pragma("unroll") for (int k = 0; k < 2; ++k) dst[n][k] = *(const LAS bf16x8*)(lds + PG8_SB(b, h) + boff + n * 2048 + k * 1024); } while (0)
#define PG8_CAT(x) __builtin_shufflevector(__builtin_bit_cast(v4i32, x[0]), __builtin_bit_cast(v4i32, x[1]), 0, 1, 2, 3, 4, 5, 6, 7)
#define PG8_MMA(ai, bj, At, Bt) do { __builtin_amdgcn_s_setprio(1); _Pragma("unroll") for (int m = 0; m < 4; ++m) _Pragma("unroll") for (int n = 0; n < 2; ++n) { \
        if constexpr (FP8) { const v8i32 _a = PG8_CAT(Bt[n]), _b = PG8_CAT(At[m]); asm volatile("v_mfma_scale_f32_16x16x128_f8f6f4 %0, %1, %2, %0, %3, %3 op_sel_hi:[0,0,0]" : "+v"(acc[ai][bj][m][n]) : "v"(_a), "v"(_b), "v"(sc1)); } \
        else { _Pragma("unroll") for (int k = 0; k < 2; ++k) acc[ai][bj][m][n] = __builtin_amdgcn_mfma_f32_16x16x32_bf16(Bt[n][k], At[m][k], acc[ai][bj][m][n], 0, 0, 0); } } __builtin_amdgcn_s_setprio(0); } while (0)
#define PG8_WAIT_V(n) asm volatile("s_waitcnt vmcnt(" #n ")" ::: "memory")
#define PG8_WAIT_L(n) asm volatile("s_waitcnt lgkmcnt(" #n ")" ::: "memory")
#define PG8_BAR __builtin_amdgcn_s_barrier()
#define PG8_SCHED __builtin_amdgcn_sched_barrier(0)
    Unit cur, nxt; int ui = 0;
    if (!S.next(0, cur)) return;
    const int sc1 = 0x7f7f7f7f;
    unsigned vAc[2][2], vAn[2][2];
    a_offsets<GATHER>(cur, K, vAc);
    f32x4 acc[2][2][4][2];
#pragma unroll
    for (int a = 0; a < 2; ++a)
#pragma unroll
        for (int b = 0; b < 2; ++b)
#pragma unroll
            for (int m = 0; m < 4; ++m)
#pragma unroll
                for (int n = 0; n < 2; ++n) acc[a][b][m][n] = (f32x4){0.f, 0.f, 0.f, 0.f};
    bf16x8 At[4][2], B0[2][2], B1[2][2];
    const char* cA = cur.A; const char* cB = cur.B;
    PG8_STAGE(PG8_SB(0, 0), cB, voffB); PG8_STAGE(PG8_SB(0, 1), cB + hstep, voffB); PG8_STAGE(PG8_SA(0, 0), cA, vAc[0]); PG8_STAGE(PG8_SA(0, 1), cA, vAc[1]);
    if (wr == 1) PG8_BAR;
    PG8_WAIT_V(2); PG8_BAR;
    PG8_STAGE(PG8_SB(1, 0), cB + kstep, voffB); PG8_STAGE(PG8_SA(1, 0), cA + kstep, vAc[0]); PG8_STAGE(PG8_SB(1, 1), cB + hstep + kstep, voffB);
    PG8_WAIT_V(6); PG8_BAR;
    for (;;) {
        const bool has_next = S.next(ui + 1, nxt);
        if constexpr (GATHER) {
            if (has_next) a_offsets<GATHER>(nxt, K, vAn);
            else {
#pragma unroll
                for (int h = 0; h < 2; ++h)
#pragma unroll
                    for (int i = 0; i < 2; ++i) vAn[h][i] = vAc[h][i]; }
        }
        const char* nA = has_next ? nxt.A : cA; const char* nB = has_next ? nxt.B : cB;
#pragma unroll 1
        for (int t = 0; t < nt; t += 2) {
            const bool last = (t == nt - 2);
            const char* a1 = cA + (size_t)(t + 1) * kstep;
            const char* a2 = last ? nA : cA + (size_t)(t + 2) * kstep; const char* b2 = last ? nB : cB + (size_t)(t + 2) * kstep;
            const char* a3 = a2 + kstep; const char* b3 = b2 + kstep;
            unsigned v2[2][2];
#pragma unroll
            for (int h = 0; h < 2; ++h)
#pragma unroll
                for (int i = 0; i < 2; ++i) v2[h][i] = GATHER ? (last ? vAn[h][i] : vAc[h][i]) : vAc[h][i];
            PG8_LDB(B0, 0, 0); PG8_LDB(B1, 0, 1); PG8_SCHED; PG8_LDA(At, 0, 0); PG8_STAGE(PG8_SA(1, 1), a1, vAc[1]);
            PG8_WAIT_V(8); PG8_WAIT_L(0); PG8_BAR; PG8_MMA(0, 0, At, B0); PG8_MMA(0, 1, At, B1); PG8_BAR; PG8_SCHED;
            PG8_LDA(At, 0, 1); PG8_STAGE(PG8_SB(0, 0), b2, voffB); PG8_STAGE(PG8_SB(0, 1), b2 + hstep, voffB); PG8_STAGE(PG8_SA(0, 0), a2, v2[0]);
            PG8_WAIT_V(8); PG8_WAIT_L(0); PG8_BAR; PG8_MMA(1, 0, At, B0); PG8_MMA(1, 1, At, B1); PG8_BAR; PG8_SCHED;
            PG8_LDB(B0, 1, 0); PG8_LDB(B1, 1, 1); PG8_SCHED; PG8_LDA(At, 1, 0); PG8_STAGE(PG8_SA(0, 1), a2, v2[1]);
            PG8_WAIT_V(8); PG8_WAIT_L(0); PG8_BAR; PG8_MMA(0, 0, At, B0); PG8_MMA(0, 1, At, B1); PG8_BAR; PG8_SCHED;
            PG8_LDA(At, 1, 1); PG8_STAGE(PG8_SB(1, 0), b3, voffB); PG8_STAGE(PG8_SB(1, 1), b3 + hstep, voffB); PG8_STAGE(PG8_SA(1, 0), a3, v2[0]);
            PG8_WAIT_V(8); PG8_WAIT_L(0); PG8_BAR; PG8_MMA(1, 0, At, B0); PG8_MMA(1, 1, At, B1); PG8_BAR; PG8_SCHED;
        }
        if constexpr (FP8) asm volatile("s_nop 15\n\ts_nop 15" ::: "memory");
        if constexpr (ALIGN_EPI) { if (wr == 0) PG8_BAR; }
        E(acc, cur, wr, wc, fr, fq);
        if (!has_next) break;
#pragma unroll
        for (int a = 0; a < 2; ++a)
#pragma unroll
            for (int b = 0; b < 2; ++b)
#pragma unroll
                for (int m = 0; m < 4; ++m)
#pragma unroll
                    for (int n = 0; n < 2; ++n) acc[a][b][m][n] = (f32x4){0.f, 0.f, 0.f, 0.f};
        cur = nxt; cA = nA; cB = nB; ++ui;
        if constexpr (GATHER) {
#pragma unroll
            for (int h = 0; h < 2; ++h)
#pragma unroll
                for (int i = 0; i < 2; ++i) vAc[h][i] = vAn[h][i]; }
        if constexpr (ALIGN_EPI) { if (wr == 1) PG8_BAR; }
    }
    PG8_WAIT_V(0);
    if constexpr (!ALIGN_EPI) { if (wr == 0) PG8_BAR; }
    PG8_BAR;
#undef PG8_SA
#undef PG8_SB
#undef PG8_STAGE
#undef PG8_LDA
#undef PG8_LDB
#undef PG8_MMA
#undef PG8_CAT
#undef PG8_WAIT_V
#undef PG8_WAIT_L
#undef PG8_BAR
#undef PG8_SCHED
}
}

#define XB_TMO      128
#define XB_XCNT(j)  (256  + 64 * (j))
#define XB_XSUB(j)  (1280 + 64 * (j))
#define XB_XGEN(j)  (2304 + 64 * (j))
#define XB_TOP      3328
#define XB_TOPGEN   3392
#define XCD_BAR_WORDS 3456
#define XB_SPIN_CAP (1u << 18)
DI unsigned xb_ld(unsigned* p)              { return __hip_atomic_load(p, __ATOMIC_RELAXED, __HIP_MEMORY_SCOPE_AGENT); }
DI unsigned xb_add(unsigned* p, unsigned v) { return __hip_atomic_fetch_add(p, v, __ATOMIC_RELAXED, __HIP_MEMORY_SCOPE_AGENT); }
DI unsigned xb_xcc_id() { return (unsigned)__builtin_amdgcn_s_getreg((3 << 11) | 20) & 0xFu; }
#define XB_SPIN(cond, bar) do { unsigned _sp = 0; while (cond) { __builtin_amdgcn_s_sleep(1); \
    if ((++_sp & 255u) == 0u) { if (xb_ld(&(bar)[XB_TMO])) break; if (_sp > XB_SPIN_CAP) { atomicAdd(&(bar)[XB_TMO], 1u); break; } } } } while (0)
struct XcdBarrier { unsigned* bar; unsigned x; volatile LAS unsigned* st; };
DI XcdBarrier xcd_barrier_post(unsigned* bar, volatile LAS unsigned* st) {
    XcdBarrier b; b.bar = bar; b.x = xb_xcc_id(); b.st = st;
    if (threadIdx.x == 0) (void)xb_add(&bar[XB_XCNT(b.x)], 1u);
    return b;
}
DI void xcd_barrier_complete(unsigned* bar, unsigned x, unsigned& nloc, unsigned& nx) {
    const unsigned G = gridDim.x * gridDim.y * gridDim.z;
    unsigned sum, cnt, mine, sp = 0u;
    for (;;) {
        sum = 0u; cnt = 0u; mine = 0u;
#pragma unroll
        for (unsigned j = 0; j < 16; ++j) { const unsigned c = xb_ld(&bar[XB_XCNT(j)]); sum += c; cnt += (c > 0u) ? 1u : 0u; mine = (j == x) ? c : mine; }
        if (sum == G) break;
        __builtin_amdgcn_s_sleep(1);
        if ((++sp & 255u) == 0u) { if (xb_ld(&bar[XB_TMO])) break; if (sp > XB_SPIN_CAP) { atomicAdd(&bar[XB_TMO], 1u); break; } }
    }
    nloc = mine > 0u ? mine : 1u; nx = cnt > 0u ? cnt : 1u;
}
DI void xcd_barrier(const XcdBarrier& b) {
    asm volatile("s_waitcnt vmcnt(0)" ::: "memory");
    __syncthreads();
    if (threadIdx.x == 0) {
        unsigned* bar = b.bar;
        __builtin_amdgcn_s_waitcnt(0);
        unsigned nloc = b.st[0], nx = b.st[1];
        if (nloc == 0u) { xcd_barrier_complete(bar, b.x, nloc, nx); b.st[0] = nloc; b.st[1] = nx; }
        const unsigned old = xb_add(&bar[XB_XSUB(b.x)], 1u);
        const unsigned gen = old / nloc;
        if (old + 1u == (gen + 1u) * nloc) {
            __builtin_amdgcn_fence(__ATOMIC_RELEASE, "agent");
            asm volatile("s_waitcnt vmcnt(0)" ::: "memory");
            const unsigned og = xb_add(&bar[XB_TOP], 1u);
            const unsigned tg = og / nx;
            if (og + 1u == (tg + 1u) * nx) xb_add(&bar[XB_TOPGEN], 1u);
            else XB_SPIN(xb_ld(&bar[XB_TOPGEN]) == tg, bar);
            __builtin_amdgcn_fence(__ATOMIC_ACQUIRE, "agent");
            xb_add(&bar[XB_XGEN(b.x)], 1u);
            asm volatile("s_waitcnt vmcnt(0)" ::: "memory");
        } else {
            XB_SPIN(xb_ld(&bar[XB_XGEN(b.x)]) == gen, bar);
            __builtin_amdgcn_fence(__ATOMIC_ACQUIRE, "agent");
            asm volatile("s_waitcnt vmcnt(0)" ::: "memory");
        }
    }
    __syncthreads();
}

DI void p0_transpose_item(const float* W, int ldw, int K, bf16* WT, int src_n0, int dst_n0, int k0, LAS float* scr, int lane) {
#pragma unroll 8
    for (int i = 0; i < 32; ++i) { const int kk = 2 * i + (lane >> 5); scr[kk * 33 + (lane & 31)] = W[(size_t)(k0 + kk) * ldw + src_n0 + (lane & 31)]; }
    asm volatile("s_waitcnt lgkmcnt(0)" ::: "memory");
    const int c = lane & 7;
#pragma unroll
    for (int j = 0; j < 4; ++j) { const int n = (lane >> 3) + 8 * j; const LAS float* s = scr + (8 * c) * 33 + n;
        u32x4 o; o.x = pk2(s[0 * 33], s[1 * 33]); o.y = pk2(s[2 * 33], s[3 * 33]); o.z = pk2(s[4 * 33], s[5 * 33]); o.w = pk2(s[6 * 33], s[7 * 33]);
        *(u32x4*)(WT + (size_t)(dst_n0 + n) * K + k0 + 8 * c) = o; }
    asm volatile("s_waitcnt lgkmcnt(0)" ::: "memory");
}

DI void p0_fp8_load(const float* W, int ldw, int src_n0, int k0, f32x4 (&v)[16], int lane) {
    const int kq = lane >> 3, nq = lane & 7;
#pragma unroll
    for (int i = 0; i < 16; ++i) { const int k = 32 * (i >> 2) + 4 * kq + (i & 3); v[i] = *(const f32x4*)(W + (size_t)(k0 + k) * ldw + src_n0 + 4 * nq); }
}
DI void p0_fp8_finish(const f32x4 (&v)[16], unsigned char* WT, int kbytes, int dst_n0, int k0, float scale, LAS unsigned* scr, int lane) {
    const int kq = lane >> 3, nq = lane & 7;
#pragma unroll
    for (int g = 0; g < 4; ++g)
#pragma unroll
        for (int c = 0; c < 4; ++c) scr[(4 * nq + c) * 33 + 8 * g + kq] = pk4_fp8(v[4 * g][c] * scale, v[4 * g + 1][c] * scale, v[4 * g + 2][c] * scale, v[4 * g + 3][c] * scale);
    asm volatile("s_waitcnt lgkmcnt(0)" ::: "memory");
    const int ch = lane & 7;
#pragma unroll
    for (int j = 0; j < 4; ++j) { const int n = (lane >> 3) + 8 * j; const LAS unsigned* s = scr + n * 33 + 4 * ch;
        u32x4 o; o.x = s[0]; o.y = s[1]; o.z = s[2]; o.w = s[3];
        *(u32x4*)(WT + (size_t)(dst_n0 + n) * kbytes + k0 + 16 * ch) = o; }
    asm volatile("s_waitcnt lgkmcnt(0)" ::: "memory");
}
DI void p0_transpose_bf16(const float* W, int ldw, int K, bf16* WT, int src_n0, int dst_n0, int k0, LAS unsigned* scr, int lane) {
    const int kq = lane >> 4, nq = lane & 15;
    f32x4 v[16];
#pragma unroll
    for (int i = 0; i < 16; ++i) { const int k = 8 * (i >> 1) + 2 * kq + (i & 1); v[i] = *(const f32x4*)(W + (size_t)(k0 + k) * ldw + src_n0 + 4 * nq); }
#pragma unroll
    for (int pp = 0; pp < 8; ++pp)
#pragma unroll
        for (int c = 0; c < 4; ++c) scr[(4 * nq + c) * 33 + 4 * pp + kq] = pk2(v[2 * pp][c], v[2 * pp + 1][c]);
    asm volatile("s_waitcnt lgkmcnt(0)" ::: "memory");
    const int ch = lane & 7;
#pragma unroll
    for (int j = 0; j < 8; ++j) { const int n = (lane >> 3) + 8 * j; const LAS unsigned* s = scr + n * 33 + 4 * ch;
        u32x4 o; o.x = s[0]; o.y = s[1]; o.z = s[2]; o.w = s[3];
        *(u32x4*)(WT + (size_t)(dst_n0 + n) * K + k0 + 8 * ch) = o; }
    asm volatile("s_waitcnt lgkmcnt(0)" ::: "memory");
}

DI void ln_row(f32x4 (&v)[4], const float* g, const float* bta, int lane) {
    float s = 0.f;
#pragma unroll
    for (int j = 0; j < 4; ++j) s += (v[j].x + v[j].y) + (v[j].z + v[j].w);
    const float mean = wave_sum(s) * (1.f / D); float s2 = 0.f;
#pragma unroll
    for (int j = 0; j < 4; ++j) { v[j] = v[j] - mean; s2 += (v[j].x * v[j].x + v[j].y * v[j].y) + (v[j].z * v[j].z + v[j].w * v[j].w); }
    const float rstd = 1.f / sqrtf(wave_sum(s2) * (1.f / D) + LN_EPS);
#pragma unroll
    for (int j = 0; j < 4; ++j) { const f32x4 gg = *(const f32x4*)(g + 4 * lane + 256 * j), bb = *(const f32x4*)(bta + 4 * lane + 256 * j); v[j] = v[j] * rstd * gg + bb; }
}
DI void store_row_bf16(bf16* orow, const f32x4 (&v)[4], int lane) {
    u32x2* o8 = (u32x2*)orow + lane;
#pragma unroll
    for (int j = 0; j < 4; ++j) { u32x2 w; w.x = pk2(v[j].x, v[j].y); w.y = pk2(v[j].z, v[j].w); o8[64 * j] = w; }
}

DI void load_row_bf16(const bf16* irow, f32x4 (&v)[4], int lane) {
    const u32x2* i8 = (const u32x2*)irow + lane;
#pragma unroll
    for (int j = 0; j < 4; ++j) { const u32x2 w = i8[64 * j]; v[j] = (f32x4){bf_lo(w.x), bf_hi(w.x), bf_lo(w.y), bf_hi(w.y)}; }
}
DI void store_row_fp8(unsigned char* orow, const f32x4 (&v)[4], float scale, int lane) {
    unsigned* o4 = (unsigned*)orow + lane;
#pragma unroll
    for (int j = 0; j < 4; ++j) o4[64 * j] = pk4_fp8(v[j].x * scale, v[j].y * scale, v[j].z * scale, v[j].w * scale);
}

constexpr float FOX_THR = 40.f;
DI void fox_unit(int b, int h8, int qb, const bf16* U, const float* Fc2, const gu32* Kmax2, const float* fox_g, bf16* MIX, LAS unsigned char* lds) {
    const int tid = threadIdx.x, lane = tid & 63, wave = __builtin_amdgcn_readfirstlane(tid >> 6);
    const int r = lane & 31, h = lane >> 5, i16 = lane & 15, q4 = i16 >> 2, p4 = i16 & 3, blk = (lane >> 4) & 1;
    const int tok0 = b * SEQ, q0 = qb * 256, qrow = q0 + wave * 32 + r;
    const float C2 = 0.125f * LOG2E;
    bf16x8 qf[4];
    { const bf16* qp = U + (size_t)(tok0 + qrow) * NU + UC_FQ + h8 * 64 + 8 * h;
#pragma unroll
      for (int d0 = 0; d0 < 4; ++d0) qf[d0] = *(const bf16x8*)(qp + 16 * d0); }
    float qn2 = 0.f;
#pragma unroll
    for (int d0 = 0; d0 < 4; ++d0)
#pragma unroll
        for (int j = 0; j < 8; ++j) { const float f = bf2f(qf[d0][j]); qn2 += f * f; }
    qn2 = xhalf_sum(qn2);
    const float* fc = Fc2 + (size_t)(b * 8 + h8) * SEQ;
    const float qk_bound = sqrtf(wave_max(qn2) * __uint_as_float(__hip_atomic_load(Kmax2 + b * 8 + h8, RLX_AGENT))) * C2 * 1.001f;
    const float nb_first = fc[q0];
    float m = -1e30f, l = 0.f; f32x16 oT[2];
#pragma unroll
    for (int i = 0; i < 16; ++i) { oT[0][i] = 0.f; oT[1][i] = 0.f; }
    constexpr int FOXB = 18944;
    const int NT = 4 * qb + 4;
    bool active = true;
    const int srow = tid >> 3, spc = tid & 7;
    const bf16* gp0 = U + (size_t)(tok0 + srow) * NU + h8 * 64 + spc * 8;
    u32x4 kvr, vvr; float nbr = 0.f;
    { const bf16* gp = gp0 + (size_t)(64 * (NT - 1)) * NU; kvr = *(const u32x4*)(gp + UC_FK); vvr = *(const u32x4*)(gp + UC_FV); if (tid < 64) nbr = fc[64 * (NT - 1) + tid] - nb_first; }
    __syncthreads();
    *(LAS u32x4*)(lds + srow * 144 + spc * 16) = kvr; *(LAS u32x4*)(lds + 9216 + srow * 144 + spc * 16) = vvr; if (tid < 64) ((LAS float*)(lds + 18432))[tid] = nbr;
    __syncthreads();
    int cur = 0;
    for (int t = NT - 1; t >= 0; --t) {
        LAS unsigned char* Ks = lds + cur * FOXB; LAS unsigned char* Vs = Ks + 9216; LAS float* nb = (LAS float*)(Ks + 18432);
        if (t >= 1) { const bf16* gp = gp0 + (size_t)(64 * (t - 1)) * NU; kvr = *(const u32x4*)(gp + UC_FK); vvr = *(const u32x4*)(gp + UC_FV); if (tid < 64) nbr = fc[64 * (t - 1) + tid] - nb_first; }
        if (active && 64 * t <= q0 + wave * 32 + 31) {
            f32x16 p[2];
#pragma unroll
            for (int hb = 0; hb < 2; ++hb) {
                f32x16 a;
#pragma unroll
                for (int i = 0; i < 16; ++i) a[i] = 0.f;
#pragma unroll
                for (int d0 = 0; d0 < 4; ++d0) { const bf16x8 kf = *(const LAS bf16x8*)(Ks + (32 * hb + r) * 144 + (16 * d0 + 8 * h) * 2); a = mfma32(kf, qf[d0], a); }
#pragma unroll
                for (int g = 0; g < 4; ++g) { const f32x4 bb = *(const LAS f32x4*)(nb + 32 * hb + 8 * g + 4 * h);
#pragma unroll
                    for (int e = 0; e < 4; ++e) a[4 * g + e] = a[4 * g + e] * C2 + bb[e]; }
                p[hb] = a;
            }
            if (t >= NT - 4) {
#pragma unroll
                for (int hb = 0; hb < 2; ++hb)
#pragma unroll
                    for (int i = 0; i < 16; ++i) { const int kv = 64 * t + 32 * hb + crow(i, h); if (kv > qrow) p[hb][i] = -INFINITY; }
            }
            float mx = p[0][0];
#pragma unroll
            for (int i = 1; i < 16; ++i) mx = fmaxf(mx, p[0][i]);
#pragma unroll
            for (int i = 0; i < 16; ++i) mx = fmaxf(mx, p[1][i]);
            mx = xhalf_max(mx);
            if (__any(mx > m)) {
                const float mn = fmaxf(m, mx), alpha = ex2(m - mn); m = mn; l *= alpha;
#pragma unroll
                for (int i = 0; i < 16; ++i) { oT[0][i] *= alpha; oT[1][i] *= alpha; }
            }
            float rs = 0.f;
#pragma unroll
            for (int hb = 0; hb < 2; ++hb)
#pragma unroll
                for (int i = 0; i < 16; ++i) { const float e = ex2(p[hb][i] - m); p[hb][i] = e; rs += e; }
            l += rs;
            bf16x8 pf[2][2];
#pragma unroll
            for (int hb = 0; hb < 2; ++hb)
#pragma unroll
                for (int s = 0; s < 2; ++s) pf[hb][s] = pack8(p[hb], s);
#pragma unroll
            for (int d0 = 0; d0 < 2; ++d0)
#pragma unroll
                for (int hb = 0; hb < 2; ++hb)
#pragma unroll
                    for (int s = 0; s < 2; ++s) {
                        const LAS unsigned char* vp = Vs + (32 * hb + 16 * s + 4 * h + q4) * 144 + (32 * d0 + 16 * blk + 4 * p4) * 2;
                        const s16x4 lo = tr_read(vp), hi = tr_read(vp + 8 * 144);
                        oT[d0] = mfma32(cat8(lo, hi), pf[hb][s], oT[d0]);
                    }
            if (t >= 1) { const float mmin = -wave_max(-m); active = (qk_bound + (fc[64 * t - 1] - nb_first) - mmin) > -FOX_THR; }
        }
        cur ^= 1;
        { LAS unsigned char* Kn = lds + cur * FOXB; *(LAS u32x4*)(Kn + srow * 144 + spc * 16) = kvr; *(LAS u32x4*)(Kn + 9216 + srow * 144 + spc * 16) = vvr; if (tid < 64) ((LAS float*)(Kn + 18432))[tid] = nbr; }
        if (!__syncthreads_or(active ? 1 : 0)) break;
    }
    l = xhalf_sum(l);
    const float inv = 1.f / l;
    float ss = 0.f;
#pragma unroll
    for (int d0 = 0; d0 < 2; ++d0)
#pragma unroll
        for (int i = 0; i < 16; ++i) { const float o = oT[d0][i] * inv; oT[d0][i] = o; ss += o * o; }
    ss = xhalf_sum(ss);
    const float rr = 1.f / sqrtf(ss * (1.f / 64.f) + RMS_EPS);
    bf16* op = MIX + (size_t)(tok0 + qrow) * D + h8 * 64;
#pragma unroll
    for (int d0 = 0; d0 < 2; ++d0)
#pragma unroll
        for (int g = 0; g < 4; ++g) { const int d = 32 * d0 + 8 * g + 4 * h; const f32x4 gn = *(const f32x4*)(fox_g + h8 * 64 + d);
            u32x2 w; w.x = pk2(oT[d0][4 * g] * rr * gn.x, oT[d0][4 * g + 1] * rr * gn.y); w.y = pk2(oT[d0][4 * g + 2] * rr * gn.z, oT[d0][4 * g + 3] * rr * gn.w);
            *(u32x2*)(op + d) = w; }
}

DI void m1_unit(int bh, int cg, const bf16* U, const float* G, const float* conv_w, bf16* Mq, bf16* Mk, float* KvT, float* Nc, float* Gc, float* Mloc, LAS unsigned char* lds) {
    const int tid = threadIdx.x, lane = tid & 63, wave = __builtin_amdgcn_readfirstlane(tid >> 6);
    const int r = lane & 31, h = lane >> 5, i16 = lane & 15, q4 = i16 >> 2, p4 = i16 & 3, blk = (lane >> 4) & 1;
    const int b = bh >> 2, hh = bh & 3, s0 = cg * 256;
    LAS float* wa = (LAS float*)lds;
    LAS unsigned char* ksb = lds + 1024;
    LAS unsigned char* vsb = lds + 1024 + 36864;
    __syncthreads();
    if (wave < 4) {
        const int c = cg * 4 + wave, tok = b * SEQ + c * 64 + lane;
        const float lf = G[(size_t)tok * 16 + 12 + hh], li = G[(size_t)tok * 16 + 8 + hh];
        const float bsc = wave_scan_add(lf, lane);
        const float g = __shfl(bsc, 63);
        const float a = g - bsc + li;
        const float ml = wave_max(a);
        wa[wave * 64 + lane] = expf(a - ml);
        if (lane == 0) { Gc[bh * 64 + c] = g; Mloc[bh * 64 + c] = ml; }
    }
    __syncthreads();
#pragma unroll 2
    for (int i = 0; i < 8; ++i) {
        const int id = tid + 512 * i, d8 = id & 7, qk = (id >> 3) & 1, t = id >> 4;
        const int ucol = (qk ? UC_MK : UC_MQ) + hh * 64 + 8 * d8, ccol = (qk ? 256 : 0) + hh * 64 + 8 * d8;
        float acc[8];
#pragma unroll
        for (int e = 0; e < 8; ++e) acc[e] = 0.f;
#pragma unroll
        for (int j = 0; j < 4; ++j) {
            const int ts = s0 + t - 3 + j;
            if (ts >= 0) {
                const u32x4 x = *(const u32x4*)(U + (size_t)(b * SEQ + ts) * NU + ucol);
                const f32x4 w0 = *(const f32x4*)(conv_w + j * 512 + ccol), w1 = *(const f32x4*)(conv_w + j * 512 + ccol + 4);
                acc[0] += bf_lo(x.x) * w0.x; acc[1] += bf_hi(x.x) * w0.y; acc[2] += bf_lo(x.y) * w0.z; acc[3] += bf_hi(x.y) * w0.w;
                acc[4] += bf_lo(x.z) * w1.x; acc[5] += bf_hi(x.z) * w1.y; acc[6] += bf_lo(x.w) * w1.z; acc[7] += bf_hi(x.w) * w1.w;
            }
        }
#pragma unroll
        for (int e = 0; e < 8; ++e) acc[e] = acc[e] / (1.f + expf(-acc[e]));
        const size_t orow = ((size_t)bh * SEQ + s0 + t) * 64 + 8 * d8;
        if (qk == 0) {
            u32x4 w; w.x = pk2(acc[0], acc[1]); w.y = pk2(acc[2], acc[3]); w.z = pk2(acc[4], acc[5]); w.w = pk2(acc[6], acc[7]);
            *(u32x4*)(Mq + orow) = w;
        } else {
#pragma unroll
            for (int e = 0; e < 8; ++e) acc[e] *= 0.125f;
            u32x4 w; w.x = pk2(acc[0], acc[1]); w.y = pk2(acc[2], acc[3]); w.z = pk2(acc[4], acc[5]); w.w = pk2(acc[6], acc[7]);
            *(u32x4*)(Mk + orow) = w;
            const float ww = wa[t];
            u32x4 x; x.x = pk2(acc[0] * ww, acc[1] * ww); x.y = pk2(acc[2] * ww, acc[3] * ww); x.z = pk2(acc[4] * ww, acc[5] * ww); x.w = pk2(acc[6] * ww, acc[7] * ww);
            *(LAS u32x4*)(ksb + (t >> 6) * 9216 + (t & 63) * 144 + d8 * 16) = x;
        }
    }
#pragma unroll
    for (int i = 0; i < 8; ++i) { const int id = tid + 512 * i, pc = id & 15, t = id >> 4;
        const u32x4 v = *(const u32x4*)(U + (size_t)(b * SEQ + s0 + t) * NU + UC_MV + hh * 128 + pc * 8);
        *(LAS u32x4*)(vsb + (t >> 6) * 17408 + (t & 63) * 272 + pc * 16) = v; }
    __syncthreads();
    {
        const int cl = wave >> 1, eh = wave & 1, c = cg * 4 + cl;
        const LAS unsigned char* vs = vsb + cl * 17408; const LAS unsigned char* ks = ksb + cl * 9216;
        f32x16 acc[2][2];
#pragma unroll
        for (int a = 0; a < 2; ++a)
#pragma unroll
            for (int bb = 0; bb < 2; ++bb)
#pragma unroll
                for (int i = 0; i < 16; ++i) acc[a][bb][i] = 0.f;
#pragma unroll
        for (int k4 = 0; k4 < 4; ++k4) {
            bf16x8 af[2], bfr[2];
#pragma unroll
            for (int eb = 0; eb < 2; ++eb) { const LAS unsigned char* pp = vs + (16 * k4 + 8 * h + q4) * 272 + (64 * eh + 32 * eb + 16 * blk + 4 * p4) * 2; af[eb] = cat8(tr_read(pp), tr_read(pp + 4 * 272)); }
#pragma unroll
            for (int db = 0; db < 2; ++db) { const LAS unsigned char* pp = ks + (16 * k4 + 8 * h + q4) * 144 + (32 * db + 16 * blk + 4 * p4) * 2; bfr[db] = cat8(tr_read(pp), tr_read(pp + 4 * 144)); }
#pragma unroll
            for (int eb = 0; eb < 2; ++eb)
#pragma unroll
                for (int db = 0; db < 2; ++db) acc[eb][db] = mfma32(af[eb], bfr[db], acc[eb][db]);
        }
        float* op = KvT + (size_t)(bh * 64 + c) * 8192;
#pragma unroll
        for (int eb = 0; eb < 2; ++eb)
#pragma unroll
            for (int db = 0; db < 2; ++db)
#pragma unroll
                for (int i = 0; i < 16; ++i) op[(64 * eh + 32 * eb + crow(i, h)) * 64 + 32 * db + r] = acc[eb][db][i];
    }
    if (tid < 256) { const int cl = tid >> 6, d = tid & 63; const LAS unsigned char* ks = ksb + cl * 9216 + d * 2; float s = 0.f;
#pragma unroll 8
        for (int t = 0; t < 64; ++t) s += __uint_as_float(((unsigned)*(const LAS unsigned short*)(ks + t * 144)) << 16);
        Nc[(size_t)(bh * 64 + cg * 4 + cl) * 64 + d] = s; }
}

DI void m3_unit(int bh, int cg, const bf16* U, const float* G, const bf16* Mq, const bf16* Mk, const bf16* CpT, const float* Np, const float* Mp, const float* mlstm_g, bf16* MIX, LAS unsigned char* lds) {
    const int tid = threadIdx.x, lane = tid & 63, wave = __builtin_amdgcn_readfirstlane(tid >> 6);
    const int r = lane & 31, h = lane >> 5, i16 = lane & 15, q4 = i16 >> 2, p4 = i16 & 3, blk = (lane >> 4) & 1;
    const int b = bh >> 2, hh = bh & 3, cl = wave >> 1, th = wave & 1, c = cg * 4 + cl;
    const int tokc = b * SEQ + c * 64;
    const LAS unsigned char* Vs = lds + cl * 17408;
    LAS float* wsf = (LAS float*)(lds + 69632 + wave * 1024);
    __syncthreads();
#pragma unroll
    for (int i = 0; i < 8; ++i) { const int id = tid + 512 * i, pc = id & 15, t = id >> 4;
        const u32x4 v = *(const u32x4*)(U + (size_t)(b * SEQ + cg * 256 + t) * NU + UC_MV + hh * 128 + pc * 8);
        *(LAS u32x4*)(lds + (t >> 6) * 17408 + (t & 63) * 272 + pc * 16) = v; }
    const float mprev = Mp[bh * 64 + c];
    {
        const float lf = G[(size_t)(tokc + lane) * 16 + 12 + hh], li = G[(size_t)(tokc + lane) * 16 + 8 + hh];
        const float bsc = wave_scan_add(lf, lane);
        const float pm = wave_scan_max(li - bsc, lane);
        wsf[lane] = bsc; wsf[64 + lane] = li; wsf[128 + lane] = bsc + fmaxf(mprev, pm); wsf[192 + lane] = Np[(size_t)(bh * 64 + c) * 64 + lane];
    }
    __syncthreads();
    const int tl = 32 * th + r;
    const float bt = wsf[tl], mtt = wsf[128 + tl];
    const float winter = expf(bt + mprev - mtt);
    bf16x8 qf[4];
    { const bf16* qp = Mq + ((size_t)bh * SEQ + c * 64 + tl) * 64 + 8 * h;
#pragma unroll
      for (int ks = 0; ks < 4; ++ks) qf[ks] = *(const bf16x8*)(qp + 16 * ks); }
    float qn = 0.f;
#pragma unroll
    for (int ks = 0; ks < 4; ++ks)
#pragma unroll
        for (int j = 0; j < 8; ++j) qn += bf2f(qf[ks][j]) * wsf[192 + 16 * ks + 8 * h + j];
    qn = xhalf_sum(qn);
    f32x16 accT[4];
#pragma unroll
    for (int eb = 0; eb < 4; ++eb) {
        f32x16 a;
#pragma unroll
        for (int i = 0; i < 16; ++i) a[i] = 0.f;
#pragma unroll
        for (int ks = 0; ks < 4; ++ks) { const bf16x8 cf = *(const bf16x8*)(CpT + ((size_t)(bh * 64 + c) * 128 + 32 * eb + r) * 64 + 16 * ks + 8 * h); a = mfma32(cf, qf[ks], a); }
#pragma unroll
        for (int i = 0; i < 16; ++i) a[i] *= winter;
        accT[eb] = a;
    }
    float psum = 0.f; f32x16 pT[2];
#pragma unroll
    for (int sb = 0; sb < 2; ++sb) {
        f32x16 a;
#pragma unroll
        for (int i = 0; i < 16; ++i) a[i] = 0.f;
#pragma unroll
        for (int ks = 0; ks < 4; ++ks) { const bf16x8 kf = *(const bf16x8*)(Mk + ((size_t)bh * SEQ + c * 64 + 32 * sb + r) * 64 + 16 * ks + 8 * h); a = mfma32(kf, qf[ks], a); }
#pragma unroll
        for (int g = 0; g < 4; ++g) { const f32x4 b4 = *(const LAS f32x4*)(wsf + 32 * sb + 8 * g + 4 * h), l4 = *(const LAS f32x4*)(wsf + 64 + 32 * sb + 8 * g + 4 * h);
#pragma unroll
            for (int e = 0; e < 4; ++e) { const int s = 32 * sb + 8 * g + 4 * h + e; const float w = (s <= tl) ? expf(bt - b4[e] + l4[e] - mtt) * a[4 * g + e] : 0.f; a[4 * g + e] = w; psum += w; } }
        pT[sb] = a;
    }
    psum = xhalf_sum(psum);
#pragma unroll
    for (int eb = 0; eb < 4; ++eb)
#pragma unroll
        for (int sb = 0; sb < 2; ++sb)
#pragma unroll
            for (int s2 = 0; s2 < 2; ++s2) {
                const LAS unsigned char* vp = Vs + (32 * sb + 16 * s2 + 4 * h + q4) * 272 + (32 * eb + 16 * blk + 4 * p4) * 2;
                const s16x4 lo = tr_read(vp), hi = tr_read(vp + 8 * 272);
                accT[eb] = mfma32(cat8(lo, hi), pack8(pT[sb], s2), accT[eb]);
            }
    const float den = winter * qn + psum;
    const float hs = 1.f / fmaxf(fabsf(den), expf(-mtt));
    float ss = 0.f;
#pragma unroll
    for (int eb = 0; eb < 4; ++eb)
#pragma unroll
        for (int i = 0; i < 16; ++i) { const float v = accT[eb][i] * hs; accT[eb][i] = v; ss += v * v; }
    ss = xhalf_sum(ss);
    const float rr = 1.f / sqrtf(ss * (1.f / 128.f) + RMS_EPS);
    const int tok = tokc + tl;
#pragma unroll
    for (int eb = 0; eb < 4; ++eb)
#pragma unroll
        for (int g = 0; g < 4; ++g) { const int e = 32 * eb + 8 * g + 4 * h;
            const f32x4 gn = *(const f32x4*)(mlstm_g + hh * 128 + e);
            const u32x2 mo = *(const u32x2*)(U + (size_t)tok * NU + UC_MO + hh * 128 + e);
            const float o0 = accT[eb][4 * g] * rr * gn.x * sigmoid_fast(bf_lo(mo.x)), o1 = accT[eb][4 * g + 1] * rr * gn.y * sigmoid_fast(bf_hi(mo.x));
            const float o2 = accT[eb][4 * g + 2] * rr * gn.z * sigmoid_fast(bf_lo(mo.y)), o3 = accT[eb][4 * g + 3] * rr * gn.w * sigmoid_fast(bf_hi(mo.y));
            u32x2 w; w.x = pk2(o0, o1); w.y = pk2(o2, o3);
            *(u32x2*)(MIX + (size_t)tok * D + 512 + hh * 128 + e) = w; }
}

DI void xattn_unit(int b, int hx, int qb, bf16* QX, const bf16* KVx, LAS unsigned char* lds) {
    const int tid = threadIdx.x, lane = tid & 63, wave = __builtin_amdgcn_readfirstlane(tid >> 6);
    const int r = lane & 31, h = lane >> 5, i16 = lane & 15, q4 = i16 >> 2, p4 = i16 & 3, blk = (lane >> 4) & 1;
    const int tok = b * SEQ + qb * 256 + wave * 32 + r;
    bf16x8 qf[16];
    { const bf16* qp = QX + (size_t)tok * D + hx * 256 + 8 * h;
#pragma unroll
      for (int ks = 0; ks < 16; ++ks) qf[ks] = *(const bf16x8*)(qp + 16 * ks); }
    f32x16 sT[8];
    LAS unsigned char* Kx = lds; LAS unsigned char* Vx = lds + 33792;
#pragma unroll
    for (int kt = 0; kt < 4; ++kt) {
        __syncthreads();
#pragma unroll
        for (int i = 0; i < 4; ++i) { const int id = tid + 512 * i, row = id >> 5, pc = id & 31;
            const u32x4 v = *(const u32x4*)(KVx + (size_t)(b * NMEM + 64 * kt + row) * 2048 + hx * 256 + pc * 8);
            *(LAS u32x4*)(Kx + row * 528 + pc * 16) = v; }
        __syncthreads();
#pragma unroll
        for (int mb = 0; mb < 2; ++mb) {
            f32x16 a;
#pragma unroll
            for (int i = 0; i < 16; ++i) a[i] = 0.f;
#pragma unroll
            for (int ks = 0; ks < 16; ++ks) { const bf16x8 kf = *(const LAS bf16x8*)(Kx + (32 * mb + r) * 528 + (16 * ks + 8 * h) * 2); a = mfma32(kf, qf[ks], a); }
            sT[2 * kt + mb] = a;
        }
    }
    const float C2X = 0.0625f * LOG2E;
    float mx = -INFINITY;
#pragma unroll
    for (int j = 0; j < 8; ++j)
#pragma unroll
        for (int i = 0; i < 16; ++i) mx = fmaxf(mx, sT[j][i]);
    mx = xhalf_max(mx);
    const float mb2 = mx * C2X;
    float lsum = 0.f;
#pragma unroll
    for (int j = 0; j < 8; ++j)
#pragma unroll
        for (int i = 0; i < 16; ++i) { const float e = ex2(sT[j][i] * C2X - mb2); sT[j][i] = e; lsum += e; }
    lsum = xhalf_sum(lsum);
    const float inv = 1.f / lsum;
    bf16x8 pf[8][2];
#pragma unroll
    for (int j = 0; j < 8; ++j)
#pragma unroll
        for (int s = 0; s < 2; ++s) pf[j][s] = pack8(sT[j], s);
#pragma unroll
    for (int vh = 0; vh < 2; ++vh) {
        __syncthreads();
#pragma unroll
        for (int i = 0; i < 8; ++i) { const int id = tid + 512 * i, row = id >> 4, pc = id & 15;
            const u32x4 v = *(const u32x4*)(KVx + (size_t)(b * NMEM + row) * 2048 + 1024 + hx * 256 + 128 * vh + pc * 8);
            *(LAS u32x4*)(Vx + row * 272 + pc * 16) = v; }
        __syncthreads();
#pragma unroll
        for (int eb = 0; eb < 4; ++eb) {
            f32x16 acc;
#pragma unroll
            for (int i = 0; i < 16; ++i) acc[i] = 0.f;
#pragma unroll
            for (int j = 0; j < 8; ++j)
#pragma unroll
                for (int s = 0; s < 2; ++s) {
                    const LAS unsigned char* vp = Vx + (32 * j + 16 * s + 4 * h + q4) * 272 + (32 * eb + 16 * blk + 4 * p4) * 2;
                    const s16x4 lo = tr_read(vp), hi = tr_read(vp + 8 * 272);
                    acc = mfma32(cat8(lo, hi), pf[j][s], acc);
                }
#pragma unroll
            for (int g = 0; g < 4; ++g) { const int d = 128 * vh + 32 * eb + 8 * g + 4 * h;
                u32x2 w; w.x = pk2(acc[4 * g] * inv, acc[4 * g + 1] * inv); w.y = pk2(acc[4 * g + 2] * inv, acc[4 * g + 3] * inv);
                *(u32x2*)(QX + (size_t)tok * D + hx * 256 + d) = w; }
        }
    }
}

DI void moe_tables(LAS int* tb, gu32* ctl, int tid) {
    __syncthreads();
    if (tid < 32) tb[40 + tid] = (int)__hip_atomic_load(ctl + CW_CNT + 64 * tid, RLX_AGENT);
    __syncthreads();
    if (tid == 0) { int s = 0; for (int e = 0; e < 32; ++e) { tb[e] = s; s += (tb[40 + e] + 255) >> 8; } tb[32] = s; }
    __syncthreads();
}

struct Args { const float* in[26]; float* out; unsigned char* ws; int ph_lo, ph_hi, li, pad; };

__global__ void __launch_bounds__(NWAVES * 64, 2) fwd(Args args) {
    extern __shared__ __attribute__((aligned(16))) unsigned char lds_raw[];
    LAS unsigned char* lds = (LAS unsigned char*)lds_raw;
    volatile LAS unsigned* MISC = (volatile LAS unsigned*)(lds + MISC_OFF);
    const int tid = threadIdx.x, lane = tid & 63, wave = __builtin_amdgcn_readfirstlane(tid >> 6);
    const int G = gridDim.x, bx = blockIdx.x;
    const int vcu = (G % 8 == 0) ? (bx % 8) * (G / 8) + bx / 8 : bx;
    unsigned char* ws = args.ws;
    gu32* ctl = (gu32*)(ws + WS_CTL);
    const float* x = args.in[0]; const float* mem = args.in[1]; const float* w_in = args.in[2]; const float* fox_f_bias = args.in[3];
    const float* conv_w = args.in[4]; const float* i_bias = args.in[5]; const float* f_bias = args.in[6]; const float* fox_g = args.in[7];
    const float* mlstm_g = args.in[8]; const float* w_out = args.in[9]; const float* ln1_g = args.in[10]; const float* ln1_b = args.in[11];
    const float* w_xq = args.in[12]; const float* w_xk = args.in[13]; const float* w_xv = args.in[14]; const float* w_xo = args.in[15];
    const float* ln2_g = args.in[16]; const float* ln2_b = args.in[17]; const float* w_router = args.in[18]; const float* b_router = args.in[19];
    const float* w_gu = args.in[20]; const float* b_gu = args.in[21]; const float* w_dn = args.in[22]; const float* b_dn = args.in[23];
    const float* ln3_g = args.in[24]; const float* ln3_b = args.in[25];
    float* out = args.out;
    float* Gt = (float*)(ws + WS_G); float* Fc2 = (float*)(ws + WS_FC2);
    float* Gc = (float*)(ws + WS_GC); float* Mloc = Gc + 1024; float* Mp = Gc + 2048;
    float* Nc = (float*)(ws + WS_NC); float* Np = (float*)(ws + WS_NP);
    int* Tidx = (int*)(ws + WS_TIDX); float* Tgate = (float*)(ws + WS_TGATE); int* Tslot = (int*)(ws + WS_TSLOT); int* List = (int*)(ws + WS_LIST);
    bf16* KVx = (bf16*)(ws + WS_MEMKV);
    bf16* Win_t = (bf16*)(ws + WS_WIN); bf16* Wout_t = (bf16*)(ws + WS_WOUT); bf16* Wxq_t = (bf16*)(ws + WS_WXQ); bf16* Wxo_t = (bf16*)(ws + WS_WXO);
    unsigned char* Wgu8 = ws + WS_WGU; unsigned char* Wdn8 = ws + WS_WDN;
    bf16* XB = (bf16*)(ws + WS_XB); bf16* U = (bf16*)(ws + WS_U); bf16* Mq = (bf16*)(ws + WS_MQ); bf16* Mk = (bf16*)(ws + WS_MK);
    float* KvT = (float*)(ws + WS_KVT); bf16* CpT = (bf16*)(ws + WS_CPT); bf16* MIX = (bf16*)(ws + WS_MIX);
    bf16* Y1 = (bf16*)(ws + WS_Y1); bf16* X2B = (bf16*)(ws + WS_Y1 + 32 * MiB); bf16* X1B = (bf16*)(ws + WS_X1B); bf16* QX = (bf16*)(ws + WS_QX);
    bf16* Y2 = (bf16*)(ws + WS_Y2); unsigned char* X2F8 = ws + WS_X2B; unsigned char* HID8 = ws + WS_HID; bf16* YB = (bf16*)(ws + WS_YB);

    for (int u = tid; u < (LDS_BYTES - LDSCTL_OFF) / 4; u += NWAVES * 64) ((LAS unsigned*)(lds + LDSCTL_OFF))[u] = 0u;
    __syncthreads();
    XcdBarrier bar; bar.bar = (unsigned*)(ctl + CW_BAR); bar.x = 0; bar.st = nullptr;
    if (N_LAUNCHES == 1) bar = xcd_barrier_post((unsigned*)(ctl + CW_BAR), MISC + 8);
#define GRID_BAR() do { if (N_LAUNCHES == 1) xcd_barrier(bar); } while (0)
    const int lo = args.ph_lo, hi = args.ph_hi;
#ifndef PH_MASK
#define PH_MASK 0xFFFF
#endif
#define IN(k) (((PH_MASK >> (k)) & 1) && lo <= (k) && (k) < hi)
#define BOTH(k) (IN(k) && IN((k) + 1))
#ifndef REP_MASK
#define REP_MASK 0
#endif
#define REPS(k) (1 + ((REP_MASK >> (k)) & 1))
#define END_PHASE(k) do { if (BOTH(k) || rep + 1 < REPS(k)) GRID_BAR(); } while (0)

    if (IN(0)) for (int rep = 0; rep < REPS(0); ++rep) {
        {
            LAS float* wg = (LAS float*)lds;
            for (int idx = tid; idx < 1024 * 16; idx += 512) { const int k = idx >> 4, c = idx & 15; const int col = c < 8 ? 1536 + c : 2568 + (c - 8);
                const int j = k >> 8, ln = (k & 255) >> 2, i = k & 3; wg[((((j * 4 + i) * 4 + (c >> 2)) * 64 + ln) << 2) + (c & 3)] = w_in[(size_t)k * NIN + col]; }
            __syncthreads();
            for (int m0 = (bx * 8 + wave) * 2; m0 < M; m0 += G * 16) {
                asm volatile("" ::: "memory");
                f32x4 vv[2][4];
#pragma unroll
                for (int t = 0; t < 2; ++t) { const f32x4* xr = (const f32x4*)(x + (size_t)(m0 + t) * D) + lane;
#pragma unroll
                    for (int j = 0; j < 4; ++j) vv[t][j] = xr[64 * j]; }
#pragma unroll
                for (int t = 0; t < 2; ++t) {
                    const int m = m0 + t;
                    store_row_bf16(XB + (size_t)m * D, vv[t], lane);
                    float acc[16];
#pragma unroll
                    for (int c = 0; c < 16; ++c) acc[c] = 0.f;
#pragma unroll
                    for (int j = 0; j < 4; ++j)
#pragma unroll
                        for (int i = 0; i < 4; ++i) { const LAS f32x4* wp = (const LAS f32x4*)wg + ((j * 4 + i) * 4) * 64 + lane; const float xv = vv[t][j][i];
#pragma unroll
                            for (int c4 = 0; c4 < 4; ++c4) { const f32x4 w = wp[c4 * 64]; acc[4 * c4] += xv * w.x; acc[4 * c4 + 1] += xv * w.y; acc[4 * c4 + 2] += xv * w.z; acc[4 * c4 + 3] += xv * w.w; } }
#define TR_STEP(HALFN, XORM) { const bool up = (lane & (XORM)) != 0; _Pragma("unroll") for (int i = 0; i < (HALFN); ++i) { const float keep = up ? acc[(HALFN) + i] : acc[i], send = up ? acc[i] : acc[(HALFN) + i]; acc[i] = keep + __shfl_xor(send, (XORM)); } }
                    TR_STEP(8, 8) TR_STEP(4, 4) TR_STEP(2, 2) TR_STEP(1, 1)
#undef TR_STEP
                    float mine = acc[0]; mine += __shfl_xor(mine, 16); mine += __shfl_xor(mine, 32);
                    if (lane < 16) {
                        float o;
                        if (lane < 8) o = log_sigmoid_acc(mine + fox_f_bias[lane]);
                        else if (lane < 12) o = mine + i_bias[lane - 8];
                        else o = log_sigmoid_acc(mine + f_bias[lane - 12]);
                        Gt[(size_t)m * 16 + lane] = o;
                    }
                }
            }
            __syncthreads();
        }
        {
            LAS unsigned char* As = lds; LAS unsigned char* Bs = lds + 17408;
            for (int tile = bx; tile < 256; tile += G) {
                const int rt = tile >> 4, ct = tile & 15;
                const float* W = ct < 8 ? w_xk : w_xv; const int col0 = 128 * (ct & 7);
                f32x4 acc[4];
#pragma unroll
                for (int rb = 0; rb < 4; ++rb) acc[rb] = (f32x4){0.f, 0.f, 0.f, 0.f};
                for (int k0 = 0; k0 < 1024; k0 += 128) {
                    __syncthreads();
#pragma unroll
                    for (int i = 0; i < 4; ++i) { const int p = tid + 512 * i, row = p >> 5, c4 = p & 31;
                        const f32x4 a = *(const f32x4*)(mem + (size_t)(64 * rt + row) * D + k0 + 4 * c4);
                        u32x2 w; w.x = pk2(a.x, a.y); w.y = pk2(a.z, a.w); *(LAS u32x2*)(As + row * 272 + c4 * 8) = w; }
#pragma unroll
                    for (int i = 0; i < 8; ++i) { const int p = tid + 512 * i, k = p >> 5, c4 = p & 31;
                        const f32x4 a = *(const f32x4*)(W + (size_t)(k0 + k) * D + col0 + 4 * c4);
                        LAS unsigned short* bp = (LAS unsigned short*)(Bs + (4 * c4) * 272 + k * 2);
                        const unsigned w0 = pk2(a.x, a.y), w1 = pk2(a.z, a.w);
                        bp[0] = (unsigned short)(w0 & 0xffffu); bp[136] = (unsigned short)(w0 >> 16); bp[272] = (unsigned short)(w1 & 0xffffu); bp[408] = (unsigned short)(w1 >> 16); }
                    __syncthreads();
#pragma unroll
                    for (int kk = 0; kk < 4; ++kk) {
                        const bf16x8 bfr = *(const LAS bf16x8*)(Bs + (16 * wave + (lane & 15)) * 272 + (32 * kk + 8 * (lane >> 4)) * 2);
#pragma unroll
                        for (int rb = 0; rb < 4; ++rb) { const bf16x8 afr = *(const LAS bf16x8*)(As + (16 * rb + (lane & 15)) * 272 + (32 * kk + 8 * (lane >> 4)) * 2); acc[rb] = mfma16(afr, bfr, acc[rb]); }
                    }
                }
#pragma unroll
                for (int rb = 0; rb < 4; ++rb)
#pragma unroll
                    for (int j = 0; j < 4; ++j) { const int row = 64 * rt + 16 * rb + 4 * (lane >> 4) + j, col = 128 * ct + 16 * wave + (lane & 15);
                        KVx[(size_t)row * 2048 + col] = (bf16)(pk2(acc[rb][j], 0.f) & 0xffffu); }
            }
            __syncthreads();
        }
        {
            LAS unsigned* scr = (LAS unsigned*)(lds + wave * 16384);
            const int gw = vcu * NWAVES + wave, NGW = G * NWAVES;
            constexpr int I_GU = 32 * 8 * 64, I_DN = 32 * 8 * 32, NI8 = I_GU + I_DN;
#define P0_DEC(q, W_, ldw_, WT_, sn_, dn_, k0_, sc_) do { if ((q) < I_GU) { const int e_ = (q) >> 9, rr_ = (q) & 511, kb_ = rr_ >> 6, nb_ = rr_ & 63, n0_ = 32 * nb_; const int bj_ = n0_ >> 10, rem_ = n0_ & 1023; \
                W_ = w_gu + (size_t)e_ * 1024 * 2048; ldw_ = 2048; WT_ = Wgu8 + (size_t)e_ * 2048 * 1024; sn_ = n0_; dn_ = 256 * (rem_ >> 7) + 128 * bj_ + (rem_ & 127); k0_ = 128 * kb_; sc_ = WGU_SCALE; } \
              else { const int q2_ = (q) - I_GU, e_ = q2_ >> 8, rr_ = q2_ & 255, kb_ = rr_ >> 5, nb_ = rr_ & 31; W_ = w_dn + (size_t)e_ * 1024 * 1024; ldw_ = 1024; WT_ = Wdn8 + (size_t)e_ * 1024 * 1024; sn_ = 32 * nb_; dn_ = 32 * nb_; k0_ = 128 * kb_; sc_ = WDN_SCALE; } } while (0)
            {
                f32x4 va[16], vb[16];
                const float* W; int ldw; unsigned char* WT; int sn, dn, k0; float sc;
                int it = gw;
                if (it < NI8) { P0_DEC(it, W, ldw, WT, sn, dn, k0, sc); p0_fp8_load(W, ldw, sn, k0, va, lane); }
                while (it < NI8) {
                    const int nit = it + NGW;
                    const float* W2 = W; int ldw2 = ldw; unsigned char* WT2 = WT; int sn2 = sn, dn2 = dn, k02 = k0; float sc2 = sc;
                    if (nit < NI8) { P0_DEC(nit, W2, ldw2, WT2, sn2, dn2, k02, sc2); p0_fp8_load(W2, ldw2, sn2, k02, vb, lane); }
                    p0_fp8_finish(va, WT, 1024, dn, k0, sc, scr, lane);
#pragma unroll
                    for (int i = 0; i < 16; ++i) va[i] = vb[i];
                    W = W2; ldw = ldw2; WT = WT2; sn = sn2; dn = dn2; k0 = k02; sc = sc2; it = nit;
                }
            }
#undef P0_DEC
            constexpr int I_IN = 16 * 48, I_SQ = 16 * 16, NIB = I_IN + 3 * I_SQ;
            for (int it = gw; it < NIB; it += NGW) {
                int q = it;
                if (q < I_IN) { const int kb = q / 48, nb = q % 48, dn0 = 64 * nb; const int sn0 = dn0 < 1536 ? dn0 : (dn0 < 2560 ? dn0 + 8 : dn0 + 16);
                    p0_transpose_bf16(w_in, NIN, 1024, Win_t, sn0, dn0, 64 * kb, scr, lane); continue; }
                q -= I_IN;
                { const int which = q / I_SQ, rr = q % I_SQ, kb = rr >> 4, nb = rr & 15;
                  const float* W = which == 0 ? w_out : (which == 1 ? w_xq : w_xo); bf16* WT = which == 0 ? Wout_t : (which == 1 ? Wxq_t : Wxo_t);
                  p0_transpose_bf16(W, 1024, 1024, WT, 64 * nb, 64 * nb, 64 * kb, scr, lane); }
            }
        }
        END_PHASE(0);
    }

    if (IN(1)) for (int rep = 0; rep < REPS(1); ++rep) {
        pg8::StaticSched S; S.init(XB, Win_t, M, NU, D, G, bx);
        pg8::EpiBf16 E{U, NU, nullptr, 0, 1.f};
        pg8::gemm_phase<pg8::EpiBf16, pg8::StaticSched, false, true>(lds, D, S, E);
        END_PHASE(1);
    }

    if (IN(2)) for (int rep = 0; rep < REPS(2); ++rep) {
        for (int u = bx; u < 256; u += G) m1_unit(u >> 4, u & 15, U, Gt, conv_w, Mq, Mk, KvT, Nc, Gc, Mloc, lds);
        __syncthreads();
        for (int sq = bx; sq < 32; sq += G) {
            const int b8 = sq >> 3, h8 = sq & 7; LAS float* wt = (LAS float*)lds;
            float v[8]; float run = 0.f;
#pragma unroll
            for (int i = 0; i < 8; ++i) { run += Gt[(size_t)(b8 * SEQ + 8 * tid + i) * 16 + h8]; v[i] = run; }
            const float incl = wave_scan_add(run, lane);
            if (lane == 63) wt[wave] = incl;
            __syncthreads();
            float off = incl - run;
            for (int w = 0; w < wave; ++w) off += wt[w];
#pragma unroll
            for (int i = 0; i < 8; ++i) Fc2[(size_t)sq * SEQ + 8 * tid + i] = -(off + v[i]) * LOG2E;
            __syncthreads();
        }
        for (int ch = bx; ch < 256; ch += G) { const int sq = ch >> 3, pos = 512 * (ch & 7) + tid;
            const u32x4* kp = (const u32x4*)(U + (size_t)((sq >> 3) * SEQ + pos) * NU + UC_FK + (sq & 7) * 64); float s2 = 0.f;
#pragma unroll
            for (int c = 0; c < 8; ++c) { const u32x4 w = kp[c]; s2 += bf_lo(w.x) * bf_lo(w.x) + bf_hi(w.x) * bf_hi(w.x) + bf_lo(w.y) * bf_lo(w.y) + bf_hi(w.y) * bf_hi(w.y) + bf_lo(w.z) * bf_lo(w.z) + bf_hi(w.z) * bf_hi(w.z) + bf_lo(w.w) * bf_lo(w.w) + bf_hi(w.w) * bf_hi(w.w); }
            s2 = wave_max(s2);
            if (lane == 0) __hip_atomic_fetch_max(ctl + CW_KMAX + sq, __float_as_uint(s2), RLX_AGENT); }
        END_PHASE(2);
    }

    if (IN(3)) for (int rep = 0; rep < REPS(3); ++rep) {
        LAS float* sg = (LAS float*)lds;
        for (int ch = bx; ch < 256; ch += G) {
            const int bh = ch >> 4, part = ch & 15, idx = 512 * part + tid;
            __syncthreads();
            if (tid < 64) { sg[tid] = Gc[bh * 64 + tid]; sg[64 + tid] = Mloc[bh * 64 + tid]; }
            __syncthreads();
            if (tid == 0) { float mm = 0.f;
                for (int c = 0; c < 64; ++c) { const float g = sg[c], mc = sg[64 + c]; if (part == 0) Mp[bh * 64 + c] = mm; const float mn = fmaxf(g + mm, mc); sg[128 + c] = expf(g + mm - mn); sg[192 + c] = expf(mc - mn); mm = mn; } }
            __syncthreads();
            float C = 0.f;
            const float* kp = KvT + (size_t)bh * 64 * 8192 + idx; bf16* cp = CpT + (size_t)bh * 64 * 8192 + idx;
            float kvv[64];
#pragma unroll
            for (int c = 0; c < 64; ++c) kvv[c] = kp[(size_t)c * 8192];
#pragma unroll
            for (int c = 0; c < 64; ++c) { cp[(size_t)c * 8192] = (bf16)(pk2(C, 0.f) & 0xffffu); C = sg[128 + c] * C + sg[192 + c] * kvv[c]; }
            if (part == 0 && tid < 64) { float n = 0.f;
#pragma unroll 8
                for (int c = 0; c < 64; ++c) { Np[(size_t)(bh * 64 + c) * 64 + tid] = n; n = sg[128 + c] * n + sg[192 + c] * Nc[(size_t)(bh * 64 + c) * 64 + tid]; } }
        }
        END_PHASE(3);
    }

    if (IN(4)) for (int rep = 0; rep < REPS(4); ++rep) {
        for (int pr = vcu; pr < 256; pr += G) { const int bh8 = pr >> 3, s = pr & 7;
            fox_unit(bh8 >> 3, bh8 & 7, 15 - s, U, Fc2, ctl + CW_KMAX, fox_g, MIX, lds);
            fox_unit(bh8 >> 3, bh8 & 7, s, U, Fc2, ctl + CW_KMAX, fox_g, MIX, lds); }
        for (int u = bx; u < 256; u += G) m3_unit(u >> 4, u & 15, U, Gt, Mq, Mk, CpT, Np, Mp, mlstm_g, MIX, lds);
        END_PHASE(4);
    }

    if (IN(5)) for (int rep = 0; rep < REPS(5); ++rep) {
        pg8::StaticSched S; S.init(MIX, Wout_t, M, D, D, G, bx);
        pg8::EpiResBf16 E{XB, Y1, D, ALPHA};
        pg8::gemm_phase<pg8::EpiResBf16, pg8::StaticSched, false, false>(lds, D, S, E);
        END_PHASE(5);
    }

    if (IN(6)) for (int rep = 0; rep < REPS(6); ++rep) {
        for (int m = bx * 8 + wave; m < M; m += G * 8) {
            f32x4 v[4];
            load_row_bf16(Y1 + (size_t)m * D, v, lane);
            ln_row(v, ln1_g, ln1_b, lane);
            store_row_bf16(X1B + (size_t)m * D, v, lane);
        }
        END_PHASE(6);
    }

    if (IN(7)) for (int rep = 0; rep < REPS(7); ++rep) {
        pg8::StaticSched S; S.init(X1B, Wxq_t, M, D, D, G, bx);
        pg8::EpiBf16 E{QX, D, nullptr, 0, 1.f};
        pg8::gemm_phase<pg8::EpiBf16, pg8::StaticSched, false, false>(lds, D, S, E);
        END_PHASE(7);
    }

    if (IN(8)) for (int rep = 0; rep < REPS(8); ++rep) {
        for (int u = vcu; u < 256; u += G) xattn_unit(u >> 6, (u >> 4) & 3, u & 15, QX, KVx, lds);
        END_PHASE(8);
    }

    if (IN(9)) for (int rep = 0; rep < REPS(9); ++rep) {
        pg8::StaticSched S; S.init(QX, Wxo_t, M, D, D, G, bx);
        pg8::EpiResBf16 E{X1B, Y2, D, ALPHA};
        pg8::gemm_phase<pg8::EpiResBf16, pg8::StaticSched, false, false>(lds, D, S, E);
        END_PHASE(9);
    }

    if (IN(10)) for (int rep = 0; rep < REPS(10); ++rep) {
        LAS float* wrT = (LAS float*)lds;
        LAS int* hist = (LAS int*)(lds + RT_OFF); LAS int* ebase = hist + 32; LAS int* tokE = hist + 64; LAS int* tokR = hist + 320;
        __syncthreads();
        for (int idx = tid; idx < 1024 * 8; idx += 512) { const int k = idx >> 3, e4 = (idx & 7) * 4; const f32x4 w = *(const f32x4*)(w_router + k * 32 + e4);
            wrT[(e4 + 0) * 1024 + k] = w.x; wrT[(e4 + 1) * 1024 + k] = w.y; wrT[(e4 + 2) * 1024 + k] = w.z; wrT[(e4 + 3) * 1024 + k] = w.w; }
        if (tid < 32) hist[tid] = 0;
        __syncthreads();
        for (int grp = bx; grp < M / 64; grp += G) {
            for (int tl = wave; tl < 64; tl += 8) {
                const int tok = grp * 64 + tl;
                f32x4 v[4];
                load_row_bf16(Y2 + (size_t)tok * D, v, lane);
                ln_row(v, ln2_g, ln2_b, lane);
                store_row_bf16(X2B + (size_t)tok * D, v, lane);
                store_row_fp8(X2F8 + (size_t)tok * D, v, X2_SCALE, lane);
                float acc[32];
#pragma unroll
                for (int e = 0; e < 32; ++e) { float a = 0.f;
#pragma unroll
                    for (int j = 0; j < 4; ++j) { const f32x4 w = *(const LAS f32x4*)(wrT + e * 1024 + 256 * j + 4 * lane); a += (v[j].x * w.x + v[j].y * w.y) + (v[j].z * w.z + v[j].w * w.w); }
                    acc[e] = a; }
#define TR_STEP(HALFN, XORM) { const bool up = (lane & (XORM)) != 0; _Pragma("unroll") for (int i = 0; i < (HALFN); ++i) { const float keep = up ? acc[(HALFN) + i] : acc[i], send = up ? acc[i] : acc[(HALFN) + i]; acc[i] = keep + __shfl_xor(send, (XORM)); } }
                TR_STEP(16, 16) TR_STEP(8, 8) TR_STEP(4, 4) TR_STEP(2, 2) TR_STEP(1, 1)
#undef TR_STEP
                float lg = acc[0] + __shfl_xor(acc[0], 32);
                lg += b_router[lane & 31];
                float tv[4]; int ti[4]; float cur = lg;
#pragma unroll
                for (int k = 0; k < 4; ++k) {
                    float bv = cur; int bi = lane & 31;
#pragma unroll
                    for (int o = 1; o < 32; o <<= 1) { const float ov = __shfl_xor(bv, o); const int oi = __shfl_xor(bi, o); if (ov > bv || (ov == bv && oi < bi)) { bv = ov; bi = oi; } }
                    tv[k] = bv; ti[k] = bi; if ((lane & 31) == bi) cur = -INFINITY;
                }
                const float e1 = expf(tv[1] - tv[0]), e2 = expf(tv[2] - tv[0]), e3 = expf(tv[3] - tv[0]); const float isum = 1.f / (1.f + e1 + e2 + e3);
                if (lane == 0) {
                    const float gs[4] = {isum, e1 * isum, e2 * isum, e3 * isum};
#pragma unroll
                    for (int k = 0; k < 4; ++k) { const int rk = atomicAdd((int*)&hist[ti[k]], 1); tokE[tl * 4 + k] = ti[k]; tokR[tl * 4 + k] = rk; Tidx[tok * 4 + k] = ti[k]; Tgate[tok * 4 + k] = gs[k]; }
                }
            }
            __syncthreads();
            if (tid < 32) { const int c = hist[tid]; ebase[tid] = c ? (int)__hip_atomic_fetch_add(ctl + CW_CNT + 64 * tid, (unsigned)c, RLX_AGENT) : 0; hist[tid] = 0; }
            __syncthreads();
            if (tid < 256) { const int tl = tid >> 2, e = tokE[tid], slot = ebase[e] + tokR[tid]; List[(size_t)e * LCAP + slot] = grp * 64 + tl; Tslot[(grp * 64 + tl) * 4 + (tid & 3)] = slot; }
            __syncthreads();
        }
        END_PHASE(10);
    }

    if (IN(11)) for (int rep = 0; rep < REPS(11); ++rep) {
        LAS int* tb = (LAS int*)(lds + MOE_TB_OFF);
        moe_tables(tb, ctl, tid);
        pg8::MoeSched S; S.A = (const char*)X2F8; S.B = (const char*)Wgu8; S.list = List; S.tb = tb; S.K = 512; S.NT = 8; S.nwg = __builtin_amdgcn_readfirstlane(tb[32]) * 8; S.G = G; S.c = bx; S.bexp = (size_t)2048 * 1024; S.gather = true;
        pg8::EpiSwiglu E{HID8, b_gu, 1.f / (WGU_SCALE * X2_SCALE), HID_SCALE};
        pg8::gemm_phase<pg8::EpiSwiglu, pg8::MoeSched, true, true, true>(lds, 512, S, E);
        END_PHASE(11);
    }

    if (IN(12)) for (int rep = 0; rep < REPS(12); ++rep) {
        LAS int* tb = (LAS int*)(lds + MOE_TB_OFF);
        moe_tables(tb, ctl, tid);
        pg8::MoeSched S; S.A = (const char*)HID8; S.B = (const char*)Wdn8; S.list = List; S.tb = tb; S.K = 512; S.NT = 4; S.nwg = __builtin_amdgcn_readfirstlane(tb[32]) * 4; S.G = G; S.c = bx; S.bexp = (size_t)1024 * 1024; S.gather = false;
        pg8::EpiBf16 E{YB, D, b_dn, 1024, 1.f / (WDN_SCALE * HID_SCALE)};
        pg8::gemm_phase<pg8::EpiBf16, pg8::MoeSched, false, true, true>(lds, 512, S, E);
        END_PHASE(12);
    }

    if (IN(13)) for (int rep = 0; rep < REPS(13); ++rep) {
        LAS int* tb = (LAS int*)(lds + MOE_TB_OFF);
        moe_tables(tb, ctl, tid);
        for (int m0 = (bx * 8 + wave) * 2; m0 < M; m0 += G * 16) {
            int rowi = 0; float gk = 0.f;
            if (lane < 8) { const int q = (m0 + (lane >> 2)) * 4 + (lane & 3); const int e = Tidx[q]; rowi = tb[e] * 256 + Tslot[q]; gk = Tgate[q]; }
            f32x4 v[2][4]; u32x2 y[2][4][4]; float gg[2][4];
#pragma unroll
            for (int t = 0; t < 2; ++t) {
                const u32x2* xr = (const u32x2*)(X2B + (size_t)(m0 + t) * D) + lane;
#pragma unroll
                for (int j = 0; j < 4; ++j) { const u32x2 w = xr[64 * j]; v[t][j] = (f32x4){bf_lo(w.x), bf_hi(w.x), bf_lo(w.y), bf_hi(w.y)}; }
#pragma unroll
                for (int k = 0; k < 4; ++k) { const int rk = __shfl(rowi, 4 * t + k); gg[t][k] = __shfl(gk, 4 * t + k);
                    const u32x2* yr = (const u32x2*)(YB + (size_t)rk * D) + lane;
#pragma unroll
                    for (int j = 0; j < 4; ++j) y[t][k][j] = yr[64 * j]; }
            }
#pragma unroll
            for (int t = 0; t < 2; ++t) {
#pragma unroll
                for (int j = 0; j < 4; ++j) v[t][j] = v[t][j] * ALPHA;
#pragma unroll
                for (int k = 0; k < 4; ++k)
#pragma unroll
                    for (int j = 0; j < 4; ++j) { const u32x2 w = y[t][k][j]; const float g1 = gg[t][k]; v[t][j].x += g1 * bf_lo(w.x); v[t][j].y += g1 * bf_hi(w.x); v[t][j].z += g1 * bf_lo(w.y); v[t][j].w += g1 * bf_hi(w.y); }
                ln_row(v[t], ln3_g, ln3_b, lane);
                f32x4* orow = (f32x4*)(out + (size_t)(m0 + t) * D) + lane;
#pragma unroll
                for (int j = 0; j < 4; ++j) orow[64 * j] = v[t][j];
            }
        }
        if (rep + 1 < REPS(13)) GRID_BAR();
    }
#undef IN
#undef BOTH
#undef GRID_BAR
}

extern "C" void kernel_launch(void* const* d_in, const int* in_sizes, int n_in, void* d_out, int out_size, void* d_ws, size_t ws_size, hipStream_t stream) {
    static int grid = 0;
    if (grid == 0) {
        if (n_in != 26 || in_sizes[0] != M * D || out_size != M * D || ws_size < WS_END) { fprintf(stderr, "kernel_launch: unexpected shapes (n_in %d, in0 %d, out %d, ws %zu)\n", n_in, n_in > 0 ? in_sizes[0] : -1, out_size, ws_size); grid = -1; return; }
        int dev = 0, cus = 0, per_cu = 0;
        if (hipGetDevice(&dev) != hipSuccess || hipDeviceGetAttribute(&cus, hipDeviceAttributeMultiprocessorCount, dev) != hipSuccess) { grid = -1; return; }
        if (hipFuncSetAttribute((const void*)fwd, hipFuncAttributeMaxDynamicSharedMemorySize, LDS_BYTES) != hipSuccess) { fprintf(stderr, "kernel_launch: hipFuncSetAttribute failed\n"); grid = -1; return; }
        if (hipOccupancyMaxActiveBlocksPerMultiprocessor(&per_cu, (const void*)fwd, NWAVES * 64, LDS_BYTES) != hipSuccess || per_cu < 1) fprintf(stderr, "kernel_launch: occupancy query reports %d\n", per_cu);
        (void)hipGetLastError();
        grid = cus;
    }
    if (grid < 0) return;
    if (hipMemsetAsync((char*)d_ws + WS_CTL, 0, CTL_ZERO_BYTES, stream) != hipSuccess) return;
    Args a{};
    for (int i = 0; i < 26; ++i) a.in[i] = (const float*)d_in[i];
    a.out = (float*)d_out; a.ws = (unsigned char*)d_ws;
    if (N_LAUNCHES == 1) {
        a.ph_lo = 0; a.ph_hi = NPHASE; a.li = 0;
        hipLaunchKernelGGL(fwd, dim3(grid), dim3(NWAVES * 64), LDS_BYTES, stream, a);
    } else {
        for (int li = 0; li < NPHASE; ++li) { a.ph_lo = li; a.ph_hi = li + 1; a.li = li; hipLaunchKernelGGL(fwd, dim3(grid), dim3(NWAVES * 64), LDS_BYTES, stream, a); }
    }
}
```

```cpp
#include <hip/hip_runtime.h>
#include <cstdio>
#include <cstdint>
#include <cmath>

#define DI __device__ __forceinline__
#define LAS __attribute__((address_space(3)))
#define GAS __attribute__((address_space(1)))
typedef unsigned short bf16;
typedef short bf16x8 __attribute__((ext_vector_type(8)));
typedef short s16x4 __attribute__((ext_vector_type(4)));
typedef float f32x2 __attribute__((ext_vector_type(2)));
typedef float f32x4 __attribute__((ext_vector_type(4)));
typedef float f32x16 __attribute__((ext_vector_type(16)));
typedef unsigned u32x2 __attribute__((ext_vector_type(2)));
typedef unsigned u32x4 __attribute__((ext_vector_type(4)));
typedef GAS unsigned gu32;

#ifndef MK_N_LAUNCHES
#define MK_N_LAUNCHES 1
#endif

constexpr int BATCH = 4, SEQ = 4096, D = 1024, M = BATCH * SEQ, NMEM = 256;
constexpr int NIN = 3088;
constexpr int NU = 3072;
constexpr int UC_FQ = 0, UC_FK = 512, UC_FV = 1024, UC_MQ = 1536, UC_MK = 1792, UC_MV = 2048, UC_MO = 2560;
constexpr int NE = 32, TOPK = 4, LCAP = 16384;
constexpr int PROWS = M * TOPK + NE * 256;
constexpr float ALPHA = 1.189207115002721f;
constexpr float LOG2E = 1.4426950408889634f;
constexpr float LN_EPS = 1e-5f, RMS_EPS = 1e-6f;
constexpr int NPHASE = 14;
constexpr float WGU_SCALE = 32.f, WDN_SCALE = 64.f, X2_SCALE = 4.f, HID_SCALE = 4.f;
constexpr int N_LAUNCHES = MK_N_LAUNCHES;

constexpr size_t MiB = 1u << 20;
constexpr size_t WS_CTL = 0, CTL_ZERO_BYTES = 1 * MiB;
constexpr size_t WS_G = 1 * MiB;
constexpr size_t WS_FC2 = 2 * MiB;
constexpr size_t WS_GC = 2 * MiB + 512 * 1024;
constexpr size_t WS_NC = 3 * MiB;
constexpr size_t WS_NP = 3 * MiB + 256 * 1024;
constexpr size_t WS_TIDX = 3 * MiB + 512 * 1024;
constexpr size_t WS_TGATE = 3 * MiB + 768 * 1024;
constexpr size_t WS_TSLOT = 4 * MiB;
constexpr size_t WS_LIST = 5 * MiB;
constexpr size_t WS_MEMKV = 8 * MiB;
constexpr size_t WS_WIN = 16 * MiB, WS_WOUT = 22 * MiB, WS_WXQ = 24 * MiB, WS_WXO = 26 * MiB;
constexpr size_t WS_WGU = 32 * MiB, WS_WDN = 160 * MiB;
constexpr size_t WS_XB = 224 * MiB;
constexpr size_t WS_U = 256 * MiB;
constexpr size_t WS_MQ = 352 * MiB, WS_MK = 360 * MiB;
constexpr size_t WS_KVT = 368 * MiB;
constexpr size_t WS_CPT = 400 * MiB;
constexpr size_t WS_MIX = 432 * MiB;
constexpr size_t WS_Y1 = 464 * MiB;
constexpr size_t WS_X1B = 528 * MiB;
constexpr size_t WS_QX = 560 * MiB;
constexpr size_t WS_Y2 = 596 * MiB;
constexpr size_t WS_X2B = 660 * MiB;
constexpr size_t WS_HID = 692 * MiB;
constexpr size_t WS_YB = 836 * MiB;
constexpr size_t WS_END = 980 * MiB;
constexpr int CW_TMO = 0, CW_CODE = 1;
constexpr int CW_CNT = 1024;
constexpr int CW_BAR = 4096;
static_assert(CW_CNT + 64 * 31 < 3200 && 3200 + 32 <= CW_BAR, "CTL words: expert counts, key-norm words and the barrier region must not overlap");
constexpr int CW_KMAX = 3200;

constexpr int RING_BYTES = 131072;
constexpr int LDSCTL_OFF = RING_BYTES, MISC_OFF = LDSCTL_OFF + 320;
constexpr int MOE_TB_OFF = LDSCTL_OFF + 1024;
constexpr int RT_OFF = LDSCTL_OFF + 2048;
constexpr int LDS_BYTES = 147456;
constexpr int NWAVES = 8;

#define RLX_AGENT __ATOMIC_RELAXED, __HIP_MEMORY_SCOPE_AGENT
DI float bf_lo(unsigned u) { return __uint_as_float(u << 16); }
DI float bf_hi(unsigned u) { return __uint_as_float(u & 0xffff0000u); }
DI float bf2f(short s) { return __uint_as_float(((unsigned)(unsigned short)s) << 16); }
typedef __bf16 bf16x2_t __attribute__((ext_vector_type(2)));
DI unsigned pk2(float lo, float hi) { f32x2 v = {lo, hi}; bf16x2_t b = __builtin_convertvector(v, bf16x2_t); return __builtin_bit_cast(unsigned, b); }
DI float wave_sum(float v) {
#pragma unroll
    for (int o = 1; o < 64; o <<= 1) v += __shfl_xor(v, o);
    return v;
}
DI float wave_max(float v) {
#pragma unroll
    for (int o = 1; o < 64; o <<= 1) v = fmaxf(v, __shfl_xor(v, o));
    return v;
}
DI float wave_scan_add(float v, int lane) {
#pragma unroll
    for (int o = 1; o < 64; o <<= 1) { const float t = __shfl_up(v, o); if (lane >= o) v += t; }
    return v;
}
DI float wave_scan_max(float v, int lane) {
#pragma unroll
    for (int o = 1; o < 64; o <<= 1) { const float t = __shfl_up(v, o); if (lane >= o) v = fmaxf(v, t); }
    return v;
}
DI float xhalf_sum(float v) { return v + __shfl_xor(v, 32); }
DI float xhalf_max(float v) { return fmaxf(v, __shfl_xor(v, 32)); }
DI float ex2(float x) { return __builtin_amdgcn_exp2f(x); }
DI float exp_fast(float x) { return __builtin_amdgcn_exp2f(x * LOG2E); }
DI float sigmoid_fast(float x) { return __builtin_amdgcn_rcpf(1.f + exp_fast(-x)); }
DI float log_sigmoid_acc(float x) { return fminf(x, 0.f) - log1pf(expf(-fabsf(x))); }
DI f32x16 mfma32(bf16x8 a, bf16x8 b, f32x16 c) { return __builtin_amdgcn_mfma_f32_32x32x16_bf16(a, b, c, 0, 0, 0); }
DI f32x4 mfma16(bf16x8 a, bf16x8 b, f32x4 c) { return __builtin_amdgcn_mfma_f32_16x16x32_bf16(a, b, c, 0, 0, 0); }
typedef short v4i16_t __attribute__((ext_vector_type(4)));
DI s16x4 tr_read(const LAS unsigned char* p) { return __builtin_bit_cast(s16x4, __builtin_amdgcn_ds_read_tr16_b64_v4i16((LAS v4i16_t*)p)); }
DI bf16x8 cat8(s16x4 lo, s16x4 hi) { return __builtin_shufflevector(lo, hi, 0, 1, 2, 3, 4, 5, 6, 7); }
typedef int v8i32 __attribute__((ext_vector_type(8)));
typedef int v4i32 __attribute__((ext_vector_type(4)));
DI unsigned pk4_fp8(float a, float b, float c, float d) { int w = 0; w = __builtin_amdgcn_cvt_pk_fp8_f32(a, b, w, false); w = __builtin_amdgcn_cvt_pk_fp8_f32(c, d, w, true); return (unsigned)w; }
DI int crow(int r, int hi) { return (r & 3) + 8 * (r >> 2) + 4 * hi; }
DI bf16x8 pack8(const f32x16& x, int s) {
    u32x4 p;
    p.x = pk2(x[8 * s + 0], x[8 * s + 1]); p.y = pk2(x[8 * s + 2], x[8 * s + 3]); p.z = pk2(x[8 * s + 4], x[8 * s + 5]); p.w = pk2(x[8 * s + 6], x[8 * s + 7]);
    return __builtin_bit_cast(bf16x8, p);
}

namespace pg8 {
constexpr int BM = 256, BK = 64, HALF = 128, HTB = HALF * BK * 2, STAGE_BYTES = 8 * HTB, NXCD = 8, WGM = 8;
__host__ __device__ __forceinline__ int lds_byte(int r, int c) { const int st = (r >> 4) * 2 + (c >> 5), rr = r & 15, cc = c & 31, ob = rr * 64 + cc * 2; return st * 1024 + (ob ^ (((ob >> 9) & 1) << 5)); }
__host__ __device__ __forceinline__ void stage_rc(int b, int& R, int& C) { const int st = b / 1024, sb = b % 1024, swz = sb ^ (((sb >> 9) & 1) << 5); R = (st >> 1) * 16 + swz / 64; C = (st & 1) * 32 + (swz % 64) / 2; }
__host__ __device__ __forceinline__ int perm32(int rho) { const int n = rho >> 4, i = rho & 15; return 8 * (i >> 2) + 4 * n + (i & 3); }

struct Unit { int pm, pn, e, nvalid; const char* A; const char* B; const int* list; };

struct StaticSched {
    const char* A; const char* B; int K, nM, nN, nwg, G, c;
    DI void init(const void* A_, const void* B_, int M_, int N_, int K_, int G_, int c_) { A = (const char*)A_; B = (const char*)B_; K = K_; nM = M_ / BM; nN = N_ / BM; nwg = nM * nN; G = G_; c = c_; }
    DI bool next(int i, Unit& u) const {
        const long L = (long)i * G + c; if (L >= nwg) return false;
        int wgid = (int)L; { const int q = nwg / NXCD, r = nwg % NXCD, xcd = wgid % NXCD, off = wgid / NXCD; wgid = (xcd < r ? xcd * (q + 1) : r * (q + 1) + (xcd - r) * q) + off; }
        const int nig = WGM * nN, gid = wgid / nig, fm = gid * WGM, gsz = (nM - fm) < WGM ? (nM - fm) : WGM;
        u.pm = fm + ((wgid % nig) % gsz); u.pn = (wgid % nig) / gsz; u.e = 0; u.nvalid = BM; u.list = nullptr;
        u.A = A + (size_t)u.pm * BM * K * 2; u.B = B + (size_t)u.pn * BM * K * 2; return true;
    }
};
struct MoeSched {
    const char* A; const char* B; const int* list; const LAS int* tb; int K, NT, nwg, G, c; size_t bexp; bool gather;
    DI bool next(int i, Unit& u) const {
        const long L = (long)i * G + c; if (L >= nwg) return false;
        int wgid = (int)L; { const int q = nwg / NXCD, r = nwg % NXCD, xcd = wgid % NXCD, off = wgid / NXCD; wgid = (xcd < r ? xcd * (q + 1) : r * (q + 1) + (xcd - r) * q) + off; }
        const int g = wgid / NT, nt = wgid % NT;
        int e = 0;
#pragma unroll
        for (int j = 1; j < 32; ++j) e += (tb[j] <= g) ? 1 : 0;
        e = __builtin_amdgcn_readfirstlane(e);
        const int mt = g - __builtin_amdgcn_readfirstlane(tb[e]);
        u.pm = g; u.pn = nt; u.e = e; u.nvalid = __builtin_amdgcn_readfirstlane(tb[40 + e]) - mt * BM; u.list = list + (size_t)e * LCAP + mt * BM;
        u.A = gather ? A : A + (size_t)g * BM * K * 2; u.B = B + (size_t)e * bexp + (size_t)nt * BM * K * 2; return true;
    }
};

template <bool GATHER> DI void a_offsets(const Unit& u, int K, unsigned (&v)[2][2]) {
    int R[2], C[2];
#pragma unroll
    for (int i = 0; i < 2; ++i) stage_rc((int)threadIdx.x * 16 + i * 8192, R[i], C[i]);
#pragma unroll
    for (int h = 0; h < 2; ++h)
#pragma unroll
        for (int i = 0; i < 2; ++i) {
            const int row = h * HALF + R[i];
            if constexpr (GATHER) { const int rc = row < u.nvalid ? row : u.nvalid - 1; const int tok = u.list[rc]; v[h][i] = (unsigned)(tok * K + C[i]) * 2u; }
            else v[h][i] = (unsigned)(row * K + C[i]) * 2u;
        }
}

struct EpiBf16 {
    static constexpr bool PERM = true;
    bf16* O; int ldc; const float* bias; int bias_estride; float scale;
    DI void operator()(const f32x4 (&acc)[2][2][4][2], const Unit& u, int wr, int wc, int fr, int fq) const {
        const int row0 = u.pm * BM + wr * 64 + fr; const int col0 = u.pn * BM + wc * 32 + 8 * fq;
        f32x4 bv[2][2];
#pragma unroll
        for (int bj = 0; bj < 2; ++bj)
#pragma unroll
            for (int n = 0; n < 2; ++n) bv[bj][n] = bias ? *(const f32x4*)(bias + (size_t)u.e * bias_estride + col0 + bj * HALF + 4 * n) : (f32x4){0.f, 0.f, 0.f, 0.f};
#pragma unroll
        for (int ai = 0; ai < 2; ++ai)
#pragma unroll
            for (int m = 0; m < 4; ++m) { bf16* rowp = O + (size_t)(row0 + ai * HALF + m * 16) * ldc + col0;
#pragma unroll
                for (int bj = 0; bj < 2; ++bj) { const f32x4 v0 = acc[ai][bj][m][0] * scale + bv[bj][0], v1 = acc[ai][bj][m][1] * scale + bv[bj][1];
                    u32x4 w; w.x = pk2(v0[0], v0[1]); w.y = pk2(v0[2], v0[3]); w.z = pk2(v1[0], v1[1]); w.w = pk2(v1[2], v1[3]);
                    *(u32x4*)(rowp + bj * HALF) = w; } }
    }
};
struct EpiResF32 {
    static constexpr bool PERM = false;
    const float* base; float* out; int ldc; float alpha;
    DI void operator()(const f32x4 (&acc)[2][2][4][2], const Unit& u, int wr, int wc, int fr, int fq) const {
        const int col0 = u.pn * BM + wc * 32 + 4 * fq;
#pragma unroll
        for (int ai = 0; ai < 2; ++ai)
#pragma unroll
            for (int m = 0; m < 4; ++m) { const size_t off = (size_t)(u.pm * BM + ai * HALF + wr * 64 + m * 16 + fr) * ldc + col0;
#pragma unroll
                for (int bj = 0; bj < 2; ++bj)
#pragma unroll
                    for (int n = 0; n < 2; ++n) { const f32x4 bs = *(const f32x4*)(base + off + bj * HALF + n * 16); *(f32x4*)(out + off + bj * HALF + n * 16) = bs * alpha + acc[ai][bj][m][n]; } }
    }
};
struct EpiResBf16 {
    static constexpr bool PERM = true;
    const bf16* base; bf16* out; int ldc; float alpha;
    DI void operator()(const f32x4 (&acc)[2][2][4][2], const Unit& u, int wr, int wc, int fr, int fq) const {
        const int row0 = u.pm * BM + wr * 64 + fr; const int col0 = u.pn * BM + wc * 32 + 8 * fq;
#pragma unroll
        for (int ai = 0; ai < 2; ++ai)
#pragma unroll
            for (int m = 0; m < 4; ++m) { const size_t off = (size_t)(row0 + ai * HALF + m * 16) * ldc + col0;
#pragma unroll
                for (int bj = 0; bj < 2; ++bj) { const u32x4 b = *(const u32x4*)(base + off + bj * HALF); const f32x4 a0 = acc[ai][bj][m][0], a1 = acc[ai][bj][m][1];
                    u32x4 w; w.x = pk2(bf_lo(b.x) * alpha + a0[0], bf_hi(b.x) * alpha + a0[1]); w.y = pk2(bf_lo(b.y) * alpha + a0[2], bf_hi(b.y) * alpha + a0[3]);
                    w.z = pk2(bf_lo(b.z) * alpha + a1[0], bf_hi(b.z) * alpha + a1[1]); w.w = pk2(bf_lo(b.w) * alpha + a1[2], bf_hi(b.w) * alpha + a1[3]);
                    *(u32x4*)(out + off + bj * HALF) = w; } }
    }
};
struct EpiSwiglu {
    static constexpr bool PERM = true;
    unsigned char* O; const float* bias; float scale, oscale;
    DI void operator()(const f32x4 (&acc)[2][2][4][2], const Unit& u, int wr, int wc, int fr, int fq) const {
        const int row0 = u.pm * BM + wr * 64 + fr; const int j0 = wc * 32 + 8 * fq; const int col0 = u.pn * HALF + j0;
        const float* bg = bias + (size_t)u.e * 2048 + col0; const float* bl = bg + 1024;
        f32x4 bgv[2], blv[2];
#pragma unroll
        for (int n = 0; n < 2; ++n) { bgv[n] = *(const f32x4*)(bg + 4 * n); blv[n] = *(const f32x4*)(bl + 4 * n); }
#pragma unroll
        for (int ai = 0; ai < 2; ++ai)
#pragma unroll
            for (int m = 0; m < 4; ++m) { unsigned char* rowp = O + (size_t)(row0 + ai * HALF + m * 16) * 1024 + col0;
                float o[8];
#pragma unroll
                for (int n = 0; n < 2; ++n) { const f32x4 g = acc[ai][0][m][n] * scale + bgv[n], l = acc[ai][1][m][n] * scale + blv[n];
#pragma unroll
                    for (int q = 0; q < 4; ++q) { const float gg = fminf(g[q], 7.0f), ll = fminf(fmaxf(l[q], -7.0f), 7.0f);
                        o[4 * n + q] = gg * __builtin_amdgcn_rcpf(1.f + ex2(gg * (-1.702f * LOG2E))) * (ll + 1.f) * oscale; } }
                u32x2 w; w.x = pk4_fp8(o[0], o[1], o[2], o[3]); w.y = pk4_fp8(o[4], o[5], o[6], o[7]);
                *(u32x2*)rowp = w; }
    }
};

template <class Epi, class Sched, bool GATHER, bool ALIGN_EPI, bool FP8 = false>
DI void gemm_phase(LAS unsigned char* lds, const int K, const Sched& S, const Epi& E) {
    const int tid = threadIdx.x, wid = __builtin_amdgcn_readfirstlane(tid >> 6), lane = tid & 63, wr = wid >> 2, wc = wid & 3, fr = lane & 15, fq = lane >> 4;
    const int nt = K / BK;
    unsigned voffB[2];
#pragma unroll
    for (int i = 0; i < 2; ++i) { int R, C; stage_rc(tid * 16 + i * 8192, R, C); const int Rb = Epi::PERM ? ((R & ~31) + perm32(R & 31)) : R; voffB[i] = (unsigned)(Rb * K + C) * 2u; }
    const size_t kstep = (size_t)(BK * 2);
    const size_t hstep = (size_t)HALF * K * 2;
    const unsigned ldsw = (unsigned)wid * 1024u;
    const int aoff = lds_byte(wr * 64 + fr, fq * 8), boff = lds_byte(wc * 32 + fr, fq * 8);
#define PG8_SA(b, h) (((b) * 2 + (h)) * HTB)
#define PG8_SB(b, h) ((4 + (b) * 2 + (h)) * HTB)
#define PG8_STAGE(bufoff, gbase, voff) do { _Pragma("unroll") for (int _i = 0; _i < 2; ++_i) { unsigned _o = (voff)[_i]; asm volatile("" : "+v"(_o));   \
        __builtin_amdgcn_global_load_lds((const unsigned*)((const char*)(gbase) + _o), (LAS unsigned*)(lds + (bufoff) + ldsw + _i * 8192), 16, 0, 0); } } while (0)
#define PG8_LDA(dst, b, h) do { _Pragma("unroll") for (int m = 0; m < 4; ++m) _Pragma("unroll") for (int k = 0; k < 2; ++k) dst[m][k] = *(const LAS bf16x8*)(lds + PG8_SA(b, h) + aoff + m * 2048 + k * 1024); } while (0)
#define PG8_LDB(dst, b, h) do { _Pragma("unroll") for (int n = 0; n < 2; ++n) _Pragma("unroll") for (int k = 0; k < 2; ++k) dst[n][k] = *(const LAS bf16x8*)(lds + PG8_SB(b, h) + boff + n * 2048 + k * 1024); } while (0)
#define PG8_CAT(x) __builtin_shufflevector(__builtin_bit_cast(v4i32, x[0]), __builtin_bit_cast(v4i32, x[1]), 0, 1, 2, 3, 4, 5, 6, 7)
#define PG8_MMA(ai, bj, At, Bt) do { __builtin_amdgcn_s_setprio(1); _Pragma("unroll") for (int m = 0; m < 4; ++m) _Pragma("unroll") for (int n = 0; n < 2; ++n) { \
        if constexpr (FP8) { const v8i32 _a = PG8_CAT(Bt[n]), _b = PG8_CAT(At[m]); asm volatile("v_mfma_scale_f32_16x16x128_f8f6f4 %0, %1, %2, %0, %3, %3 op_sel_hi:[0,0,0]" : "+v"(acc[ai][bj][m][n]) : "v"(_a), "v"(_b), "v"(sc1)); } \
        else { _Pragma("unroll") for (int k = 0; k < 2; ++k) acc[ai][bj][m][n] = __builtin_amdgcn_mfma_f32_16x16x32_bf16(Bt[n][k], At[m][k], acc[ai][bj][m][n], 0, 0, 0); } } __builtin_amdgcn_s_setprio(0); } while (0)
#define PG8_WAIT_V(n) asm volatile("s_waitcnt vmcnt(" #n ")" ::: "memory")
#define PG8_WAIT_L(n) asm volatile("s_waitcnt lgkmcnt(" #n ")" ::: "memory")
#define PG8_BAR __builtin_amdgcn_s_barrier()
#define PG8_SCHED __builtin_amdgcn_sched_barrier(0)
    Unit cur, nxt; int ui = 0;
    if (!S.next(0, cur)) return;
    const int sc1 = 0x7f7f7f7f;
    unsigned vAc[2][2], vAn[2][2];
    a_offsets<GATHER>(cur, K, vAc);
    f32x4 acc[2][2][4][2];
#pragma unroll
    for (int a = 0; a < 2; ++a)
#pragma unroll
        for (int b = 0; b < 2; ++b)
#pragma unroll
            for (int m = 0; m < 4; ++m)
#pragma unroll
                for (int n = 0; n < 2; ++n) acc[a][b][m][n] = (f32x4){0.f, 0.f, 0.f, 0.f};
    bf16x8 At[4][2], B0[2][2], B1[2][2];
    const char* cA = cur.A; const char* cB = cur.B;
    PG8_STAGE(PG8_SB(0, 0), cB, voffB); PG8_STAGE(PG8_SB(0, 1), cB + hstep, voffB); PG8_STAGE(PG8_SA(0, 0), cA, vAc[0]); PG8_STAGE(PG8_SA(0, 1), cA, vAc[1]);
    if (wr == 1) PG8_BAR;
    PG8_WAIT_V(2); PG8_BAR;
    PG8_STAGE(PG8_SB(1, 0), cB + kstep, voffB); PG8_STAGE(PG8_SA(1, 0), cA + kstep, vAc[0]); PG8_STAGE(PG8_SB(1, 1), cB + hstep + kstep, voffB);
    PG8_WAIT_V(6); PG8_BAR;
    for (;;) {
        const bool has_next = S.next(ui + 1, nxt);
        if constexpr (GATHER) {
            if (has_next) a_offsets<GATHER>(nxt, K, vAn);
            else {
#pragma unroll
                for (int h = 0; h < 2; ++h)
#pragma unroll
                    for (int i = 0; i < 2; ++i) vAn[h][i] = vAc[h][i]; }
        }
        const char* nA = has_next ? nxt.A : cA; const char* nB = has_next ? nxt.B : cB;
#pragma unroll 1
        for (int t = 0; t < nt; t += 2) {
            const bool last = (t == nt - 2);
            const char* a1 = cA + (size_t)(t + 1) * kstep;
            const char* a2 = last ? nA : cA + (size_t)(t + 2) * kstep; const char* b2 = last ? nB : cB + (size_t)(t + 2) * kstep;
            const char* a3 = a2 + kstep; const char* b3 = b2 + kstep;
            unsigned v2[2][2];
#pragma unroll
            for (int h = 0; h < 2; ++h)
#pragma unroll
                for (int i = 0; i < 2; ++i) v2[h][i] = GATHER ? (last ? vAn[h][i] : vAc[h][i]) : vAc[h][i];
            PG8_LDB(B0, 0, 0); PG8_LDB(B1, 0, 1); PG8_SCHED; PG8_LDA(At, 0, 0); PG8_STAGE(PG8_SA(1, 1), a1, vAc[1]);
            PG8_WAIT_V(8); PG8_WAIT_L(0); PG8_BAR; PG8_MMA(0, 0, At, B0); PG8_MMA(0, 1, At, B1); PG8_BAR; PG8_SCHED;
            PG8_LDA(At, 0, 1); PG8_STAGE(PG8_SB(0, 0), b2, voffB); PG8_STAGE(PG8_SB(0, 1), b2 + hstep, voffB); PG8_STAGE(PG8_SA(0, 0), a2, v2[0]);
            PG8_WAIT_V(8); PG8_WAIT_L(0); PG8_BAR; PG8_MMA(1, 0, At, B0); PG8_MMA(1, 1, At, B1); PG8_BAR; PG8_SCHED;
            PG8_LDB(B0, 1, 0); PG8_LDB(B1, 1, 1); PG8_SCHED; PG8_LDA(At, 1, 0); PG8_STAGE(PG8_SA(0, 1), a2, v2[1]);
            PG8_WAIT_V(8); PG8_WAIT_L(0); PG8_BAR; PG8_MMA(0, 0, At, B0); PG8_MMA(0, 1, At, B1); PG8_BAR; PG8_SCHED;
            PG8_LDA(At, 1, 1); PG8_STAGE(PG8_SB(1, 0), b3, voffB); PG8_STAGE(PG8_SB(1, 1), b3 + hstep, voffB); PG8_STAGE(PG8_SA(1, 0), a3, v2[0]);
            PG8_WAIT_V(8); PG8_WAIT_L(0); PG8_BAR; PG8_MMA(1, 0, At, B0); PG8_MMA(1, 1, At, B1); PG8_BAR; PG8_SCHED;
        }
        if constexpr (FP8) asm volatile("s_nop 15\n\ts_nop 15" ::: "memory");
        if constexpr (ALIGN_EPI) { if (wr == 0) PG8_BAR; }
        E(acc, cur, wr, wc, fr, fq);
        if (!has_next) break;
#pragma unroll
        for (int a = 0; a < 2; ++a)
#pragma unroll
            for (int b = 0; b < 2; ++b)
#pragma unroll
                for (int m = 0; m < 4; ++m)
#pragma unroll
                    for (int n = 0; n < 2; ++n) acc[a][b][m][n] = (f32x4){0.f, 0.f, 0.f, 0.f};
        cur = nxt; cA = nA; cB = nB; ++ui;
        if constexpr (GATHER) {
#pragma unroll
            for (int h = 0; h < 2; ++h)
#pragma unroll
                for (int i = 0; i < 2; ++i) vAc[h][i] = vAn[h][i]; }
        if constexpr (ALIGN_EPI) { if (wr == 1) PG8_BAR; }
    }
    PG8_WAIT_V(0);
    if constexpr (!ALIGN_EPI) { if (wr == 0) PG8_BAR; }
    PG8_BAR;
#undef PG8_SA
#undef PG8_SB
#undef PG8_STAGE
#undef PG8_LDA
#undef PG8_LDB
#undef PG8_MMA
#undef PG8_CAT
#undef PG8_WAIT_V
#undef PG8_WAIT_L
#undef PG8_BAR
#undef PG8_SCHED
}
}

#define XB_TMO      128
#define XB_XCNT(j)  (256  + 64 * (j))
#define XB_XSUB(j)  (1280 + 64 * (j))
#define XB_XGEN(j)  (2304 + 64 * (j))
#define XB_TOP      3328
#define XB_TOPGEN   3392
#define XCD_BAR_WORDS 3456
#define XB_SPIN_CAP (1u << 18)
DI unsigned xb_ld(unsigned* p)              { return __hip_atomic_load(p, __ATOMIC_RELAXED, __HIP_MEMORY_SCOPE_AGENT); }
DI unsigned xb_add(unsigned* p, unsigned v) { return __hip_atomic_fetch_add(p, v, __ATOMIC_RELAXED, __HIP_MEMORY_SCOPE_AGENT); }
DI unsigned xb_xcc_id() { return (unsigned)__builtin_amdgcn_s_getreg((3 << 11) | 20) & 0xFu; }
#define XB_SPIN(cond, bar) do { unsigned _sp = 0; while (cond) { __builtin_amdgcn_s_sleep(1); \
    if ((++_sp & 255u) == 0u) { if (xb_ld(&(bar)[XB_TMO])) break; if (_sp > XB_SPIN_CAP) { atomicAdd(&(bar)[XB_TMO], 1u); break; } } } } while (0)
struct XcdBarrier { unsigned* bar; unsigned x; volatile LAS unsigned* st; };
DI XcdBarrier xcd_barrier_post(unsigned* bar, volatile LAS unsigned* st) {
    XcdBarrier b; b.bar = bar; b.x = xb_xcc_id(); b.st = st;
    if (threadIdx.x == 0) (void)xb_add(&bar[XB_XCNT(b.x)], 1u);
    return b;
}
DI void xcd_barrier_complete(unsigned* bar, unsigned x, unsigned& nloc, unsigned& nx) {
    const unsigned G = gridDim.x * gridDim.y * gridDim.z;
    unsigned sum, cnt, mine, sp = 0u;
    for (;;) {
        sum = 0u; cnt = 0u; mine = 0u;
#pragma unroll
        for (unsigned j = 0; j < 16; ++j) { const unsigned c = xb_ld(&bar[XB_XCNT(j)]); sum += c; cnt += (c > 0u) ? 1u : 0u; mine = (j == x) ? c : mine; }
        if (sum == G) break;
        __builtin_amdgcn_s_sleep(1);
        if ((++sp & 255u) == 0u) { if (xb_ld(&bar[XB_TMO])) break; if (sp > XB_SPIN_CAP) { atomicAdd(&bar[XB_TMO], 1u); break; } }
    }
    nloc = mine > 0u ? mine : 1u; nx = cnt > 0u ? cnt : 1u;
}
DI void xcd_barrier(const XcdBarrier& b) {
    asm volatile("s_waitcnt vmcnt(0)" ::: "memory");
    __syncthreads();
    if (threadIdx.x == 0) {
        unsigned* bar = b.bar;
        __builtin_amdgcn_s_waitcnt(0);
        unsigned nloc = b.st[0], nx = b.st[1];
        if (nloc == 0u) { xcd_barrier_complete(bar, b.x, nloc, nx); b.st[0] = nloc; b.st[1] = nx; }
        const unsigned old = xb_add(&bar[XB_XSUB(b.x)], 1u);
        const unsigned gen = old / nloc;
        if (old + 1u == (gen + 1u) * nloc) {
            __builtin_amdgcn_fence(__ATOMIC_RELEASE, "agent");
            asm volatile("s_waitcnt vmcnt(0)" ::: "memory");
            const unsigned og = xb_add(&bar[XB_TOP], 1u);
            const unsigned tg = og / nx;
            if (og + 1u == (tg + 1u) * nx) xb_add(&bar[XB_TOPGEN], 1u);
            else XB_SPIN(xb_ld(&bar[XB_TOPGEN]) == tg, bar);
            __builtin_amdgcn_fence(__ATOMIC_ACQUIRE, "agent");
            xb_add(&bar[XB_XGEN(b.x)], 1u);
            asm volatile("s_waitcnt vmcnt(0)" ::: "memory");
        } else {
            XB_SPIN(xb_ld(&bar[XB_XGEN(b.x)]) == gen, bar);
            __builtin_amdgcn_fence(__ATOMIC_ACQUIRE, "agent");
            asm volatile("s_waitcnt vmcnt(0)" ::: "memory");
        }
    }
    __syncthreads();
}

DI void p0_transpose_item(const float* W, int ldw, int K, bf16* WT, int src_n0, int dst_n0, int k0, LAS float* scr, int lane) {
#pragma unroll 8
    for (int i = 0; i < 32; ++i) { const int kk = 2 * i + (lane >> 5); scr[kk * 33 + (lane & 31)] = W[(size_t)(k0 + kk) * ldw + src_n0 + (lane & 31)]; }
    asm volatile("s_waitcnt lgkmcnt(0)" ::: "memory");
    const int c = lane & 7;
#pragma unroll
    for (int j = 0; j < 4; ++j) { const int n = (lane >> 3) + 8 * j; const LAS float* s = scr + (8 * c) * 33 + n;
        u32x4 o; o.x = pk2(s[0 * 33], s[1 * 33]); o.y = pk2(s[2 * 33], s[3 * 33]); o.z = pk2(s[4 * 33], s[5 * 33]); o.w = pk2(s[6 * 33], s[7 * 33]);
        *(u32x4*)(WT + (size_t)(dst_n0 + n) * K + k0 + 8 * c) = o; }
    asm volatile("s_waitcnt lgkmcnt(0)" ::: "memory");
}

DI void p0_fp8_load(const float* W, int ldw, int src_n0, int k0, f32x4 (&v)[16], int lane) {
    const int kq = lane >> 3, nq = lane & 7;
#pragma unroll
    for (int i = 0; i < 16; ++i) { const int k = 32 * (i >> 2) + 4 * kq + (i & 3); v[i] = *(const f32x4*)(W + (size_t)(k0 + k) * ldw + src_n0 + 4 * nq); }
}
DI void p0_fp8_finish(const f32x4 (&v)[16], unsigned char* WT, int kbytes, int dst_n0, int k0, float scale, LAS unsigned* scr, int lane) {
    const int kq = lane >> 3, nq = lane & 7;
#pragma unroll
    for (int g = 0; g < 4; ++g)
#pragma unroll
        for (int c = 0; c < 4; ++c) scr[(4 * nq + c) * 33 + 8 * g + kq] = pk4_fp8(v[4 * g][c] * scale, v[4 * g + 1][c] * scale, v[4 * g + 2][c] * scale, v[4 * g + 3][c] * scale);
    asm volatile("s_waitcnt lgkmcnt(0)" ::: "memory");
    const int ch = lane & 7;
#pragma unroll
    for (int j = 0; j < 4; ++j) { const int n = (lane >> 3) + 8 * j; const LAS unsigned* s = scr + n * 33 + 4 * ch;
        u32x4 o; o.x = s[0]; o.y = s[1]; o.z = s[2]; o.w = s[3];
        *(u32x4*)(WT + (size_t)(dst_n0 + n) * kbytes + k0 + 16 * ch) = o; }
    asm volatile("s_waitcnt lgkmcnt(0)" ::: "memory");
}
DI void p0_transpose_bf16(const float* W, int ldw, int K, bf16* WT, int src_n0, int dst_n0, int k0, LAS unsigned* scr, int lane) {
    const int kq = lane >> 4, nq = lane & 15;
    f32x4 v[16];
#pragma unroll
    for (int i = 0; i < 16; ++i) { const int k = 8 * (i >> 1) + 2 * kq + (i & 1); v[i] = *(const f32x4*)(W + (size_t)(k0 + k) * ldw + src_n0 + 4 * nq); }
#pragma unroll
    for (int pp = 0; pp < 8; ++pp)
#pragma unroll
        for (int c = 0; c < 4; ++c) scr[(4 * nq + c) * 33 + 4 * pp + kq] = pk2(v[2 * pp][c], v[2 * pp + 1][c]);
    asm volatile("s_waitcnt lgkmcnt(0)" ::: "memory");
    const int ch = lane & 7;
#pragma unroll
    for (int j = 0; j < 8; ++j) { const int n = (lane >> 3) + 8 * j; const LAS unsigned* s = scr + n * 33 + 4 * ch;
        u32x4 o; o.x = s[0]; o.y = s[1]; o.z = s[2]; o.w = s[3];
        *(u32x4*)(WT + (size_t)(dst_n0 + n) * K + k0 + 8 * ch) = o; }
    asm volatile("s_waitcnt lgkmcnt(0)" ::: "memory");
}

DI void ln_row(f32x4 (&v)[4], const float* g, const float* bta, int lane) {
    float s = 0.f;
#pragma unroll
    for (int j = 0; j < 4; ++j) s += (v[j].x + v[j].y) + (v[j].z + v[j].w);
    const float mean = wave_sum(s) * (1.f / D); float s2 = 0.f;
#pragma unroll
    for (int j = 0; j < 4; ++j) { v[j] = v[j] - mean; s2 += (v[j].x * v[j].x + v[j].y * v[j].y) + (v[j].z * v[j].z + v[j].w * v[j].w); }
    const float rstd = 1.f / sqrtf(wave_sum(s2) * (1.f / D) + LN_EPS);
#pragma unroll
    for (int j = 0; j < 4; ++j) { const f32x4 gg = *(const f32x4*)(g + 4 * lane + 256 * j), bb = *(const f32x4*)(bta + 4 * lane + 256 * j); v[j] = v[j] * rstd * gg + bb; }
}
DI void store_row_bf16(bf16* orow, const f32x4 (&v)[4], int lane) {
    u32x2* o8 = (u32x2*)orow + lane;
#pragma unroll
    for (int j = 0; j < 4; ++j) { u32x2 w; w.x = pk2(v[j].x, v[j].y); w.y = pk2(v[j].z, v[j].w); o8[64 * j] = w; }
}

DI void load_row_bf16(const bf16* irow, f32x4 (&v)[4], int lane) {
    const u32x2* i8 = (const u32x2*)irow + lane;
#pragma unroll
    for (int j = 0; j < 4; ++j) { const u32x2 w = i8[64 * j]; v[j] = (f32x4){bf_lo(w.x), bf_hi(w.x), bf_lo(w.y), bf_hi(w.y)}; }
}
DI void store_row_fp8(unsigned char* orow, const f32x4 (&v)[4], float scale, int lane) {
    unsigned* o4 = (unsigned*)orow + lane;
#pragma unroll
    for (int j = 0; j < 4; ++j) o4[64 * j] = pk4_fp8(v[j].x * scale, v[j].y * scale, v[j].z * scale, v[j].w * scale);
}

constexpr float FOX_THR = 40.f;
DI void fox_unit(int b, int h8, int qb, const bf16* U, const float* Fc2, const gu32* Kmax2, const float* fox_g, bf16* MIX, LAS unsigned char* lds) {
    const int tid = threadIdx.x, lane = tid & 63, wave = __builtin_amdgcn_readfirstlane(tid >> 6);
    const int r = lane & 31, h = lane >> 5, i16 = lane & 15, q4 = i16 >> 2, p4 = i16 & 3, blk = (lane >> 4) & 1;
    const int tok0 = b * SEQ, q0 = qb * 256, qrow = q0 + wave * 32 + r;
    const float C2 = 0.125f * LOG2E;
    bf16x8 qf[4];
    { const bf16* qp = U + (size_t)(tok0 + qrow) * NU + UC_FQ + h8 * 64 + 8 * h;
#pragma unroll
      for (int d0 = 0; d0 < 4; ++d0) qf[d0] = *(const bf16x8*)(qp + 16 * d0); }
    float qn2 = 0.f;
#pragma unroll
    for (int d0 = 0; d0 < 4; ++d0)
#pragma unroll
        for (int j = 0; j < 8; ++j) { const float f = bf2f(qf[d0][j]); qn2 += f * f; }
    qn2 = xhalf_sum(qn2);
    const float* fc = Fc2 + (size_t)(b * 8 + h8) * SEQ;
    const float qk_bound = sqrtf(wave_max(qn2) * __uint_as_float(__hip_atomic_load(Kmax2 + b * 8 + h8, RLX_AGENT))) * C2 * 1.001f;
    const float nb_first = fc[q0];
    float m = -1e30f, l = 0.f; f32x16 oT[2];
#pragma unroll
    for (int i = 0; i < 16; ++i) { oT[0][i] = 0.f; oT[1][i] = 0.f; }
    constexpr int FOXB = 18944;
    const int NT = 4 * qb + 4;
    bool active = true;
    const int srow = tid >> 3, spc = tid & 7;
    const bf16* gp0 = U + (size_t)(tok0 + srow) * NU + h8 * 64 + spc * 8;
    u32x4 kvr, vvr; float nbr = 0.f;
    { const bf16* gp = gp0 + (size_t)(64 * (NT - 1)) * NU; kvr = *(const u32x4*)(gp + UC_FK); vvr = *(const u32x4*)(gp + UC_FV); if (tid < 64) nbr = fc[64 * (NT - 1) + tid] - nb_first; }
    __syncthreads();
    *(LAS u32x4*)(lds + srow * 144 + spc * 16) = kvr; *(LAS u32x4*)(lds + 9216 + srow * 144 + spc * 16) = vvr; if (tid < 64) ((LAS float*)(lds + 18432))[tid] = nbr;
    __syncthreads();
    int cur = 0;
    for (int t = NT - 1; t >= 0; --t) {
        LAS unsigned char* Ks = lds + cur * FOXB; LAS unsigned char* Vs = Ks + 9216; LAS float* nb = (LAS float*)(Ks + 18432);
        if (t >= 1) { const bf16* gp = gp0 + (size_t)(64 * (t - 1)) * NU; kvr = *(const u32x4*)(gp + UC_FK); vvr = *(const u32x4*)(gp + UC_FV); if (tid < 64) nbr = fc[64 * (t - 1) + tid] - nb_first; }
        if (active && 64 * t <= q0 + wave * 32 + 31) {
            f32x16 p[2];
#pragma unroll
            for (int hb = 0; hb < 2; ++hb) {
                f32x16 a;
#pragma unroll
                for (int i = 0; i < 16; ++i) a[i] = 0.f;
#pragma unroll
                for (int d0 = 0; d0 < 4; ++d0) { const bf16x8 kf = *(const LAS bf16x8*)(Ks + (32 * hb + r) * 144 + (16 * d0 + 8 * h) * 2); a = mfma32(kf, qf[d0], a); }
#pragma unroll
                for (int g = 0; g < 4; ++g) { const f32x4 bb = *(const LAS f32x4*)(nb + 32 * hb + 8 * g + 4 * h);
#pragma unroll
                    for (int e = 0; e < 4; ++e) a[4 * g + e] = a[4 * g + e] * C2 + bb[e]; }
                p[hb] = a;
            }
            if (t >= NT - 4) {
#pragma unroll
                for (int hb = 0; hb < 2; ++hb)
#pragma unroll
                    for (int i = 0; i < 16; ++i) { const int kv = 64 * t + 32 * hb + crow(i, h); if (kv > qrow) p[hb][i] = -INFINITY; }
            }
            float mx = p[0][0];
#pragma unroll
            for (int i = 1; i < 16; ++i) mx = fmaxf(mx, p[0][i]);
#pragma unroll
            for (int i = 0; i < 16; ++i) mx = fmaxf(mx, p[1][i]);
            mx = xhalf_max(mx);
            if (__any(mx > m)) {
                const float mn = fmaxf(m, mx), alpha = ex2(m - mn); m = mn; l *= alpha;
#pragma unroll
                for (int i = 0; i < 16; ++i) { oT[0][i] *= alpha; oT[1][i] *= alpha; }
            }
            float rs = 0.f;
#pragma unroll
            for (int hb = 0; hb < 2; ++hb)
#pragma unroll
                for (int i = 0; i < 16; ++i) { const float e = ex2(p[hb][i] - m); p[hb][i] = e; rs += e; }
            l += rs;
            bf16x8 pf[2][2];
#pragma unroll
            for (int hb = 0; hb < 2; ++hb)
#pragma unroll
                for (int s = 0; s < 2; ++s) pf[hb][s] = pack8(p[hb], s);
#pragma unroll
            for (int d0 = 0; d0 < 2; ++d0)
#pragma unroll
                for (int hb = 0; hb < 2; ++hb)
#pragma unroll
                    for (int s = 0; s < 2; ++s) {
                        const LAS unsigned char* vp = Vs + (32 * hb + 16 * s + 4 * h + q4) * 144 + (32 * d0 + 16 * blk + 4 * p4) * 2;
                        const s16x4 lo = tr_read(vp), hi = tr_read(vp + 8 * 144);
                        oT[d0] = mfma32(cat8(lo, hi), pf[hb][s], oT[d0]);
                    }
            if (t >= 1) { const float mmin = -wave_max(-m); active = (qk_bound + (fc[64 * t - 1] - nb_first) - mmin) > -FOX_THR; }
        }
        cur ^= 1;
        { LAS unsigned char* Kn = lds + cur * FOXB; *(LAS u32x4*)(Kn + srow * 144 + spc * 16) = kvr; *(LAS u32x4*)(Kn + 9216 + srow * 144 + spc * 16) = vvr; if (tid < 64) ((LAS float*)(Kn + 18432))[tid] = nbr; }
        if (!__syncthreads_or(active ? 1 : 0)) break;
    }
    l = xhalf_sum(l);
    const float inv = 1.f / l;
    float ss = 0.f;
#pragma unroll
    for (int d0 = 0; d0 < 2; ++d0)
#pragma unroll
        for (int i = 0; i < 16; ++i) { const float o = oT[d0][i] * inv; oT[d0][i] = o; ss += o * o; }
    ss = xhalf_sum(ss);
    const float rr = 1.f / sqrtf(ss * (1.f / 64.f) + RMS_EPS);
    bf16* op = MIX + (size_t)(tok0 + qrow) * D + h8 * 64;
#pragma unroll
    for (int d0 = 0; d0 < 2; ++d0)
#pragma unroll
        for (int g = 0; g < 4; ++g) { const int d = 32 * d0 + 8 * g + 4 * h; const f32x4 gn = *(const f32x4*)(fox_g + h8 * 64 + d);
            u32x2 w; w.x = pk2(oT[d0][4 * g] * rr * gn.x, oT[d0][4 * g + 1] * rr * gn.y); w.y = pk2(oT[d0][4 * g + 2] * rr * gn.z, oT[d0][4 * g + 3] * rr * gn.w);
            *(u32x2*)(op + d) = w; }
}

DI void m1_unit(int bh, int cg, const bf16* U, const float* G, const float* conv_w, bf16* Mq, bf16* Mk, float* KvT, float* Nc, float* Gc, float* Mloc, LAS unsigned char* lds) {
    const int tid = threadIdx.x, lane = tid & 63, wave = __builtin_amdgcn_readfirstlane(tid >> 6);
    const int r = lane & 31, h = lane >> 5, i16 = lane & 15, q4 = i16 >> 2, p4 = i16 & 3, blk = (lane >> 4) & 1;
    const int b = bh >> 2, hh = bh & 3, s0 = cg * 256;
    LAS float* wa = (LAS float*)lds;
    LAS unsigned char* ksb = lds + 1024;
    LAS unsigned char* vsb = lds + 1024 + 36864;
    __syncthreads();
    if (wave < 4) {
        const int c = cg * 4 + wave, tok = b * SEQ + c * 64 + lane;
        const float lf = G[(size_t)tok * 16 + 12 + hh], li = G[(size_t)tok * 16 + 8 + hh];
        const float bsc = wave_scan_add(lf, lane);
        const float g = __shfl(bsc, 63);
        const float a = g - bsc + li;
        const float ml = wave_max(a);
        wa[wave * 64 + lane] = expf(a - ml);
        if (lane == 0) { Gc[bh * 64 + c] = g; Mloc[bh * 64 + c] = ml; }
    }
    __syncthreads();
#pragma unroll 2
    for (int i = 0; i < 8; ++i) {
        const int id = tid + 512 * i, d8 = id & 7, qk = (id >> 3) & 1, t = id >> 4;
        const int ucol = (qk ? UC_MK : UC_MQ) + hh * 64 + 8 * d8, ccol = (qk ? 256 : 0) + hh * 64 + 8 * d8;
        float acc[8];
#pragma unroll
        for (int e = 0; e < 8; ++e) acc[e] = 0.f;
#pragma unroll
        for (int j = 0; j < 4; ++j) {
            const int ts = s0 + t - 3 + j;
            if (ts >= 0) {
                const u32x4 x = *(const u32x4*)(U + (size_t)(b * SEQ + ts) * NU + ucol);
                const f32x4 w0 = *(const f32x4*)(conv_w + j * 512 + ccol), w1 = *(const f32x4*)(conv_w + j * 512 + ccol + 4);
                acc[0] += bf_lo(x.x) * w0.x; acc[1] += bf_hi(x.x) * w0.y; acc[2] += bf_lo(x.y) * w0.z; acc[3] += bf_hi(x.y) * w0.w;
                acc[4] += bf_lo(x.z) * w1.x; acc[5] += bf_hi(x.z) * w1.y; acc[6] += bf_lo(x.w) * w1.z; acc[7] += bf_hi(x.w) * w1.w;
            }
        }
#pragma unroll
        for (int e = 0; e < 8; ++e) acc[e] = acc[e] / (1.f + expf(-acc[e]));
        const size_t orow = ((size_t)bh * SEQ + s0 + t) * 64 + 8 * d8;
        if (qk == 0) {
            u32x4 w; w.x = pk2(acc[0], acc[1]); w.y = pk2(acc[2], acc[3]); w.z = pk2(acc[4], acc[5]); w.w = pk2(acc[6], acc[7]);
            *(u32x4*)(Mq + orow) = w;
        } else {
#pragma unroll
            for (int e = 0; e < 8; ++e) acc[e] *= 0.125f;
            u32x4 w; w.x = pk2(acc[0], acc[1]); w.y = pk2(acc[2], acc[3]); w.z = pk2(acc[4], acc[5]); w.w = pk2(acc[6], acc[7]);
            *(u32x4*)(Mk + orow) = w;
            const float ww = wa[t];
            u32x4 x; x.x = pk2(acc[0] * ww, acc[1] * ww); x.y = pk2(acc[2] * ww, acc[3] * ww); x.z = pk2(acc[4] * ww, acc[5] * ww); x.w = pk2(acc[6] * ww, acc[7] * ww);
            *(LAS u32x4*)(ksb + (t >> 6) * 9216 + (t & 63) * 144 + d8 * 16) = x;
        }
    }
#pragma unroll
    for (int i = 0; i < 8; ++i) { const int id = tid + 512 * i, pc = id & 15, t = id >> 4;
        const u32x4 v = *(const u32x4*)(U + (size_t)(b * SEQ + s0 + t) * NU + UC_MV + hh * 128 + pc * 8);
        *(LAS u32x4*)(vsb + (t >> 6) * 17408 + (t & 63) * 272 + pc * 16) = v; }
    __syncthreads();
    {
        const int cl = wave >> 1, eh = wave & 1, c = cg * 4 + cl;
        const LAS unsigned char* vs = vsb + cl * 17408; const LAS unsigned char* ks = ksb + cl * 9216;
        f32x16 acc[2][2];
#pragma unroll
        for (int a = 0; a < 2; ++a)
#pragma unroll
            for (int bb = 0; bb < 2; ++bb)
#pragma unroll
                for (int i = 0; i < 16; ++i) acc[a][bb][i] = 0.f;
#pragma unroll
        for (int k4 = 0; k4 < 4; ++k4) {
            bf16x8 af[2], bfr[2];
#pragma unroll
            for (int eb = 0; eb < 2; ++eb) { const LAS unsigned char* pp = vs + (16 * k4 + 8 * h + q4) * 272 + (64 * eh + 32 * eb + 16 * blk + 4 * p4) * 2; af[eb] = cat8(tr_read(pp), tr_read(pp + 4 * 272)); }
#pragma unroll
            for (int db = 0; db < 2; ++db) { const LAS unsigned char* pp = ks + (16 * k4 + 8 * h + q4) * 144 + (32 * db + 16 * blk + 4 * p4) * 2; bfr[db] = cat8(tr_read(pp), tr_read(pp + 4 * 144)); }
#pragma unroll
            for (int eb = 0; eb < 2; ++eb)
#pragma unroll
                for (int db = 0; db < 2; ++db) acc[eb][db] = mfma32(af[eb], bfr[db], acc[eb][db]);
        }
        float* op = KvT + (size_t)(bh * 64 + c) * 8192;
#pragma unroll
        for (int eb = 0; eb < 2; ++eb)
#pragma unroll
            for (int db = 0; db < 2; ++db)
#pragma unroll
                for (int i = 0; i < 16; ++i) op[(64 * eh + 32 * eb + crow(i, h)) * 64 + 32 * db + r] = acc[eb][db][i];
    }
    if (tid < 256) { const int cl = tid >> 6, d = tid & 63; const LAS unsigned char* ks = ksb + cl * 9216 + d * 2; float s = 0.f;
#pragma unroll 8
        for (int t = 0; t < 64; ++t) s += __uint_as_float(((unsigned)*(const LAS unsigned short*)(ks + t * 144)) << 16);
        Nc[(size_t)(bh * 64 + cg * 4 + cl) * 64 + d] = s; }
}

DI void m3_unit(int bh, int cg, const bf16* U, const float* G, const bf16* Mq, const bf16* Mk, const bf16* CpT, const float* Np, const float* Mp, const float* mlstm_g, bf16* MIX, LAS unsigned char* lds) {
    const int tid = threadIdx.x, lane = tid & 63, wave = __builtin_amdgcn_readfirstlane(tid >> 6);
    const int r = lane & 31, h = lane >> 5, i16 = lane & 15, q4 = i16 >> 2, p4 = i16 & 3, blk = (lane >> 4) & 1;
    const int b = bh >> 2, hh = bh & 3, cl = wave >> 1, th = wave & 1, c = cg * 4 + cl;
    const int tokc = b * SEQ + c * 64;
    const LAS unsigned char* Vs = lds + cl * 17408;
    LAS float* wsf = (LAS float*)(lds + 69632 + wave * 1024);
    __syncthreads();
#pragma unroll
    for (int i = 0; i < 8; ++i) { const int id = tid + 512 * i, pc = id & 15, t = id >> 4;
        const u32x4 v = *(const u32x4*)(U + (size_t)(b * SEQ + cg * 256 + t) * NU + UC_MV + hh * 128 + pc * 8);
        *(LAS u32x4*)(lds + (t >> 6) * 17408 + (t & 63) * 272 + pc * 16) = v; }
    const float mprev = Mp[bh * 64 + c];
    {
        const float lf = G[(size_t)(tokc + lane) * 16 + 12 + hh], li = G[(size_t)(tokc + lane) * 16 + 8 + hh];
        const float bsc = wave_scan_add(lf, lane);
        const float pm = wave_scan_max(li - bsc, lane);
        wsf[lane] = bsc; wsf[64 + lane] = li; wsf[128 + lane] = bsc + fmaxf(mprev, pm); wsf[192 + lane] = Np[(size_t)(bh * 64 + c) * 64 + lane];
    }
    __syncthreads();
    const int tl = 32 * th + r;
    const float bt = wsf[tl], mtt = wsf[128 + tl];
    const float winter = expf(bt + mprev - mtt);
    bf16x8 qf[4];
    { const bf16* qp = Mq + ((size_t)bh * SEQ + c * 64 + tl) * 64 + 8 * h;
#pragma unroll
      for (int ks = 0; ks < 4; ++ks) qf[ks] = *(const bf16x8*)(qp + 16 * ks); }
    float qn = 0.f;
#pragma unroll
    for (int ks = 0; ks < 4; ++ks)
#pragma unroll
        for (int j = 0; j < 8; ++j) qn += bf2f(qf[ks][j]) * wsf[192 + 16 * ks + 8 * h + j];
    qn = xhalf_sum(qn);
    f32x16 accT[4];
#pragma unroll
    for (int eb = 0; eb < 4; ++eb) {
        f32x16 a;
#pragma unroll
        for (int i = 0; i < 16; ++i) a[i] = 0.f;
#pragma unroll
        for (int ks = 0; ks < 4; ++ks) { const bf16x8 cf = *(const bf16x8*)(CpT + ((size_t)(bh * 64 + c) * 128 + 32 * eb + r) * 64 + 16 * ks + 8 * h); a = mfma32(cf, qf[ks], a); }
#pragma unroll
        for (int i = 0; i < 16; ++i) a[i] *= winter;
        accT[eb] = a;
    }
    float psum = 0.f; f32x16 pT[2];
#pragma unroll
    for (int sb = 0; sb < 2; ++sb) {
        f32x16 a;
#pragma unroll
        for (int i = 0; i < 16; ++i) a[i] = 0.f;
#pragma unroll
        for (int ks = 0; ks < 4; ++ks) { const bf16x8 kf = *(const bf16x8*)(Mk + ((size_t)bh * SEQ + c * 64 + 32 * sb + r) * 64 + 16 * ks + 8 * h); a = mfma32(kf, qf[ks], a); }
#pragma unroll
        for (int g = 0; g < 4; ++g) { const f32x4 b4 = *(const LAS f32x4*)(wsf + 32 * sb + 8 * g + 4 * h), l4 = *(const LAS f32x4*)(wsf + 64 + 32 * sb + 8 * g + 4 * h);
#pragma unroll
            for (int e = 0; e < 4; ++e) { const int s = 32 * sb + 8 * g + 4 * h + e; const float w = (s <= tl) ? expf(bt - b4[e] + l4[e] - mtt) * a[4 * g + e] : 0.f; a[4 * g + e] = w; psum += w; } }
        pT[sb] = a;
    }
    psum = xhalf_sum(psum);
#pragma unroll
    for (int eb = 0; eb < 4; ++eb)
#pragma unroll
        for (int sb = 0; sb < 2; ++sb)
#pragma unroll
            for (int s2 = 0; s2 < 2; ++s2) {
                const LAS unsigned char* vp = Vs + (32 * sb + 16 * s2 + 4 * h + q4) * 272 + (32 * eb + 16 * blk + 4 * p4) * 2;
                const s16x4 lo = tr_read(vp), hi = tr_read(vp + 8 * 272);
                accT[eb] = mfma32(cat8(lo, hi), pack8(pT[sb], s2), accT[eb]);
            }
    const float den = winter * qn + psum;
    const float hs = 1.f / fmaxf(fabsf(den), expf(-mtt));
    float ss = 0.f;
#pragma unroll
    for (int eb = 0; eb < 4; ++eb)
#pragma unroll
        for (int i = 0; i < 16; ++i) { const float v = accT[eb][i] * hs; accT[eb][i] = v; ss += v * v; }
    ss = xhalf_sum(ss);
    const float rr = 1.f / sqrtf(ss * (1.f / 128.f) + RMS_EPS);
    const int tok = tokc + tl;
#pragma unroll
    for (int eb = 0; eb < 4; ++eb)
#pragma unroll
        for (int g = 0; g < 4; ++g) { const int e = 32 * eb + 8 * g + 4 * h;
            const f32x4 gn = *(const f32x4*)(mlstm_g + hh * 128 + e);
            const u32x2 mo = *(const u32x2*)(U + (size_t)tok * NU + UC_MO + hh * 128 + e);
            const float o0 = accT[eb][4 * g] * rr * gn.x * sigmoid_fast(bf_lo(mo.x)), o1 = accT[eb][4 * g + 1] * rr * gn.y * sigmoid_fast(bf_hi(mo.x));
            const float o2 = accT[eb][4 * g + 2] * rr * gn.z * sigmoid_fast(bf_lo(mo.y)), o3 = accT[eb][4 * g + 3] * rr * gn.w * sigmoid_fast(bf_hi(mo.y));
            u32x2 w; w.x = pk2(o0, o1); w.y = pk2(o2, o3);
            *(u32x2*)(MIX + (size_t)tok * D + 512 + hh * 128 + e) = w; }
}

DI void xattn_unit(int b, int hx, int qb, bf16* QX, const bf16* KVx, LAS unsigned char* lds) {
    const int tid = threadIdx.x, lane = tid & 63, wave = __builtin_amdgcn_readfirstlane(tid >> 6);
    const int r = lane & 31, h = lane >> 5, i16 = lane & 15, q4 = i16 >> 2, p4 = i16 & 3, blk = (lane >> 4) & 1;
    const int tok = b * SEQ + qb * 256 + wave * 32 + r;
    bf16x8 qf[16];
    { const bf16* qp = QX + (size_t)tok * D + hx * 256 + 8 * h;
#pragma unroll
      for (int ks = 0; ks < 16; ++ks) qf[ks] = *(const bf16x8*)(qp + 16 * ks); }
    f32x16 sT[8];
    LAS unsigned char* Kx = lds; LAS unsigned char* Vx = lds + 33792;
#pragma unroll
    for (int kt = 0; kt < 4; ++kt) {
        __syncthreads();
#pragma unroll
        for (int i = 0; i < 4; ++i) { const int id = tid + 512 * i, row = id >> 5, pc = id & 31;
            const u32x4 v = *(const u32x4*)(KVx + (size_t)(b * NMEM + 64 * kt + row) * 2048 + hx * 256 + pc * 8);
            *(LAS u32x4*)(Kx + row * 528 + pc * 16) = v; }
        __syncthreads();
#pragma unroll
        for (int mb = 0; mb < 2; ++mb) {
            f32x16 a;
#pragma unroll
            for (int i = 0; i < 16; ++i) a[i] = 0.f;
#pragma unroll
            for (int ks = 0; ks < 16; ++ks) { const bf16x8 kf = *(const LAS bf16x8*)(Kx + (32 * mb + r) * 528 + (16 * ks + 8 * h) * 2); a = mfma32(kf, qf[ks], a); }
            sT[2 * kt + mb] = a;
        }
    }
    const float C2X = 0.0625f * LOG2E;
    float mx = -INFINITY;
#pragma unroll
    for (int j = 0; j < 8; ++j)
#pragma unroll
        for (int i = 0; i < 16; ++i) mx = fmaxf(mx, sT[j][i]);
    mx = xhalf_max(mx);
    const float mb2 = mx * C2X;
    float lsum = 0.f;
#pragma unroll
    for (int j = 0; j < 8; ++j)
#pragma unroll
        for (int i = 0; i < 16; ++i) { const float e = ex2(sT[j][i] * C2X - mb2); sT[j][i] = e; lsum += e; }
    lsum = xhalf_sum(lsum);
    const float inv = 1.f / lsum;
    bf16x8 pf[8][2];
#pragma unroll
    for (int j = 0; j < 8; ++j)
#pragma unroll
        for (int s = 0; s < 2; ++s) pf[j][s] = pack8(sT[j], s);
#pragma unroll
    for (int vh = 0; vh < 2; ++vh) {
        __syncthreads();
#pragma unroll
        for (int i = 0; i < 8; ++i) { const int id = tid + 512 * i, row = id >> 4, pc = id & 15;
            const u32x4 v = *(const u32x4*)(KVx + (size_t)(b * NMEM + row) * 2048 + 1024 + hx * 256 + 128 * vh + pc * 8);
            *(LAS u32x4*)(Vx + row * 272 + pc * 16) = v; }
        __syncthreads();
#pragma unroll
        for (int eb = 0; eb < 4; ++eb) {
            f32x16 acc;
#pragma unroll
            for (int i = 0; i < 16; ++i) acc[i] = 0.f;
#pragma unroll
            for (int j = 0; j < 8; ++j)
#pragma unroll
                for (int s = 0; s < 2; ++s) {
                    const LAS unsigned char* vp = Vx + (32 * j + 16 * s + 4 * h + q4) * 272 + (32 * eb + 16 * blk + 4 * p4) * 2;
                    const s16x4 lo = tr_read(vp), hi = tr_read(vp + 8 * 272);
                    acc = mfma32(cat8(lo, hi), pf[j][s], acc);
                }
#pragma unroll
            for (int g = 0; g < 4; ++g) { const int d = 128 * vh + 32 * eb + 8 * g + 4 * h;
                u32x2 w; w.x = pk2(acc[4 * g] * inv, acc[4 * g + 1] * inv); w.y = pk2(acc[4 * g + 2] * inv, acc[4 * g + 3] * inv);
                *(u32x2*)(QX + (size_t)tok * D + hx * 256 + d) = w; }
        }
    }
}

DI void moe_tables(LAS int* tb, gu32* ctl, int tid) {
    __syncthreads();
    if (tid < 32) tb[40 + tid] = (int)__hip_atomic_load(ctl + CW_CNT + 64 * tid, RLX_AGENT);
    __syncthreads();
    if (tid == 0) { int s = 0; for (int e = 0; e < 32; ++e) { tb[e] = s; s += (tb[40 + e] + 255) >> 8; } tb[32] = s; }
    __syncthreads();
}

struct Args { const float* in[26]; float* out; unsigned char* ws; int ph_lo, ph_hi, li, pad; };

__global__ void __launch_bounds__(NWAVES * 64, 2) fwd(Args args) {
    extern __shared__ __attribute__((aligned(16))) unsigned char lds_raw[];
    LAS unsigned char* lds = (LAS unsigned char*)lds_raw;
    volatile LAS unsigned* MISC = (volatile LAS unsigned*)(lds + MISC_OFF);
    const int tid = threadIdx.x, lane = tid & 63, wave = __builtin_amdgcn_readfirstlane(tid >> 6);
    const int G = gridDim.x, bx = blockIdx.x;
    const int vcu = (G % 8 == 0) ? (bx % 8) * (G / 8) + bx / 8 : bx;
    unsigned char* ws = args.ws;
    gu32* ctl = (gu32*)(ws + WS_CTL);
    const float* x = args.in[0]; const float* mem = args.in[1]; const float* w_in = args.in[2]; const float* fox_f_bias = args.in[3];
    const float* conv_w = args.in[4]; const float* i_bias = args.in[5]; const float* f_bias = args.in[6]; const float* fox_g = args.in[7];
    const float* mlstm_g = args.in[8]; const float* w_out = args.in[9]; const float* ln1_g = args.in[10]; const float* ln1_b = args.in[11];
    const float* w_xq = args.in[12]; const float* w_xk = args.in[13]; const float* w_xv = args.in[14]; const float* w_xo = args.in[15];
    const float* ln2_g = args.in[16]; const float* ln2_b = args.in[17]; const float* w_router = args.in[18]; const float* b_router = args.in[19];
    const float* w_gu = args.in[20]; const float* b_gu = args.in[21]; const float* w_dn = args.in[22]; const float* b_dn = args.in[23];
    const float* ln3_g = args.in[24]; const float* ln3_b = args.in[25];
    float* out = args.out;
    float* Gt = (float*)(ws + WS_G); float* Fc2 = (float*)(ws + WS_FC2);
    float* Gc = (float*)(ws + WS_GC); float* Mloc = Gc + 1024; float* Mp = Gc + 2048;
    float* Nc = (float*)(ws + WS_NC); float* Np = (float*)(ws + WS_NP);
    int* Tidx = (int*)(ws + WS_TIDX); float* Tgate = (float*)(ws + WS_TGATE); int* Tslot = (int*)(ws + WS_TSLOT); int* List = (int*)(ws + WS_LIST);
    bf16* KVx = (bf16*)(ws + WS_MEMKV);
    bf16* Win_t = (bf16*)(ws + WS_WIN); bf16* Wout_t = (bf16*)(ws + WS_WOUT); bf16* Wxq_t = (bf16*)(ws + WS_WXQ); bf16* Wxo_t = (bf16*)(ws + WS_WXO);
    unsigned char* Wgu8 = ws + WS_WGU; unsigned char* Wdn8 = ws + WS_WDN;
    bf16* XB = (bf16*)(ws + WS_XB); bf16* U = (bf16*)(ws + WS_U); bf16* Mq = (bf16*)(ws + WS_MQ); bf16* Mk = (bf16*)(ws + WS_MK);
    float* KvT = (float*)(ws + WS_KVT); bf16* CpT = (bf16*)(ws + WS_CPT); bf16* MIX = (bf16*)(ws + WS_MIX);
    bf16* Y1 = (bf16*)(ws + WS_Y1); bf16* X2B = (bf16*)(ws + WS_Y1 + 32 * MiB); bf16* X1B = (bf16*)(ws + WS_X1B); bf16* QX = (bf16*)(ws + WS_QX);
    bf16* Y2 = (bf16*)(ws + WS_Y2); unsigned char* X2F8 = ws + WS_X2B; unsigned char* HID8 = ws + WS_HID; bf16* YB = (bf16*)(ws + WS_YB);

    for (int u = tid; u < (LDS_BYTES - LDSCTL_OFF) / 4; u += NWAVES * 64) ((LAS unsigned*)(lds + LDSCTL_OFF))[u] = 0u;
    __syncthreads();
    XcdBarrier bar; bar.bar = (unsigned*)(ctl + CW_BAR); bar.x = 0; bar.st = nullptr;
    if (N_LAUNCHES == 1) bar = xcd_barrier_post((unsigned*)(ctl + CW_BAR), MISC + 8);
#define GRID_BAR() do { if (N_LAUNCHES == 1) xcd_barrier(bar); } while (0)
    const int lo = args.ph_lo, hi = args.ph_hi;
#ifndef PH_MASK
#define PH_MASK 0xFFFF
#endif
#define IN(k) (((PH_MASK >> (k)) & 1) && lo <= (k) && (k) < hi)
#define BOTH(k) (IN(k) && IN((k) + 1))
#ifndef REP_MASK
#define REP_MASK 0
#endif
#define REPS(k) (1 + ((REP_MASK >> (k)) & 1))
#define END_PHASE(k) do { if (BOTH(k) || rep + 1 < REPS(k)) GRID_BAR(); } while (0)

    if (IN(0)) for (int rep = 0; rep < REPS(0); ++rep) {
#ifndef REP_P0
#define REP_P0 0
#endif
        for (int r0_ = 0; r0_ < 1 + ((REP_P0 >> 0) & 1); ++r0_) {
            asm volatile("" ::: "memory");
            LAS float* wg = (LAS float*)lds;
            for (int idx = tid; idx < 1024 * 16; idx += 512) { const int k = idx >> 4, c = idx & 15; const int col = c < 8 ? 1536 + c : 2568 + (c - 8);
                const int j = k >> 8, ln = (k & 255) >> 2, i = k & 3; wg[((((j * 4 + i) * 4 + (c >> 2)) * 64 + ln) << 2) + (c & 3)] = w_in[(size_t)k * NIN + col]; }
            __syncthreads();
            f32x4 vn[2][4];
#pragma unroll
            for (int t = 0; t < 2; ++t) { const f32x4* xr = (const f32x4*)(x + (size_t)((bx * 8 + wave) * 2 + t) * D) + lane;
#pragma unroll
                for (int j = 0; j < 4; ++j) vn[t][j] = xr[64 * j]; }
            for (int m0 = (bx * 8 + wave) * 2; m0 < M; m0 += G * 16) {
                asm volatile("" ::: "memory");
                f32x4 vv[2][4];
#pragma unroll
                for (int t = 0; t < 2; ++t)
#pragma unroll
                    for (int j = 0; j < 4; ++j) vv[t][j] = vn[t][j];
                if (m0 + G * 16 < M) {
#pragma unroll
                    for (int t = 0; t < 2; ++t) { const f32x4* xr = (const f32x4*)(x + (size_t)(m0 + G * 16 + t) * D) + lane;
#pragma unroll
                        for (int j = 0; j < 4; ++j) vn[t][j] = xr[64 * j]; }
                }
#pragma unroll
                for (int t = 0; t < 2; ++t) {
                    const int m = m0 + t;
                    store_row_bf16(XB + (size_t)m * D, vv[t], lane);
                    float acc[16];
#pragma unroll
                    for (int c = 0; c < 16; ++c) acc[c] = 0.f;
#pragma unroll
                    for (int j = 0; j < 4; ++j)
#pragma unroll
                        for (int i = 0; i < 4; ++i) { const LAS f32x4* wp = (const LAS f32x4*)wg + ((j * 4 + i) * 4) * 64 + lane; const float xv = vv[t][j][i];
#pragma unroll
                            for (int c4 = 0; c4 < 4; ++c4) { const f32x4 w = wp[c4 * 64]; acc[4 * c4] += xv * w.x; acc[4 * c4 + 1] += xv * w.y; acc[4 * c4 + 2] += xv * w.z; acc[4 * c4 + 3] += xv * w.w; } }
#define TR_STEP(HALFN, XORM) { const bool up = (lane & (XORM)) != 0; _Pragma("unroll") for (int i = 0; i < (HALFN); ++i) { const float keep = up ? acc[(HALFN) + i] : acc[i], send = up ? acc[i] : acc[(HALFN) + i]; acc[i] = keep + __shfl_xor(send, (XORM)); } }
                    TR_STEP(8, 8) TR_STEP(4, 4) TR_STEP(2, 2) TR_STEP(1, 1)
#undef TR_STEP
                    float mine = acc[0]; mine += __shfl_xor(mine, 16); mine += __shfl_xor(mine, 32);
                    if (lane < 16) {
                        float o;
                        if (lane < 8) o = log_sigmoid_acc(mine + fox_f_bias[lane]);
                        else if (lane < 12) o = mine + i_bias[lane - 8];
                        else o = log_sigmoid_acc(mine + f_bias[lane - 12]);
                        Gt[(size_t)m * 16 + lane] = o;
                    }
                }
            }
            __syncthreads();
        }
        for (int r1_ = 0; r1_ < 1 + ((REP_P0 >> 1) & 1); ++r1_) {
            asm volatile("" ::: "memory");
            LAS unsigned char* As = lds; LAS unsigned char* Bs = lds + 17408;
            const int i16 = lane & 15, q4 = i16 >> 2, p4 = i16 & 3, quad = lane >> 4;
            for (int tile = bx; tile < 256; tile += G) {
                const int rt = tile >> 4, ct = tile & 15;
                const float* W = ct < 8 ? w_xk : w_xv; const int col0 = 128 * (ct & 7);
                f32x4 acc[4];
#pragma unroll
                for (int rb = 0; rb < 4; ++rb) acc[rb] = (f32x4){0.f, 0.f, 0.f, 0.f};
                f32x4 ra[4], rb8[8];
#pragma unroll
                for (int i = 0; i < 4; ++i) { const int p = tid + 512 * i; ra[i] = *(const f32x4*)(mem + (size_t)(64 * rt + (p >> 5)) * D + 4 * (p & 31)); }
#pragma unroll
                for (int i = 0; i < 8; ++i) { const int p = tid + 512 * i; rb8[i] = *(const f32x4*)(W + (size_t)(p >> 5) * D + col0 + 4 * (p & 31)); }
                for (int k0 = 0; k0 < 1024; k0 += 128) {
                    __syncthreads();
#pragma unroll
                    for (int i = 0; i < 4; ++i) { const int p = tid + 512 * i; u32x2 w; w.x = pk2(ra[i].x, ra[i].y); w.y = pk2(ra[i].z, ra[i].w); *(LAS u32x2*)(As + (p >> 5) * 272 + (p & 31) * 8) = w; }
#pragma unroll
                    for (int i = 0; i < 8; ++i) { const int p = tid + 512 * i; u32x2 w; w.x = pk2(rb8[i].x, rb8[i].y); w.y = pk2(rb8[i].z, rb8[i].w); *(LAS u32x2*)(Bs + (p >> 5) * 272 + (p & 31) * 8) = w; }
                    if (k0 + 128 < 1024) {
#pragma unroll
                        for (int i = 0; i < 4; ++i) { const int p = tid + 512 * i; ra[i] = *(const f32x4*)(mem + (size_t)(64 * rt + (p >> 5)) * D + k0 + 128 + 4 * (p & 31)); }
#pragma unroll
                        for (int i = 0; i < 8; ++i) { const int p = tid + 512 * i; rb8[i] = *(const f32x4*)(W + (size_t)(k0 + 128 + (p >> 5)) * D + col0 + 4 * (p & 31)); }
                    }
                    __syncthreads();
#pragma unroll
                    for (int kk = 0; kk < 4; ++kk) {
                        const LAS unsigned char* bp = Bs + (32 * kk + 8 * quad + q4) * 272 + (16 * wave + 4 * p4) * 2;
                        const bf16x8 bfr = cat8(tr_read(bp), tr_read(bp + 4 * 272));
#pragma unroll
                        for (int rb = 0; rb < 4; ++rb) { const bf16x8 afr = *(const LAS bf16x8*)(As + (16 * rb + i16) * 272 + (32 * kk + 8 * quad) * 2); acc[rb] = mfma16(afr, bfr, acc[rb]); }
                    }
                }
#pragma unroll
                for (int rb = 0; rb < 4; ++rb)
#pragma unroll
                    for (int j = 0; j < 4; ++j) { const int row = 64 * rt + 16 * rb + 4 * quad + j, col = 128 * ct + 16 * wave + i16;
                        KVx[(size_t)row * 2048 + col] = (bf16)(pk2(acc[rb][j], 0.f) & 0xffffu); }
            }
            __syncthreads();
        }
        {
            LAS unsigned* scr = (LAS unsigned*)(lds + wave * 16384);
            const int gw = vcu * NWAVES + wave, NGW = G * NWAVES;
            constexpr int I_GU = 32 * 8 * 64, I_DN = 32 * 8 * 32, NI8 = I_GU + I_DN;
#define P0_DEC(q, W_, ldw_, WT_, sn_, dn_, k0_, sc_) do { if ((q) < I_GU) { const int e_ = (q) >> 9, rr_ = (q) & 511, kb_ = rr_ >> 6, nb_ = rr_ & 63, n0_ = 32 * nb_; const int bj_ = n0_ >> 10, rem_ = n0_ & 1023; \
                W_ = w_gu + (size_t)e_ * 1024 * 2048; ldw_ = 2048; WT_ = Wgu8 + (size_t)e_ * 2048 * 1024; sn_ = n0_; dn_ = 256 * (rem_ >> 7) + 128 * bj_ + (rem_ & 127); k0_ = 128 * kb_; sc_ = WGU_SCALE; } \
              else { const int q2_ = (q) - I_GU, e_ = q2_ >> 8, rr_ = q2_ & 255, kb_ = rr_ >> 5, nb_ = rr_ & 31; W_ = w_dn + (size_t)e_ * 1024 * 1024; ldw_ = 1024; WT_ = Wdn8 + (size_t)e_ * 1024 * 1024; sn_ = 32 * nb_; dn_ = 32 * nb_; k0_ = 128 * kb_; sc_ = WDN_SCALE; } } while (0)
            for (int r2_ = 0; r2_ < 1 + ((REP_P0 >> 2) & 1); ++r2_) {
                asm volatile("" ::: "memory");
                f32x4 va[16], vb[16];
                const float* W; int ldw; unsigned char* WT; int sn, dn, k0; float sc;
                int it = gw;
                if (it < NI8) { P0_DEC(it, W, ldw, WT, sn, dn, k0, sc); p0_fp8_load(W, ldw, sn, k0, va, lane); }
                while (it < NI8) {
                    const int nit = it + NGW;
                    const float* W2 = W; int ldw2 = ldw; unsigned char* WT2 = WT; int sn2 = sn, dn2 = dn, k02 = k0; float sc2 = sc;
                    if (nit < NI8) { P0_DEC(nit, W2, ldw2, WT2, sn2, dn2, k02, sc2); p0_fp8_load(W2, ldw2, sn2, k02, vb, lane); }
                    p0_fp8_finish(va, WT, 1024, dn, k0, sc, scr, lane);
#pragma unroll
                    for (int i = 0; i < 16; ++i) va[i] = vb[i];
                    W = W2; ldw = ldw2; WT = WT2; sn = sn2; dn = dn2; k0 = k02; sc = sc2; it = nit;
                }
            }
#undef P0_DEC
            constexpr int I_IN = 16 * 48, I_SQ = 16 * 16, NIB = I_IN + 3 * I_SQ;
            for (int r3_ = 0; r3_ < 1 + ((REP_P0 >> 3) & 1); ++r3_)
            for (int it = gw; it < NIB; it += NGW) {
                int q = it;
                if (q < I_IN) { const int kb = q / 48, nb = q % 48, dn0 = 64 * nb; const int sn0 = dn0 < 1536 ? dn0 : (dn0 < 2560 ? dn0 + 8 : dn0 + 16);
                    p0_transpose_bf16(w_in, NIN, 1024, Win_t, sn0, dn0, 64 * kb, scr, lane); continue; }
                q -= I_IN;
                { const int which = q / I_SQ, rr = q % I_SQ, kb = rr >> 4, nb = rr & 15;
                  const float* W = which == 0 ? w_out : (which == 1 ? w_xq : w_xo); bf16* WT = which == 0 ? Wout_t : (which == 1 ? Wxq_t : Wxo_t);
                  p0_transpose_bf16(W, 1024, 1024, WT, 64 * nb, 64 * nb, 64 * kb, scr, lane); }
            }
        }
        END_PHASE(0);
    }

    if (IN(1)) for (int rep = 0; rep < REPS(1); ++rep) {
        pg8::StaticSched S; S.init(XB, Win_t, M, NU, D, G, bx);
        pg8::EpiBf16 E{U, NU, nullptr, 0, 1.f};
        pg8::gemm_phase<pg8::EpiBf16, pg8::StaticSched, false, true>(lds, D, S, E);
        END_PHASE(1);
    }

    if (IN(2)) for (int rep = 0; rep < REPS(2); ++rep) {
        for (int u = bx; u < 256; u += G) m1_unit(u >> 4, u & 15, U, Gt, conv_w, Mq, Mk, KvT, Nc, Gc, Mloc, lds);
        __syncthreads();
        for (int sq = bx; sq < 32; sq += G) {
            const int b8 = sq >> 3, h8 = sq & 7; LAS float* wt = (LAS float*)lds;
            float v[8]; float run = 0.f;
#pragma unroll
            for (int i = 0; i < 8; ++i) { run += Gt[(size_t)(b8 * SEQ + 8 * tid + i) * 16 + h8]; v[i] = run; }
            const float incl = wave_scan_add(run, lane);
            if (lane == 63) wt[wave] = incl;
            __syncthreads();
            float off = incl - run;
            for (int w = 0; w < wave; ++w) off += wt[w];
#pragma unroll
            for (int i = 0; i < 8; ++i) Fc2[(size_t)sq * SEQ + 8 * tid + i] = -(off + v[i]) * LOG2E;
            __syncthreads();
        }
        for (int ch = bx; ch < 256; ch += G) { const int sq = ch >> 3, pos = 512 * (ch & 7) + tid;
            const u32x4* kp = (const u32x4*)(U + (size_t)((sq >> 3) * SEQ + pos) * NU + UC_FK + (sq & 7) * 64); float s2 = 0.f;
#pragma unroll
            for (int c = 0; c < 8; ++c) { const u32x4 w = kp[c]; s2 += bf_lo(w.x) * bf_lo(w.x) + bf_hi(w.x) * bf_hi(w.x) + bf_lo(w.y) * bf_lo(w.y) + bf_hi(w.y) * bf_hi(w.y) + bf_lo(w.z) * bf_lo(w.z) + bf_hi(w.z) * bf_hi(w.z) + bf_lo(w.w) * bf_lo(w.w) + bf_hi(w.w) * bf_hi(w.w); }
            s2 = wave_max(s2);
            if (lane == 0) __hip_atomic_fetch_max(ctl + CW_KMAX + sq, __float_as_uint(s2), RLX_AGENT); }
        END_PHASE(2);
    }

    if (IN(3)) for (int rep = 0; rep < REPS(3); ++rep) {
        LAS float* sg = (LAS float*)lds;
        for (int ch = bx; ch < 256; ch += G) {
            const int bh = ch >> 4, part = ch & 15, idx = 512 * part + tid;
            __syncthreads();
            if (tid < 64) { sg[tid] = Gc[bh * 64 + tid]; sg[64 + tid] = Mloc[bh * 64 + tid]; }
            __syncthreads();
            if (tid == 0) { float mm = 0.f;
                for (int c = 0; c < 64; ++c) { const float g = sg[c], mc = sg[64 + c]; if (part == 0) Mp[bh * 64 + c] = mm; const float mn = fmaxf(g + mm, mc); sg[128 + c] = expf(g + mm - mn); sg[192 + c] = expf(mc - mn); mm = mn; } }
            __syncthreads();
            float C = 0.f;
            const float* kp = KvT + (size_t)bh * 64 * 8192 + idx; bf16* cp = CpT + (size_t)bh * 64 * 8192 + idx;
            float kvv[64];
#pragma unroll
            for (int c = 0; c < 64; ++c) kvv[c] = kp[(size_t)c * 8192];
#pragma unroll
            for (int c = 0; c < 64; ++c) { cp[(size_t)c * 8192] = (bf16)(pk2(C, 0.f) & 0xffffu); C = sg[128 + c] * C + sg[192 + c] * kvv[c]; }
            if (part == 0 && tid < 64) { float n = 0.f;
#pragma unroll 8
                for (int c = 0; c < 64; ++c) { Np[(size_t)(bh * 64 + c) * 64 + tid] = n; n = sg[128 + c] * n + sg[192 + c] * Nc[(size_t)(bh * 64 + c) * 64 + tid]; } }
        }
        END_PHASE(3);
    }

    if (IN(4)) for (int rep = 0; rep < REPS(4); ++rep) {
        for (int pr = vcu; pr < 256; pr += G) { const int bh8 = pr >> 3, s = pr & 7;
            fox_unit(bh8 >> 3, bh8 & 7, 15 - s, U, Fc2, ctl + CW_KMAX, fox_g, MIX, lds);
            fox_unit(bh8 >> 3, bh8 & 7, s, U, Fc2, ctl + CW_KMAX, fox_g, MIX, lds); }
        for (int u = bx; u < 256; u += G) m3_unit(u >> 4, u & 15, U, Gt, Mq, Mk, CpT, Np, Mp, mlstm_g, MIX, lds);
        END_PHASE(4);
    }

    if (IN(5)) for (int rep = 0; rep < REPS(5); ++rep) {
        pg8::StaticSched S; S.init(MIX, Wout_t, M, D, D, G, bx);
        pg8::EpiResBf16 E{XB, Y1, D, ALPHA};
        pg8::gemm_phase<pg8::EpiResBf16, pg8::StaticSched, false, false>(lds, D, S, E);
        END_PHASE(5);
    }

    if (IN(6)) for (int rep = 0; rep < REPS(6); ++rep) {
        for (int m = bx * 8 + wave; m < M; m += G * 8) {
            f32x4 v[4];
            load_row_bf16(Y1 + (size_t)m * D, v, lane);
            ln_row(v, ln1_g, ln1_b, lane);
            store_row_bf16(X1B + (size_t)m * D, v, lane);
        }
        END_PHASE(6);
    }

    if (IN(7)) for (int rep = 0; rep < REPS(7); ++rep) {
        pg8::StaticSched S; S.init(X1B, Wxq_t, M, D, D, G, bx);
        pg8::EpiBf16 E{QX, D, nullptr, 0, 1.f};
        pg8::gemm_phase<pg8::EpiBf16, pg8::StaticSched, false, false>(lds, D, S, E);
        END_PHASE(7);
    }

    if (IN(8)) for (int rep = 0; rep < REPS(8); ++rep) {
        for (int u = vcu; u < 256; u += G) xattn_unit(u >> 6, (u >> 4) & 3, u & 15, QX, KVx, lds);
        END_PHASE(8);
    }

    if (IN(9)) for (int rep = 0; rep < REPS(9); ++rep) {
        pg8::StaticSched S; S.init(QX, Wxo_t, M, D, D, G, bx);
        pg8::EpiResBf16 E{X1B, Y2, D, ALPHA};
        pg8::gemm_phase<pg8::EpiResBf16, pg8::StaticSched, false, false>(lds, D, S, E);
        END_PHASE(9);
    }

    if (IN(10)) for (int rep = 0; rep < REPS(10); ++rep) {
        LAS float* wrT = (LAS float*)lds;
        LAS int* hist = (LAS int*)(lds + RT_OFF); LAS int* ebase = hist + 32; LAS int* tokE = hist + 64; LAS int* tokR = hist + 320;
        __syncthreads();
        for (int idx = tid; idx < 1024 * 8; idx += 512) { const int k = idx >> 3, e4 = (idx & 7) * 4; const f32x4 w = *(const f32x4*)(w_router + k * 32 + e4);
            wrT[(e4 + 0) * 1024 + k] = w.x; wrT[(e4 + 1) * 1024 + k] = w.y; wrT[(e4 + 2) * 1024 + k] = w.z; wrT[(e4 + 3) * 1024 + k] = w.w; }
        if (tid < 32) hist[tid] = 0;
        __syncthreads();
        for (int grp = bx; grp < M / 64; grp += G) {
            for (int tl = wave; tl < 64; tl += 8) {
                const int tok = grp * 64 + tl;
                f32x4 v[4];
                load_row_bf16(Y2 + (size_t)tok * D, v, lane);
                ln_row(v, ln2_g, ln2_b, lane);
                store_row_bf16(X2B + (size_t)tok * D, v, lane);
                store_row_fp8(X2F8 + (size_t)tok * D, v, X2_SCALE, lane);
                float acc[32];
#pragma unroll
                for (int e = 0; e < 32; ++e) { float a = 0.f;
#pragma unroll
                    for (int j = 0; j < 4; ++j) { const f32x4 w = *(const LAS f32x4*)(wrT + e * 1024 + 256 * j + 4 * lane); a += (v[j].x * w.x + v[j].y * w.y) + (v[j].z * w.z + v[j].w * w.w); }
                    acc[e] = a; }
#define TR_STEP(HALFN, XORM) { const bool up = (lane & (XORM)) != 0; _Pragma("unroll") for (int i = 0; i < (HALFN); ++i) { const float keep = up ? acc[(HALFN) + i] : acc[i], send = up ? acc[i] : acc[(HALFN) + i]; acc[i] = keep + __shfl_xor(send, (XORM)); } }
                TR_STEP(16, 16) TR_STEP(8, 8) TR_STEP(4, 4) TR_STEP(2, 2) TR_STEP(1, 1)
#undef TR_STEP
                float lg = acc[0] + __shfl_xor(acc[0], 32);
                lg += b_router[lane & 31];
                float tv[4]; int ti[4]; float cur = lg;
#pragma unroll
                for (int k = 0; k < 4; ++k) {
                    float bv = cur; int bi = lane & 31;
#pragma unroll
                    for (int o = 1; o < 32; o <<= 1) { const float ov = __shfl_xor(bv, o); const int oi = __shfl_xor(bi, o); if (ov > bv || (ov == bv && oi < bi)) { bv = ov; bi = oi; } }
                    tv[k] = bv; ti[k] = bi; if ((lane & 31) == bi) cur = -INFINITY;
                }
                const float e1 = expf(tv[1] - tv[0]), e2 = expf(tv[2] - tv[0]), e3 = expf(tv[3] - tv[0]); const float isum = 1.f / (1.f + e1 + e2 + e3);
                if (lane == 0) {
                    const float gs[4] = {isum, e1 * isum, e2 * isum, e3 * isum};
#pragma unroll
                    for (int k = 0; k < 4; ++k) { const int rk = atomicAdd((int*)&hist[ti[k]], 1); tokE[tl * 4 + k] = ti[k]; tokR[tl * 4 + k] = rk; Tidx[tok * 4 + k] = ti[k]; Tgate[tok * 4 + k] = gs[k]; }
                }
            }
            __syncthreads();
            if (tid < 32) { const int c = hist[tid]; ebase[tid] = c ? (int)__hip_atomic_fetch_add(ctl + CW_CNT + 64 * tid, (unsigned)c, RLX_AGENT) : 0; hist[tid] = 0; }
            __syncthreads();
            if (tid < 256) { const int tl = tid >> 2, e = tokE[tid], slot = ebase[e] + tokR[tid]; List[(size_t)e * LCAP + slot] = grp * 64 + tl; Tslot[(grp * 64 + tl) * 4 + (tid & 3)] = slot; }
            __syncthreads();
        }
        END_PHASE(10);
    }

    if (IN(11)) for (int rep = 0; rep < REPS(11); ++rep) {
        LAS int* tb = (LAS int*)(lds + MOE_TB_OFF);
        moe_tables(tb, ctl, tid);
        pg8::MoeSched S; S.A = (const char*)X2F8; S.B = (const char*)Wgu8; S.list = List; S.tb = tb; S.K = 512; S.NT = 8; S.nwg = __builtin_amdgcn_readfirstlane(tb[32]) * 8; S.G = G; S.c = bx; S.bexp = (size_t)2048 * 1024; S.gather = true;
        pg8::EpiSwiglu E{HID8, b_gu, 1.f / (WGU_SCALE * X2_SCALE), HID_SCALE};
        pg8::gemm_phase<pg8::EpiSwiglu, pg8::MoeSched, true, true, true>(lds, 512, S, E);
        END_PHASE(11);
    }

    if (IN(12)) for (int rep = 0; rep < REPS(12); ++rep) {
        LAS int* tb = (LAS int*)(lds + MOE_TB_OFF);
        moe_tables(tb, ctl, tid);
        pg8::MoeSched S; S.A = (const char*)HID8; S.B = (const char*)Wdn8; S.list = List; S.tb = tb; S.K = 512; S.NT = 4; S.nwg = __builtin_amdgcn_readfirstlane(tb[32]) * 4; S.G = G; S.c = bx; S.bexp = (size_t)1024 * 1024; S.gather = false;
        pg8::EpiBf16 E{YB, D, b_dn, 1024, 1.f / (WDN_SCALE * HID_SCALE)};
        pg8::gemm_phase<pg8::EpiBf16, pg8::MoeSched, false, true, true>(lds, 512, S, E);
        END_PHASE(12);
    }

    if (IN(13)) for (int rep = 0; rep < REPS(13); ++rep) {
        LAS int* tb = (LAS int*)(lds + MOE_TB_OFF);
        moe_tables(tb, ctl, tid);
        for (int m0 = (bx * 8 + wave) * 2; m0 < M; m0 += G * 16) {
            int rowi = 0; float gk = 0.f;
            if (lane < 8) { const int q = (m0 + (lane >> 2)) * 4 + (lane & 3); const int e = Tidx[q]; rowi = tb[e] * 256 + Tslot[q]; gk = Tgate[q]; }
            f32x4 v[2][4]; u32x2 y[2][4][4]; float gg[2][4];
#pragma unroll
            for (int t = 0; t < 2; ++t) {
                const u32x2* xr = (const u32x2*)(X2B + (size_t)(m0 + t) * D) + lane;
#pragma unroll
                for (int j = 0; j < 4; ++j) { const u32x2 w = xr[64 * j]; v[t][j] = (f32x4){bf_lo(w.x), bf_hi(w.x), bf_lo(w.y), bf_hi(w.y)}; }
#pragma unroll
                for (int k = 0; k < 4; ++k) { const int rk = __shfl(rowi, 4 * t + k); gg[t][k] = __shfl(gk, 4 * t + k);
                    const u32x2* yr = (const u32x2*)(YB + (size_t)rk * D) + lane;
#pragma unroll
                    for (int j = 0; j < 4; ++j) y[t][k][j] = yr[64 * j]; }
            }
#pragma unroll
            for (int t = 0; t < 2; ++t) {
#pragma unroll
                for (int j = 0; j < 4; ++j) v[t][j] = v[t][j] * ALPHA;
#pragma unroll
                for (int k = 0; k < 4; ++k)
#pragma unroll
                    for (int j = 0; j < 4; ++j) { const u32x2 w = y[t][k][j]; const float g1 = gg[t][k]; v[t][j].x += g1 * bf_lo(w.x); v[t][j].y += g1 * bf_hi(w.x); v[t][j].z += g1 * bf_lo(w.y); v[t][j].w += g1 * bf_hi(w.y); }
                ln_row(v[t], ln3_g, ln3_b, lane);
                f32x4* orow = (f32x4*)(out + (size_t)(m0 + t) * D) + lane;
#pragma unroll
                for (int j = 0; j < 4; ++j) orow[64 * j] = v[t][j];
            }
        }
        if (rep + 1 < REPS(13)) GRID_BAR();
    }
#undef IN
#undef BOTH
#undef GRID_BAR
}

extern "C" void kernel_launch(void* const* d_in, const int* in_sizes, int n_in, void* d_out, int out_size, void* d_ws, size_t ws_size, hipStream_t stream) {
    static int grid = 0;
    if (grid == 0) {
        if (n_in != 26 || in_sizes[0] != M * D || out_size != M * D || ws_size < WS_END) { fprintf(stderr, "kernel_launch: unexpected shapes (n_in %d, in0 %d, out %d, ws %zu)\n", n_in, n_in > 0 ? in_sizes[0] : -1, out_size, ws_size); grid = -1; return; }
        int dev = 0, cus = 0, per_cu = 0;
        if (hipGetDevice(&dev) != hipSuccess || hipDeviceGetAttribute(&cus, hipDeviceAttributeMultiprocessorCount, dev) != hipSuccess) { grid = -1; return; }
        if (hipFuncSetAttribute((const void*)fwd, hipFuncAttributeMaxDynamicSharedMemorySize, LDS_BYTES) != hipSuccess) { fprintf(stderr, "kernel_launch: hipFuncSetAttribute failed\n"); grid = -1; return; }
        if (hipOccupancyMaxActiveBlocksPerMultiprocessor(&per_cu, (const void*)fwd, NWAVES * 64, LDS_BYTES) != hipSuccess || per_cu < 1) fprintf(stderr, "kernel_launch: occupancy query reports %d\n", per_cu);
        (void)hipGetLastError();
        grid = cus;
    }
    if (grid < 0) return;
    if (hipMemsetAsync((char*)d_ws + WS_CTL, 0, CTL_ZERO_BYTES, stream) != hipSuccess) return;
    Args a{};
    for (int i = 0; i < 26; ++i) a.in[i] = (const float*)d_in[i];
    a.out = (float*)d_out; a.ws = (unsigned char*)d_ws;
    if (N_LAUNCHES == 1) {
        a.ph_lo = 0; a.ph_hi = NPHASE; a.li = 0;
        hipLaunchKernelGGL(fwd, dim3(grid), dim3(NWAVES * 64), LDS_BYTES, stream, a);
    } else {
        for (int li = 0; li < NPHASE; ++li) { a.ph_lo = li; a.ph_hi = li + 1; a.li = li; hipLaunchKernelGGL(fwd, dim3(grid), dim3(NWAVES * 64), LDS_BYTES, stream, a); }
    }
}
```

```cpp
#include <hip/hip_runtime.h>
#include <cstdio>
#include <cstdint>
#include <cmath>

#define DI __device__ __forceinline__
#define LAS __attribute__((address_space(3)))
#define GAS __attribute__((address_space(1)))
typedef unsigned short bf16;
typedef short bf16x8 __attribute__((ext_vector_type(8)));
typedef short s16x4 __attribute__((ext_vector_type(4)));
typedef float f32x2 __attribute__((ext_vector_type(2)));
typedef float f32x4 __attribute__((ext_vector_type(4)));
typedef float f32x16 __attribute__((ext_vector_type(16)));
typedef unsigned u32x2 __attribute__((ext_vector_type(2)));
typedef unsigned u32x4 __attribute__((ext_vector_type(4)));
typedef GAS unsigned gu32;

#ifndef MK_N_LAUNCHES
#define MK_N_LAUNCHES 1
#endif

constexpr int BATCH = 4, SEQ = 4096, D = 1024, M = BATCH * SEQ, NMEM = 256;
constexpr int NIN = 3088;
constexpr int NU = 3072;
constexpr int UC_FQ = 0, UC_FK = 512, UC_FV = 1024, UC_MQ = 1536, UC_MK = 1792, UC_MV = 2048, UC_MO = 2560;
constexpr int NE = 32, TOPK = 4, LCAP = 16384;
constexpr int PROWS = M * TOPK + NE * 256;
constexpr float ALPHA = 1.189207115002721f;
constexpr float LOG2E = 1.4426950408889634f;
constexpr float LN_EPS = 1e-5f, RMS_EPS = 1e-6f;
constexpr int NPHASE = 14;
constexpr float WGU_SCALE = 32.f, WDN_SCALE = 64.f, X2_SCALE = 4.f, HID_SCALE = 4.f;
constexpr int N_LAUNCHES = MK_N_LAUNCHES;

constexpr size_t MiB = 1u << 20;
constexpr size_t WS_CTL = 0, CTL_ZERO_BYTES = 1 * MiB;
constexpr size_t WS_G = 1 * MiB;
constexpr size_t WS_FC2 = 2 * MiB;
constexpr size_t WS_GC = 2 * MiB + 512 * 1024;
constexpr size_t WS_NC = 3 * MiB;
constexpr size_t WS_NP = 3 * MiB + 256 * 1024;
constexpr size_t WS_TIDX = 3 * MiB + 512 * 1024;
constexpr size_t WS_TGATE = 3 * MiB + 768 * 1024;
constexpr size_t WS_TSLOT = 4 * MiB;
constexpr size_t WS_LIST = 5 * MiB;
constexpr size_t WS_MEMKV = 8 * MiB;
constexpr size_t WS_WIN = 16 * MiB, WS_WOUT = 22 * MiB, WS_WXQ = 24 * MiB, WS_WXO = 26 * MiB;
constexpr size_t WS_WGU = 32 * MiB, WS_WDN = 160 * MiB;
constexpr size_t WS_XB = 224 * MiB;
constexpr size_t WS_U = 256 * MiB;
constexpr size_t WS_MQ = 352 * MiB, WS_MK = 360 * MiB;
constexpr size_t WS_KVT = 368 * MiB;
constexpr size_t WS_CPT = 400 * MiB;
constexpr size_t WS_MIX = 432 * MiB;
constexpr size_t WS_Y1 = 464 * MiB;
constexpr size_t WS_X1B = 528 * MiB;
constexpr size_t WS_QX = 560 * MiB;
constexpr size_t WS_Y2 = 596 * MiB;
constexpr size_t WS_X2B = 660 * MiB;
constexpr size_t WS_HID = 692 * MiB;
constexpr size_t WS_YB = 836 * MiB;
constexpr size_t WS_END = 980 * MiB;
constexpr int CW_TMO = 0, CW_CODE = 1;
constexpr int CW_CNT = 1024;
constexpr int CW_BAR = 4096;
static_assert(CW_CNT + 64 * 31 < 3200 && 3200 + 32 <= CW_BAR, "CTL words: expert counts, key-norm words and the barrier region must not overlap");
constexpr int CW_KMAX = 3200;

constexpr int RING_BYTES = 131072;
constexpr int LDSCTL_OFF = RING_BYTES, MISC_OFF = LDSCTL_OFF + 320;
constexpr int MOE_TB_OFF = LDSCTL_OFF + 1024;
constexpr int RT_OFF = LDSCTL_OFF + 2048;
constexpr int LDS_BYTES = 147456;
constexpr int NWAVES = 8;

#define RLX_AGENT __ATOMIC_RELAXED, __HIP_MEMORY_SCOPE_AGENT
DI float bf_lo(unsigned u) { return __uint_as_float(u << 16); }
DI float bf_hi(unsigned u) { return __uint_as_float(u & 0xffff0000u); }
DI float bf2f(short s) { return __uint_as_float(((unsigned)(unsigned short)s) << 16); }
typedef __bf16 bf16x2_t __attribute__((ext_vector_type(2)));
DI unsigned pk2(float lo, float hi) { f32x2 v = {lo, hi}; bf16x2_t b = __builtin_convertvector(v, bf16x2_t); return __builtin_bit_cast(unsigned, b); }
DI float wave_sum(float v) {
#pragma unroll
    for (int o = 1; o < 64; o <<= 1) v += __shfl_xor(v, o);
    return v;
}
DI float wave_max(float v) {
#pragma unroll
    for (int o = 1; o < 64; o <<= 1) v = fmaxf(v, __shfl_xor(v, o));
    return v;
}
DI float wave_scan_add(float v, int lane) {
#pragma unroll
    for (int o = 1; o < 64; o <<= 1) { const float t = __shfl_up(v, o); if (lane >= o) v += t; }
    return v;
}
DI float wave_scan_max(float v, int lane) {
#pragma unroll
    for (int o = 1; o < 64; o <<= 1) { const float t = __shfl_up(v, o); if (lane >= o) v = fmaxf(v, t); }
    return v;
}
DI float xhalf_sum(float v) { return v + __shfl_xor(v, 32); }
DI float xhalf_max(float v) { return fmaxf(v, __shfl_xor(v, 32)); }
DI float ex2(float x) { return __builtin_amdgcn_exp2f(x); }
DI float exp_fast(float x) { return __builtin_amdgcn_exp2f(x * LOG2E); }
DI float sigmoid_fast(float x) { return __builtin_amdgcn_rcpf(1.f + exp_fast(-x)); }
DI float log_sigmoid_acc(float x) { return fminf(x, 0.f) - log1pf(expf(-fabsf(x))); }
DI f32x16 mfma32(bf16x8 a, bf16x8 b, f32x16 c) { return __builtin_amdgcn_mfma_f32_32x32x16_bf16(a, b, c, 0, 0, 0); }
DI f32x4 mfma16(bf16x8 a, bf16x8 b, f32x4 c) { return __builtin_amdgcn_mfma_f32_16x16x32_bf16(a, b, c, 0, 0, 0); }
typedef short v4i16_t __attribute__((ext_vector_type(4)));
DI s16x4 tr_read(const LAS unsigned char* p) { return __builtin_bit_cast(s16x4, __builtin_amdgcn_ds_read_tr16_b64_v4i16((LAS v4i16_t*)p)); }
DI bf16x8 cat8(s16x4 lo, s16x4 hi) { return __builtin_shufflevector(lo, hi, 0, 1, 2, 3, 4, 5, 6, 7); }
typedef int v8i32 __attribute__((ext_vector_type(8)));
typedef int v4i32 __attribute__((ext_vector_type(4)));
DI unsigned pk4_fp8(float a, float b, float c, float d) { int w = 0; w = __builtin_amdgcn_cvt_pk_fp8_f32(a, b, w, false); w = __builtin_amdgcn_cvt_pk_fp8_f32(c, d, w, true); return (unsigned)w; }
DI int crow(int r, int hi) { return (r & 3) + 8 * (r >> 2) + 4 * hi; }
DI bf16x8 pack8(const f32x16& x, int s) {
    u32x4 p;
    p.x = pk2(x[8 * s + 0], x[8 * s + 1]); p.y = pk2(x[8 * s + 2], x[8 * s + 3]); p.z = pk2(x[8 * s + 4], x[8 * s + 5]); p.w = pk2(x[8 * s + 6], x[8 * s + 7]);
    return __builtin_bit_cast(bf16x8, p);
}

namespace pg8 {
constexpr int BM = 256, BK = 64, HALF = 128, HTB = HALF * BK * 2, STAGE_BYTES = 8 * HTB, NXCD = 8, WGM = 8;
__host__ __device__ __forceinline__ int lds_byte(int r, int c) { const int st = (r >> 4) * 2 + (c >> 5), rr = r & 15, cc = c & 31, ob = rr * 64 + cc * 2; return st * 1024 + (ob ^ (((ob >> 9) & 1) << 5)); }
__host__ __device__ __forceinline__ void stage_rc(int b, int& R, int& C) { const int st = b / 1024, sb = b % 1024, swz = sb ^ (((sb >> 9) & 1) << 5); R = (st >> 1) * 16 + swz / 64; C = (st & 1) * 32 + (swz % 64) / 2; }
__host__ __device__ __forceinline__ int perm32(int rho) { const int n = rho >> 4, i = rho & 15; return 8 * (i >> 2) + 4 * n + (i & 3); }

struct Unit { int pm, pn, e, nvalid; const char* A; const char* B; const int* list; };

struct StaticSched {
    const char* A; const char* B; int K, nM, nN, nwg, G, c;
    DI void init(const void* A_, const void* B_, int M_, int N_, int K_, int G_, int c_) { A = (const char*)A_; B = (const char*)B_; K = K_; nM = M_ / BM; nN = N_ / BM; nwg = nM * nN; G = G_; c = c_; }
    DI bool next(int i, Unit& u) const {
        const long L = (long)i * G + c; if (L >= nwg) return false;
        int wgid = (int)L; { const int q = nwg / NXCD, r = nwg % NXCD, xcd = wgid % NXCD, off = wgid / NXCD; wgid = (xcd < r ? xcd * (q + 1) : r * (q + 1) + (xcd - r) * q) + off; }
        const int nig = WGM * nN, gid = wgid / nig, fm = gid * WGM, gsz = (nM - fm) < WGM ? (nM - fm) : WGM;
        u.pm = fm + ((wgid % nig) % gsz); u.pn = (wgid % nig) / gsz; u.e = 0; u.nvalid = BM; u.list = nullptr;
        u.A = A + (size_t)u.pm * BM * K * 2; u.B = B + (size_t)u.pn * BM * K * 2; return true;
    }
};
struct MoeSched {
    const char* A; const char* B; const int* list; const LAS int* tb; int K, NT, nwg, G, c; size_t bexp; bool gather;
    DI bool next(int i, Unit& u) const {
        const long L = (long)i * G + c; if (L >= nwg) return false;
        int wgid = (int)L; { const int q = nwg / NXCD, r = nwg % NXCD, xcd = wgid % NXCD, off = wgid / NXCD; wgid = (xcd < r ? xcd * (q + 1) : r * (q + 1) + (xcd - r) * q) + off; }
        const int g = wgid / NT, nt = wgid % NT;
        int e = 0;
#pragma unroll
        for (int j = 1; j < 32; ++j) e += (tb[j] <= g) ? 1 : 0;
        e = __builtin_amdgcn_readfirstlane(e);
        const int mt = g - __builtin_amdgcn_readfirstlane(tb[e]);
        u.pm = g; u.pn = nt; u.e = e; u.nvalid = __builtin_amdgcn_readfirstlane(tb[40 + e]) - mt * BM; u.list = list + (size_t)e * LCAP + mt * BM;
        u.A = gather ? A : A + (size_t)g * BM * K * 2; u.B = B + (size_t)e * bexp + (size_t)nt * BM * K * 2; return true;
    }
};

template <bool GATHER> DI void a_offsets(const Unit& u, int K, unsigned (&v)[2][2]) {
    int R[2], C[2];
#pragma unroll
    for (int i = 0; i < 2; ++i) stage_rc((int)threadIdx.x * 16 + i * 8192, R[i], C[i]);
#pragma unroll
    for (int h = 0; h < 2; ++h)
#pragma unroll
        for (int i = 0; i < 2; ++i) {
            const int row = h * HALF + R[i];
            if constexpr (GATHER) { const int rc = row < u.nvalid ? row : u.nvalid - 1; const int tok = u.list[rc]; v[h][i] = (unsigned)(tok * K + C[i]) * 2u; }
            else v[h][i] = (unsigned)(row * K + C[i]) * 2u;
        }
}

struct EpiBf16 {
    static constexpr bool PERM = true;
    bf16* O; int ldc; const float* bias; int bias_estride; float scale;
    DI void operator()(const f32x4 (&acc)[2][2][4][2], const Unit& u, int wr, int wc, int fr, int fq) const {
        const int row0 = u.pm * BM + wr * 64 + fr; const int col0 = u.pn * BM + wc * 32 + 8 * fq;
        f32x4 bv[2][2];
#pragma unroll
        for (int bj = 0; bj < 2; ++bj)
#pragma unroll
            for (int n = 0; n < 2; ++n) bv[bj][n] = bias ? *(const f32x4*)(bias + (size_t)u.e * bias_estride + col0 + bj * HALF + 4 * n) : (f32x4){0.f, 0.f, 0.f, 0.f};
#pragma unroll
        for (int ai = 0; ai < 2; ++ai)
#pragma unroll
            for (int m = 0; m < 4; ++m) { bf16* rowp = O + (size_t)(row0 + ai * HALF + m * 16) * ldc + col0;
#pragma unroll
                for (int bj = 0; bj < 2; ++bj) { const f32x4 v0 = acc[ai][bj][m][0] * scale + bv[bj][0], v1 = acc[ai][bj][m][1] * scale + bv[bj][1];
                    u32x4 w; w.x = pk2(v0[0], v0[1]); w.y = pk2(v0[2], v0[3]); w.z = pk2(v1[0], v1[1]); w.w = pk2(v1[2], v1[3]);
                    *(u32x4*)(rowp + bj * HALF) = w; } }
    }
};
struct EpiResF32 {
    static constexpr bool PERM = false;
    const float* base; float* out; int ldc; float alpha;
    DI void operator()(const f32x4 (&acc)[2][2][4][2], const Unit& u, int wr, int wc, int fr, int fq) const {
        const int col0 = u.pn * BM + wc * 32 + 4 * fq;
#pragma unroll
        for (int ai = 0; ai < 2; ++ai)
#pragma unroll
            for (int m = 0; m < 4; ++m) { const size_t off = (size_t)(u.pm * BM + ai * HALF + wr * 64 + m * 16 + fr) * ldc + col0;
#pragma unroll
                for (int bj = 0; bj < 2; ++bj)
#pragma unroll
                    for (int n = 0; n < 2; ++n) { const f32x4 bs = *(const f32x4*)(base + off + bj * HALF + n * 16); *(f32x4*)(out + off + bj * HALF + n * 16) = bs * alpha + acc[ai][bj][m][n]; } }
    }
};
struct EpiResBf16 {
    static constexpr bool PERM = true;
    const bf16* base; bf16* out; int ldc; float alpha;
    DI void operator()(const f32x4 (&acc)[2][2][4][2], const Unit& u, int wr, int wc, int fr, int fq) const {
        const int row0 = u.pm * BM + wr * 64 + fr; const int col0 = u.pn * BM + wc * 32 + 8 * fq;
#pragma unroll
        for (int ai = 0; ai < 2; ++ai)
#pragma unroll
            for (int m = 0; m < 4; ++m) { const size_t off = (size_t)(row0 + ai * HALF + m * 16) * ldc + col0;
#pragma unroll
                for (int bj = 0; bj < 2; ++bj) { const u32x4 b = *(const u32x4*)(base + off + bj * HALF); const f32x4 a0 = acc[ai][bj][m][0], a1 = acc[ai][bj][m][1];
                    u32x4 w; w.x = pk2(bf_lo(b.x) * alpha + a0[0], bf_hi(b.x) * alpha + a0[1]); w.y = pk2(bf_lo(b.y) * alpha + a0[2], bf_hi(b.y) * alpha + a0[3]);
                    w.z = pk2(bf_lo(b.z) * alpha + a1[0], bf_hi(b.z) * alpha + a1[1]); w.w = pk2(bf_lo(b.w) * alpha + a1[2], bf_hi(b.w) * alpha + a1[3]);
                    *(u32x4*)(out + off + bj * HALF) = w; } }
    }
};
struct EpiSwiglu {
    static constexpr bool PERM = true;
    unsigned char* O; const float* bias; float scale, oscale;
    DI void operator()(const f32x4 (&acc)[2][2][4][2], const Unit& u, int wr, int wc, int fr, int fq) const {
        const int row0 = u.pm * BM + wr * 64 + fr; const int j0 = wc * 32 + 8 * fq; const int col0 = u.pn * HALF + j0;
        const float* bg = bias + (size_t)u.e * 2048 + col0; const float* bl = bg + 1024;
        f32x4 bgv[2], blv[2];
#pragma unroll
        for (int n = 0; n < 2; ++n) { bgv[n] = *(const f32x4*)(bg + 4 * n); blv[n] = *(const f32x4*)(bl + 4 * n); }
#pragma unroll
        for (int ai = 0; ai < 2; ++ai)
#pragma unroll
            for (int m = 0; m < 4; ++m) { unsigned char* rowp = O + (size_t)(row0 + ai * HALF + m * 16) * 1024 + col0;
                float o[8];
#pragma unroll
                for (int n = 0; n < 2; ++n) { const f32x4 g = acc[ai][0][m][n] * scale + bgv[n], l = acc[ai][1][m][n] * scale + blv[n];
#pragma unroll
                    for (int q = 0; q < 4; ++q) { const float gg = fminf(g[q], 7.0f), ll = fminf(fmaxf(l[q], -7.0f), 7.0f);
                        o[4 * n + q] = gg * __builtin_amdgcn_rcpf(1.f + ex2(gg * (-1.702f * LOG2E))) * (ll + 1.f) * oscale; } }
                u32x2 w; w.x = pk4_fp8(o[0], o[1], o[2], o[3]); w.y = pk4_fp8(o[4], o[5], o[6], o[7]);
                *(u32x2*)rowp = w; }
    }
};

template <class Epi, class Sched, bool GATHER, bool ALIGN_EPI, bool FP8 = false>
DI void gemm_phase(LAS unsigned char* lds, const int K, const Sched& S, const Epi& E) {
    const int tid = threadIdx.x, wid = __builtin_amdgcn_readfirstlane(tid >> 6), lane = tid & 63, wr = wid >> 2, wc = wid & 3, fr = lane & 15, fq = lane >> 4;
    const int nt = K / BK;
    unsigned voffB[2];
#pragma unroll
    for (int i = 0; i < 2; ++i) { int R, C; stage_rc(tid * 16 + i * 8192, R, C); const int Rb = Epi::PERM ? ((R & ~31) + perm32(R & 31)) : R; voffB[i] = (unsigned)(Rb * K + C) * 2u; }
    const size_t kstep = (size_t)(BK * 2);
    const size_t hstep = (size_t)HALF * K * 2;
    const unsigned ldsw = (unsigned)wid * 1024u;
    const int aoff = lds_byte(wr * 64 + fr, fq * 8), boff = lds_byte(wc * 32 + fr, fq * 8);
#define PG8_SA(b, h) (((b) * 2 + (h)) * HTB)
#define PG8_SB(b, h) ((4 + (b) * 2 + (h)) * HTB)
#define PG8_STAGE(bufoff, gbase, voff) do { _Pragma("unroll") for (int _i = 0; _i < 2; ++_i) { unsigned _o = (voff)[_i]; asm volatile("" : "+v"(_o));   \
        __builtin_amdgcn_global_load_lds((const unsigned*)((const char*)(gbase) + _o), (LAS unsigned*)(lds + (bufoff) + ldsw + _i * 8192), 16, 0, 0); } } while (0)
#define PG8_LDA(dst, b, h) do { _Pragma("unroll") for (int m = 0; m < 4; ++m) _Pragma("unroll") for (int k = 0; k < 2; ++k) dst[m][k] = *(const LAS bf16x8*)(lds + PG8_SA(b, h) + aoff + m * 2048 + k * 1024); } while (0)
#define PG8_LDB(dst, b, h) do { _Pragma("unroll") for (int n = 0; n < 2; ++n) _Pragma("unroll") for (int k = 0; k < 2; ++k) dst[n][k] = *(const LAS bf16x8*)(lds + PG8_SB(b, h) + boff + n * 2048 + k * 1024); } while (0)
#define PG8_CAT(x) __builtin_shufflevector(__builtin_bit_cast(v4i32, x[0]), __builtin_bit_cast(v4i32, x[1]), 0, 1, 2, 3, 4, 5, 6, 7)
#define PG8_MMA(ai, bj, At, Bt) do { __builtin_amdgcn_s_setprio(1); _Pragma("unroll") for (int m = 0; m < 4; ++m) _Pragma("unroll") for (int n = 0; n < 2; ++n) { \
        if constexpr (FP8) { const v8i32 _a = PG8_CAT(Bt[n]), _b = PG8_CAT(At[m]); asm volatile("v_mfma_scale_f32_16x16x128_f8f6f4 %0, %1, %2, %0, %3, %3 op_sel_hi:[0,0,0]" : "+v"(acc[ai][bj][m][n]) : "v"(_a), "v"(_b), "v"(sc1)); } \
        else { _Pragma("unroll") for (int k = 0; k < 2; ++k) acc[ai][bj][m][n] = __builtin_amdgcn_mfma_f32_16x16x32_bf16(Bt[n][k], At[m][k], acc[ai][bj][m][n], 0, 0, 0); } } __builtin_amdgcn_s_setprio(0); } while (0)
#define PG8_WAIT_V(n) asm volatile("s_waitcnt vmcnt(" #n ")" ::: "memory")
#define PG8_WAIT_L(n) asm volatile("s_waitcnt lgkmcnt(" #n ")" ::: "memory")
#define PG8_BAR __builtin_amdgcn_s_barrier()
#define PG8_SCHED __builtin_amdgcn_sched_barrier(0)
    Unit cur, nxt; int ui = 0;
    if (!S.next(0, cur)) return;
    const int sc1 = 0x7f7f7f7f;
    unsigned vAc[2][2], vAn[2][2];
    a_offsets<GATHER>(cur, K, vAc);
    f32x4 acc[2][2][4][2];
#pragma unroll
    for (int a = 0; a < 2; ++a)
#pragma unroll
        for (int b = 0; b < 2; ++b)
#pragma unroll
            for (int m = 0; m < 4; ++m)
#pragma unroll
                for (int n = 0; n < 2; ++n) acc[a][b][m][n] = (f32x4){0.f, 0.f, 0.f, 0.f};
    bf16x8 At[4][2], B0[2][2], B1[2][2];
    const char* cA = cur.A; const char* cB = cur.B;
    PG8_STAGE(PG8_SB(0, 0), cB, voffB); PG8_STAGE(PG8_SB(0, 1), cB + hstep, voffB); PG8_STAGE(PG8_SA(0, 0), cA, vAc[0]); PG8_STAGE(PG8_SA(0, 1), cA, vAc[1]);
    if (wr == 1) PG8_BAR;
    PG8_WAIT_V(2); PG8_BAR;
    PG8_STAGE(PG8_SB(1, 0), cB + kstep, voffB); PG8_STAGE(PG8_SA(1, 0), cA + kstep, vAc[0]); PG8_STAGE(PG8_SB(1, 1), cB + hstep + kstep, voffB);
    PG8_WAIT_V(6); PG8_BAR;
    for (;;) {
        const bool has_next = S.next(ui + 1, nxt);
        if constexpr (GATHER) {
            if (has_next) a_offsets<GATHER>(nxt, K, vAn);
            else {
#pragma unroll
                for (int h = 0; h < 2; ++h)
#pragma unroll
                    for (int i = 0; i < 2; ++i) vAn[h][i] = vAc[h][i]; }
        }
        const char* nA = has_next ? nxt.A : cA; const char* nB = has_next ? nxt.B : cB;
#pragma unroll 1
        for (int t = 0; t < nt; t += 2) {
            const bool last = (t == nt - 2);
            const char* a1 = cA + (size_t)(t + 1) * kstep;
            const char* a2 = last ? nA : cA + (size_t)(t + 2) * kstep; const char* b2 = last ? nB : cB + (size_t)(t + 2) * kstep;
            const char* a3 = a2 + kstep; const char* b3 = b2 + kstep;
            unsigned v2[2][2];
#pragma unroll
            for (int h = 0; h < 2; ++h)
#pragma unroll
                for (int i = 0; i < 2; ++i) v2[h][i] = GATHER ? (last ? vAn[h][i] : vAc[h][i]) : vAc[h][i];
            PG8_LDB(B0, 0, 0); PG8_LDB(B1, 0, 1); PG8_SCHED; PG8_LDA(At, 0, 0); PG8_STAGE(PG8_SA(1, 1), a1, vAc[1]);
            PG8_WAIT_V(8); PG8_WAIT_L(0); PG8_BAR; PG8_MMA(0, 0, At, B0); PG8_MMA(0, 1, At, B1); PG8_BAR; PG8_SCHED;
            PG8_LDA(At, 0, 1); PG8_STAGE(PG8_SB(0, 0), b2, voffB); PG8_STAGE(PG8_SB(0, 1), b2 + hstep, voffB); PG8_STAGE(PG8_SA(0, 0), a2, v2[0]);
            PG8_WAIT_V(8); PG8_WAIT_L(0); PG8_BAR; PG8_MMA(1, 0, At, B0); PG8_MMA(1, 1, At, B1); PG8_BAR; PG8_SCHED;
            PG8_LDB(B0, 1, 0); PG8_LDB(B1, 1, 1); PG8_SCHED; PG8_LDA(At, 1, 0); PG8_STAGE(PG8_SA(0, 1), a2, v2[1]);
            PG8_WAIT_V(8); PG8_WAIT_L(0); PG8_BAR; PG8_MMA(0, 0, At, B0); PG8_MMA(0, 1, At, B1); PG8_BAR; PG8_SCHED;
            PG8_LDA(At, 1, 1); PG8_STAGE(PG8_SB(1, 0), b3, voffB); PG8_STAGE(PG8_SB(1, 1), b3 + hstep, voffB); PG8_STAGE(PG8_SA(1, 0), a3, v2[0]);
            PG8_WAIT_V(8); PG8_WAIT_L(0); PG8_BAR; PG8_MMA(1, 0, At, B0); PG8_MMA(1, 1, At, B1); PG8_BAR; PG8_SCHED;
        }
        if constexpr (FP8) asm volatile("s_nop 15\n\ts_nop 15" ::: "memory");
        if constexpr (ALIGN_EPI) { if (wr == 0) PG8_BAR; }
        E(acc, cur, wr, wc, fr, fq);
        if (!has_next) break;
#pragma unroll
        for (int a = 0; a < 2; ++a)
#pragma unroll
            for (int b = 0; b < 2; ++b)
#pragma unroll
                for (int m = 0; m < 4; ++m)
#pragma unroll
                    for (int n = 0; n < 2; ++n) acc[a][b][m][n] = (f32x4){0.f, 0.f, 0.f, 0.f};
        cur = nxt; cA = nA; cB = nB; ++ui;
        if constexpr (GATHER) {
#pragma unroll
            for (int h = 0; h < 2; ++h)
#pragma unroll
                for (int i = 0; i < 2; ++i) vAc[h][i] = vAn[h][i]; }
        if constexpr (ALIGN_EPI) { if (wr == 1) PG8_BAR; }
    }
    PG8_WAIT_V(0);
    if constexpr (!ALIGN_EPI) { if (wr == 0) PG8_BAR; }
    PG8_BAR;
#undef PG8_SA
#undef PG8_SB
#undef PG8_STAGE
#undef PG8_LDA
#undef PG8_LDB
#undef PG8_MMA
#undef PG8_CAT
#undef PG8_WAIT_V
#undef PG8_WAIT_L
#undef PG8_BAR
#undef PG8_SCHED
}
}

#define XB_TMO      128
#define XB_XCNT(j)  (256  + 64 * (j))
#define XB_XSUB(j)  (1280 + 64 * (j))
#define XB_XGEN(j)  (2304 + 64 * (j))
#define XB_TOP      3328
#define XB_TOPGEN   3392
#define XCD_BAR_WORDS 3456
#define XB_SPIN_CAP (1u << 18)
DI unsigned xb_ld(unsigned* p)              { return __hip_atomic_load(p, __ATOMIC_RELAXED, __HIP_MEMORY_SCOPE_AGENT); }
DI unsigned xb_add(unsigned* p, unsigned v) { return __hip_atomic_fetch_add(p, v, __ATOMIC_RELAXED, __HIP_MEMORY_SCOPE_AGENT); }
DI unsigned xb_xcc_id() { return (unsigned)__builtin_amdgcn_s_getreg((3 << 11) | 20) & 0xFu; }
#define XB_SPIN(cond, bar) do { unsigned _sp = 0; while (cond) { __builtin_amdgcn_s_sleep(1); \
    if ((++_sp & 255u) == 0u) { if (xb_ld(&(bar)[XB_TMO])) break; if (_sp > XB_SPIN_CAP) { atomicAdd(&(bar)[XB_TMO], 1u); break; } } } } while (0)
struct XcdBarrier { unsigned* bar; unsigned x; volatile LAS unsigned* st; };
DI XcdBarrier xcd_barrier_post(unsigned* bar, volatile LAS unsigned* st) {
    XcdBarrier b; b.bar = bar; b.x = xb_xcc_id(); b.st = st;
    if (threadIdx.x == 0) (void)xb_add(&bar[XB_XCNT(b.x)], 1u);
    return b;
}
DI void xcd_barrier_complete(unsigned* bar, unsigned x, unsigned& nloc, unsigned& nx) {
    const unsigned G = gridDim.x * gridDim.y * gridDim.z;
    unsigned sum, cnt, mine, sp = 0u;
    for (;;) {
        sum = 0u; cnt = 0u; mine = 0u;
#pragma unroll
        for (unsigned j = 0; j < 16; ++j) { const unsigned c = xb_ld(&bar[XB_XCNT(j)]); sum += c; cnt += (c > 0u) ? 1u : 0u; mine = (j == x) ? c : mine; }
        if (sum == G) break;
        __builtin_amdgcn_s_sleep(1);
        if ((++sp & 255u) == 0u) { if (xb_ld(&bar[XB_TMO])) break; if (sp > XB_SPIN_CAP) { atomicAdd(&bar[XB_TMO], 1u); break; } }
    }
    nloc = mine > 0u ? mine : 1u; nx = cnt > 0u ? cnt : 1u;
}
DI void xcd_barrier(const XcdBarrier& b) {
    asm volatile("s_waitcnt vmcnt(0)" ::: "memory");
    __syncthreads();
    if (threadIdx.x == 0) {
        unsigned* bar = b.bar;
        __builtin_amdgcn_s_waitcnt(0);
        unsigned nloc = b.st[0], nx = b.st[1];
        if (nloc == 0u) { xcd_barrier_complete(bar, b.x, nloc, nx); b.st[0] = nloc; b.st[1] = nx; }
        const unsigned old = xb_add(&bar[XB_XSUB(b.x)], 1u);
        const unsigned gen = old / nloc;
        if (old + 1u == (gen + 1u) * nloc) {
            __builtin_amdgcn_fence(__ATOMIC_RELEASE, "agent");
            asm volatile("s_waitcnt vmcnt(0)" ::: "memory");
            const unsigned og = xb_add(&bar[XB_TOP], 1u);
            const unsigned tg = og / nx;
            if (og + 1u == (tg + 1u) * nx) xb_add(&bar[XB_TOPGEN], 1u);
            else XB_SPIN(xb_ld(&bar[XB_TOPGEN]) == tg, bar);
            __builtin_amdgcn_fence(__ATOMIC_ACQUIRE, "agent");
            xb_add(&bar[XB_XGEN(b.x)], 1u);
            asm volatile("s_waitcnt vmcnt(0)" ::: "memory");
        } else {
            XB_SPIN(xb_ld(&bar[XB_XGEN(b.x)]) == gen, bar);
            __builtin_amdgcn_fence(__ATOMIC_ACQUIRE, "agent");
            asm volatile("s_waitcnt vmcnt(0)" ::: "memory");
        }
    }
    __syncthreads();
}

DI void p0_transpose_item(const float* W, int ldw, int K, bf16* WT, int src_n0, int dst_n0, int k0, LAS float* scr, int lane) {
#pragma unroll 8
    for (int i = 0; i < 32; ++i) { const int kk = 2 * i + (lane >> 5); scr[kk * 33 + (lane & 31)] = W[(size_t)(k0 + kk) * ldw + src_n0 + (lane & 31)]; }
    asm volatile("s_waitcnt lgkmcnt(0)" ::: "memory");
    const int c = lane & 7;
#pragma unroll
    for (int j = 0; j < 4; ++j) { const int n = (lane >> 3) + 8 * j; const LAS float* s = scr + (8 * c) * 33 + n;
        u32x4 o; o.x = pk2(s[0 * 33], s[1 * 33]); o.y = pk2(s[2 * 33], s[3 * 33]); o.z = pk2(s[4 * 33], s[5 * 33]); o.w = pk2(s[6 * 33], s[7 * 33]);
        *(u32x4*)(WT + (size_t)(dst_n0 + n) * K + k0 + 8 * c) = o; }
    asm volatile("s_waitcnt lgkmcnt(0)" ::: "memory");
}

DI void p0_fp8_load(const float* W, int ldw, int src_n0, int k0, f32x4 (&v)[16], int lane) {
    const int kq = lane >> 3, nq = lane & 7;
#pragma unroll
    for (int i = 0; i < 16; ++i) { const int k = 32 * (i >> 2) + 4 * kq + (i & 3); v[i] = *(const f32x4*)(W + (size_t)(k0 + k) * ldw + src_n0 + 4 * nq); }
}
DI void p0_fp8_finish(const f32x4 (&v)[16], unsigned char* WT, int kbytes, int dst_n0, int k0, float scale, LAS unsigned* scr, int lane) {
    const int kq = lane >> 3, nq = lane & 7;
#pragma unroll
    for (int g = 0; g < 4; ++g)
#pragma unroll
        for (int c = 0; c < 4; ++c) scr[(4 * nq + c) * 33 + 8 * g + kq] = pk4_fp8(v[4 * g][c] * scale, v[4 * g + 1][c] * scale, v[4 * g + 2][c] * scale, v[4 * g + 3][c] * scale);
    asm volatile("s_waitcnt lgkmcnt(0)" ::: "memory");
    const int ch = lane & 7;
#pragma unroll
    for (int j = 0; j < 4; ++j) { const int n = (lane >> 3) + 8 * j; const LAS unsigned* s = scr + n * 33 + 4 * ch;
        u32x4 o; o.x = s[0]; o.y = s[1]; o.z = s[2]; o.w = s[3];
        *(u32x4*)(WT + (size_t)(dst_n0 + n) * kbytes + k0 + 16 * ch) = o; }
    asm volatile("s_waitcnt lgkmcnt(0)" ::: "memory");
}
DI void p0_transpose_bf16(const float* W, int ldw, int K, bf16* WT, int src_n0, int dst_n0, int k0, LAS unsigned* scr, int lane) {
    const int kq = lane >> 4, nq = lane & 15;
    f32x4 v[16];
#pragma unroll
    for (int i = 0; i < 16; ++i) { const int k = 8 * (i >> 1) + 2 * kq + (i & 1); v[i] = *(const f32x4*)(W + (size_t)(k0 + k) * ldw + src_n0 + 4 * nq); }
#pragma unroll
    for (int pp = 0; pp < 8; ++pp)
#pragma unroll
        for (int c = 0; c < 4; ++c) scr[(4 * nq + c) * 33 + 4 * pp + kq] = pk2(v[2 * pp][c], v[2 * pp + 1][c]);
    asm volatile("s_waitcnt lgkmcnt(0)" ::: "memory");
    const int ch = lane & 7;
#pragma unroll
    for (int j = 0; j < 8; ++j) { const int n = (lane >> 3) + 8 * j; const LAS unsigned* s = scr + n * 33 + 4 * ch;
        u32x4 o; o.x = s[0]; o.y = s[1]; o.z = s[2]; o.w = s[3];
        *(u32x4*)(WT + (size_t)(dst_n0 + n) * K + k0 + 8 * ch) = o; }
    asm volatile("s_waitcnt lgkmcnt(0)" ::: "memory");
}

DI void ln_row(f32x4 (&v)[4], const float* g, const float* bta, int lane) {
    float s = 0.f;
#pragma unroll
    for (int j = 0; j < 4; ++j) s += (v[j].x + v[j].y) + (v[j].z + v[j].w);
    const float mean = wave_sum(s) * (1.f / D); float s2 = 0.f;
#pragma unroll
    for (int j = 0; j < 4; ++j) { v[j] = v[j] - mean; s2 += (v[j].x * v[j].x + v[j].y * v[j].y) + (v[j].z * v[j].z + v[j].w * v[j].w); }
    const float rstd = 1.f / sqrtf(wave_sum(s2) * (1.f / D) + LN_EPS);
#pragma unroll
    for (int j = 0; j < 4; ++j) { const f32x4 gg = *(const f32x4*)(g + 4 * lane + 256 * j), bb = *(const f32x4*)(bta + 4 * lane + 256 * j); v[j] = v[j] * rstd * gg + bb; }
}
DI void store_row_bf16(bf16* orow, const f32x4 (&v)[4], int lane) {
    u32x2* o8 = (u32x2*)orow + lane;
#pragma unroll
    for (int j = 0; j < 4; ++j) { u32x2 w; w.x = pk2(v[j].x, v[j].y); w.y = pk2(v[j].z, v[j].w); o8[64 * j] = w; }
}

DI void load_row_bf16(const bf16* irow, f32x4 (&v)[4], int lane) {
    const u32x2* i8 = (const u32x2*)irow + lane;
#pragma unroll
    for (int j = 0; j < 4; ++j) { const u32x2 w = i8[64 * j]; v[j] = (f32x4){bf_lo(w.x), bf_hi(w.x), bf_lo(w.y), bf_hi(w.y)}; }
}
DI void store_row_fp8(unsigned char* orow, const f32x4 (&v)[4], float scale, int lane) {
    unsigned* o4 = (unsigned*)orow + lane;
#pragma unroll
    for (int j = 0; j < 4; ++j) o4[64 * j] = pk4_fp8(v[j].x * scale, v[j].y * scale, v[j].z * scale, v[j].w * scale);
}

constexpr float FOX_THR = 40.f;
DI void fox_unit(int b, int h8, int qb, const bf16* U, const float* Fc2, const gu32* Kmax2, const float* fox_g, bf16* MIX, LAS unsigned char* lds) {
    const int tid = threadIdx.x, lane = tid & 63, wave = __builtin_amdgcn_readfirstlane(tid >> 6);
    const int r = lane & 31, h = lane >> 5, i16 = lane & 15, q4 = i16 >> 2, p4 = i16 & 3, blk = (lane >> 4) & 1;
    const int tok0 = b * SEQ, q0 = qb * 256, qrow = q0 + wave * 32 + r;
    const float C2 = 0.125f * LOG2E;
    bf16x8 qf[4];
    { const bf16* qp = U + (size_t)(tok0 + qrow) * NU + UC_FQ + h8 * 64 + 8 * h;
#pragma unroll
      for (int d0 = 0; d0 < 4; ++d0) qf[d0] = *(const bf16x8*)(qp + 16 * d0); }
    float qn2 = 0.f;
#pragma unroll
    for (int d0 = 0; d0 < 4; ++d0)
#pragma unroll
        for (int j = 0; j < 8; ++j) { const float f = bf2f(qf[d0][j]); qn2 += f * f; }
    qn2 = xhalf_sum(qn2);
    const float* fc = Fc2 + (size_t)(b * 8 + h8) * SEQ;
    const float qk_bound = sqrtf(wave_max(qn2) * __uint_as_float(__hip_atomic_load(Kmax2 + b * 8 + h8, RLX_AGENT))) * C2 * 1.001f;
    const float nb_first = fc[q0];
    float m = -1e30f, l = 0.f; f32x16 oT[2];
#pragma unroll
    for (int i = 0; i < 16; ++i) { oT[0][i] = 0.f; oT[1][i] = 0.f; }
    constexpr int FOXB = 18944;
    const int NT = 4 * qb + 4;
    bool active = true;
    const int srow = tid >> 3, spc = tid & 7;
    const bf16* gp0 = U + (size_t)(tok0 + srow) * NU + h8 * 64 + spc * 8;
    u32x4 kvr, vvr; float nbr = 0.f;
    { const bf16* gp = gp0 + (size_t)(64 * (NT - 1)) * NU; kvr = *(const u32x4*)(gp + UC_FK); vvr = *(const u32x4*)(gp + UC_FV); if (tid < 64) nbr = fc[64 * (NT - 1) + tid] - nb_first; }
    __syncthreads();
    *(LAS u32x4*)(lds + srow * 144 + spc * 16) = kvr; *(LAS u32x4*)(lds + 9216 + srow * 144 + spc * 16) = vvr; if (tid < 64) ((LAS float*)(lds + 18432))[tid] = nbr;
    __syncthreads();
    int cur = 0;
    for (int t = NT - 1; t >= 0; --t) {
        LAS unsigned char* Ks = lds + cur * FOXB; LAS unsigned char* Vs = Ks + 9216; LAS float* nb = (LAS float*)(Ks + 18432);
        if (t >= 1) { const bf16* gp = gp0 + (size_t)(64 * (t - 1)) * NU; kvr = *(const u32x4*)(gp + UC_FK); vvr = *(const u32x4*)(gp + UC_FV); if (tid < 64) nbr = fc[64 * (t - 1) + tid] - nb_first; }
        if (active && 64 * t <= q0 + wave * 32 + 31) {
            f32x16 p[2];
#pragma unroll
            for (int hb = 0; hb < 2; ++hb) {
                f32x16 a;
#pragma unroll
                for (int i = 0; i < 16; ++i) a[i] = 0.f;
#pragma unroll
                for (int d0 = 0; d0 < 4; ++d0) { const bf16x8 kf = *(const LAS bf16x8*)(Ks + (32 * hb + r) * 144 + (16 * d0 + 8 * h) * 2); a = mfma32(kf, qf[d0], a); }
#pragma unroll
                for (int g = 0; g < 4; ++g) { const f32x4 bb = *(const LAS f32x4*)(nb + 32 * hb + 8 * g + 4 * h);
#pragma unroll
                    for (int e = 0; e < 4; ++e) a[4 * g + e] = a[4 * g + e] * C2 + bb[e]; }
                p[hb] = a;
            }
            if (t >= NT - 4) {
#pragma unroll
                for (int hb = 0; hb < 2; ++hb)
#pragma unroll
                    for (int i = 0; i < 16; ++i) { const int kv = 64 * t + 32 * hb + crow(i, h); if (kv > qrow) p[hb][i] = -INFINITY; }
            }
            float mx = p[0][0];
#pragma unroll
            for (int i = 1; i < 16; ++i) mx = fmaxf(mx, p[0][i]);
#pragma unroll
            for (int i = 0; i < 16; ++i) mx = fmaxf(mx, p[1][i]);
            mx = xhalf_max(mx);
            if (__any(mx > m)) {
                const float mn = fmaxf(m, mx), alpha = ex2(m - mn); m = mn; l *= alpha;
#pragma unroll
                for (int i = 0; i < 16; ++i) { oT[0][i] *= alpha; oT[1][i] *= alpha; }
            }
            float rs = 0.f;
#pragma unroll
            for (int hb = 0; hb < 2; ++hb)
#pragma unroll
                for (int i = 0; i < 16; ++i) { const float e = ex2(p[hb][i] - m); p[hb][i] = e; rs += e; }
            l += rs;
            bf16x8 pf[2][2];
#pragma unroll
            for (int hb = 0; hb < 2; ++hb)
#pragma unroll
                for (int s = 0; s < 2; ++s) pf[hb][s] = pack8(p[hb], s);
#pragma unroll
            for (int d0 = 0; d0 < 2; ++d0)
#pragma unroll
                for (int hb = 0; hb < 2; ++hb)
#pragma unroll
                    for (int s = 0; s < 2; ++s) {
                        const LAS unsigned char* vp = Vs + (32 * hb + 16 * s + 4 * h + q4) * 144 + (32 * d0 + 16 * blk + 4 * p4) * 2;
                        const s16x4 lo = tr_read(vp), hi = tr_read(vp + 8 * 144);
                        oT[d0] = mfma32(cat8(lo, hi), pf[hb][s], oT[d0]);
                    }
            if (t >= 1) { const float mmin = -wave_max(-m); active = (qk_bound + (fc[64 * t - 1] - nb_first) - mmin) > -FOX_THR; }
        }
        cur ^= 1;
        { LAS unsigned char* Kn = lds + cur * FOXB; *(LAS u32x4*)(Kn + srow * 144 + spc * 16) = kvr; *(LAS u32x4*)(Kn + 9216 + srow * 144 + spc * 16) = vvr; if (tid < 64) ((LAS float*)(Kn + 18432))[tid] = nbr; }
        if (!__syncthreads_or(active ? 1 : 0)) break;
    }
    l = xhalf_sum(l);
    const float inv = 1.f / l;
    float ss = 0.f;
#pragma unroll
    for (int d0 = 0; d0 < 2; ++d0)
#pragma unroll
        for (int i = 0; i < 16; ++i) { const float o = oT[d0][i] * inv; oT[d0][i] = o; ss += o * o; }
    ss = xhalf_sum(ss);
    const float rr = 1.f / sqrtf(ss * (1.f / 64.f) + RMS_EPS);
    bf16* op = MIX + (size_t)(tok0 + qrow) * D + h8 * 64;
#pragma unroll
    for (int d0 = 0; d0 < 2; ++d0)
#pragma unroll
        for (int g = 0; g < 4; ++g) { const int d = 32 * d0 + 8 * g + 4 * h; const f32x4 gn = *(const f32x4*)(fox_g + h8 * 64 + d);
            u32x2 w; w.x = pk2(oT[d0][4 * g] * rr * gn.x, oT[d0][4 * g + 1] * rr * gn.y); w.y = pk2(oT[d0][4 * g + 2] * rr * gn.z, oT[d0][4 * g + 3] * rr * gn.w);
            *(u32x2*)(op + d) = w; }
}

DI void m1_unit(int bh, int cg, const bf16* U, const float* G, const float* conv_w, bf16* Mq, bf16* Mk, float* KvT, float* Nc, float* Gc, float* Mloc, LAS unsigned char* lds) {
    const int tid = threadIdx.x, lane = tid & 63, wave = __builtin_amdgcn_readfirstlane(tid >> 6);
    const int r = lane & 31, h = lane >> 5, i16 = lane & 15, q4 = i16 >> 2, p4 = i16 & 3, blk = (lane >> 4) & 1;
    const int b = bh >> 2, hh = bh & 3, s0 = cg * 256;
    LAS float* wa = (LAS float*)lds;
    LAS unsigned char* ksb = lds + 1024;
    LAS unsigned char* vsb = lds + 1024 + 36864;
    __syncthreads();
    if (wave < 4) {
        const int c = cg * 4 + wave, tok = b * SEQ + c * 64 + lane;
        const float lf = G[(size_t)tok * 16 + 12 + hh], li = G[(size_t)tok * 16 + 8 + hh];
        const float bsc = wave_scan_add(lf, lane);
        const float g = __shfl(bsc, 63);
        const float a = g - bsc + li;
        const float ml = wave_max(a);
        wa[wave * 64 + lane] = expf(a - ml);
        if (lane == 0) { Gc[bh * 64 + c] = g; Mloc[bh * 64 + c] = ml; }
    }
    __syncthreads();
#pragma unroll 2
    for (int i = 0; i < 8; ++i) {
        const int id = tid + 512 * i, d8 = id & 7, qk = (id >> 3) & 1, t = id >> 4;
        const int ucol = (qk ? UC_MK : UC_MQ) + hh * 64 + 8 * d8, ccol = (qk ? 256 : 0) + hh * 64 + 8 * d8;
        float acc[8];
#pragma unroll
        for (int e = 0; e < 8; ++e) acc[e] = 0.f;
#pragma unroll
        for (int j = 0; j < 4; ++j) {
            const int ts = s0 + t - 3 + j;
            if (ts >= 0) {
                const u32x4 x = *(const u32x4*)(U + (size_t)(b * SEQ + ts) * NU + ucol);
                const f32x4 w0 = *(const f32x4*)(conv_w + j * 512 + ccol), w1 = *(const f32x4*)(conv_w + j * 512 + ccol + 4);
                acc[0] += bf_lo(x.x) * w0.x; acc[1] += bf_hi(x.x) * w0.y; acc[2] += bf_lo(x.y) * w0.z; acc[3] += bf_hi(x.y) * w0.w;
                acc[4] += bf_lo(x.z) * w1.x; acc[5] += bf_hi(x.z) * w1.y; acc[6] += bf_lo(x.w) * w1.z; acc[7] += bf_hi(x.w) * w1.w;
            }
        }
#pragma unroll
        for (int e = 0; e < 8; ++e) acc[e] = acc[e] / (1.f + expf(-acc[e]));
        const size_t orow = ((size_t)bh * SEQ + s0 + t) * 64 + 8 * d8;
        if (qk == 0) {
            u32x4 w; w.x = pk2(acc[0], acc[1]); w.y = pk2(acc[2], acc[3]); w.z = pk2(acc[4], acc[5]); w.w = pk2(acc[6], acc[7]);
            *(u32x4*)(Mq + orow) = w;
        } else {
#pragma unroll
            for (int e = 0; e < 8; ++e) acc[e] *= 0.125f;
            u32x4 w; w.x = pk2(acc[0], acc[1]); w.y = pk2(acc[2], acc[3]); w.z = pk2(acc[4], acc[5]); w.w = pk2(acc[6], acc[7]);
            *(u32x4*)(Mk + orow) = w;
            const float ww = wa[t];
            u32x4 x; x.x = pk2(acc[0] * ww, acc[1] * ww); x.y = pk2(acc[2] * ww, acc[3] * ww); x.z = pk2(acc[4] * ww, acc[5] * ww); x.w = pk2(acc[6] * ww, acc[7] * ww);
            *(LAS u32x4*)(ksb + (t >> 6) * 9216 + (t & 63) * 144 + d8 * 16) = x;
        }
    }
#pragma unroll
    for (int i = 0; i < 8; ++i) { const int id = tid + 512 * i, pc = id & 15, t = id >> 4;
        const u32x4 v = *(const u32x4*)(U + (size_t)(b * SEQ + s0 + t) * NU + UC_MV + hh * 128 + pc * 8);
        *(LAS u32x4*)(vsb + (t >> 6) * 17408 + (t & 63) * 272 + pc * 16) = v; }
    __syncthreads();
    {
        const int cl = wave >> 1, eh = wave & 1, c = cg * 4 + cl;
        const LAS unsigned char* vs = vsb + cl * 17408; const LAS unsigned char* ks = ksb + cl * 9216;
        f32x16 acc[2][2];
#pragma unroll
        for (int a = 0; a < 2; ++a)
#pragma unroll
            for (int bb = 0; bb < 2; ++bb)
#pragma unroll
                for (int i = 0; i < 16; ++i) acc[a][bb][i] = 0.f;
#pragma unroll
        for (int k4 = 0; k4 < 4; ++k4) {
            bf16x8 af[2], bfr[2];
#pragma unroll
            for (int eb = 0; eb < 2; ++eb) { const LAS unsigned char* pp = vs + (16 * k4 + 8 * h + q4) * 272 + (64 * eh + 32 * eb + 16 * blk + 4 * p4) * 2; af[eb] = cat8(tr_read(pp), tr_read(pp + 4 * 272)); }
#pragma unroll
            for (int db = 0; db < 2; ++db) { const LAS unsigned char* pp = ks + (16 * k4 + 8 * h + q4) * 144 + (32 * db + 16 * blk + 4 * p4) * 2; bfr[db] = cat8(tr_read(pp), tr_read(pp + 4 * 144)); }
#pragma unroll
            for (int eb = 0; eb < 2; ++eb)
#pragma unroll
                for (int db = 0; db < 2; ++db) acc[eb][db] = mfma32(af[eb], bfr[db], acc[eb][db]);
        }
        float* op = KvT + (size_t)(bh * 64 + c) * 8192;
#pragma unroll
        for (int eb = 0; eb < 2; ++eb)
#pragma unroll
            for (int db = 0; db < 2; ++db)
#pragma unroll
                for (int i = 0; i < 16; ++i) op[(64 * eh + 32 * eb + crow(i, h)) * 64 + 32 * db + r] = acc[eb][db][i];
    }
    if (tid < 256) { const int cl = tid >> 6, d = tid & 63; const LAS unsigned char* ks = ksb + cl * 9216 + d * 2; float s = 0.f;
#pragma unroll 8
        for (int t = 0; t < 64; ++t) s += __uint_as_float(((unsigned)*(const LAS unsigned short*)(ks + t * 144)) << 16);
        Nc[(size_t)(bh * 64 + cg * 4 + cl) * 64 + d] = s; }
}

DI void m3_unit(int bh, int cg, const bf16* U, const float* G, const bf16* Mq, const bf16* Mk, const bf16* CpT, const float* Np, const float* Mp, const float* mlstm_g, bf16* MIX, LAS unsigned char* lds) {
    const int tid = threadIdx.x, lane = tid & 63, wave = __builtin_amdgcn_readfirstlane(tid >> 6);
    const int r = lane & 31, h = lane >> 5, i16 = lane & 15, q4 = i16 >> 2, p4 = i16 & 3, blk = (lane >> 4) & 1;
    const int b = bh >> 2, hh = bh & 3, cl = wave >> 1, th = wave & 1, c = cg * 4 + cl;
    const int tokc = b * SEQ + c * 64;
    const LAS unsigned char* Vs = lds + cl * 17408;
    LAS float* wsf = (LAS float*)(lds + 69632 + wave * 1024);
    __syncthreads();
#pragma unroll
    for (int i = 0; i < 8; ++i) { const int id = tid + 512 * i, pc = id & 15, t = id >> 4;
        const u32x4 v = *(const u32x4*)(U + (size_t)(b * SEQ + cg * 256 + t) * NU + UC_MV + hh * 128 + pc * 8);
        *(LAS u32x4*)(lds + (t >> 6) * 17408 + (t & 63) * 272 + pc * 16) = v; }
    const float mprev = Mp[bh * 64 + c];
    {
        const float lf = G[(size_t)(tokc + lane) * 16 + 12 + hh], li = G[(size_t)(tokc + lane) * 16 + 8 + hh];
        const float bsc = wave_scan_add(lf, lane);
        const float pm = wave_scan_max(li - bsc, lane);
        wsf[lane] = bsc; wsf[64 + lane] = li; wsf[128 + lane] = bsc + fmaxf(mprev, pm); wsf[192 + lane] = Np[(size_t)(bh * 64 + c) * 64 + lane];
    }
    __syncthreads();
    const int tl = 32 * th + r;
    const float bt = wsf[tl], mtt = wsf[128 + tl];
    const float winter = expf(bt + mprev - mtt);
    bf16x8 qf[4];
    { const bf16* qp = Mq + ((size_t)bh * SEQ + c * 64 + tl) * 64 + 8 * h;
#pragma unroll
      for (int ks = 0; ks < 4; ++ks) qf[ks] = *(const bf16x8*)(qp + 16 * ks); }
    float qn = 0.f;
#pragma unroll
    for (int ks = 0; ks < 4; ++ks)
#pragma unroll
        for (int j = 0; j < 8; ++j) qn += bf2f(qf[ks][j]) * wsf[192 + 16 * ks + 8 * h + j];
    qn = xhalf_sum(qn);
    f32x16 accT[4];
#pragma unroll
    for (int eb = 0; eb < 4; ++eb) {
        f32x16 a;
#pragma unroll
        for (int i = 0; i < 16; ++i) a[i] = 0.f;
#pragma unroll
        for (int ks = 0; ks < 4; ++ks) { const bf16x8 cf = *(const bf16x8*)(CpT + ((size_t)(bh * 64 + c) * 128 + 32 * eb + r) * 64 + 16 * ks + 8 * h); a = mfma32(cf, qf[ks], a); }
#pragma unroll
        for (int i = 0; i < 16; ++i) a[i] *= winter;
        accT[eb] = a;
    }
    float psum = 0.f; f32x16 pT[2];
#pragma unroll
    for (int sb = 0; sb < 2; ++sb) {
        f32x16 a;
#pragma unroll
        for (int i = 0; i < 16; ++i) a[i] = 0.f;
#pragma unroll
        for (int ks = 0; ks < 4; ++ks) { const bf16x8 kf = *(const bf16x8*)(Mk + ((size_t)bh * SEQ + c * 64 + 32 * sb + r) * 64 + 16 * ks + 8 * h); a = mfma32(kf, qf[ks], a); }
#pragma unroll
        for (int g = 0; g < 4; ++g) { const f32x4 b4 = *(const LAS f32x4*)(wsf + 32 * sb + 8 * g + 4 * h), l4 = *(const LAS f32x4*)(wsf + 64 + 32 * sb + 8 * g + 4 * h);
#pragma unroll
            for (int e = 0; e < 4; ++e) { const int s = 32 * sb + 8 * g + 4 * h + e; const float w = (s <= tl) ? expf(bt - b4[e] + l4[e] - mtt) * a[4 * g + e] : 0.f; a[4 * g + e] = w; psum += w; } }
        pT[sb] = a;
    }
    psum = xhalf_sum(psum);
#pragma unroll
    for (int eb = 0; eb < 4; ++eb)
#pragma unroll
        for (int sb = 0; sb < 2; ++sb)
#pragma unroll
            for (int s2 = 0; s2 < 2; ++s2) {
                const LAS unsigned char* vp = Vs + (32 * sb + 16 * s2 + 4 * h + q4) * 272 + (32 * eb + 16 * blk + 4 * p4) * 2;
                const s16x4 lo = tr_read(vp), hi = tr_read(vp + 8 * 272);
                accT[eb] = mfma32(cat8(lo, hi), pack8(pT[sb], s2), accT[eb]);
            }
    const float den = winter * qn + psum;
    const float hs = 1.f / fmaxf(fabsf(den), expf(-mtt));
    float ss = 0.f;
#pragma unroll
    for (int eb = 0; eb < 4; ++eb)
#pragma unroll
        for (int i = 0; i < 16; ++i) { const float v = accT[eb][i] * hs; accT[eb][i] = v; ss += v * v; }
    ss = xhalf_sum(ss);
    const float rr = 1.f / sqrtf(ss * (1.f / 128.f) + RMS_EPS);
    const int tok = tokc + tl;
#pragma unroll
    for (int eb = 0; eb < 4; ++eb)
#pragma unroll
        for (int g = 0; g < 4; ++g) { const int e = 32 * eb + 8 * g + 4 * h;
            const f32x4 gn = *(const f32x4*)(mlstm_g + hh * 128 + e);
            const u32x2 mo = *(const u32x2*)(U + (size_t)tok * NU + UC_MO + hh * 128 + e);
            const float o0 = accT[eb][4 * g] * rr * gn.x * sigmoid_fast(bf_lo(mo.x)), o1 = accT[eb][4 * g + 1] * rr * gn.y * sigmoid_fast(bf_hi(mo.x));
            const float o2 = accT[eb][4 * g + 2] * rr * gn.z * sigmoid_fast(bf_lo(mo.y)), o3 = accT[eb][4 * g + 3] * rr * gn.w * sigmoid_fast(bf_hi(mo.y));
            u32x2 w; w.x = pk2(o0, o1); w.y = pk2(o2, o3);
            *(u32x2*)(MIX + (size_t)tok * D + 512 + hh * 128 + e) = w; }
}

DI void xattn_unit(int b, int hx, int qb, const bf16* QX, bf16* OX, const bf16* KVx, LAS unsigned char* lds) {
    const int tid = threadIdx.x, lane = tid & 63, wave = __builtin_amdgcn_readfirstlane(tid >> 6);
    const int r = lane & 31, h = lane >> 5, i16 = lane & 15, q4 = i16 >> 2, p4 = i16 & 3, blk = (lane >> 4) & 1;
    const int tok = b * SEQ + qb * 256 + wave * 32 + r;
    bf16x8 qf[16];
    { const bf16* qp = QX + (size_t)tok * D + hx * 256 + 8 * h;
#pragma unroll
      for (int ks = 0; ks < 16; ++ks) qf[ks] = *(const bf16x8*)(qp + 16 * ks); }
    f32x16 sT[8];
    LAS unsigned char* Kx = lds; LAS unsigned char* Vx = lds + 33792;
#pragma unroll
    for (int kt = 0; kt < 4; ++kt) {
        __syncthreads();
#pragma unroll
        for (int i = 0; i < 4; ++i) { const int id = tid + 512 * i, row = id >> 5, pc = id & 31;
            const u32x4 v = *(const u32x4*)(KVx + (size_t)(b * NMEM + 64 * kt + row) * 2048 + hx * 256 + pc * 8);
            *(LAS u32x4*)(Kx + row * 528 + pc * 16) = v; }
        __syncthreads();
#pragma unroll
        for (int mb = 0; mb < 2; ++mb) {
            f32x16 a;
#pragma unroll
            for (int i = 0; i < 16; ++i) a[i] = 0.f;
#pragma unroll
            for (int ks = 0; ks < 16; ++ks) { const bf16x8 kf = *(const LAS bf16x8*)(Kx + (32 * mb + r) * 528 + (16 * ks + 8 * h) * 2); a = mfma32(kf, qf[ks], a); }
            sT[2 * kt + mb] = a;
        }
    }
    const float C2X = 0.0625f * LOG2E;
    float mx = -INFINITY;
#pragma unroll
    for (int j = 0; j < 8; ++j)
#pragma unroll
        for (int i = 0; i < 16; ++i) mx = fmaxf(mx, sT[j][i]);
    mx = xhalf_max(mx);
    const float mb2 = mx * C2X;
    float lsum = 0.f;
#pragma unroll
    for (int j = 0; j < 8; ++j)
#pragma unroll
        for (int i = 0; i < 16; ++i) { const float e = ex2(sT[j][i] * C2X - mb2); sT[j][i] = e; lsum += e; }
    lsum = xhalf_sum(lsum);
    const float inv = 1.f / lsum;
    bf16x8 pf[8][2];
#pragma unroll
    for (int j = 0; j < 8; ++j)
#pragma unroll
        for (int s = 0; s < 2; ++s) pf[j][s] = pack8(sT[j], s);
#pragma unroll
    for (int vh = 0; vh < 2; ++vh) {
        __syncthreads();
#pragma unroll
        for (int i = 0; i < 8; ++i) { const int id = tid + 512 * i, row = id >> 4, pc = id & 15;
            const u32x4 v = *(const u32x4*)(KVx + (size_t)(b * NMEM + row) * 2048 + 1024 + hx * 256 + 128 * vh + pc * 8);
            *(LAS u32x4*)(Vx + row * 272 + pc * 16) = v; }
        __syncthreads();
#pragma unroll
        for (int eb = 0; eb < 4; ++eb) {
            f32x16 acc;
#pragma unroll
            for (int i = 0; i < 16; ++i) acc[i] = 0.f;
#pragma unroll
            for (int j = 0; j < 8; ++j)
#pragma unroll
                for (int s = 0; s < 2; ++s) {
                    const LAS unsigned char* vp = Vx + (32 * j + 16 * s + 4 * h + q4) * 272 + (32 * eb + 16 * blk + 4 * p4) * 2;
                    const s16x4 lo = tr_read(vp), hi = tr_read(vp + 8 * 272);
                    acc = mfma32(cat8(lo, hi), pf[j][s], acc);
                }
#pragma unroll
            for (int g = 0; g < 4; ++g) { const int d = 128 * vh + 32 * eb + 8 * g + 4 * h;
                u32x2 w; w.x = pk2(acc[4 * g] * inv, acc[4 * g + 1] * inv); w.y = pk2(acc[4 * g + 2] * inv, acc[4 * g + 3] * inv);
                *(u32x2*)(OX + (size_t)tok * D + hx * 256 + d) = w; }
        }
    }
}

DI void moe_tables(LAS int* tb, gu32* ctl, int tid) {
    __syncthreads();
    if (tid < 32) tb[40 + tid] = (int)__hip_atomic_load(ctl + CW_CNT + 64 * tid, RLX_AGENT);
    __syncthreads();
    if (tid == 0) { int s = 0; for (int e = 0; e < 32; ++e) { tb[e] = s; s += (tb[40 + e] + 255) >> 8; } tb[32] = s; }
    __syncthreads();
}

struct Args { const float* in[26]; float* out; unsigned char* ws; int ph_lo, ph_hi, li, pad; };

__global__ void __launch_bounds__(NWAVES * 64, 2) fwd(Args args) {
    extern __shared__ __attribute__((aligned(16))) unsigned char lds_raw[];
    LAS unsigned char* lds = (LAS unsigned char*)lds_raw;
    volatile LAS unsigned* MISC = (volatile LAS unsigned*)(lds + MISC_OFF);
    const int tid = threadIdx.x, lane = tid & 63, wave = __builtin_amdgcn_readfirstlane(tid >> 6);
    const int G = gridDim.x, bx = blockIdx.x;
    const int vcu = (G % 8 == 0) ? (bx % 8) * (G / 8) + bx / 8 : bx;
    unsigned char* ws = args.ws;
    gu32* ctl = (gu32*)(ws + WS_CTL);
    const float* x = args.in[0]; const float* mem = args.in[1]; const float* w_in = args.in[2]; const float* fox_f_bias = args.in[3];
    const float* conv_w = args.in[4]; const float* i_bias = args.in[5]; const float* f_bias = args.in[6]; const float* fox_g = args.in[7];
    const float* mlstm_g = args.in[8]; const float* w_out = args.in[9]; const float* ln1_g = args.in[10]; const float* ln1_b = args.in[11];
    const float* w_xq = args.in[12]; const float* w_xk = args.in[13]; const float* w_xv = args.in[14]; const float* w_xo = args.in[15];
    const float* ln2_g = args.in[16]; const float* ln2_b = args.in[17]; const float* w_router = args.in[18]; const float* b_router = args.in[19];
    const float* w_gu = args.in[20]; const float* b_gu = args.in[21]; const float* w_dn = args.in[22]; const float* b_dn = args.in[23];
    const float* ln3_g = args.in[24]; const float* ln3_b = args.in[25];
    float* out = args.out;
    float* Gt = (float*)(ws + WS_G); float* Fc2 = (float*)(ws + WS_FC2);
    float* Gc = (float*)(ws + WS_GC); float* Mloc = Gc + 1024; float* Mp = Gc + 2048;
    float* Nc = (float*)(ws + WS_NC); float* Np = (float*)(ws + WS_NP);
    int* Tidx = (int*)(ws + WS_TIDX); float* Tgate = (float*)(ws + WS_TGATE); int* Tslot = (int*)(ws + WS_TSLOT); int* List = (int*)(ws + WS_LIST);
    bf16* KVx = (bf16*)(ws + WS_MEMKV);
    bf16* Win_t = (bf16*)(ws + WS_WIN); bf16* Wout_t = (bf16*)(ws + WS_WOUT); bf16* Wxq_t = (bf16*)(ws + WS_WXQ); bf16* Wxo_t = (bf16*)(ws + WS_WXO);
    unsigned char* Wgu8 = ws + WS_WGU; unsigned char* Wdn8 = ws + WS_WDN;
    bf16* XB = (bf16*)(ws + WS_XB); bf16* U = (bf16*)(ws + WS_U); bf16* Mq = (bf16*)(ws + WS_MQ); bf16* Mk = (bf16*)(ws + WS_MK);
    float* KvT = (float*)(ws + WS_KVT); bf16* CpT = (bf16*)(ws + WS_CPT); bf16* MIX = (bf16*)(ws + WS_MIX);
    bf16* Y1 = (bf16*)(ws + WS_Y1); bf16* X2B = (bf16*)(ws + WS_Y1 + 32 * MiB); bf16* X1B = (bf16*)(ws + WS_X1B); bf16* QX = (bf16*)(ws + WS_QX);
    bf16* Y2 = (bf16*)(ws + WS_Y2); unsigned char* X2F8 = ws + WS_X2B; unsigned char* HID8 = ws + WS_HID; bf16* YB = (bf16*)(ws + WS_YB);

    for (int u = tid; u < (LDS_BYTES - LDSCTL_OFF) / 4; u += NWAVES * 64) ((LAS unsigned*)(lds + LDSCTL_OFF))[u] = 0u;
    __syncthreads();
    XcdBarrier bar; bar.bar = (unsigned*)(ctl + CW_BAR); bar.x = 0; bar.st = nullptr;
    if (N_LAUNCHES == 1) bar = xcd_barrier_post((unsigned*)(ctl + CW_BAR), MISC + 8);
#define GRID_BAR() do { if (N_LAUNCHES == 1) xcd_barrier(bar); } while (0)
    const int lo = args.ph_lo, hi = args.ph_hi;
#ifndef PH_MASK
#define PH_MASK 0xFFFF
#endif
#define IN(k) (((PH_MASK >> (k)) & 1) && lo <= (k) && (k) < hi)
#define BOTH(k) (IN(k) && IN((k) + 1))
#ifndef REP_MASK
#define REP_MASK 0
#endif
#define REPS(k) (1 + ((REP_MASK >> (k)) & 1))
#define END_PHASE(k) do { if (BOTH(k) || rep + 1 < REPS(k)) GRID_BAR(); } while (0)

    if (IN(0)) for (int rep = 0; rep < REPS(0); ++rep) {
#ifndef REP_P0
#define REP_P0 0
#endif
        for (int r0_ = 0; r0_ < 1 + ((REP_P0 >> 0) & 1); ++r0_) {
            asm volatile("" ::: "memory");
            LAS float* wg = (LAS float*)lds;
            for (int idx = tid; idx < 1024 * 16; idx += 512) { const int k = idx >> 4, c = idx & 15; const int col = c < 8 ? 1536 + c : 2568 + (c - 8);
                const int j = k >> 8, ln = (k & 255) >> 2, i = k & 3; wg[((((j * 4 + i) * 4 + (c >> 2)) * 64 + ln) << 2) + (c & 3)] = w_in[(size_t)k * NIN + col]; }
            __syncthreads();
            f32x4 vn[2][4];
#pragma unroll
            for (int t = 0; t < 2; ++t) { const f32x4* xr = (const f32x4*)(x + (size_t)((bx * 8 + wave) * 2 + t) * D) + lane;
#pragma unroll
                for (int j = 0; j < 4; ++j) vn[t][j] = xr[64 * j]; }
            for (int m0 = (bx * 8 + wave) * 2; m0 < M; m0 += G * 16) {
                asm volatile("" ::: "memory");
                f32x4 vv[2][4];
#pragma unroll
                for (int t = 0; t < 2; ++t)
#pragma unroll
                    for (int j = 0; j < 4; ++j) vv[t][j] = vn[t][j];
                if (m0 + G * 16 < M) {
#pragma unroll
                    for (int t = 0; t < 2; ++t) { const f32x4* xr = (const f32x4*)(x + (size_t)(m0 + G * 16 + t) * D) + lane;
#pragma unroll
                        for (int j = 0; j < 4; ++j) vn[t][j] = xr[64 * j]; }
                }
#pragma unroll
                for (int t = 0; t < 2; ++t) {
                    const int m = m0 + t;
                    store_row_bf16(XB + (size_t)m * D, vv[t], lane);
                    float acc[16];
#pragma unroll
                    for (int c = 0; c < 16; ++c) acc[c] = 0.f;
#pragma unroll
                    for (int j = 0; j < 4; ++j)
#pragma unroll
                        for (int i = 0; i < 4; ++i) { const LAS f32x4* wp = (const LAS f32x4*)wg + ((j * 4 + i) * 4) * 64 + lane; const float xv = vv[t][j][i];
#pragma unroll
                            for (int c4 = 0; c4 < 4; ++c4) { const f32x4 w = wp[c4 * 64]; acc[4 * c4] += xv * w.x; acc[4 * c4 + 1] += xv * w.y; acc[4 * c4 + 2] += xv * w.z; acc[4 * c4 + 3] += xv * w.w; } }
#define TR_STEP(HALFN, XORM) { const bool up = (lane & (XORM)) != 0; _Pragma("unroll") for (int i = 0; i < (HALFN); ++i) { const float keep = up ? acc[(HALFN) + i] : acc[i], send = up ? acc[i] : acc[(HALFN) + i]; acc[i] = keep + __shfl_xor(send, (XORM)); } }
                    TR_STEP(8, 8) TR_STEP(4, 4) TR_STEP(2, 2) TR_STEP(1, 1)
#undef TR_STEP
                    float mine = acc[0]; mine += __shfl_xor(mine, 16); mine += __shfl_xor(mine, 32);
                    if (lane < 16) {
                        float o;
                        if (lane < 8) o = log_sigmoid_acc(mine + fox_f_bias[lane]);
                        else if (lane < 12) o = mine + i_bias[lane - 8];
                        else o = log_sigmoid_acc(mine + f_bias[lane - 12]);
                        Gt[(size_t)m * 16 + lane] = o;
                    }
                }
            }
            __syncthreads();
        }
        for (int r1_ = 0; r1_ < 1 + ((REP_P0 >> 1) & 1); ++r1_) {
            asm volatile("" ::: "memory");
            LAS unsigned char* As = lds; LAS unsigned char* Bs = lds + 17408;
            const int i16 = lane & 15, q4 = i16 >> 2, p4 = i16 & 3, quad = lane >> 4;
            for (int tile = bx; tile < 256; tile += G) {
                const int rt = tile >> 4, ct = tile & 15;
                const float* W = ct < 8 ? w_xk : w_xv; const int col0 = 128 * (ct & 7);
                f32x4 acc[4];
#pragma unroll
                for (int rb = 0; rb < 4; ++rb) acc[rb] = (f32x4){0.f, 0.f, 0.f, 0.f};
                f32x4 ra[4], rb8[8];
#pragma unroll
                for (int i = 0; i < 4; ++i) { const int p = tid + 512 * i; ra[i] = *(const f32x4*)(mem + (size_t)(64 * rt + (p >> 5)) * D + 4 * (p & 31)); }
#pragma unroll
                for (int i = 0; i < 8; ++i) { const int p = tid + 512 * i; rb8[i] = *(const f32x4*)(W + (size_t)(p >> 5) * D + col0 + 4 * (p & 31)); }
                for (int k0 = 0; k0 < 1024; k0 += 128) {
                    __syncthreads();
#pragma unroll
                    for (int i = 0; i < 4; ++i) { const int p = tid + 512 * i; u32x2 w; w.x = pk2(ra[i].x, ra[i].y); w.y = pk2(ra[i].z, ra[i].w); *(LAS u32x2*)(As + (p >> 5) * 272 + (p & 31) * 8) = w; }
#pragma unroll
                    for (int i = 0; i < 8; ++i) { const int p = tid + 512 * i; u32x2 w; w.x = pk2(rb8[i].x, rb8[i].y); w.y = pk2(rb8[i].z, rb8[i].w); *(LAS u32x2*)(Bs + (p >> 5) * 272 + (p & 31) * 8) = w; }
                    if (k0 + 128 < 1024) {
#pragma unroll
                        for (int i = 0; i < 4; ++i) { const int p = tid + 512 * i; ra[i] = *(const f32x4*)(mem + (size_t)(64 * rt + (p >> 5)) * D + k0 + 128 + 4 * (p & 31)); }
#pragma unroll
                        for (int i = 0; i < 8; ++i) { const int p = tid + 512 * i; rb8[i] = *(const f32x4*)(W + (size_t)(k0 + 128 + (p >> 5)) * D + col0 + 4 * (p & 31)); }
                    }
                    __syncthreads();
#pragma unroll
                    for (int kk = 0; kk < 4; ++kk) {
                        const LAS unsigned char* bp = Bs + (32 * kk + 8 * quad + q4) * 272 + (16 * wave + 4 * p4) * 2;
                        const bf16x8 bfr = cat8(tr_read(bp), tr_read(bp + 4 * 272));
#pragma unroll
                        for (int rb = 0; rb < 4; ++rb) { const bf16x8 afr = *(const LAS bf16x8*)(As + (16 * rb + i16) * 272 + (32 * kk + 8 * quad) * 2); acc[rb] = mfma16(afr, bfr, acc[rb]); }
                    }
                }
#pragma unroll
                for (int rb = 0; rb < 4; ++rb)
#pragma unroll
                    for (int j = 0; j < 4; ++j) { const int row = 64 * rt + 16 * rb + 4 * quad + j, col = 128 * ct + 16 * wave + i16;
                        KVx[(size_t)row * 2048 + col] = (bf16)(pk2(acc[rb][j], 0.f) & 0xffffu); }
            }
            __syncthreads();
        }
        {
            LAS unsigned* scr = (LAS unsigned*)(lds + wave * 16384);
            const int gw = vcu * NWAVES + wave, NGW = G * NWAVES;
            constexpr int I_GU = 32 * 8 * 64, I_DN = 32 * 8 * 32, NI8 = I_GU + I_DN;
#define P0_DEC(q, W_, ldw_, WT_, sn_, dn_, k0_, sc_) do { if ((q) < I_GU) { const int e_ = (q) >> 9, rr_ = (q) & 511, kb_ = rr_ >> 6, nb_ = rr_ & 63, n0_ = 32 * nb_; const int bj_ = n0_ >> 10, rem_ = n0_ & 1023; \
                W_ = w_gu + (size_t)e_ * 1024 * 2048; ldw_ = 2048; WT_ = Wgu8 + (size_t)e_ * 2048 * 1024; sn_ = n0_; dn_ = 256 * (rem_ >> 7) + 128 * bj_ + (rem_ & 127); k0_ = 128 * kb_; sc_ = WGU_SCALE; } \
              else { const int q2_ = (q) - I_GU, e_ = q2_ >> 8, rr_ = q2_ & 255, kb_ = rr_ >> 5, nb_ = rr_ & 31; W_ = w_dn + (size_t)e_ * 1024 * 1024; ldw_ = 1024; WT_ = Wdn8 + (size_t)e_ * 1024 * 1024; sn_ = 32 * nb_; dn_ = 32 * nb_; k0_ = 128 * kb_; sc_ = WDN_SCALE; } } while (0)
            for (int r2_ = 0; r2_ < 1 + ((REP_P0 >> 2) & 1); ++r2_) {
                asm volatile("" ::: "memory");
                f32x4 va[16], vb[16];
                const float* W; int ldw; unsigned char* WT; int sn, dn, k0; float sc;
                int it = gw;
                if (it < NI8) { P0_DEC(it, W, ldw, WT, sn, dn, k0, sc); p0_fp8_load(W, ldw, sn, k0, va, lane); }
                while (it < NI8) {
                    const int nit = it + NGW;
                    const float* W2 = W; int ldw2 = ldw; unsigned char* WT2 = WT; int sn2 = sn, dn2 = dn, k02 = k0; float sc2 = sc;
                    if (nit < NI8) { P0_DEC(nit, W2, ldw2, WT2, sn2, dn2, k02, sc2); p0_fp8_load(W2, ldw2, sn2, k02, vb, lane); }
                    p0_fp8_finish(va, WT, 1024, dn, k0, sc, scr, lane);
#pragma unroll
                    for (int i = 0; i < 16; ++i) va[i] = vb[i];
                    W = W2; ldw = ldw2; WT = WT2; sn = sn2; dn = dn2; k0 = k02; sc = sc2; it = nit;
                }
            }
#undef P0_DEC
            constexpr int I_IN = 16 * 48, I_SQ = 16 * 16, NIB = I_IN + 3 * I_SQ;
            for (int r3_ = 0; r3_ < 1 + ((REP_P0 >> 3) & 1); ++r3_)
            for (int it = gw; it < NIB; it += NGW) {
                int q = it;
                if (q < I_IN) { const int kb = q / 48, nb = q % 48, dn0 = 64 * nb; const int sn0 = dn0 < 1536 ? dn0 : (dn0 < 2560 ? dn0 + 8 : dn0 + 16);
                    p0_transpose_bf16(w_in, NIN, 1024, Win_t, sn0, dn0, 64 * kb, scr, lane); continue; }
                q -= I_IN;
                { const int which = q / I_SQ, rr = q % I_SQ, kb = rr >> 4, nb = rr & 15;
                  const float* W = which == 0 ? w_out : (which == 1 ? w_xq : w_xo); bf16* WT = which == 0 ? Wout_t : (which == 1 ? Wxq_t : Wxo_t);
                  p0_transpose_bf16(W, 1024, 1024, WT, 64 * nb, 64 * nb, 64 * kb, scr, lane); }
            }
        }
        END_PHASE(0);
    }

    if (IN(1)) for (int rep = 0; rep < REPS(1); ++rep) {
        pg8::StaticSched S; S.init(XB, Win_t, M, NU, D, G, bx);
        pg8::EpiBf16 E{U, NU, nullptr, 0, 1.f};
        pg8::gemm_phase<pg8::EpiBf16, pg8::StaticSched, false, true>(lds, D, S, E);
        END_PHASE(1);
    }

    if (IN(2)) for (int rep = 0; rep < REPS(2); ++rep) {
        for (int u = bx; u < 256; u += G) m1_unit(u >> 4, u & 15, U, Gt, conv_w, Mq, Mk, KvT, Nc, Gc, Mloc, lds);
        __syncthreads();
        for (int sq = bx; sq < 32; sq += G) {
            const int b8 = sq >> 3, h8 = sq & 7; LAS float* wt = (LAS float*)lds;
            float v[8]; float run = 0.f;
#pragma unroll
            for (int i = 0; i < 8; ++i) { run += Gt[(size_t)(b8 * SEQ + 8 * tid + i) * 16 + h8]; v[i] = run; }
            const float incl = wave_scan_add(run, lane);
            if (lane == 63) wt[wave] = incl;
            __syncthreads();
            float off = incl - run;
            for (int w = 0; w < wave; ++w) off += wt[w];
#pragma unroll
            for (int i = 0; i < 8; ++i) Fc2[(size_t)sq * SEQ + 8 * tid + i] = -(off + v[i]) * LOG2E;
            __syncthreads();
        }
        for (int ch = bx; ch < 256; ch += G) { const int sq = ch >> 3, pos = 512 * (ch & 7) + tid;
            const u32x4* kp = (const u32x4*)(U + (size_t)((sq >> 3) * SEQ + pos) * NU + UC_FK + (sq & 7) * 64); float s2 = 0.f;
#pragma unroll
            for (int c = 0; c < 8; ++c) { const u32x4 w = kp[c]; s2 += bf_lo(w.x) * bf_lo(w.x) + bf_hi(w.x) * bf_hi(w.x) + bf_lo(w.y) * bf_lo(w.y) + bf_hi(w.y) * bf_hi(w.y) + bf_lo(w.z) * bf_lo(w.z) + bf_hi(w.z) * bf_hi(w.z) + bf_lo(w.w) * bf_lo(w.w) + bf_hi(w.w) * bf_hi(w.w); }
            s2 = wave_max(s2);
            if (lane == 0) __hip_atomic_fetch_max(ctl + CW_KMAX + sq, __float_as_uint(s2), RLX_AGENT); }
        END_PHASE(2);
    }

    if (IN(3)) for (int rep = 0; rep < REPS(3); ++rep) {
        LAS float* sg = (LAS float*)lds;
        for (int ch = bx; ch < 256; ch += G) {
            const int bh = ch >> 4, part = ch & 15, idx = 512 * part + tid;
            __syncthreads();
            if (tid < 64) { sg[tid] = Gc[bh * 64 + tid]; sg[64 + tid] = Mloc[bh * 64 + tid]; }
            __syncthreads();
            if (tid == 0) { float mm = 0.f;
                for (int c = 0; c < 64; ++c) { const float g = sg[c], mc = sg[64 + c]; if (part == 0) Mp[bh * 64 + c] = mm; const float mn = fmaxf(g + mm, mc); sg[128 + c] = expf(g + mm - mn); sg[192 + c] = expf(mc - mn); mm = mn; } }
            __syncthreads();
            float C = 0.f;
            const float* kp = KvT + (size_t)bh * 64 * 8192 + idx; bf16* cp = CpT + (size_t)bh * 64 * 8192 + idx;
            float kvv[64];
#pragma unroll
            for (int c = 0; c < 64; ++c) kvv[c] = kp[(size_t)c * 8192];
#pragma unroll
            for (int c = 0; c < 64; ++c) { cp[(size_t)c * 8192] = (bf16)(pk2(C, 0.f) & 0xffffu); C = sg[128 + c] * C + sg[192 + c] * kvv[c]; }
            if (part == 0 && tid < 64) { float n = 0.f;
#pragma unroll 8
                for (int c = 0; c < 64; ++c) { Np[(size_t)(bh * 64 + c) * 64 + tid] = n; n = sg[128 + c] * n + sg[192 + c] * Nc[(size_t)(bh * 64 + c) * 64 + tid]; } }
        }
        END_PHASE(3);
    }

    if (IN(4)) for (int rep = 0; rep < REPS(4); ++rep) {
        for (int pr = vcu; pr < 256; pr += G) { const int bh8 = pr >> 3, s = pr & 7;
            fox_unit(bh8 >> 3, bh8 & 7, 15 - s, U, Fc2, ctl + CW_KMAX, fox_g, MIX, lds);
            fox_unit(bh8 >> 3, bh8 & 7, s, U, Fc2, ctl + CW_KMAX, fox_g, MIX, lds); }
        for (int u = bx; u < 256; u += G) m3_unit(u >> 4, u & 15, U, Gt, Mq, Mk, CpT, Np, Mp, mlstm_g, MIX, lds);
        END_PHASE(4);
    }

    if (IN(5)) for (int rep = 0; rep < REPS(5); ++rep) {
        pg8::StaticSched S; S.init(MIX, Wout_t, M, D, D, G, bx);
        pg8::EpiResBf16 E{XB, Y1, D, ALPHA};
        pg8::gemm_phase<pg8::EpiResBf16, pg8::StaticSched, false, false>(lds, D, S, E);
        END_PHASE(5);
    }

    if (IN(6)) for (int rep = 0; rep < REPS(6); ++rep) {
        for (int m = bx * 8 + wave; m < M; m += G * 8) {
            f32x4 v[4];
            load_row_bf16(Y1 + (size_t)m * D, v, lane);
            ln_row(v, ln1_g, ln1_b, lane);
            store_row_bf16(X1B + (size_t)m * D, v, lane);
        }
        END_PHASE(6);
    }

    if (IN(7)) for (int rep = 0; rep < REPS(7); ++rep) {
        pg8::StaticSched S; S.init(X1B, Wxq_t, M, D, D, G, bx);
        pg8::EpiBf16 E{QX, D, nullptr, 0, 1.f};
        pg8::gemm_phase<pg8::EpiBf16, pg8::StaticSched, false, false>(lds, D, S, E);
        END_PHASE(7);
    }

    if (IN(8)) for (int rep = 0; rep < REPS(8); ++rep) {
        for (int u = vcu; u < 256; u += G) xattn_unit(u >> 6, (u >> 4) & 3, u & 15, QX, MIX, KVx, lds);
        END_PHASE(8);
    }

    if (IN(9)) for (int rep = 0; rep < REPS(9); ++rep) {
        pg8::StaticSched S; S.init(MIX, Wxo_t, M, D, D, G, bx);
        pg8::EpiResBf16 E{X1B, Y2, D, ALPHA};
        pg8::gemm_phase<pg8::EpiResBf16, pg8::StaticSched, false, false>(lds, D, S, E);
        END_PHASE(9);
    }

    if (IN(10)) for (int rep = 0; rep < REPS(10); ++rep) {
        LAS float* XR = (LAS float*)lds;
        LAS float* PART = (LAS float*)lds; LAS float* LOGT = (LAS float*)(lds + 32768);
        LAS int* hist = (LAS int*)(lds + RT_OFF); LAS int* ebase = hist + 32; LAS int* tokE = hist + 64; LAS int* tokR = hist + 320;
        __syncthreads();
        if (tid < 32) hist[tid] = 0;
        __syncthreads();
        for (int grp = bx; grp < M / 64; grp += G) {
#pragma unroll 1
            for (int pass = 0; pass < 2; ++pass) {
                const int tl0 = 32 * pass + 4 * wave;
                u32x2 raw[4][4];
#pragma unroll
                for (int i = 0; i < 4; ++i) { const u32x2* i8 = (const u32x2*)(Y2 + (size_t)(grp * 64 + tl0 + i) * D) + lane;
#pragma unroll
                    for (int j = 0; j < 4; ++j) raw[i][j] = i8[64 * j]; }
#pragma unroll
                for (int i = 0; i < 4; ++i) {
                    const int tok = grp * 64 + tl0 + i; f32x4 v[4];
#pragma unroll
                    for (int j = 0; j < 4; ++j) v[j] = (f32x4){bf_lo(raw[i][j].x), bf_hi(raw[i][j].x), bf_lo(raw[i][j].y), bf_hi(raw[i][j].y)};
                    ln_row(v, ln2_g, ln2_b, lane);
                    store_row_bf16(X2B + (size_t)tok * D, v, lane);
                    store_row_fp8(X2F8 + (size_t)tok * D, v, X2_SCALE, lane);
                    LAS float* xr = XR + (4 * wave + i) * 1025 + 4 * lane;
#pragma unroll
                    for (int j = 0; j < 4; ++j) { xr[256 * j] = v[j].x; xr[256 * j + 1] = v[j].y; xr[256 * j + 2] = v[j].z; xr[256 * j + 3] = v[j].w; }
                }
                __syncthreads();
                f32x16 acc;
#pragma unroll
                for (int i = 0; i < 16; ++i) acc[i] = 0.f;
                { const LAS float* ap = XR + (lane & 31) * 1025 + 128 * wave + (lane >> 5); const float* bp = w_router + (size_t)(128 * wave + (lane >> 5)) * 32 + (lane & 31);
#pragma unroll
                  for (int ks = 0; ks < 64; ++ks) acc = __builtin_amdgcn_mfma_f32_32x32x2f32(ap[2 * ks], bp[64 * ks], acc, 0, 0, 0); }
                __syncthreads();
#pragma unroll
                for (int i = 0; i < 16; ++i) PART[(wave * 32 + crow(i, lane >> 5)) * 32 + (lane & 31)] = acc[i];
                __syncthreads();
                { const int t = tid >> 4, e2 = (tid & 15) * 2; float s0 = b_router[e2], s1 = b_router[e2 + 1];
#pragma unroll
                  for (int w = 0; w < 8; ++w) { s0 += PART[(w * 32 + t) * 32 + e2]; s1 += PART[(w * 32 + t) * 32 + e2 + 1]; }
                  LOGT[t * 33 + e2] = s0; LOGT[t * 33 + e2 + 1] = s1; }
                __syncthreads();
                if (tid < 32) {
                    const int tl = 32 * pass + tid, tok = grp * 64 + tl; LAS float* lg = LOGT + tid * 33;
                    float tv[4]; int ti[4];
#pragma unroll
                    for (int k = 0; k < 4; ++k) { float best = -INFINITY; int bi = 0;
#pragma unroll 8
                        for (int e = 0; e < 32; ++e) { const float v = lg[e]; if (v > best) { best = v; bi = e; } }
                        tv[k] = best; ti[k] = bi; lg[bi] = -INFINITY; }
                    const float e1 = expf(tv[1] - tv[0]), e2 = expf(tv[2] - tv[0]), e3 = expf(tv[3] - tv[0]); const float isum = 1.f / (1.f + e1 + e2 + e3);
                    const float gs[4] = {isum, e1 * isum, e2 * isum, e3 * isum};
#pragma unroll
                    for (int k = 0; k < 4; ++k) { const int rk = __hip_atomic_fetch_add(hist + ti[k], 1, __ATOMIC_RELAXED, __HIP_MEMORY_SCOPE_WORKGROUP); tokE[tl * 4 + k] = ti[k]; tokR[tl * 4 + k] = rk; Tidx[tok * 4 + k] = ti[k]; Tgate[tok * 4 + k] = gs[k]; }
                }
                __syncthreads();
            }
            if (tid < 32) { const int c = hist[tid]; ebase[tid] = c ? (int)__hip_atomic_fetch_add(ctl + CW_CNT + 64 * tid, (unsigned)c, RLX_AGENT) : 0; hist[tid] = 0; }
            __syncthreads();
            if (tid < 256) { const int tl = tid >> 2, e = tokE[tid], slot = ebase[e] + tokR[tid]; List[(size_t)e * LCAP + slot] = grp * 64 + tl; Tslot[(grp * 64 + tl) * 4 + (tid & 3)] = slot; }
            __syncthreads();
        }
        END_PHASE(10);
#if (REP_MASK >> 10) & 1
        if (rep == 0) { if (bx == 0 && tid < 32) __hip_atomic_store(ctl + CW_CNT + 64 * tid, 0u, RLX_AGENT); GRID_BAR(); }
#endif
    }

    if (IN(11)) for (int rep = 0; rep < REPS(11); ++rep) {
        LAS int* tb = (LAS int*)(lds + MOE_TB_OFF);
        moe_tables(tb, ctl, tid);
        pg8::MoeSched S; S.A = (const char*)X2F8; S.B = (const char*)Wgu8; S.list = List; S.tb = tb; S.K = 512; S.NT = 8; S.nwg = __builtin_amdgcn_readfirstlane(tb[32]) * 8; S.G = G; S.c = bx; S.bexp = (size_t)2048 * 1024; S.gather = true;
        pg8::EpiSwiglu E{HID8, b_gu, 1.f / (WGU_SCALE * X2_SCALE), HID_SCALE};
        pg8::gemm_phase<pg8::EpiSwiglu, pg8::MoeSched, true, true, true>(lds, 512, S, E);
        END_PHASE(11);
    }

    if (IN(12)) for (int rep = 0; rep < REPS(12); ++rep) {
        LAS int* tb = (LAS int*)(lds + MOE_TB_OFF);
        moe_tables(tb, ctl, tid);
        pg8::MoeSched S; S.A = (const char*)HID8; S.B = (const char*)Wdn8; S.list = List; S.tb = tb; S.K = 512; S.NT = 4; S.nwg = __builtin_amdgcn_readfirstlane(tb[32]) * 4; S.G = G; S.c = bx; S.bexp = (size_t)1024 * 1024; S.gather = false;
        pg8::EpiBf16 E{YB, D, b_dn, 1024, 1.f / (WDN_SCALE * HID_SCALE)};
        pg8::gemm_phase<pg8::EpiBf16, pg8::MoeSched, false, true, true>(lds, 512, S, E);
        END_PHASE(12);
    }

    if (IN(13)) for (int rep = 0; rep < REPS(13); ++rep) {
        LAS int* tb = (LAS int*)(lds + MOE_TB_OFF);
        moe_tables(tb, ctl, tid);
        for (int m0 = (bx * 8 + wave) * 2; m0 < M; m0 += G * 16) {
            int rowi = 0; float gk = 0.f;
            if (lane < 8) { const int q = (m0 + (lane >> 2)) * 4 + (lane & 3); const int e = Tidx[q]; rowi = tb[e] * 256 + Tslot[q]; gk = Tgate[q]; }
            f32x4 v[2][4]; u32x2 y[2][4][4]; float gg[2][4];
#pragma unroll
            for (int t = 0; t < 2; ++t) {
                const u32x2* xr = (const u32x2*)(X2B + (size_t)(m0 + t) * D) + lane;
#pragma unroll
                for (int j = 0; j < 4; ++j) { const u32x2 w = xr[64 * j]; v[t][j] = (f32x4){bf_lo(w.x), bf_hi(w.x), bf_lo(w.y), bf_hi(w.y)}; }
#pragma unroll
                for (int k = 0; k < 4; ++k) { const int rk = __shfl(rowi, 4 * t + k); gg[t][k] = __shfl(gk, 4 * t + k);
                    const u32x2* yr = (const u32x2*)(YB + (size_t)rk * D) + lane;
#pragma unroll
                    for (int j = 0; j < 4; ++j) y[t][k][j] = yr[64 * j]; }
            }
#pragma unroll
            for (int t = 0; t < 2; ++t) {
#pragma unroll
                for (int j = 0; j < 4; ++j) v[t][j] = v[t][j] * ALPHA;
#pragma unroll
                for (int k = 0; k < 4; ++k)
#pragma unroll
                    for (int j = 0; j < 4; ++j) { const u32x2 w = y[t][k][j]; const float g1 = gg[t][k]; v[t][j].x += g1 * bf_lo(w.x); v[t][j].y += g1 * bf_hi(w.x); v[t][j].z += g1 * bf_lo(w.y); v[t][j].w += g1 * bf_hi(w.y); }
                ln_row(v[t], ln3_g, ln3_b, lane);
                f32x4* orow = (f32x4*)(out + (size_t)(m0 + t) * D) + lane;
#pragma unroll
                for (int j = 0; j < 4; ++j) orow[64 * j] = v[t][j];
            }
        }
        if (rep + 1 < REPS(13)) GRID_BAR();
    }
#undef IN
#undef BOTH
#undef GRID_BAR
}

extern "C" void kernel_launch(void* const* d_in, const int* in_sizes, int n_in, void* d_out, int out_size, void* d_ws, size_t ws_size, hipStream_t stream) {
    static int grid = 0;
    if (grid == 0) {
        if (n_in != 26 || in_sizes[0] != M * D || out_size != M * D || ws_size < WS_END) { fprintf(stderr, "kernel_launch: unexpected shapes (n_in %d, in0 %d, out %d, ws %zu)\n", n_in, n_in > 0 ? in_sizes[0] : -1, out_size, ws_size); grid = -1; return; }
        int dev = 0, cus = 0, per_cu = 0;
        if (hipGetDevice(&dev) != hipSuccess || hipDeviceGetAttribute(&cus, hipDeviceAttributeMultiprocessorCount, dev) != hipSuccess) { grid = -1; return; }
        if (hipFuncSetAttribute((const void*)fwd, hipFuncAttributeMaxDynamicSharedMemorySize, LDS_BYTES) != hipSuccess) { fprintf(stderr, "kernel_launch: hipFuncSetAttribute failed\n"); grid = -1; return; }
        if (hipOccupancyMaxActiveBlocksPerMultiprocessor(&per_cu, (const void*)fwd, NWAVES * 64, LDS_BYTES) != hipSuccess || per_cu < 1) fprintf(stderr, "kernel_launch: occupancy query reports %d\n", per_cu);
        (void)hipGetLastError();
        grid = cus;
    }
    if (grid < 0) return;
    if (hipMemsetAsync((char*)d_ws + WS_CTL, 0, CTL_ZERO_BYTES, stream) != hipSuccess) return;
    Args a{};
    for (int i = 0; i < 26; ++i) a.in[i] = (const float*)d_in[i];
    a.out = (float*)d_out; a.ws = (unsigned char*)d_ws;
    if (N_LAUNCHES == 1) {
        a.ph_lo = 0; a.ph_hi = NPHASE; a.li = 0;
        hipLaunchKernelGGL(fwd, dim3(grid), dim3(NWAVES * 64), LDS_BYTES, stream, a);
    } else {
        for (int li = 0; li < NPHASE; ++li) { a.ph_lo = li; a.ph_hi = li + 1; a.li = li; hipLaunchKernelGGL(fwd, dim3(grid), dim3(NWAVES * 64), LDS_BYTES, stream, a); }
    }
}
```
